# Optimizing an MI355X kernel written in HIP

```python
import math
import jax, jax.numpy as jnp
from jax import lax
import numpy as np

D_MODEL = 1024
BATCH = 32
SEQ = 2048
DEPTH = 4

GRID_W = 64
CTX_LEN = 256
HEAD_DIM = 64
N_MIXERS = 4
GROUP_W = D_MODEL // N_MIXERS
HEADS = GROUP_W // HEAD_DIM
KV_HEADS_A = HEADS // 2
KV_HEADS_D = HEADS // 2
DIFF_DIM = HEAD_DIM // 2
WINDOW = 128
BLOCK_Q = 128
NA_ROWS = 8
NA_COLS = 16
ROPE_BASE = 10000.0
N_EXPERTS = 16
N_EXPERT_GROUPS = 4
EXPERTS_PER_GROUP = N_EXPERTS // N_EXPERT_GROUPS
TOP_K = 2
D_EXPERT = D_MODEL // 2
MOE_BLOCK = 256
ADA_CHUNKS = 6
EPS = 1e-6
NEG = -1e30
F32 = jnp.float32
COL_SIZES = (HEADS * HEAD_DIM, KV_HEADS_A * HEAD_DIM, KV_HEADS_A * HEAD_DIM,
             HEADS * HEAD_DIM, HEADS * HEAD_DIM, HEADS * HEAD_DIM,
             HEADS * 2 * DIFF_DIM, HEADS * 2 * DIFF_DIM, HEADS * HEAD_DIM,
             HEADS * HEAD_DIM, KV_HEADS_D * HEAD_DIM, KV_HEADS_D * HEAD_DIM)
D_IN = sum(COL_SIZES)

kernel_name = "hybrid_headgroup_diffusion_moe_trunk"


def rms(x, eps=EPS):
    x32 = x.astype(F32)
    return (x32 * lax.rsqrt(jnp.mean(x32 * x32, axis=-1, keepdims=True) + eps)).astype(x.dtype)


def rms_norm(x, g):
    return rms(x) * g.astype(x.dtype)


def modulate(h, shift, scale):
    return h * (1.0 + scale) + shift


def to_heads(t, n):
    B, T = t.shape[:2]
    return t.reshape(B, T, n, -1).transpose(0, 2, 1, 3)


def from_heads(o):
    B, H, T, d = o.shape
    return o.transpose(0, 2, 1, 3).reshape(B, T, H * d)


def to_diff_heads(t):
    B, T = t.shape[:2]
    return t.reshape(B, T, HEADS, 2, DIFF_DIM).transpose(0, 2, 3, 1, 4)


def split_cols(u):
    points, acc = [], 0
    for size in COL_SIZES[:-1]:
        acc += size
        points.append(acc)
    return jnp.split(u, points, axis=-1)


def rope_1d(x, pos):
    half = x.shape[-1] // 2
    inv = ROPE_BASE ** (-jnp.arange(half, dtype=F32) / half)
    ang = pos.astype(F32)[:, None] * inv
    cos, sin = jnp.cos(ang), jnp.sin(ang)
    x32 = x.astype(F32)
    x1, x2 = x32[..., :half], x32[..., half:]
    return jnp.concatenate([x1 * cos - x2 * sin, x1 * sin + x2 * cos], axis=-1).astype(x.dtype)


def rope_2d(x, row, col):
    h = x.shape[-1] // 2
    return jnp.concatenate([rope_1d(x[..., :h], row), rope_1d(x[..., h:], col)], axis=-1)


def attend_gqa(q, k, v, scale):
    s = jnp.einsum('bhgqd,bhkd->bhgqk', q, k).astype(F32) * scale
    p = jax.nn.softmax(s, axis=-1).astype(v.dtype)
    return jnp.einsum('bhgqk,bhkd->bhgqd', p, v)


def mixer_window(q, k, v, qc, kc, vc, g, sink, row, col, need_ctx):
    q = rope_2d(rms_norm(to_heads(q, HEADS), g[0]), row, col)
    k = rope_2d(rms_norm(to_heads(k, KV_HEADS_A), g[1]), row, col)
    v = to_heads(v, KV_HEADS_A)
    qc = rms_norm(to_heads(qc, HEADS), g[0])
    kc = rms_norm(to_heads(kc, KV_HEADS_A), g[1])
    vc = to_heads(vc, KV_HEADS_A)
    B, H, S, d = q.shape
    G = H // KV_HEADS_A
    NB, BQ, L = S // BLOCK_Q, BLOCK_Q, kc.shape[2]
    scale = d ** -0.5
    pad = ((0, 0), (0, 0), (BQ, BQ), (0, 0))
    kp, vp = jnp.pad(k, pad), jnp.pad(v, pad)

    def band(t):
        return jnp.concatenate([t[:, :, o * BQ:o * BQ + S].reshape(B, KV_HEADS_A, NB, BQ, d) for o in range(3)], axis=3)

    kb, vb = band(kp), band(vp)
    qb = q.reshape(B, KV_HEADS_A, G, NB, BQ, d)
    qpos = jnp.arange(S).reshape(NB, BQ, 1)
    kpos = (jnp.arange(NB)[:, None, None] - 1) * BQ + jnp.arange(3 * BQ)[None, None, :]
    valid = (jnp.abs(kpos - qpos) <= WINDOW) & (kpos >= 0) & (kpos < S)
    s_loc = jnp.where(valid, jnp.einsum('bhgnqd,bhnkd->bhgnqk', qb, kb).astype(F32) * scale, NEG)
    s_ctx = jnp.einsum('bhgnqd,bhkd->bhgnqk', qb, kc).astype(F32) * scale
    sink_b = sink.astype(F32).reshape(1, KV_HEADS_A, G, 1, 1, 1)
    s_sink = jnp.broadcast_to(sink_b, s_ctx.shape[:-1] + (1,))
    p = jax.nn.softmax(jnp.concatenate([s_loc, s_ctx, s_sink], axis=-1), axis=-1).astype(v.dtype)
    o = (jnp.einsum('bhgnqk,bhnkd->bhgnqd', p[..., :3 * BQ], vb)
         + jnp.einsum('bhgnqk,bhkd->bhgnqd', p[..., 3 * BQ:3 * BQ + L], vc))
    o = o.reshape(B, H, S, d)
    oc = None
    if need_ctx:
        qg = qc.reshape(B, KV_HEADS_A, G, L, d)
        s = jnp.einsum('bhgqd,bhkd->bhgqk', qg, kc).astype(F32) * scale
        s_sink_c = jnp.broadcast_to(sink_b[..., 0], s.shape[:-1] + (1,))
        pc = jax.nn.softmax(jnp.concatenate([s, s_sink_c], axis=-1), axis=-1).astype(vc.dtype)
        oc = from_heads(jnp.einsum('bhgqk,bhkd->bhgqd', pc[..., :L], vc).reshape(B, H, L, d))
    return from_heads(o), oc


def mixer_neighbourhood(q, k, v, qc, kc, vc, g, rpb, need_ctx):
    q = rms_norm(to_heads(q, HEADS), g[0])
    k = rms_norm(to_heads(k, HEADS), g[1])
    v = to_heads(v, HEADS)
    qc = rms_norm(to_heads(qc, HEADS), g[0])
    kc = rms_norm(to_heads(kc, HEADS), g[1])
    vc = to_heads(vc, HEADS)
    B, H, S, d = q.shape
    W = GRID_W
    R = S // W
    NR, NC = min(NA_ROWS, R), NA_COLS
    KN = NR * W
    scale = d ** -0.5
    qg, kg, vg = (t.reshape(B, H, R, W, d) for t in (q, k, v))
    q_col = jnp.arange(W)
    c_start = jnp.clip(q_col - NC // 2, 0, W - NC)
    k_col = jnp.tile(jnp.arange(W), NR)
    k_row = jnp.repeat(jnp.arange(NR), W)
    col_ok = (k_col[None, :] >= c_start[:, None]) & (k_col[None, :] < c_start[:, None] + NC)
    dc_idx = jnp.clip(k_col[None, :] - q_col[:, None] + NA_COLS - 1, 0, 2 * NA_COLS - 2)

    def row_block(r):
        r_start = jnp.clip(r - NR // 2, 0, R - NR)
        kr = lax.dynamic_slice_in_dim(kg, r_start, NR, axis=2).reshape(B, H, KN, d)
        vr = lax.dynamic_slice_in_dim(vg, r_start, NR, axis=2).reshape(B, H, KN, d)
        qr = lax.dynamic_index_in_dim(qg, r, axis=2, keepdims=False)
        dr_idx = r_start + k_row - r + NA_ROWS - 1
        bias = rpb[:, dr_idx[None, :], dc_idx].astype(F32)
        s_loc = jnp.einsum('bhqd,bhkd->bhqk', qr, kr).astype(F32) * scale + bias
        s_loc = jnp.where(col_ok, s_loc, NEG)
        s_ctx = jnp.einsum('bhqd,bhkd->bhqk', qr, kc).astype(F32) * scale
        p = jax.nn.softmax(jnp.concatenate([s_loc, s_ctx], axis=-1), axis=-1).astype(v.dtype)
        return jnp.einsum('bhqk,bhkd->bhqd', p[..., :KN], vr) + jnp.einsum('bhqk,bhkd->bhqd', p[..., KN:], vc)

    o = lax.map(row_block, jnp.arange(R))
    o = o.transpose(1, 2, 0, 3, 4).reshape(B, H, S, d)
    oc = from_heads(attend_gqa(qc[:, :, None], kc, vc, scale)[:, :, 0]) if need_ctx else None
    return from_heads(o), oc


def diff_attend(q, k, v, lam, scale):
    s = jnp.einsum('bhiqd,bhikd->bhiqk', q, k).astype(F32) * scale
    p = jax.nn.softmax(s, axis=-1)
    a = (p[:, :, 0] - lam * p[:, :, 1]).astype(v.dtype)
    return jnp.einsum('bhqk,bhkd->bhqd', a, v)


def mixer_diff(q, k, v, qc, kc, vc, g, lam_p, lam_init, row, col, need_ctx):
    q = rope_2d(rms_norm(to_diff_heads(q), g[0]), row, col)
    k = rope_2d(rms_norm(to_diff_heads(k), g[1]), row, col)
    v = to_heads(v, HEADS)
    qc = rms_norm(to_diff_heads(qc), g[0])
    kc = rms_norm(to_diff_heads(kc), g[1])
    vc = to_heads(vc, HEADS)
    B, H, _, S, dh = q.shape
    NB = S // BLOCK_Q
    scale = dh ** -0.5
    lp = lam_p.astype(F32)
    lam = jnp.exp(jnp.sum(lp[0] * lp[1])) - jnp.exp(jnp.sum(lp[2] * lp[3])) + lam_init
    k_all = jnp.concatenate([k, kc], axis=3)
    v_all = jnp.concatenate([v, vc], axis=2)
    qb = q.reshape(B, H, 2, NB, BLOCK_Q, dh).transpose(3, 0, 1, 2, 4, 5)
    o = lax.map(lambda blk: diff_attend(blk, k_all, v_all, lam, scale), qb)
    o = o.transpose(1, 2, 0, 3, 4).reshape(B, H, S, -1)

    def post(t):
        return from_heads(rms(t) * (1.0 - lam_init))

    oc = post(diff_attend(qc, kc, vc, lam, scale)) if need_ctx else None
    return post(o), oc


def mixer_dense(q, k, v, qc, kc, vc, g, row, col, need_ctx):
    q = rope_2d(rms_norm(to_heads(q, HEADS), g[0]), row, col)
    k = rope_2d(rms_norm(to_heads(k, KV_HEADS_D), g[1]), row, col)
    v = to_heads(v, KV_HEADS_D)
    qc = rms_norm(to_heads(qc, HEADS), g[0])
    kc = rms_norm(to_heads(kc, KV_HEADS_D), g[1])
    vc = to_heads(vc, KV_HEADS_D)
    B, H, S, d = q.shape
    G = H // KV_HEADS_D
    NB, L = S // BLOCK_Q, kc.shape[2]
    scale = d ** -0.5
    k_all = jnp.concatenate([k, kc], axis=2)
    v_all = jnp.concatenate([v, vc], axis=2)
    qb = q.reshape(B, KV_HEADS_D, G, NB, BLOCK_Q, d).transpose(3, 0, 1, 2, 4, 5)
    o = lax.map(lambda blk: attend_gqa(blk, k_all, v_all, scale), qb)
    o = o.transpose(1, 2, 3, 0, 4, 5).reshape(B, H, S, d)
    oc = from_heads(attend_gqa(qc.reshape(B, KV_HEADS_D, G, L, d), kc, vc, scale).reshape(B, H, L, d)) if need_ctx else None
    return from_heads(o), oc


def token_mix(u, uc, layer, g_win, g_na, g_diff, g_gqa, sink, rpb, lam_p, gain, row, col, need_ctx):
    pl, pc = split_cols(u), split_cols(uc)
    lam_init = 0.8 - 0.6 * math.exp(-0.3 * layer)
    y_win, c_win = mixer_window(*pl[0:3], *pc[0:3], g_win, sink, row, col, need_ctx)
    y_na, c_na = mixer_neighbourhood(*pl[3:6], *pc[3:6], g_na, rpb, need_ctx)
    y_diff, c_diff = mixer_diff(*pl[6:9], *pc[6:9], g_diff, lam_p, lam_init, row, col, need_ctx)
    y_gqa, c_gqa = mixer_dense(*pl[9:12], *pc[9:12], g_gqa, row, col, need_ctx)

    def merge(a, b, dd, e):
        return jnp.concatenate([rms(a), rms(b), dd, rms(e)], axis=-1) * gain.astype(a.dtype)

    y = merge(y_win, y_na, y_diff, y_gqa)
    yc = merge(c_win, c_na, c_diff, c_gqa) if need_ctx else None
    return y, yc


def route(h, router_w, router_b):
    N = h.shape[0]
    score = jax.nn.sigmoid((h @ router_w).astype(F32))
    sel = score + router_b.astype(F32)
    sel_g = sel.reshape(N, N_EXPERT_GROUPS, EXPERTS_PER_GROUP)
    g_score = lax.top_k(sel_g, TOP_K)[0].sum(-1)
    g_idx = jnp.argmax(g_score, axis=-1).astype(jnp.int32)
    idx = jnp.broadcast_to(g_idx[:, None, None], (N, 1, EXPERTS_PER_GROUP))
    in_group = jnp.take_along_axis(sel_g, idx, axis=1)[:, 0]
    _, local = lax.top_k(in_group, TOP_K)
    expert = (g_idx[:, None] * EXPERTS_PER_GROUP + local).astype(jnp.int32)
    w = jnp.take_along_axis(score, expert, axis=-1)
    return expert, w / jnp.sum(w, axis=-1, keepdims=True)


def moe_ffn(h, router_w, router_b, w_gate, w_up, w_down):
    shp = h.shape
    hf = h.reshape(-1, shp[-1])
    N = hf.shape[0]
    expert, w = route(hf, router_w, router_b)
    A = N * TOP_K
    e_flat = expert.reshape(A)
    t_flat = jnp.repeat(jnp.arange(N, dtype=jnp.int32), TOP_K)
    w_flat = w.reshape(A)
    order = jnp.argsort(e_flat)
    e_s, t_s, w_s = e_flat[order], t_flat[order], w_flat[order]
    counts = jnp.bincount(e_flat, length=N_EXPERTS)
    padded = (counts + MOE_BLOCK - 1) // MOE_BLOCK * MOE_BLOCK
    p_end = jnp.cumsum(padded)
    p_start = p_end - padded
    c_start = jnp.cumsum(counts) - counts
    dest = p_start[e_s] + jnp.arange(A, dtype=jnp.int32) - c_start[e_s]
    n_blocks = -(-A // MOE_BLOCK) + N_EXPERTS
    P = n_blocks * MOE_BLOCK
    buf_t = jnp.zeros((P,), jnp.int32).at[dest].set(t_s)
    buf_w = jnp.zeros((P,), F32).at[dest].set(w_s)
    blk_e = jnp.minimum(jnp.searchsorted(p_end, jnp.arange(n_blocks, dtype=jnp.int32) * MOE_BLOCK, side='right'),
                        N_EXPERTS - 1)
    xb = hf[buf_t].reshape(n_blocks, MOE_BLOCK, shp[-1])

    def expert_block(args):
        xe, e = args
        return (jax.nn.silu(xe @ w_gate[e]) * (xe @ w_up[e])) @ w_down[e]

    yb = lax.map(expert_block, (xb, blk_e)).reshape(P, shp[-1])
    y = jnp.zeros_like(hf).at[buf_t].add(yb * buf_w[:, None].astype(yb.dtype))
    return y.reshape(shp)


def setup_inputs(seed: int = 0) -> dict:
    key = jax.random.key(seed)
    ks = jax.random.split(key, 23)
    D = D_MODEL

    def nrm(k, shape, s):
        return jax.random.normal(k, shape, jnp.float32) * s

    def gain(k, shape):
        return 1.0 + 0.02 * jax.random.normal(k, shape, jnp.float32)

    return {
        "x": nrm(ks[0], (BATCH, SEQ, D), 1.0),
        "c": nrm(ks[1], (BATCH, D), 1.0),
        "ctx": nrm(ks[2], (BATCH, CTX_LEN, D), 1.0),
        "c_ctx": nrm(ks[3], (D,), 1.0),
        "ada_w": nrm(ks[4], (DEPTH, D, ADA_CHUNKS * D), 0.25 * D ** -0.5),
        "ada_b": nrm(ks[5], (DEPTH, ADA_CHUNKS * D), 0.02),
        "norm_mix_g": gain(ks[6], (DEPTH, D)),
        "norm_ffn_g": gain(ks[7], (DEPTH, D)),
        "w_in": nrm(ks[8], (DEPTH, D, D_IN), D ** -0.5),
        "qk_g_win": gain(ks[9], (DEPTH, 2, HEAD_DIM)),
        "qk_g_na": gain(ks[10], (DEPTH, 2, HEAD_DIM)),
        "qk_g_diff": gain(ks[11], (DEPTH, 2, DIFF_DIM)),
        "qk_g_gqa": gain(ks[12], (DEPTH, 2, HEAD_DIM)),
        "sink_win": nrm(ks[13], (DEPTH, HEADS), 0.5),
        "rpb_na": nrm(ks[14], (DEPTH, HEADS, 2 * NA_ROWS - 1, 2 * NA_COLS - 1), 0.1),
        "lambda_diff": nrm(ks[15], (DEPTH, 4, DIFF_DIM), 0.1),
        "out_gain": gain(ks[16], (DEPTH, D)),
        "w_out": nrm(ks[17], (DEPTH, D, D), D ** -0.5),
        "router_w": nrm(ks[18], (D, N_EXPERTS), D ** -0.5),
        "router_b": nrm(ks[19], (N_EXPERTS,), 0.01),
        "w_gate": nrm(ks[20], (DEPTH, N_EXPERTS, D, D_EXPERT), D ** -0.5),
        "w_up": nrm(ks[21], (DEPTH, N_EXPERTS, D, D_EXPERT), D ** -0.5),
        "w_down": nrm(ks[22], (DEPTH, N_EXPERTS, D_EXPERT, D), D_EXPERT ** -0.5),
    }


def reference(x, c, ctx, c_ctx, ada_w, ada_b, norm_mix_g, norm_ffn_g, w_in, qk_g_win, qk_g_na, qk_g_diff,
              qk_g_gqa, sink_win, rpb_na, lambda_diff, out_gain, w_out, router_w, router_b, w_gate, w_up, w_down):
    S = x.shape[1]
    pos = jnp.arange(S, dtype=jnp.int32)
    row, col = pos // GRID_W, pos % GRID_W
    s_lat = jax.nn.silu(c)
    s_ctx = jax.nn.silu(c_ctx)
    for layer in range(DEPTH):
        need_ctx = layer < DEPTH - 1
        m_lat = jnp.split((s_lat @ ada_w[layer] + ada_b[layer])[:, None, :], ADA_CHUNKS, axis=-1)
        m_ctx = jnp.split(s_ctx @ ada_w[layer] + ada_b[layer], ADA_CHUNKS, axis=-1)
        h = modulate(rms_norm(x, norm_mix_g[layer]), m_lat[0], m_lat[1])
        hc = modulate(rms_norm(ctx, norm_mix_g[layer]), m_ctx[0], m_ctx[1])
        y, yc = token_mix(h @ w_in[layer], hc @ w_in[layer], layer, qk_g_win[layer], qk_g_na[layer],
                          qk_g_diff[layer], qk_g_gqa[layer], sink_win[layer], rpb_na[layer], lambda_diff[layer],
                          out_gain[layer], row, col, need_ctx)
        x = x + m_lat[2] * (y @ w_out[layer])
        h2 = modulate(rms_norm(x, norm_ffn_g[layer]), m_lat[3], m_lat[4])
        x = x + m_lat[5] * moe_ffn(h2, router_w, router_b, w_gate[layer], w_up[layer], w_down[layer])
        if need_ctx:
            ctx = ctx + m_ctx[2] * (yc @ w_out[layer])
            hc2 = modulate(rms_norm(ctx, norm_ffn_g[layer]), m_ctx[3], m_ctx[4])
            ctx = ctx + m_ctx[5] * moe_ffn(hc2, router_w, router_b, w_gate[layer], w_up[layer], w_down[layer])
    return x
```

```cpp
#include <hip/hip_runtime.h>
#include <cstdio>
#include <cstdint>
#define GAS __attribute__((address_space(1)))

#define XB_TMO      128
#define XB_XCNT(j)  (256  + 64 * (j))
#define XB_XSUB(j)  (1280 + 64 * (j))
#define XB_XGEN(j)  (2304 + 64 * (j))
#define XB_TOP      3328
#define XB_TOPGEN   3392
#define XCD_BAR_WORDS 3456
#define XB_SPIN_CAP (1u << 18)
#define LAS __attribute__((address_space(3)))

__device__ __forceinline__ unsigned xb_ld(unsigned* p)              { return __hip_atomic_load(p, __ATOMIC_RELAXED, __HIP_MEMORY_SCOPE_AGENT); }
__device__ __forceinline__ unsigned xb_add(unsigned* p, unsigned v) { return __hip_atomic_fetch_add(p, v, __ATOMIC_RELAXED, __HIP_MEMORY_SCOPE_AGENT); }
__device__ __forceinline__ unsigned xb_xcc_id() { return (unsigned)__builtin_amdgcn_s_getreg((3 << 11) | 20) & 0xFu; }
#define XB_SPIN(cond, bar) do { unsigned _sp = 0; while (cond) { __builtin_amdgcn_s_sleep(1); \
    if ((++_sp & 255u) == 0u) { if (xb_ld(&(bar)[XB_TMO])) break; if (_sp > XB_SPIN_CAP) { atomicAdd(&(bar)[XB_TMO], 1u); break; } } } } while (0)

struct XcdBarrier {
    unsigned* bar; unsigned x;
    volatile LAS unsigned* st;
};

__device__ __forceinline__ XcdBarrier xcd_barrier_post(unsigned* bar, volatile LAS unsigned* st, bool t0  ) {
    XcdBarrier b; b.bar = bar; b.x = xb_xcc_id(); b.st = st;
    if (t0) (void)xb_add(&bar[XB_XCNT(b.x)], 1u);
    return b;
}
__device__ __forceinline__ void xcd_barrier_complete(unsigned* bar, unsigned x, unsigned& nloc, unsigned& nx) {
    const unsigned G = gridDim.x * gridDim.y * gridDim.z;
    unsigned sum, cnt, mine, sp = 0u;
    for (;;) {
        sum = 0u; cnt = 0u; mine = 0u;
#pragma unroll
        for (unsigned j = 0; j < 16; ++j) { const unsigned c = xb_ld(&bar[XB_XCNT(j)]); sum += c; cnt += (c > 0u) ? 1u : 0u; mine = (j == x) ? c : mine; }
        if (sum == G) break;
        __builtin_amdgcn_s_sleep(1);
        if ((++sp & 255u) == 0u) { if (xb_ld(&bar[XB_TMO])) break; if (sp > XB_SPIN_CAP) { atomicAdd(&bar[XB_TMO], 1u); break; } }
    }
    nloc = mine > 0u ? mine : 1u; nx = cnt > 0u ? cnt : 1u;
}

__device__ __forceinline__ void xcd_barrier(const XcdBarrier& b, bool t0  ) {
    asm volatile("s_waitcnt vmcnt(0)" ::: "memory");
    __syncthreads();
    if (t0) {
        unsigned* bar = b.bar;
        __builtin_amdgcn_s_waitcnt(0);
        unsigned nloc = b.st[0], nx = b.st[1];
        if (nloc == 0u) { xcd_barrier_complete(bar, b.x, nloc, nx); b.st[0] = nloc; b.st[1] = nx; }
        const unsigned old = xb_add(&bar[XB_XSUB(b.x)], 1u);
        const unsigned gen = old / nloc;
        if (old + 1u == (gen + 1u) * nloc) {
            __builtin_amdgcn_fence(__ATOMIC_RELEASE, "agent");
            asm volatile("s_waitcnt vmcnt(0)" ::: "memory");
            const unsigned og = xb_add(&bar[XB_TOP], 1u);
            const unsigned tg = og / nx;
            if (og + 1u == (tg + 1u) * nx) xb_add(&bar[XB_TOPGEN], 1u);
            else XB_SPIN(xb_ld(&bar[XB_TOPGEN]) == tg, bar);
            __builtin_amdgcn_fence(__ATOMIC_ACQUIRE, "agent");
            xb_add(&bar[XB_XGEN(b.x)], 1u);
            asm volatile("s_waitcnt vmcnt(0)" ::: "memory");
        } else {
            XB_SPIN(xb_ld(&bar[XB_XGEN(b.x)]) == gen, bar);
            __builtin_amdgcn_fence(__ATOMIC_ACQUIRE, "agent");
            asm volatile("s_waitcnt vmcnt(0)" ::: "memory");
        }
    }
    __syncthreads();
}
constexpr int D = 1024, NBATCH = 32, SEQ = 2048, DEPTH = 4, CTXL = 256, NLAT = NBATCH * SEQ, NCTX = NBATCH * CTXL, MTOT = NLAT + NCTX, DIN = 2560;
constexpr int NEXP = 16, DEXP = 512, NCLS = 24, ADA = 6 * D;
constexpr float EPS = 1e-6f, LOG2E = 1.4426950408889634f;
constexpr int QA = 0, KA = 256, VA = 384, QB = 512, KB = 768, VB = 1024, QC = 1280, KC = 1536, VC = 1792, QD = 2048, KD = 2304, VD = 2432;
constexpr size_t MiB = 1u << 20;
constexpr size_t WS_CTL = 0, CTL_ZERO_BYTES = 128 * 1024;
constexpr size_t WS_MOD = 1 * MiB;
constexpr size_t WS_TAB = 4 * MiB + 256 * 1024;
constexpr size_t WS_RW = 4 * MiB + 320 * 1024;
constexpr size_t WS_PERM = 5 * MiB;
constexpr size_t WS_WIN = 12 * MiB;
constexpr size_t WS_WOUT = 32 * MiB;
constexpr size_t WS_W1 = 40 * MiB;
constexpr size_t WS_W2 = 168 * MiB;
constexpr size_t WS_XB = 232 * MiB;
constexpr size_t WS_Y = 376 * MiB;
constexpr size_t WS_U = 520 * MiB;
constexpr size_t WS_ACT = WS_U;
constexpr size_t WS_H = 880 * MiB;
constexpr size_t WS_END = 1024 * MiB;
static_assert(WS_MOD + (size_t)DEPTH * 33 * 6144 * 4 <= WS_TAB && WS_RW + (size_t)MTOT * 8 <= WS_PERM && WS_PERM + (size_t)NCLS * MTOT * 4 <= WS_WIN, "ws map");
constexpr int CW_BAR = 4096;
constexpr int CW_CNT = 16384;
static_assert((CW_CNT + DEPTH * NCLS * 64) * 4 <= (int)CTL_ZERO_BYTES && (CW_BAR + 3456) <= CW_CNT, "ctl");
constexpr int TAB_T64 = 0;
constexpr int TAB_T32 = 2048;
constexpr int TAB_LAM = 3072;
constexpr int NWAVES = 8;
constexpr int LDS_BYTES = 159744;
constexpr int RING_BYTES = 131072;
constexpr int MOE_OFF = 131072;
constexpr int NRM_OFF = 134144;
constexpr int MISC_OFF = 155648;
constexpr int AT_BUFB = 70656, AT_VOFF = 33792, AT_RPB = 141312, AT_GSS = 148992;

typedef unsigned short bf16_t;
typedef short bf16x8 __attribute__((ext_vector_type(8)));
typedef short s16x4 __attribute__((ext_vector_type(4)));
typedef float f32x4 __attribute__((ext_vector_type(4)));
typedef float f32x2 __attribute__((ext_vector_type(2)));
typedef float f32x16 __attribute__((ext_vector_type(16)));
typedef unsigned u32x4 __attribute__((ext_vector_type(4)));
typedef unsigned u32x2 __attribute__((ext_vector_type(2)));
typedef __bf16 bf16x2_t __attribute__((ext_vector_type(2)));

__device__ __forceinline__ unsigned pk2(float lo, float hi) { f32x2 v = {lo, hi}; bf16x2_t b = __builtin_convertvector(v, bf16x2_t); return __builtin_bit_cast(unsigned, b); }
__device__ __forceinline__ float bflo(unsigned w) { return __uint_as_float(w << 16); }
__device__ __forceinline__ float bfhi(unsigned w) { return __uint_as_float(w & 0xffff0000u); }
__device__ __forceinline__ float sx(float v, int lane, int m) { return __int_as_float(__builtin_amdgcn_ds_bpermute((lane ^ m) << 2, __float_as_int(v))); }
__device__ __forceinline__ float x32_sum(float v) { auto rr = __builtin_amdgcn_permlane32_swap(__float_as_uint(v), __float_as_uint(v), false, false); return __uint_as_float(rr[0]) + __uint_as_float(rr[1]); }
__device__ __forceinline__ float x32_max(float v) { auto rr = __builtin_amdgcn_permlane32_swap(__float_as_uint(v), __float_as_uint(v), false, false); return fmaxf(__uint_as_float(rr[0]), __uint_as_float(rr[1])); }
__device__ __forceinline__ float swap32(float v, bool upper_half) { auto rr = __builtin_amdgcn_permlane32_swap(__float_as_uint(v), __float_as_uint(v), false, false); return __uint_as_float(upper_half ? rr[0] : rr[1]); }
__device__ __forceinline__ float wave_sum(float v, int lane) {
#pragma unroll
    for (int o = 1; o < 32; o <<= 1) v += sx(v, lane, o);
    return x32_sum(v);
}
#define LDS_WAIT() asm volatile("s_waitcnt lgkmcnt(0)" ::: "memory")
#define WG_BAR() asm volatile("s_waitcnt lgkmcnt(0)\n\ts_barrier" ::: "memory")

struct Args { const float* in[23]; float* out; unsigned char* ws; int ph_lo, ph_hi, use_bar, pad; };
typedef __attribute__((address_space(4))) const unsigned char* kptr_t;
struct Frame {
    LAS unsigned char* lds;
    GAS unsigned char* ws;
    GAS float* out;
    kptr_t ka;
    int tid, lane, wave, G, bx;
};
#define FARGS Frame& F
typedef const GAS float* cfp_t;
__device__ __forceinline__ const GAS float* inp(const Frame& F, int i) { return *(__attribute__((address_space(4))) const cfp_t*)(F.ka + 8 * i); }
#define INP(i) inp(F, (i))
#define CTL(F) ((GAS unsigned*)((F).ws + WS_CTL))
__device__ __forceinline__ void refresh(Frame& F) {
    unsigned z = 0u; asm volatile("" : "+v"(z));
    const int ln = (int)__builtin_amdgcn_mbcnt_hi(~0u, __builtin_amdgcn_mbcnt_lo(~0u, z));
    F.lane = ln; F.tid = F.wave * 64 + ln;
    asm volatile("" : "+s"(F.ws)); asm volatile("" : "+s"(F.out)); asm volatile("" : "+s"(F.ka));
}
#define OPAQUE_S(x) asm volatile("" : "+s"(x))
namespace pg8 {
#define PG8_LAS __attribute__((address_space(3)))
#define PG8_GAS __attribute__((address_space(1)))
typedef unsigned short bf16_t;
typedef short bf16x8 __attribute__((ext_vector_type(8)));
typedef float f32x4 __attribute__((ext_vector_type(4)));
typedef unsigned u32x4 __attribute__((ext_vector_type(4)));
#ifndef MK_WGM
#define MK_WGM 8
#endif
constexpr int BM = 256, BK = 64, HALF = 128, HTB = HALF * BK * 2, STAGE_BYTES = 8 * HTB, NXCD = 8, WGM = MK_WGM;

__host__ __device__ __forceinline__ int lds_byte(int r, int c) { const int st = (r >> 4) * 2 + (c >> 5), rr = r & 15, cc = c & 31, ob = rr * 64 + cc * 2; return st * 1024 + (ob ^ (((ob >> 9) & 1) << 5)); }
__host__ __device__ __forceinline__ void stage_rc(int b, int& R, int& C) { const int st = b / 1024, sb = b % 1024, swz = sb ^ (((sb >> 9) & 1) << 5); R = (st >> 1) * 16 + swz / 64; C = (st & 1) * 32 + (swz % 64) / 2; }
__host__ __device__ __forceinline__ int perm32(int rho) { const int n = rho >> 4, i = rho & 15; return 8 * (i >> 2) + 4 * n + (i & 3); }

struct Unit { int pm, pn; };

struct Order {
    int nM, nN, nwg, G, c;
    __device__ __forceinline__ void init(int nM_, int nN_, int G_, int c_) { nM = nM_; nN = nN_; nwg = nM * nN; G = G_; c = c_; }
    __device__ __forceinline__ bool next(int i, Unit& u) const {
        const long L = (long)i * G + c; if (L >= nwg) return false;
        int wgid = (int)L; { const int q = nwg / NXCD, r = nwg % NXCD, xcd = wgid % NXCD, off = wgid / NXCD; wgid = (xcd < r ? xcd * (q + 1) : r * (q + 1) + (xcd - r) * q) + off; }
        const int nig = WGM * nN, gid = wgid / nig, fm = gid * WGM, gsz = (nM - fm) < WGM ? (nM - fm) : WGM;
        u.pm = __builtin_amdgcn_readfirstlane(fm + ((wgid % nig) % gsz)); u.pn = __builtin_amdgcn_readfirstlane((wgid % nig) / gsz); return true;
    }
};

__device__ __forceinline__ unsigned cvt_pk_bf16(float lo, float hi) { unsigned r; asm volatile("v_cvt_pk_bf16_f32 %0, %1, %2" : "=v"(r) : "v"(lo), "v"(hi)); return r; }

template <class Epi, class Prob>
__device__ __forceinline__ void gemm_phase(PG8_LAS unsigned char* lds, const Prob& P, const Epi& E, int tid) {
    const int wid = __builtin_amdgcn_readfirstlane(tid >> 6), lane = tid & 63, wr = wid >> 2, wc = wid & 3, fr = lane & 15, fq = lane >> 4;
    const int nt = P.K / BK;
    unsigned voffB[2];
    { int R0, C0, R1, C1; stage_rc(tid * 16, R0, C0); stage_rc(tid * 16 + 8192, R1, C1); const int Rb0 = Epi::PERM ? ((R0 & ~31) + perm32(R0 & 31)) : R0, Rb1 = Epi::PERM ? ((R1 & ~31) + perm32(R1 & 31)) : R1;
      voffB[0] = (unsigned)(Rb0 * P.ldb + C0) * 2u; voffB[1] = (unsigned)(Rb1 * P.ldb + C1) * 2u; }
    const size_t hstepB = P.hstepB;
    const unsigned ldsw = (unsigned)wid * 1024u;
    const int aoff = lds_byte(wr * 64 + fr, fq * 8), boff = lds_byte(wc * 32 + fr, fq * 8);
#define PG8_SA(b, h) (((b) * 2 + (h)) * HTB)
#define PG8_SB(b, h) ((4 + (b) * 2 + (h)) * HTB)
#define PG8_STAGE(bufoff, gbase, voff) do { _Pragma("unroll") for (int _i = 0; _i < 2; ++_i) \
        __builtin_amdgcn_global_load_lds((const PG8_GAS unsigned*)((const PG8_GAS char*)(gbase) + (voff)[_i]), (PG8_LAS unsigned*)(lds + (bufoff) + ldsw + _i * 8192), 16, 0, 0); } while (0)
#define PG8_LDA(dst, b, h) do { _Pragma("unroll") for (int m = 0; m < 4; ++m) _Pragma("unroll") for (int k = 0; k < 2; ++k) dst[m][k] = *(const PG8_LAS bf16x8*)(lds + PG8_SA(b, h) + aoff + m * 2048 + k * 1024); } while (0)
#define PG8_LDB(dst, b, h) do { _Pragma("unroll") for (int n = 0; n < 2; ++n) _Pragma("unroll") for (int k = 0; k < 2; ++k) dst[n][k] = *(const PG8_LAS bf16x8*)(lds + PG8_SB(b, h) + boff + n * 2048 + k * 1024); } while (0)
#define PG8_MMA(ai, bj, At, Bt) do { __builtin_amdgcn_s_setprio(1); _Pragma("unroll") for (int m = 0; m < 4; ++m) _Pragma("unroll") for (int n = 0; n < 2; ++n) _Pragma("unroll") for (int k = 0; k < 2; ++k) \
        acc[ai][bj][m][n] = __builtin_amdgcn_mfma_f32_16x16x32_bf16(Bt[n][k], At[m][k], acc[ai][bj][m][n], 0, 0, 0); __builtin_amdgcn_s_setprio(0); } while (0)
#define PG8_WAIT_V(n) asm volatile("s_waitcnt vmcnt(" #n ")" ::: "memory")
#define PG8_WAIT_L(n) asm volatile("s_waitcnt lgkmcnt(" #n ")" ::: "memory")
#define PG8_BAR __builtin_amdgcn_s_barrier()
#define PG8_SCHED __builtin_amdgcn_sched_barrier(0)
    Unit cur, nxt; int ui = 0;
    if (!P.next(0, cur)) return;
    float zf = 0.f; asm volatile("" : "+v"(zf));
    f32x4 acc[2][2][4][2];
#pragma unroll
    for (int a = 0; a < 2; ++a)
#pragma unroll
        for (int b = 0; b < 2; ++b)
#pragma unroll
            for (int m = 0; m < 4; ++m)
#pragma unroll
                for (int n = 0; n < 2; ++n) acc[a][b][m][n] = (f32x4){zf, zf, zf, zf};
    bf16x8 At[4][2], B0[2][2], B1[2][2];
    constexpr int NH = Prob::GATHER ? 2 : 1;
    unsigned voC[NH][2];
    P.template a_off<NH>(cur, tid, voC);
    const PG8_GAS char* const Ab = P.A;
    const size_t hstepA = Prob::GATHER ? (size_t)0 : P.hstepA;
#define PG8_STAGE_A(bufoff, h, kbyte, VO) PG8_STAGE(bufoff, Ab + (kbyte) + ((h) ? hstepA : (size_t)0), VO[Prob::GATHER ? (h) : 0])
    { const PG8_GAS char* b0 = P.b_tile(cur, 0); const PG8_GAS char* b1 = P.b_tile(cur, 1);
      PG8_STAGE(PG8_SB(0, 0), b0, voffB); PG8_STAGE(PG8_SB(0, 1), b0 + hstepB, voffB); PG8_STAGE_A(PG8_SA(0, 0), 0, (size_t)0, voC); PG8_STAGE_A(PG8_SA(0, 1), 1, (size_t)0, voC);
      if (wr == 1) PG8_BAR;
      PG8_WAIT_V(2); PG8_BAR;
      PG8_STAGE(PG8_SB(1, 0), b1, voffB); PG8_STAGE_A(PG8_SA(1, 0), 0, (size_t)128, voC); PG8_STAGE(PG8_SB(1, 1), b1 + hstepB, voffB);
      PG8_WAIT_V(6); PG8_BAR; }
    for (;;) {
        const bool has_next = P.next(ui + 1, nxt);
        if (!has_next) nxt = cur;
        for (int t = 0; t < nt; t += 2) {
            const bool last = (t == nt - 2);
            const size_t k1 = (size_t)(t + 1) * 128, k2 = last ? (size_t)0 : (size_t)(t + 2) * 128, k3 = k2 + 128;
            const PG8_GAS char* b2 = last ? P.b_tile(nxt, 0) : P.b_tile(cur, t + 2);
            const PG8_GAS char* b3 = last ? P.b_tile(nxt, 1) : P.b_tile(cur, t + 3);
#ifndef MK_RELAX
#define MK_RELAX 0
#endif
            int fz_ = __builtin_amdgcn_readfirstlane((MK_RELAX && (t == 0) && (ui > 0)) ? 1 : 0); asm volatile("" : "+s"(fz_));
            const bool fresh = fz_ != 0;
#define PG8_WAIT_VR() do { if (fresh) { if constexpr (Epi::NSTORES == 32) PG8_WAIT_V(40); else if constexpr (Epi::NSTORES == 16) PG8_WAIT_V(24); else PG8_WAIT_V(8); } else PG8_WAIT_V(8); } while (0)
            PG8_LDB(B0, 0, 0); PG8_LDB(B1, 0, 1); PG8_SCHED; PG8_LDA(At, 0, 0); if (!fresh) PG8_STAGE_A(PG8_SA(1, 1), 1, k1, voC);
            PG8_WAIT_VR(); PG8_WAIT_L(0); PG8_BAR; PG8_MMA(0, 0, At, B0); PG8_MMA(0, 1, At, B1); PG8_BAR; PG8_SCHED;
            if (last) {
                P.template a_off<NH>(nxt, tid, voC);
            }
            PG8_LDA(At, 0, 1); PG8_STAGE(PG8_SB(0, 0), b2, voffB); PG8_STAGE(PG8_SB(0, 1), b2 + hstepB, voffB); PG8_STAGE_A(PG8_SA(0, 0), 0, k2, voC);
            PG8_WAIT_VR(); PG8_WAIT_L(0); PG8_BAR; PG8_MMA(1, 0, At, B0); PG8_MMA(1, 1, At, B1); PG8_BAR; PG8_SCHED;
            PG8_LDB(B0, 1, 0); PG8_LDB(B1, 1, 1); PG8_SCHED; PG8_LDA(At, 1, 0); PG8_STAGE_A(PG8_SA(0, 1), 1, k2, voC);
            PG8_WAIT_VR(); PG8_WAIT_L(0); PG8_BAR; PG8_MMA(0, 0, At, B0); PG8_MMA(0, 1, At, B1); PG8_BAR; PG8_SCHED;
            PG8_LDA(At, 1, 1); PG8_STAGE(PG8_SB(1, 0), b3, voffB); PG8_STAGE(PG8_SB(1, 1), b3 + hstepB, voffB); PG8_STAGE_A(PG8_SA(1, 0), 0, k3, voC);
            PG8_WAIT_V(8); PG8_WAIT_L(0); PG8_BAR; PG8_MMA(1, 0, At, B0); PG8_MMA(1, 1, At, B1); PG8_BAR; PG8_SCHED;
        }
        if (MK_RELAX) PG8_STAGE_A(PG8_SA(1, 1), 1, (size_t)128, voC);
#ifndef MK_ALIGN
#define MK_ALIGN 1
#endif
        if (MK_ALIGN && wr == 0) PG8_BAR;
        { Unit eu = cur; asm volatile("" : "+s"(eu.pm), "+s"(eu.pn));
          E(acc, eu, wr, wc, fr, fq); }
        if (!has_next) break;
#pragma unroll
        for (int a = 0; a < 2; ++a)
#pragma unroll
            for (int b = 0; b < 2; ++b)
#pragma unroll
                for (int m = 0; m < 4; ++m)
#pragma unroll
                    for (int n = 0; n < 2; ++n) acc[a][b][m][n] = (f32x4){zf, zf, zf, zf};
        cur = nxt; ++ui;
        if (MK_ALIGN && wr == 1) PG8_BAR;
    }
    PG8_WAIT_V(0);
    if (!MK_ALIGN && wr == 0) PG8_BAR;
    PG8_BAR;
#undef PG8_SA
#undef PG8_SB
#undef PG8_STAGE
#undef PG8_STAGE_A
#undef PG8_WAIT_VR
#undef PG8_LDA
#undef PG8_LDB
#undef PG8_MMA
#undef PG8_WAIT_V
#undef PG8_WAIT_L
#undef PG8_BAR
#undef PG8_SCHED
}
}
__device__ __forceinline__ void transpose_item(const GAS float* W, int N, int k0, int n0, GAS bf16_t* dst, int ldd, const GAS float* kscale, LAS float* scr, int lane) {
    const int kq = lane >> 4, n4 = (lane & 15) * 4;
#pragma unroll
    for (int i = 0; i < 16; ++i) { const int kk = 4 * i + kq; f32x4 v = *(const GAS f32x4*)(W + (size_t)(k0 + kk) * N + n0 + n4); if (kscale) v = v * kscale[k0 + kk];
        LAS float* p = scr + kk * 65 + n4; p[0] = v.x; p[1] = v.y; p[2] = v.z; p[3] = v.w; }
    LDS_WAIT(); asm volatile("" ::: "memory");
    const int c = lane & 7;
#pragma unroll
    for (int j = 0; j < 8; ++j) { const int n = (lane >> 3) + 8 * j; const LAS float* s = scr + (8 * c) * 65 + n;
        u32x4 o; o.x = pk2(s[0 * 65], s[1 * 65]); o.y = pk2(s[2 * 65], s[3 * 65]); o.z = pk2(s[4 * 65], s[5 * 65]); o.w = pk2(s[6 * 65], s[7 * 65]);
        *(GAS u32x4*)(dst + (size_t)n * ldd + k0 + 8 * c) = o; }
    LDS_WAIT(); asm volatile("" ::: "memory");
}

__device__ __forceinline__ void ada_unit(FARGS, int unit) {
    const GAS float* c = INP(1); const GAS float* c_ctx = INP(3); const GAS float* ada_w = INP(4); const GAS float* ada_b = INP(5);
    GAS float* mod = (GAS float*)(F.ws + WS_MOD);
    LAS float* S = (LAS float*)F.lds;
    const int L = unit / 48, cb = unit % 48, tid = F.tid;
    for (int i = tid; i < 33 * 1024; i += 512) { const int r = i >> 10, k = i & 1023; const float v = (r < 32) ? c[r * 1024 + k] : c_ctx[k]; S[i] = v / (1.f + expf(-v)); }
    __syncthreads();
    const int col = tid & 127, kg = tid >> 7;
    float acc[33];
#pragma unroll
    for (int r = 0; r < 33; ++r) acc[r] = 0.f;
    const GAS float* wp = ada_w + ((size_t)L * 1024 + kg * 256) * ADA + cb * 128 + col;
    for (int k4 = 0; k4 < 64; ++k4) {
        const float w0 = wp[(size_t)(k4 * 4 + 0) * ADA], w1 = wp[(size_t)(k4 * 4 + 1) * ADA], w2 = wp[(size_t)(k4 * 4 + 2) * ADA], w3 = wp[(size_t)(k4 * 4 + 3) * ADA];
        const LAS f32x4* sp = (const LAS f32x4*)(S + kg * 256 + k4 * 4);
#pragma unroll
        for (int r = 0; r < 33; ++r) { const f32x4 s4 = sp[r * 256]; acc[r] += (s4.x * w0 + s4.y * w1) + (s4.z * w2 + s4.w * w3); }
    }
    __syncthreads();
    LAS float* R = S;
#pragma unroll
    for (int r = 0; r < 33; ++r) R[(kg * 33 + r) * 128 + col] = acc[r];
    __syncthreads();
    for (int i = tid; i < 33 * 128; i += 512) { const int r = i >> 7, cc = i & 127, n = cb * 128 + cc;
        const float v = (R[(0 * 33 + r) * 128 + cc] + R[(1 * 33 + r) * 128 + cc]) + (R[(2 * 33 + r) * 128 + cc] + R[(3 * 33 + r) * 128 + cc]);
        mod[((size_t)L * 33 + r) * ADA + n] = v + ada_b[L * ADA + n]; }
    __syncthreads();
}

__device__ __forceinline__ void tables_unit(FARGS) {
    GAS float* tab = (GAS float*)(F.ws + WS_TAB);
    const int tid = F.tid;
    for (int i = tid; i < 64 * 16; i += 512) { const int p = i >> 4, f = i & 15; const float inv = expf(-(float)f * (1.f / 16.f) * 9.210340371976184f); const float a = (float)p * inv; tab[TAB_T64 + 2 * i] = cosf(a); tab[TAB_T64 + 2 * i + 1] = sinf(a); }
    for (int i = tid; i < 64 * 8; i += 512) { const int p = i >> 3, f = i & 7; const float inv = expf(-(float)f * (1.f / 8.f) * 9.210340371976184f); const float a = (float)p * inv; tab[TAB_T32 + 2 * i] = cosf(a); tab[TAB_T32 + 2 * i + 1] = sinf(a); }
    if (tid < DEPTH) { const GAS float* lp = INP(15) + tid * 4 * 32; float s01 = 0.f, s23 = 0.f;
        for (int i = 0; i < 32; ++i) { s01 += lp[i] * lp[32 + i]; s23 += lp[64 + i] * lp[96 + i]; }
        const float li = 0.8f - 0.6f * expf(-0.3f * (float)tid);
        tab[TAB_LAM + tid] = expf(s01) - expf(s23) + li; tab[TAB_LAM + DEPTH + tid] = 1.f - li; }
}

__device__ __forceinline__ void prologue_phase(FARGS) {
    refresh(F);
    if (F.bx < 192) ada_unit(F, F.bx);
    else if (F.bx == 192) tables_unit(F);
    __syncthreads();
    LAS float* scr = (LAS float*)(F.lds + F.wave * 16640);
    const int gw = F.bx * NWAVES + F.wave, NGW = F.G * NWAVES;
    GAS bf16_t* WIN = (GAS bf16_t*)(F.ws + WS_WIN); GAS bf16_t* WOUT = (GAS bf16_t*)(F.ws + WS_WOUT); GAS bf16_t* W1 = (GAS bf16_t*)(F.ws + WS_W1); GAS bf16_t* W2 = (GAS bf16_t*)(F.ws + WS_W2);
    constexpr int I_IN = 16 * 40, I_OUT = 16 * 16, I_G = 16 * 8, I_D = 8 * 16;
    constexpr int N_IN = DEPTH * I_IN, N_OUT = DEPTH * I_OUT, N_G = DEPTH * NEXP * I_G, N_D = DEPTH * NEXP * I_D;
    constexpr int NITEMS = N_IN + N_OUT + 2 * N_G + N_D;
    for (int it = gw; it < NITEMS; it += NGW) {
        int r = it;
        if (r < N_IN) { const int L = r / I_IN, q = r % I_IN, kb = q / 40, nb = q % 40;
            transpose_item(INP(8) + (size_t)L * D * DIN, DIN, kb * 64, nb * 64, WIN + ((size_t)L * DIN + nb * 64) * D, D, nullptr, scr, F.lane); continue; } r -= N_IN;
        if (r < N_OUT) { const int L = r / I_OUT, q = r % I_OUT, kb = q / 16, nb = q % 16;
            transpose_item(INP(17) + (size_t)L * D * D, D, kb * 64, nb * 64, WOUT + ((size_t)L * D + nb * 64) * D, D, INP(16) + L * D, scr, F.lane); continue; } r -= N_OUT;
        if (r < 2 * N_G) { const int up = r >= N_G; if (up) r -= N_G; const int le = r / I_G, q = r % I_G, kb = q / 8, nb = q % 8, n0 = nb * 64;
            const int drow = (n0 >> 7) * 256 + (n0 & 127) + (up ? 128 : 0);
            transpose_item((up ? INP(21) : INP(20)) + (size_t)le * D * DEXP, DEXP, kb * 64, n0, W1 + ((size_t)le * 1024 + drow) * D, D, nullptr, scr, F.lane); continue; } r -= 2 * N_G;
        { const int le = r / I_D, q = r % I_D, kb = q / 16, nb = q % 16;
            transpose_item(INP(22) + (size_t)le * DEXP * D, D, kb * 64, nb * 64, W2 + ((size_t)le * 1024 + nb * 64) * DEXP, DEXP, nullptr, scr, F.lane); }
    }
    __syncthreads();
}

__device__ __forceinline__ void top2of4(float x0, float x1, float x2, float x3, int& i1, int& i2, float& m1, float& m2) {
    i1 = 0; m1 = x0; if (x1 > m1) { m1 = x1; i1 = 1; } if (x2 > m1) { m1 = x2; i1 = 2; } if (x3 > m1) { m1 = x3; i1 = 3; }
    i2 = -1; m2 = -3.0e38f;
    if (i1 != 0 && x0 > m2) { m2 = x0; i2 = 0; } if (i1 != 1 && x1 > m2) { m2 = x1; i2 = 1; } if (i1 != 2 && x2 > m2) { m2 = x2; i2 = 2; } if (i1 != 3 && x3 > m2) { m2 = x3; i2 = 3; }
}
template <bool ROUTER>
__device__ __forceinline__ void norm_phase(FARGS, int L, int M, bool first, const GAS float* g, int shift_off, int scale_off, bool live = true) {
    refresh(F); OPAQUE_S(L); OPAQUE_S(M);
    const GAS float* mod = (const GAS float*)(F.ws + WS_MOD) + (size_t)L * 33 * ADA;
    GAS bf16_t* H = (GAS bf16_t*)(F.ws + WS_H);
    const GAS bf16_t* XB = (const GAS bf16_t*)(F.ws + WS_XB);
    const GAS float* xlat = INP(0); const GAS float* xctx = INP(2);
    const int lane = F.lane, gw = F.bx * NWAVES + F.wave, NGW = F.G * NWAVES, rpw = (M + NGW - 1) / NGW;
    const int r0 = gw * rpw, r1 = (r0 + rpw < M) ? r0 + rpw : M;
    constexpr int RB = ROUTER ? 1 : 4;
    LAS float* RWT = (LAS float*)F.lds;
    LAS float* LG = (LAS float*)(F.lds + 65536) + F.wave * 640;
    LAS int* hist = (LAS int*)(F.lds + NRM_OFF); LAS int* base = hist + 32;
    if (ROUTER) {
        const GAS float* rw = INP(18);
        for (int i = F.tid; i < 16 * 1024; i += 512) { const int k = i >> 4, e = i & 15; RWT[e * 1024 + k] = rw[i]; }
        if (F.tid < 32) hist[F.tid] = 0;
        __syncthreads();
    }
    int curb = -1; f32x4 gm[4], sh[4];
    u32x4 nraw[RB][2];
    if (!first) {
#pragma unroll
        for (int r = 0; r < RB; ++r)
#pragma unroll
            for (int jj = 0; jj < 2; ++jj) nraw[r][jj] = *(const GAS u32x4*)(XB + (size_t)(r0 + r) * D + 8 * lane + 512 * jj);
    }
#pragma unroll 1
    for (int row = r0; row < r1; row += RB) {
        const int b = row < NLAT ? (row >> 11) : 32;
        if (b != curb) { curb = b;
#pragma unroll
            for (int j = 0; j < 4; ++j) { const int c0 = 8 * lane + 512 * (j >> 1) + 4 * (j & 1); const f32x4 gg = *(const GAS f32x4*)(g + c0), sc = *(const GAS f32x4*)(mod + b * ADA + scale_off + c0);
                gm[j] = gg * (sc + 1.0f); sh[j] = *(const GAS f32x4*)(mod + b * ADA + shift_off + c0); } }
        const GAS float* xr = row < NLAT ? xlat + (size_t)row * D : xctx + (size_t)(row - NLAT) * D;
        f32x4 v[RB][4]; float ss[RB];
        if (first) {
#pragma unroll
            for (int r = 0; r < RB; ++r)
#pragma unroll
                for (int jj = 0; jj < 2; ++jj) { v[r][2 * jj] = *(const GAS f32x4*)(xr + (size_t)r * D + 8 * lane + 512 * jj); v[r][2 * jj + 1] = *(const GAS f32x4*)(xr + (size_t)r * D + 8 * lane + 512 * jj + 4); }
        } else {
            u32x4 raw[RB][2];
#pragma unroll
            for (int r = 0; r < RB; ++r)
#pragma unroll
                for (int jj = 0; jj < 2; ++jj) raw[r][jj] = nraw[r][jj];
            if (row + RB < r1) {
#pragma unroll
                for (int r = 0; r < RB; ++r)
#pragma unroll
                    for (int jj = 0; jj < 2; ++jj) nraw[r][jj] = *(const GAS u32x4*)(XB + (size_t)(row + RB + r) * D + 8 * lane + 512 * jj);
            }
#pragma unroll
            for (int r = 0; r < RB; ++r)
#pragma unroll
                for (int jj = 0; jj < 2; ++jj) { const u32x4 w = raw[r][jj];
                    v[r][2 * jj] = (f32x4){bflo(w.x), bfhi(w.x), bflo(w.y), bfhi(w.y)}; v[r][2 * jj + 1] = (f32x4){bflo(w.z), bfhi(w.z), bflo(w.w), bfhi(w.w)}; }
        }
#pragma unroll
        for (int r = 0; r < RB; ++r) { float s = 0.f;
#pragma unroll
            for (int j = 0; j < 4; ++j) s += (v[r][j].x * v[r][j].x + v[r][j].y * v[r][j].y) + (v[r][j].z * v[r][j].z + v[r][j].w * v[r][j].w);
            ss[r] = s; }
#pragma unroll
        for (int o = 1; o < 32; o <<= 1) {
#pragma unroll
            for (int r = 0; r < RB; ++r) ss[r] += sx(ss[r], lane, o); }
#pragma unroll
        for (int r = 0; r < RB; ++r) { const float rstd = 1.0f / sqrtf(x32_sum(ss[r]) * (1.f / D) + EPS);
#pragma unroll
            for (int j = 0; j < 4; ++j) v[r][j] = v[r][j] * rstd * gm[j] + sh[j];
#pragma unroll
            for (int jj = 0; jj < 2; ++jj) { u32x4 o; o.x = pk2(v[r][2 * jj].x, v[r][2 * jj].y); o.y = pk2(v[r][2 * jj].z, v[r][2 * jj].w); o.z = pk2(v[r][2 * jj + 1].x, v[r][2 * jj + 1].y); o.w = pk2(v[r][2 * jj + 1].z, v[r][2 * jj + 1].w);
                if (live) *(GAS u32x4*)(H + (size_t)(row + r) * D + 8 * lane + 512 * jj) = o; } }
        if (ROUTER) {
            float p[RB][16];
#pragma unroll
            for (int e = 0; e < 16; ++e) {
#pragma unroll
                for (int r = 0; r < RB; ++r) p[r][e] = 0.f;
#pragma unroll
                for (int j = 0; j < 4; ++j) { const f32x4 w = *(const LAS f32x4*)(RWT + e * 1024 + 8 * lane + 512 * (j >> 1) + 4 * (j & 1));
#pragma unroll
                    for (int r = 0; r < RB; ++r) p[r][e] += (v[r][j].x * w.x + v[r][j].y * w.y) + (v[r][j].z * w.z + v[r][j].w * w.w); } }
            const bool h32 = lane & 32, h16 = lane & 16, h8 = lane & 8, h4 = lane & 4;
#pragma unroll
            for (int r = 0; r < RB; ++r) {
                float a8[8], b4[4], c2[2], d1;
#pragma unroll
                for (int e = 0; e < 8; ++e) { const float send = h32 ? p[r][e] : p[r][e + 8], keep = h32 ? p[r][e + 8] : p[r][e]; a8[e] = keep + sx(send, lane, 32); }
#pragma unroll
                for (int e = 0; e < 4; ++e) { const float send = h16 ? a8[e] : a8[e + 4], keep = h16 ? a8[e + 4] : a8[e]; b4[e] = keep + sx(send, lane, 16); }
#pragma unroll
                for (int e = 0; e < 2; ++e) { const float send = h8 ? b4[e] : b4[e + 2], keep = h8 ? b4[e + 2] : b4[e]; c2[e] = keep + sx(send, lane, 8); }
                { const float send = h4 ? c2[0] : c2[1], keep = h4 ? c2[1] : c2[0]; d1 = keep + sx(send, lane, 4); }
                d1 += sx(d1, lane, 2); d1 += sx(d1, lane, 1);
                if ((lane & 3) == 0) LG[(row + r - r0) * 16 + (lane >> 2)] = d1;
            }
        }
    }
    if (ROUTER) {
        LDS_WAIT();
        int cls = 0, ls = 0; const bool mine = r0 + lane < r1;
        { const LAS f32x4* lp = (const LAS f32x4*)(LG + (mine ? lane : 0) * 16);
          const f32x4 q0 = lp[0], q1 = lp[1], q2 = lp[2], q3 = lp[3];
          const float lg[16] = {q0.x, q0.y, q0.z, q0.w, q1.x, q1.y, q1.z, q1.w, q2.x, q2.y, q2.z, q2.w, q3.x, q3.y, q3.z, q3.w};
          float sc[16], sel[16];
#pragma unroll
          for (int e = 0; e < 16; ++e) { sc[e] = 1.0f / (1.0f + __builtin_amdgcn_exp2f(-lg[e] * LOG2E)); sel[e] = sc[e] + INP(19)[e]; }
          float gs[4];
#pragma unroll
          for (int q = 0; q < 4; ++q) { int i1, i2; float m1, m2; top2of4(sel[4 * q], sel[4 * q + 1], sel[4 * q + 2], sel[4 * q + 3], i1, i2, m1, m2); gs[q] = m1 + m2; }
          int gi = 0; float gmx = gs[0]; if (gs[1] > gmx) { gmx = gs[1]; gi = 1; } if (gs[2] > gmx) { gmx = gs[2]; gi = 2; } if (gs[3] > gmx) { gmx = gs[3]; gi = 3; }
          float x4[4], s4[4];
#pragma unroll
          for (int i = 0; i < 4; ++i) { x4[i] = gi == 0 ? sel[i] : gi == 1 ? sel[4 + i] : gi == 2 ? sel[8 + i] : sel[12 + i]; s4[i] = gi == 0 ? sc[i] : gi == 1 ? sc[4 + i] : gi == 2 ? sc[8 + i] : sc[12 + i]; }
          int i1, i2; float m1, m2; top2of4(x4[0], x4[1], x4[2], x4[3], i1, i2, m1, m2);
          const int lo = i1 < i2 ? i1 : i2, hi = i1 < i2 ? i2 : i1;
          const int pr = lo == 0 ? hi - 1 : (lo == 1 ? hi + 1 : 5);
          const float slo = lo == 0 ? s4[0] : lo == 1 ? s4[1] : s4[2], shi = hi == 1 ? s4[1] : hi == 2 ? s4[2] : s4[3];
          const float inv = 1.0f / (slo + shi);
          cls = gi * 6 + pr;
          if (mine && live) { ls = __hip_atomic_fetch_add(&hist[cls], 1, __ATOMIC_RELAXED, __HIP_MEMORY_SCOPE_WORKGROUP);
              f32x2 w2 = {slo * inv, shi * inv}; *(GAS f32x2*)((GAS float*)(F.ws + WS_RW) + (size_t)(r0 + lane) * 2) = w2; }
        }
        __syncthreads();
        if (F.tid < NCLS && live) base[F.tid] = (int)__hip_atomic_fetch_add(CTL(F) + CW_CNT + (L * NCLS + F.tid) * 64, (unsigned)hist[F.tid], __ATOMIC_RELAXED, __HIP_MEMORY_SCOPE_AGENT);
        __syncthreads();
        GAS int* perm = (GAS int*)(F.ws + WS_PERM);
        if (mine && live) perm[(size_t)cls * MTOT + base[cls] + ls] = r0 + lane;
        __syncthreads();
    }
}

__device__ __forceinline__ void norm2_phase(FARGS, int L, int M) {
    refresh(F); OPAQUE_S(L); OPAQUE_S(M);
    constexpr int SG = 2064;
    constexpr int GT_BYTES = 32 * SG, C_OFF = 2 * GT_BYTES, RS_OFF = C_OFF + 256, RI_OFF = RS_OFF + 8 * 40 * 4, HB_OFF = RI_OFF + 8 * 40 * 4;
    static_assert(HB_OFF + 256 <= MISC_OFF, "norm2 LDS map");
    const GAS float* mod = (const GAS float*)(F.ws + WS_MOD) + (size_t)L * 33 * ADA;
    const GAS float* g2 = INP(7) + L * D; const GAS float* Wr = INP(18);
    GAS bf16_t* H = (GAS bf16_t*)(F.ws + WS_H);
    const GAS bf16_t* XB = (const GAS bf16_t*)(F.ws + WS_XB);
    const int lane = F.lane, tid = F.tid, w = F.wave, l31 = lane & 31, hi = lane >> 5;
    const int NGW = F.G * NWAVES, rpw = (M + NGW - 1) / NGW;
    const int R0 = F.bx * NWAVES * rpw, R1 = (R0 + NWAVES * rpw < M) ? R0 + NWAVES * rpw : M;
    const int r0 = R0 + w * rpw < M ? R0 + w * rpw : M, r1 = (r0 + rpw < M) ? r0 + rpw : M;
    LAS unsigned char* GT = F.lds; LAS float* Ctab = (LAS float*)(F.lds + C_OFF); LAS float* RS = (LAS float*)(F.lds + RS_OFF) + w * 40; LAS int* RI = (LAS int*)(F.lds + RI_OFF) + w * 40;
    LAS int* hist = (LAS int*)(F.lds + HB_OFF); LAS int* base = hist + 32;
    if (tid < 32) hist[tid] = 0;
    const int bfirst = R0 < NLAT ? (R0 >> 11) : 32, blast = (R1 - 1) < NLAT ? ((R1 - 1) >> 11) : 32;
    for (int s = 0; s <= (blast != bfirst ? 1 : 0); ++s) {
        const int b = s == 0 ? bfirst : blast;
        const GAS float* sc = mod + (size_t)b * ADA + 4 * 1024; const GAS float* shp = mod + (size_t)b * ADA + 3 * 1024;
        LAS unsigned char* gt = GT + s * GT_BYTES;
        for (int k = tid; k < D; k += 512) {
            const float gmk = g2[k] * (1.0f + sc[k]);
            const f32x4 w0 = *(const GAS f32x4*)(Wr + k * 16), w1 = *(const GAS f32x4*)(Wr + k * 16 + 4), w2 = *(const GAS f32x4*)(Wr + k * 16 + 8), w3 = *(const GAS f32x4*)(Wr + k * 16 + 12);
            const float wr_[16] = {w0.x, w0.y, w0.z, w0.w, w1.x, w1.y, w1.z, w1.w, w2.x, w2.y, w2.z, w2.w, w3.x, w3.y, w3.z, w3.w};
#pragma unroll
            for (int e = 0; e < 16; ++e) { const float G = gmk * wr_[e]; const unsigned hb = pk2(G, 0.f) & 0xffffu; const float lo = G - __uint_as_float(hb << 16); const unsigned lb = pk2(lo, 0.f) & 0xffffu;
                *(LAS bf16_t*)(gt + e * SG + k * 2) = (bf16_t)hb; *(LAS bf16_t*)(gt + (16 + e) * SG + k * 2) = (bf16_t)lb; }
        }
#pragma unroll
        for (int ee = 0; ee < 2; ++ee) { const int e = 2 * w + ee; float p = 0.f;
            for (int k = lane; k < D; k += 64) p += shp[k] * Wr[k * 16 + e];
            p = wave_sum(p, lane); if (lane == 0) Ctab[s * 16 + e] = p; }
    }
    __syncthreads();
    for (int cur = r0; cur < r1; ) {
        const int bcur = cur < NLAT ? (cur >> 11) : 32;
        int cnt = r1 - cur; if (cnt > 32) cnt = 32;
        if (cur < NLAT) { const int bnd = ((cur >> 11) + 1) << 11; if (bnd - cur < cnt) cnt = bnd - cur; }
        const int s = bcur == bfirst ? 0 : 1;
        const int row = cur + (l31 < cnt ? l31 : cnt - 1);
        const GAS bf16_t* xp = XB + (size_t)row * D + 8 * hi;
        const LAS unsigned char* gp = GT + s * GT_BYTES + l31 * SG + 16 * hi;
        f32x16 acc = f32x16{}; float ss = 0.f;
#pragma unroll 1
        for (int kg = 0; kg < 8; ++kg) {
            bf16x8 xf[8];
#pragma unroll
            for (int j = 0; j < 8; ++j) xf[j] = *(const GAS bf16x8*)(xp + (kg * 8 + j) * 16);
#pragma unroll
            for (int j = 0; j < 8; ++j) {
                const bf16x8 gf = *(const LAS bf16x8*)(gp + (kg * 8 + j) * 32);
                const u32x4 wv = __builtin_bit_cast(u32x4, xf[j]);
                const float a0 = bflo(wv.x), a1 = bfhi(wv.x), a2 = bflo(wv.y), a3 = bfhi(wv.y), a4 = bflo(wv.z), a5 = bfhi(wv.z), a6 = bflo(wv.w), a7 = bfhi(wv.w);
                ss += (a0 * a0 + a1 * a1) + (a2 * a2 + a3 * a3) + (a4 * a4 + a5 * a5) + (a6 * a6 + a7 * a7);
                acc = __builtin_amdgcn_mfma_f32_32x32x16_bf16(gf, xf[j], acc, 0, 0, 0);
            }
        }
        const float rstd = 1.0f / sqrtf(x32_sum(ss) * (1.f / D) + EPS);
        float mine[8], oth[8];
#pragma unroll
        for (int i = 0; i < 8; ++i) { mine[i] = acc[i] + acc[i + 8]; oth[i] = swap32(mine[i], hi != 0); }
        float lg[16];
#pragma unroll
        for (int i = 0; i < 4; ++i) { lg[i] = hi ? oth[i] : mine[i]; lg[4 + i] = hi ? mine[i] : oth[i]; lg[8 + i] = hi ? oth[4 + i] : mine[4 + i]; lg[12 + i] = hi ? mine[4 + i] : oth[4 + i]; }
        float sc_[16], sel[16];
#pragma unroll
        for (int e = 0; e < 16; ++e) { const float z = rstd * lg[e] + Ctab[s * 16 + e]; sc_[e] = 1.0f / (1.0f + __builtin_amdgcn_exp2f(-z * LOG2E)); sel[e] = sc_[e] + INP(19)[e]; }
        float gs[4];
#pragma unroll
        for (int q = 0; q < 4; ++q) { int i1, i2; float m1, m2; top2of4(sel[4 * q], sel[4 * q + 1], sel[4 * q + 2], sel[4 * q + 3], i1, i2, m1, m2); gs[q] = m1 + m2; }
        int gi = 0; float gmx = gs[0]; if (gs[1] > gmx) { gmx = gs[1]; gi = 1; } if (gs[2] > gmx) { gmx = gs[2]; gi = 2; } if (gs[3] > gmx) { gmx = gs[3]; gi = 3; }
        float x4[4], s4[4];
#pragma unroll
        for (int i = 0; i < 4; ++i) { x4[i] = gi == 0 ? sel[i] : gi == 1 ? sel[4 + i] : gi == 2 ? sel[8 + i] : sel[12 + i]; s4[i] = gi == 0 ? sc_[i] : gi == 1 ? sc_[4 + i] : gi == 2 ? sc_[8 + i] : sc_[12 + i]; }
        int i1, i2; float m1, m2; top2of4(x4[0], x4[1], x4[2], x4[3], i1, i2, m1, m2);
        const int lo_ = i1 < i2 ? i1 : i2, hi_ = i1 < i2 ? i2 : i1;
        const int pr = lo_ == 0 ? hi_ - 1 : (lo_ == 1 ? hi_ + 1 : 5);
        const float slo = lo_ == 0 ? s4[0] : lo_ == 1 ? s4[1] : s4[2], shi = hi_ == 1 ? s4[1] : hi_ == 2 ? s4[2] : s4[3];
        const float inv = 1.0f / (slo + shi);
        const int cls = gi * 6 + pr;
        if (hi == 0 && l31 < cnt) { const int ls = __hip_atomic_fetch_add(&hist[cls], 1, __ATOMIC_RELAXED, __HIP_MEMORY_SCOPE_WORKGROUP);
            const int ri = cur - r0 + l31; RS[ri] = rstd; RI[ri] = cls | (ls << 8);
            f32x2 w2 = {slo * inv, shi * inv}; *(GAS f32x2*)((GAS float*)(F.ws + WS_RW) + (size_t)(cur + l31) * 2) = w2; }
        cur += cnt;
    }
    LDS_WAIT();
    { int curb = -1; f32x4 gm[4], sh[4];
#pragma unroll 1
      for (int row = r0; row < r1; row += 4) {
        const int b = row < NLAT ? (row >> 11) : 32;
        if (b != curb) { curb = b;
#pragma unroll
            for (int j = 0; j < 4; ++j) { const int c0 = 8 * lane + 512 * (j >> 1) + 4 * (j & 1); const f32x4 gg = *(const GAS f32x4*)(g2 + c0), sc = *(const GAS f32x4*)(mod + b * ADA + 4 * 1024 + c0);
                gm[j] = gg * (sc + 1.0f); sh[j] = *(const GAS f32x4*)(mod + b * ADA + 3 * 1024 + c0); } }
        u32x4 raw[4][2];
#pragma unroll
        for (int r = 0; r < 4; ++r)
#pragma unroll
            for (int jj = 0; jj < 2; ++jj) raw[r][jj] = *(const GAS u32x4*)(XB + (size_t)(row + r) * D + 8 * lane + 512 * jj);
#pragma unroll
        for (int r = 0; r < 4; ++r) { const float rstd = RS[row - r0 + r];
#pragma unroll
            for (int jj = 0; jj < 2; ++jj) { const u32x4 wv = raw[r][jj];
                const f32x4 v0 = (f32x4){bflo(wv.x), bfhi(wv.x), bflo(wv.y), bfhi(wv.y)} * rstd * gm[2 * jj] + sh[2 * jj], v1 = (f32x4){bflo(wv.z), bfhi(wv.z), bflo(wv.w), bfhi(wv.w)} * rstd * gm[2 * jj + 1] + sh[2 * jj + 1];
                u32x4 o; o.x = pk2(v0.x, v0.y); o.y = pk2(v0.z, v0.w); o.z = pk2(v1.x, v1.y); o.w = pk2(v1.z, v1.w);
                *(GAS u32x4*)(H + (size_t)(row + r) * D + 8 * lane + 512 * jj) = o; } }
      } }
    __syncthreads();
    if (tid < NCLS) base[tid] = (int)__hip_atomic_fetch_add(CTL(F) + CW_CNT + (L * NCLS + tid) * 64, (unsigned)hist[tid], __ATOMIC_RELAXED, __HIP_MEMORY_SCOPE_AGENT);
    __syncthreads();
    { GAS int* perm = (GAS int*)(F.ws + WS_PERM);
      if (r0 + lane < r1) { const int ri = RI[lane], cls = ri & 255, ls = ri >> 8; perm[(size_t)cls * MTOT + base[cls] + ls] = r0 + lane; } }
    __syncthreads();
}

__device__ __forceinline__ void qkprep_phase(FARGS, int L, bool live = true) {
    refresh(F); OPAQUE_S(L);
    GAS bf16_t* U = (GAS bf16_t*)(F.ws + WS_U);
    const GAS float* tab = (const GAS float*)(F.ws + WS_TAB);
    const int lane = F.lane, gw = F.bx * NWAVES + F.wave, NGW = F.G * NWAVES, rpw = (MTOT + NGW - 1) / NGW;
    const int r0 = gw * rpw, r1 = (r0 + rpw < MTOT) ? r0 + rpw : MTOT;
    int ccol[4]; bool seg32[4], dorope[4], valid[4]; float qs[4]; f32x4 g0[4], g1[4];
#pragma unroll
    for (int i = 0; i < 4; ++i) {
        const int c = lane + 64 * i; valid[i] = c < 224;
        int col, isq; const GAS float* gp; bool s32 = false, rp = true; float sc = 0.125f * LOG2E;
        if (c < 48) { col = 8 * c; isq = c < 32; gp = INP(9) + L * 128 + (isq ? 0 : 64) + ((8 * c) & 63); }
        else if (c < 112) { const int cc = c - 48; col = QB + 8 * cc; isq = cc < 32; gp = INP(10) + L * 128 + (isq ? 0 : 64) + ((8 * cc) & 63); rp = false; }
        else if (c < 176) { const int cc = c - 112; col = QC + 8 * cc; isq = cc < 32; gp = INP(11) + L * 64 + (isq ? 0 : 32) + ((8 * cc) & 31); s32 = true; sc = 0.17677669529663687f * LOG2E; }
        else { const int cc = (c < 224 ? c : 223) - 176; col = QD + 8 * cc; isq = cc < 32; gp = INP(12) + L * 128 + (isq ? 0 : 64) + ((8 * cc) & 63); }
        ccol[i] = col; seg32[i] = s32; dorope[i] = rp; qs[i] = isq ? sc : 1.0f; g0[i] = *(const GAS f32x4*)gp; g1[i] = *(const GAS f32x4*)(gp + 4);
    }
#pragma unroll 1
    for (int row4 = r0; row4 < r1; row4 += 4) {
        u32x4 wv[4][4];
#pragma unroll
        for (int r = 0; r < 4; ++r)
#pragma unroll
            for (int i = 0; i < 4; ++i) wv[r][i] = *(const GAS u32x4*)(U + (size_t)(row4 + r) * DIN + ccol[i]);
#pragma unroll
        for (int r = 0; r < 4; ++r) {
        const int row = row4 + r;
        const bool lat = row < NLAT; const int s = row & 2047, prow = s >> 6, pcol = s & 63;
#pragma unroll
        for (int i = 0; i < 4; ++i) {
            GAS bf16_t* p = U + (size_t)row * DIN + ccol[i];
            const u32x4 w = wv[r][i];
            float x[8] = {bflo(w.x), bfhi(w.x), bflo(w.y), bfhi(w.y), bflo(w.z), bfhi(w.z), bflo(w.w), bfhi(w.w)};
            float ss = 0.f;
#pragma unroll
            for (int e = 0; e < 8; ++e) ss += x[e] * x[e];
            ss += sx(ss, lane, 1); ss += sx(ss, lane, 2); const float ss8 = ss + sx(ss, lane, 4);
            const float rstd = seg32[i] ? 1.0f / sqrtf(ss * (1.f / 32.f) + EPS) : 1.0f / sqrtf(ss8 * (1.f / 64.f) + EPS);
            const float gg[8] = {g0[i].x, g0[i].y, g0[i].z, g0[i].w, g1[i].x, g1[i].y, g1[i].z, g1[i].w};
#pragma unroll
            for (int e = 0; e < 8; ++e) x[e] = x[e] * rstd * gg[e];
            const int j = seg32[i] ? (lane & 3) : (lane & 7);
            const int pxor = seg32[i] ? 1 : 2;
            const bool first = seg32[i] ? !(j & 1) : !(j & 2);
            const int pos = seg32[i] ? ((j < 2) ? prow : pcol) : ((j < 4) ? prow : pcol);
            const GAS float* tp = seg32[i] ? tab + TAB_T32 + (pos * 8) * 2 : tab + TAB_T64 + (pos * 16 + 8 * (j & 1)) * 2;
            const bool rp = dorope[i] && lat;
#pragma unroll
            for (int e2 = 0; e2 < 4; ++e2) {
                const f32x4 cs = *(const GAS f32x4*)(tp + 4 * e2);
                const float pa = sx(x[2 * e2], lane, pxor), pb = sx(x[2 * e2 + 1], lane, pxor);
                if (rp) {
                    x[2 * e2] = first ? x[2 * e2] * cs.x - pa * cs.y : pa * cs.y + x[2 * e2] * cs.x;
                    x[2 * e2 + 1] = first ? x[2 * e2 + 1] * cs.z - pb * cs.w : pb * cs.w + x[2 * e2 + 1] * cs.z;
                }
            }
            u32x4 o; o.x = pk2(x[0] * qs[i], x[1] * qs[i]); o.y = pk2(x[2] * qs[i], x[3] * qs[i]); o.z = pk2(x[4] * qs[i], x[5] * qs[i]); o.w = pk2(x[6] * qs[i], x[7] * qs[i]);
            if (valid[i] && live) *(GAS u32x4*)p = o;
        }
        }
    }
}
#ifdef MK_USE_SB
#define MK_SB() __builtin_amdgcn_sched_barrier(0)
#else
#define MK_SB() do {} while (0)
#endif
#ifndef MK_DUAL
#define MK_DUAL 1
#endif
#ifndef MK_CHP
#define MK_CHP 1
#endif
template <int MIX> struct MixCfg;
template <> struct MixCfg<0> { static constexpr int QCOL = QA, KCOL = KA, VCOL = VA, CK = 128, CV = 128; static constexpr bool GQA = true;  };
template <> struct MixCfg<1> { static constexpr int QCOL = QB, KCOL = KB, VCOL = VB, CK = 256, CV = 256; static constexpr bool GQA = false; };
template <> struct MixCfg<2> { static constexpr int QCOL = QC, KCOL = KC, VCOL = VC, CK = MK_CHP ? 128 : 256, CV = MK_CHP ? 128 : 256; static constexpr bool GQA = false; };
template <> struct MixCfg<3> { static constexpr int QCOL = QD, KCOL = KD, VCOL = VD, CK = 128, CV = 128; static constexpr bool GQA = true;  };

__device__ __forceinline__ int crow16(int r, int hi) { return (r & 3) + 8 * (r >> 2) + 4 * hi; }
__device__ __forceinline__ s16x4 vtr(const LAS unsigned char* p) { return __builtin_bit_cast(s16x4, __builtin_amdgcn_ds_read_tr16_b64_v4i16((LAS s16x4*)p)); }

__device__ __forceinline__ void softmax_tile(f32x16& p0, f32x16& p1, float& l, bf16x8 (&pa)[4]) {
    float s0 = 0.f, s1 = 0.f;
#pragma unroll
    for (int r = 0; r < 16; ++r) { p0[r] = __builtin_amdgcn_exp2f(p0[r]); p1[r] = __builtin_amdgcn_exp2f(p1[r]); s0 += p0[r]; s1 += p1[r]; }
    l += s0 + s1;
#pragma unroll
    for (int sI = 0; sI < 4; ++sI) {
        u32x4 w;
        if (sI < 2) { const int o_ = 8 * sI; w.x = pk2(p0[o_], p0[o_ + 1]); w.y = pk2(p0[o_ + 2], p0[o_ + 3]); w.z = pk2(p0[o_ + 4], p0[o_ + 5]); w.w = pk2(p0[o_ + 6], p0[o_ + 7]); }
        else { const int o_ = 8 * (sI - 2); w.x = pk2(p1[o_], p1[o_ + 1]); w.y = pk2(p1[o_ + 2], p1[o_ + 3]); w.z = pk2(p1[o_ + 4], p1[o_ + 5]); w.w = pk2(p1[o_ + 6], p1[o_ + 7]); }
        pa[sI] = __builtin_bit_cast(bf16x8, w);
    }
}

template <int MIX>
__device__ __forceinline__ void attn_unit(FARGS, int L, int b, int qb, bool isctx, int hp) {
    typedef MixCfg<MIX> C;
    refresh(F); OPAQUE_S(L);
    constexpr int SK = C::CK * 2 + 16, SV = C::CV * 2 + 64, NKC = C::CK / 64, NVC = C::CV / 64;
    constexpr bool DIFF = (MIX == 2);
    constexpr bool DUAL = (MIX == 3) && MK_DUAL;
    constexpr bool TWO = DIFF || DUAL;
    constexpr bool HP = DIFF && MK_CHP;
    constexpr int UQ = (DUAL || HP) ? 128 : 64;
    static_assert(C::CK == C::CV, "K and V tiles share the per-thread load offsets");
    const GAS bf16_t* U = (const GAS bf16_t*)(F.ws + WS_U);
    GAS bf16_t* Y = (GAS bf16_t*)(F.ws + WS_Y);
    const GAS float* tab = (const GAS float*)(F.ws + WS_TAB);
    const int tid = F.tid, lane = F.lane, w = F.wave, l31 = lane & 31, hi = lane >> 5;
    const int hq = DUAL ? 2 * (w >> 2) : (HP ? 2 * hp + (w >> 2) : (w >> 1)), rs = (DUAL || HP) ? (w & 3) : (w & 1);
    const int hk = (DUAL || HP) ? (w >> 2) : (C::GQA ? (hq >> 1) : hq);
    const int kcolb = C::KCOL + (HP ? hp * 128 : 0), vcolb = C::VCOL + (HP ? hp * 128 : 0);
    const int qrow = isctx ? NLAT + b * CTXL + qb * UQ + rs * 32 + l31 : b * SEQ + qb * UQ + rs * 32 + l31;
    int nloc, loc0;
    if (isctx) { nloc = 0; loc0 = 0; }
    else if (MIX == 0) { const int t0 = DUAL ? 2 * qb - 2 : qb - 2, t1 = DUAL ? 2 * qb + 3 : qb + 2; loc0 = t0 < 0 ? 0 : t0; const int hiT = t1 > 31 ? 31 : t1; nloc = hiT - loc0 + 1; }
    else if (MIX == 1) { loc0 = qb - 4 < 0 ? 0 : (qb - 4 > 24 ? 24 : qb - 4); nloc = 8; }
    else { loc0 = 0; nloc = 32; }
    const int NT = nloc + 4;
    const int lrow0 = b * SEQ, crow0 = NLAT + b * CTXL;
    bf16x8 qf[4], qg[DUAL ? 4 : 1];
    { const GAS bf16_t* qp = U + (size_t)qrow * DIN + C::QCOL + hq * 64 + hi * 8;
#pragma unroll
      for (int d0 = 0; d0 < 4; ++d0) { qf[d0] = *(const GAS bf16x8*)(qp + d0 * 16); if (DUAL) qg[DUAL ? d0 : 0] = *(const GAS bf16x8*)(qp + 64 + d0 * 16); } }
    float l0 = 0.f, l1 = 0.f;
    if (MIX == 0) { l0 = hi == 0 ? __builtin_amdgcn_exp2f(INP(13)[L * 4 + hq] * LOG2E) : 0.f;
        if (DUAL) l1 = hi == 0 ? __builtin_amdgcn_exp2f(INP(13)[L * 4 + hq + 1] * LOG2E) : 0.f; }
    f32x16 o0[2], o1[2];
#pragma unroll
    for (int i = 0; i < 2; ++i) { o0[i] = f32x16{}; o1[i] = f32x16{}; }
    u32x4 kreg[NKC], vreg[NVC];
    auto tile_row = [&](int t) -> int { return t < nloc ? lrow0 + (loc0 + t) * 64 : crow0 + (t - nloc) * 64; };
    unsigned goff[NKC];
#pragma unroll
    for (int i = 0; i < NKC; ++i) { const int c = tid + 512 * i, r = c / (C::CK / 8), cc = c % (C::CK / 8); goff[i] = (unsigned)(r * DIN + cc * 8) * 2u; }
    auto issueK = [&](int t) { const GAS char* tb = (const GAS char*)(U + (size_t)tile_row(t) * DIN + kcolb);
#pragma unroll
        for (int i = 0; i < NKC; ++i) kreg[i] = *(const GAS u32x4*)(tb + goff[i]); };
    auto issueV = [&](int t) { const GAS char* tb = (const GAS char*)(U + (size_t)tile_row(t) * DIN + vcolb);
#pragma unroll
        for (int i = 0; i < NVC; ++i) vreg[i] = *(const GAS u32x4*)(tb + goff[i]); };
    auto stashK = [&](int t) { LAS unsigned char* Kw = F.lds + (t & 1) * AT_BUFB;
#pragma unroll
        for (int i = 0; i < NKC; ++i) { const int c = tid + 512 * i, r = c / (C::CK / 8), cc = c % (C::CK / 8); *(LAS u32x4*)(Kw + r * SK + cc * 16) = kreg[i]; } };
    auto stashV = [&](int t) { LAS unsigned char* Vw = F.lds + (t & 1) * AT_BUFB + AT_VOFF;
#pragma unroll
        for (int i = 0; i < NVC; ++i) { const int c = tid + 512 * i, r = c / (C::CV / 8), cc = c % (C::CV / 8); *(LAS u32x4*)(Vw + r * SV + cc * 16) = vreg[i]; } };
    const int kboff = l31 * SK + (hk * 64 + hi * 8) * 2;
    const int vboff = AT_VOFF + (4 * hi + ((lane & 15) >> 2)) * SV + (hk * 64 + 16 * ((lane >> 4) & 1) + 4 * (lane & 3)) * 2;
    bf16x8 kf[8];
    auto loadkf = [&](int t) { const LAS unsigned char* kb = F.lds + (t & 1) * AT_BUFB + kboff;
#pragma unroll
        for (int d0 = 0; d0 < 4; ++d0) { kf[2 * d0] = *(const LAS bf16x8*)(kb + d0 * 32); kf[2 * d0 + 1] = *(const LAS bf16x8*)(kb + 32 * SK + d0 * 32); } };
    bf16x8 pa0[4], pa1[4];
#pragma unroll
    for (int i = 0; i < 4; ++i) { pa0[i] = bf16x8{}; pa1[i] = bf16x8{}; }
    constexpr int VPRE = DUAL ? 1 : (TWO ? 2 : 4);
    bf16x8 vf[2 * VPRE];
    auto readvf = [&](int t, int sI, int dh) -> bf16x8 {
        const LAS unsigned char* vp = F.lds + (t & 1) * AT_BUFB + vboff + (16 * sI) * SV + dh * 64;
        const s16x4 lo = vtr(vp), hi4 = vtr(vp + 8 * SV);
        return (bf16x8){lo[0], lo[1], lo[2], lo[3], hi4[0], hi4[1], hi4[2], hi4[3]}; };
    auto loadvf = [&](int t) {
#pragma unroll
        for (int sI = 0; sI < VPRE; ++sI)
#pragma unroll
            for (int dh = 0; dh < 2; ++dh) vf[2 * sI + dh] = readvf(t, sI, dh); };
    auto pv = [&](int t) {
#pragma unroll
        for (int sI = 0; sI < 4; ++sI)
#pragma unroll
            for (int dh = 0; dh < 2; ++dh) {
                const bf16x8 v = sI < VPRE ? vf[2 * (sI < VPRE ? sI : 0) + dh] : readvf(t, sI, dh);
                o0[dh] = __builtin_amdgcn_mfma_f32_32x32x16_bf16(v, pa0[sI], o0[dh], 0, 0, 0);
                if (TWO) o1[dh] = __builtin_amdgcn_mfma_f32_32x32x16_bf16(v, pa1[sI], o1[dh], 0, 0, 0);
            } };
    const int qpos = qb * UQ + rs * 32 + l31;
    const int qc = rs * 32 + l31, cs = qc - 8 < 0 ? 0 : (qc - 8 > 48 ? 48 : qc - 8);
    const LAS float* rpb = (const LAS float*)(F.lds + AT_RPB) + hq * 465;
    issueK(0); stashK(0); issueK(1); issueV(0);
    WG_BAR();
    constexpr bool KHOLD = !TWO || HP;
    if (KHOLD) loadkf(0);
    for (int t = 0; t < NT; ++t) {
        if (t > 0) loadvf(t - 1);
        if (!KHOLD) loadkf(t);
        MK_SB();
        if (t + 1 < NT) stashK(t + 1);
        stashV(t);
        if (t + 2 < NT) issueK(t + 2);
        if (t + 1 < NT) issueV(t + 1);
        const bool local = t < nloc;
        f32x16 p0 = f32x16{}, p1 = f32x16{}, r0_ = f32x16{}, r1_ = f32x16{};
#pragma unroll
        for (int d0 = 0; d0 < (DIFF ? 2 : 4); ++d0) { p0 = __builtin_amdgcn_mfma_f32_32x32x16_bf16(kf[2 * d0], qf[d0], p0, 0, 0, 0); p1 = __builtin_amdgcn_mfma_f32_32x32x16_bf16(kf[2 * d0 + 1], qf[d0], p1, 0, 0, 0); }
        MK_SB();
        if (t > 0) pv(t - 1);
        if (DIFF) {
#pragma unroll
            for (int d0 = 2; d0 < 4; ++d0) { r0_ = __builtin_amdgcn_mfma_f32_32x32x16_bf16(kf[2 * d0], qf[d0], r0_, 0, 0, 0); r1_ = __builtin_amdgcn_mfma_f32_32x32x16_bf16(kf[2 * d0 + 1], qf[d0], r1_, 0, 0, 0); }
        }
        if (DUAL) {
#pragma unroll
            for (int d0 = 0; d0 < 4; ++d0) { r0_ = __builtin_amdgcn_mfma_f32_32x32x16_bf16(kf[2 * d0], qg[DUAL ? d0 : 0], r0_, 0, 0, 0); r1_ = __builtin_amdgcn_mfma_f32_32x32x16_bf16(kf[2 * d0 + 1], qg[DUAL ? d0 : 0], r1_, 0, 0, 0); }
        }
        MK_SB();
        if (MIX == 0 && local) {
            const int mb = (loc0 + t) * 64 + 4 * hi - qpos + 128;
#pragma unroll
            for (int r = 0; r < 16; ++r) { const int kc = (r & 3) + 8 * (r >> 2);
                if ((unsigned)(mb + kc) > 256u) { p0[r] = -INFINITY; if (DUAL) r0_[r] = -INFINITY; } if ((unsigned)(mb + kc + 32) > 256u) { p1[r] = -INFINITY; if (DUAL) r1_[r] = -INFINITY; } }
        }
        if (MIX == 1 && local) {
            const int dr = (loc0 + t) - qb + 7;
            const int kh = 4 * hi - cs; const LAS float* rp = rpb + dr * 31 + 15 - qc + 4 * hi;
#pragma unroll
            for (int r = 0; r < 16; ++r) { const int kc = (r & 3) + 8 * (r >> 2);
                const bool v0 = (unsigned)(kh + kc) < 16u, v1 = (unsigned)(kh + kc + 32) < 16u;
                const float b0 = rp[kc], b1 = rp[kc + 32];
                p0[r] = v0 ? p0[r] + b0 : -INFINITY; p1[r] = v1 ? p1[r] + b1 : -INFINITY; }
        }
        softmax_tile(p0, p1, l0, pa0);
        if (TWO) softmax_tile(r0_, r1_, l1, pa1);
        WG_BAR();
        if (KHOLD && t + 1 < NT) loadkf(t + 1);
    }
    loadvf(NT - 1); pv(NT - 1);
    { const float lt0 = x32_sum(l0); const float i0 = 1.0f / lt0;
      float sc1 = 0.f;
      if (DIFF) { const float lt1 = x32_sum(l1); sc1 = tab[TAB_LAM + L] / lt1; }
      if (DUAL) { const float lt1 = x32_sum(l1); sc1 = 1.0f / lt1; }
      float ss = 0.f, ss1 = 0.f;
#pragma unroll
      for (int dh = 0; dh < 2; ++dh)
#pragma unroll
          for (int r = 0; r < 16; ++r) { float v = o0[dh][r] * i0; if (DIFF) v -= o1[dh][r] * sc1; o0[dh][r] = v; ss += v * v;
              if (DUAL) { const float v1 = o1[dh][r] * sc1; o1[dh][r] = v1; ss1 += v1 * v1; } }
      ss = x32_sum(ss); if (DUAL) ss1 = x32_sum(ss1);
      float scl;
      if (DIFF) scl = (1.0f / sqrtf(ss * (1.f / 64.f) + EPS)) * tab[TAB_LAM + DEPTH + L];
      else {
          LAS float* gss = (LAS float*)(F.lds + AT_GSS);
          if (hi == 0) { gss[(rs * 32 + l31) * 4 + hq] = ss; if (DUAL) gss[(rs * 32 + l31) * 4 + hq + 1] = ss1; }
          WG_BAR();
          const f32x4 g4 = *(const LAS f32x4*)(gss + (rs * 32 + l31) * 4);
          scl = 1.0f / sqrtf(((g4.x + g4.y) + (g4.z + g4.w)) * (1.f / 256.f) + EPS);
      }
      int lf = l31; asm volatile("" : "+v"(lf));
      const int qrow_f = isctx ? NLAT + b * CTXL + qb * UQ + rs * 32 + lf : b * SEQ + qb * UQ + rs * 32 + lf;
      GAS bf16_t* yp = Y + (size_t)qrow_f * D + MIX * 256 + hq * 64 + 4 * hi;
#pragma unroll
      for (int dh = 0; dh < 2; ++dh)
#pragma unroll
          for (int g = 0; g < 4; ++g) { u32x2 o; o.x = pk2(o0[dh][4 * g] * scl, o0[dh][4 * g + 1] * scl); o.y = pk2(o0[dh][4 * g + 2] * scl, o0[dh][4 * g + 3] * scl);
              *(GAS u32x2*)(yp + dh * 32 + 8 * g) = o;
              if (DUAL) { u32x2 o2; o2.x = pk2(o1[dh][4 * g] * scl, o1[dh][4 * g + 1] * scl); o2.y = pk2(o1[dh][4 * g + 2] * scl, o1[dh][4 * g + 3] * scl);
                  *(GAS u32x2*)(yp + 64 + dh * 32 + 8 * g) = o2; } }
    }
}

template <int MIX>
__device__ __forceinline__ void run_mixer(FARGS, int L, bool need_ctx) {
    constexpr bool DUAL = (MIX == 3) && MK_DUAL, HP = (MIX == 2) && MK_CHP;
    constexpr int NU = DUAL ? 512 : 1024, NC = DUAL ? 64 : 128;
    const int G = F.G;
    const int c = (G % 8 == 0) ? (F.bx % 8) * (G / 8) + F.bx / 8 : F.bx;
    const int nlat = c < NU ? (NU - c + G - 1) / G : 0;
    const int j = (MIX & 1) ? c - 128 : c;
    const bool has_ctx = need_ctx && j >= 0 && j < NC;
    const int n = nlat + (has_ctx ? 1 : 0);
    for (int k = 0; k < n; ++k) { const bool isctx = k >= nlat; const int i = isctx ? j : c + k * G;
        int b, qb, hp = 0;
        if (HP) { if (isctx) { b = i >> 2; qb = (i >> 1) & 1; hp = i & 1; } else { b = i >> 5; qb = (i & 31) >> 1; hp = i & 1; } }
        else if (DUAL) { if (isctx) { b = i >> 1; qb = i & 1; } else { b = i >> 4; qb = i & 15; } }
        else { if (isctx) { b = i >> 2; qb = i & 3; } else { b = i >> 5; qb = i & 31; } }
        attn_unit<MIX>(F, L, b, qb, isctx, hp); }
}
__device__ __forceinline__ void attn_phase(FARGS, int L, bool need_ctx) {
    refresh(F);
    { LAS float* rpb = (LAS float*)(F.lds + AT_RPB); const GAS float* src = INP(14) + L * 4 * 465;
      for (int i = F.tid; i < 4 * 465; i += 512) rpb[i] = src[i] * LOG2E; }
    __syncthreads();
#ifndef MK_DOUBLE_MIX
#define MK_DOUBLE_MIX -1
#endif
#define REPM(k) for (int rep_ = 0; rep_ < ((MK_DOUBLE_MIX == (k)) ? 2 : 1); ++rep_)
    REPM(2) run_mixer<2>(F, L, need_ctx);
    REPM(3) run_mixer<3>(F, L, need_ctx);
    REPM(1) run_mixer<1>(F, L, need_ctx);
    REPM(0) run_mixer<0>(F, L, need_ctx);
    __syncthreads();
}
struct ProbPlain {
    static constexpr bool GATHER = false;
    const GAS char* A; const GAS char* Bt; int K, lda, ldb; size_t hstepA, hstepB; pg8::Order ord;
    __device__ __forceinline__ bool next(int i, pg8::Unit& u) const { return ord.next(i, u); }
    template <int NH> __device__ __forceinline__ void a_off(const pg8::Unit& u, int tid, unsigned (&v)[NH][2]) const {
        int R0, C0, R1, C1; pg8::stage_rc(tid * 16, R0, C0); pg8::stage_rc(tid * 16 + 8192, R1, C1);
        v[0][0] = (unsigned)((u.pm * 256 + R0) * lda + C0) * 2u; v[0][1] = (unsigned)((u.pm * 256 + R1) * lda + C1) * 2u;
    }
    __device__ __forceinline__ const GAS char* b_tile(const pg8::Unit& u, int t) const { return Bt + ((size_t)u.pn * 256 * ldb + (size_t)t * 64) * 2; }
};
struct EpiU {
    static constexpr bool PERM = true; static constexpr int NSTORES = 32;
    GAS bf16_t* U;
    __device__ __forceinline__ void operator()(const f32x4 (&acc)[2][2][4][2], const pg8::Unit& u, int wr, int wc, int fr, int fq) const {
        const int row0 = u.pm * 256 + wr * 64 + fr, col0 = u.pn * 256 + wc * 32 + 8 * fq;
#pragma unroll
        for (int ai = 0; ai < 2; ++ai)
#pragma unroll
            for (int m = 0; m < 4; ++m) { int frx = fr; asm volatile("" : "+v"(frx)); GAS bf16_t* rowp = U + (size_t)(u.pm * 256 + wr * 64 + frx + ai * 128 + m * 16) * DIN + col0;
#pragma unroll
                for (int bj = 0; bj < 2; ++bj) { const f32x4 v0 = acc[ai][bj][m][0], v1 = acc[ai][bj][m][1];
                    u32x4 w; w.x = pk2(v0[0], v0[1]); w.y = pk2(v0[2], v0[3]); w.z = pk2(v1[0], v1[1]); w.w = pk2(v1[2], v1[3]);
                    *(GAS u32x4*)(rowp + bj * 128) = w; } }
    }
};
struct EpiQK {
    static constexpr bool PERM = true; static constexpr int NSTORES = 32;
    GAS bf16_t* U; const GAS float* tab; const GAS float* gwin; const GAS float* gna; const GAS float* gdiff; const GAS float* ggqa; LAS float* X; float vscale;
    __device__ __forceinline__ void operator()(const f32x4 (&acc)[2][2][4][2], const pg8::Unit& u, int wr, int wc, int fr, int fq) const {
        const int pn = u.pn, lane = fr + 16 * fq;
        const bool lat = u.pm < 256;
        int kind = 0, nbj = 0; bool isq = false, rope = false; const GAS float* g = gwin; float qs = 1.f;
        if (pn == 0) { kind = 1; nbj = 2; isq = true; rope = true; g = gwin; } else if (pn == 1) { kind = 1; nbj = 1; rope = true; g = gwin + 64; }
        else if (pn == 2) { kind = 1; nbj = 2; isq = true; g = gna; } else if (pn == 3) { kind = 1; nbj = 2; g = gna + 64; }
        else if (pn == 5) { kind = 2; nbj = 2; isq = true; rope = true; g = gdiff; } else if (pn == 6) { kind = 2; nbj = 2; rope = true; g = gdiff + 32; }
        else if (pn == 8) { kind = 1; nbj = 2; isq = true; rope = true; g = ggqa; } else if (pn == 9) { kind = 1; nbj = 1; rope = true; g = ggqa + 64; }
        rope = rope && lat;
        if (isq) qs = (kind == 2 ? 0.17677669529663687f : 0.125f) * LOG2E;
        const int row0 = u.pm * 256 + wr * 64 + fr, col0 = pn * 256 + wc * 32 + 8 * fq;
        float gg[8];
        { const int dg = kind == 2 ? 8 * fq : 32 * (wc & 1) + 8 * fq; const f32x4 a = *(const GAS f32x4*)(g + dg), b = *(const GAS f32x4*)(g + dg + 4);
          gg[0] = a.x; gg[1] = a.y; gg[2] = a.z; gg[3] = a.w; gg[4] = b.x; gg[5] = b.y; gg[6] = b.z; gg[7] = b.w; }
        auto sumsq = [&](int ai, int m, int bj) -> float { const f32x4 v0 = acc[ai][bj][m][0], v1 = acc[ai][bj][m][1];
            float s = (v0[0] * v0[0] + v0[1] * v0[1]) + (v0[2] * v0[2] + v0[3] * v0[3]) + (v1[0] * v1[0] + v1[1] * v1[1]) + (v1[2] * v1[2] + v1[3] * v1[3]);
            s += sx(s, lane, 16); s += sx(s, lane, 32); return s; };
        LAS float* Xw = X + (wr * 64 + fr) * 8 + wc; const LAS float* Xr = X + (wr * 64 + fr) * 8 + (wc ^ 1);
        if (kind == 1) {
#pragma unroll
            for (int ai = 0; ai < 2; ++ai)
#pragma unroll
                for (int m = 0; m < 4; ++m)
#pragma unroll
                    for (int bj = 0; bj < 2; ++bj) { const float s = sumsq(ai, m, bj); if (fq == 0) Xw[(ai * 128 + m * 16) * 8 + bj * 4] = s; }
            asm volatile("s_waitcnt lgkmcnt(0)\n\ts_barrier" ::: "memory");
        }
        const int pxor = kind == 2 ? 16 : 32;
        const bool first = kind == 2 ? !(fq & 1) : (fq < 2);
        auto load_cs = [&](int it, f32x4 (&dst)[4]) {
            int frx = fr; asm volatile("" : "+v"(frx));
            const int row = u.pm * 256 + (it >> 2) * 128 + wr * 64 + (it & 3) * 16 + frx, s_ = row & 2047, prow = s_ >> 6, pcol = s_ & 63;
            const GAS float* tp = kind == 2 ? tab + TAB_T32 + ((fq < 2 ? prow : pcol) * 8) * 2 : tab + TAB_T64 + (((wc & 1) ? pcol : prow) * 16 + 8 * (fq & 1)) * 2;
#pragma unroll
            for (int e2 = 0; e2 < 4; ++e2) dst[e2] = *(const GAS f32x4*)(tp + 4 * e2); };
        f32x4 cs[4], ncs[4];
        if (rope) load_cs(0, cs);
#pragma unroll
        for (int ai = 0; ai < 2; ++ai)
#pragma unroll
            for (int m = 0; m < 4; ++m) {
                int frx = fr; asm volatile("" : "+v"(frx));
                const int rit = ai * 128 + wr * 64 + m * 16 + frx, row = u.pm * 256 + rit;
                GAS bf16_t* rowp = U + (size_t)row * DIN + col0;
                if (rope && ai * 4 + m < 7) load_cs(ai * 4 + m + 1, ncs);
                asm volatile("" ::: "memory");
#pragma unroll
                for (int bj = 0; bj < 2; ++bj) {
                    const f32x4 v0 = acc[ai][bj][m][0], v1 = acc[ai][bj][m][1];
                    float x[8] = {v0[0], v0[1], v0[2], v0[3], v1[0], v1[1], v1[2], v1[3]};
                    if (kind != 0 && bj < nbj) {
                        float ss = sumsq(ai, m, bj);
                        if (kind == 1) ss += Xr[(ai * 128 + m * 16) * 8 + bj * 4];
                        const float rstd = 1.0f / sqrtf(ss * (kind == 2 ? (1.f / 32.f) : (1.f / 64.f)) + EPS);
#pragma unroll
                        for (int e = 0; e < 8; ++e) x[e] = x[e] * rstd * gg[e];
                        if (rope) {
#pragma unroll
                            for (int e2 = 0; e2 < 4; ++e2) {
                                const float pa = sx(x[2 * e2], lane, pxor), pb = sx(x[2 * e2 + 1], lane, pxor);
                                x[2 * e2] = first ? x[2 * e2] * cs[e2].x - pa * cs[e2].y : pa * cs[e2].y + x[2 * e2] * cs[e2].x;
                                x[2 * e2 + 1] = first ? x[2 * e2 + 1] * cs[e2].z - pb * cs[e2].w : pb * cs[e2].w + x[2 * e2 + 1] * cs[e2].z;
                            }
                        }
#pragma unroll
                        for (int e = 0; e < 8; ++e) x[e] *= qs;
                    } else {
#pragma unroll
                        for (int e = 0; e < 8; ++e) x[e] *= vscale;
                    }
                    u32x4 w; w.x = pk2(x[0], x[1]); w.y = pk2(x[2], x[3]); w.z = pk2(x[4], x[5]); w.w = pk2(x[6], x[7]);
                    *(GAS u32x4*)(rowp + bj * 128) = w;
                }
#pragma unroll
                for (int e2 = 0; e2 < 4; ++e2) cs[e2] = ncs[e2];
            }
    }
};
struct EpiResid {
    static constexpr bool PERM = true; static constexpr int NSTORES = 32;
    const GAS float* slat; const GAS float* sctx; GAS bf16_t* XB; const GAS float* gate; bool first; float ascale;
    __device__ __forceinline__ void operator()(const f32x4 (&acc)[2][2][4][2], const pg8::Unit& u, int wr, int wc, int fr, int fq) const {
        const bool islat = u.pm < 256; const int b = islat ? (u.pm >> 3) : 32;
        const GAS float* src = islat ? slat + (size_t)u.pm * 256 * D : sctx + (size_t)(u.pm - 256) * 256 * D;
        GAS bf16_t* dst = XB + (size_t)u.pm * 256 * D;
        const GAS float* gp = gate + (size_t)b * ADA;
        const int col0 = u.pn * 256 + wc * 32 + 8 * fq;
        f32x4 gv[2][2];
#pragma unroll
        for (int bj = 0; bj < 2; ++bj)
#pragma unroll
            for (int n = 0; n < 2; ++n) gv[bj][n] = *(const GAS f32x4*)(gp + col0 + bj * 128 + n * 4) * ascale;
#pragma unroll
        for (int ai = 0; ai < 2; ++ai)
#pragma unroll
            for (int m = 0; m < 4; ++m) { int frx = fr; asm volatile("" : "+v"(frx));
                const size_t ro = (size_t)(ai * 128 + wr * 64 + m * 16 + frx) * D + col0;
#pragma unroll
                for (int bj = 0; bj < 2; ++bj) { f32x4 x0, x1;
                    if (first) { x0 = *(const GAS f32x4*)(src + ro + bj * 128); x1 = *(const GAS f32x4*)(src + ro + bj * 128 + 4); }
                    else { const u32x4 w = *(const GAS u32x4*)(dst + ro + bj * 128); x0 = (f32x4){bflo(w.x), bfhi(w.x), bflo(w.y), bfhi(w.y)}; x1 = (f32x4){bflo(w.z), bfhi(w.z), bflo(w.w), bfhi(w.w)}; }
                    x0 = x0 + gv[bj][0] * acc[ai][bj][m][0]; x1 = x1 + gv[bj][1] * acc[ai][bj][m][1];
                    u32x4 o; o.x = pk2(x0[0], x0[1]); o.y = pk2(x0[2], x0[3]); o.z = pk2(x1[0], x1[1]); o.w = pk2(x1[2], x1[3]);
                    *(GAS u32x4*)(dst + ro + bj * 128) = o; } }
    }
};
struct MoeTab { const LAS int* tcls; const LAS int* trow; const LAS int* ccnt; };
__device__ __forceinline__ void moe_pair(int cls, int& ea, int& eb) { const int g = cls / 6, pr = cls % 6; const int ia = pr < 3 ? 0 : (pr < 5 ? 1 : 2), ib = pr < 3 ? pr + 1 : (pr < 5 ? pr - 1 : 3); ea = 4 * g + ia; eb = 4 * g + ib; }
__device__ __forceinline__ int moe_build_tables(FARGS, int L) {
    LAS int* tcls = (LAS int*)(F.lds + MOE_OFF); LAS int* trow = tcls + 320; LAS int* ccnt = trow + 320; LAS int* pre = ccnt + 32;
    if (F.tid < NCLS) ccnt[F.tid] = (int)__hip_atomic_load(CTL(F) + CW_CNT + (L * NCLS + F.tid) * 64, __ATOMIC_RELAXED, __HIP_MEMORY_SCOPE_AGENT);
    __syncthreads();
    if (F.tid == 0) { int T = 0;
#pragma unroll 1
        for (int c = 0; c < NCLS; ++c) { pre[c] = T; T += (ccnt[c] + 255) >> 8; }
        pre[NCLS] = T; }
    __syncthreads();
    const int T = pre[NCLS];
    if (F.tid < T) { int c = 0;
#pragma unroll 1
        for (int k = 1; k < NCLS; ++k) if (pre[k] <= F.tid) c = k;
        tcls[F.tid] = c; trow[F.tid] = (F.tid - pre[c]) * 256; }
    __syncthreads();
    return __builtin_amdgcn_readfirstlane(T);
}
struct ProbGateUp {
    static constexpr bool GATHER = true;
    const GAS char* A; const GAS char* W1; const GAS int* perm; int K, ldb; size_t hstepA, hstepB; pg8::Order ord; MoeTab tb;
    __device__ __forceinline__ bool next(int i, pg8::Unit& u) const { return ord.next(i, u); }
    template <int NH> __device__ __forceinline__ void a_off(const pg8::Unit& u, int tid, unsigned (&v)[NH][2]) const {
        int R0, C0, R1, C1; pg8::stage_rc(tid * 16, R0, C0); pg8::stage_rc(tid * 16 + 8192, R1, C1);
        const int cls = __builtin_amdgcn_readfirstlane(tb.tcls[u.pm]), tr = __builtin_amdgcn_readfirstlane(tb.trow[u.pm]), n = __builtin_amdgcn_readfirstlane(tb.ccnt[cls]);
        const GAS int* pp = perm + (size_t)cls * MTOT + tr;
#pragma unroll
        for (int h = 0; h < 2; ++h) { const int s0 = h * 128 + R0, s1 = h * 128 + R1;
            const int t0 = (tr + s0 < n) ? pp[s0] : 0, t1 = (tr + s1 < n) ? pp[s1] : 0;
            v[h][0] = (unsigned)(t0 * D + C0) * 2u; v[h][1] = (unsigned)(t1 * D + C1) * 2u; }
    }
    __device__ __forceinline__ const GAS char* b_tile(const pg8::Unit& u, int t) const {
        const int cls = __builtin_amdgcn_readfirstlane(tb.tcls[u.pm]); int ea, eb; moe_pair(cls, ea, eb); const int e = u.pn < 4 ? ea : eb;
        return W1 + (((size_t)e * 1024 + (u.pn & 3) * 256) * D + (size_t)t * 64) * 2;
    }
};
struct EpiGateUp {
    static constexpr bool PERM = true; static constexpr int NSTORES = 16;
    GAS bf16_t* ACT; const GAS int* perm; const GAS float* RW; MoeTab tb;
    __device__ __forceinline__ void operator()(const f32x4 (&acc)[2][2][4][2], const pg8::Unit& u, int wr, int wc, int fr, int fq) const {
        const int cls = __builtin_amdgcn_readfirstlane(tb.tcls[u.pm]), tr = __builtin_amdgcn_readfirstlane(tb.trow[u.pm]), n = __builtin_amdgcn_readfirstlane(tb.ccnt[cls]);
        const GAS int* pp = perm + (size_t)cls * MTOT + tr;
        const int wsel = u.pn >> 2, colb = wsel * 512 + (u.pn & 3) * 128 + wc * 32 + 8 * fq;
#pragma unroll
        for (int ai = 0; ai < 2; ++ai)
#pragma unroll
            for (int m = 0; m < 4; ++m) { int frx = fr; asm volatile("" : "+v"(frx)); const int rr = ai * 128 + wr * 64 + m * 16 + frx; const bool valid = tr + rr < n;
                const int tok = valid ? pp[rr] : 0; const float wgt = valid ? RW[(size_t)tok * 2 + wsel] : 0.f;
                float a[8];
#pragma unroll
                for (int nn = 0; nn < 2; ++nn)
#pragma unroll
                    for (int j = 0; j < 4; ++j) { const float g = acc[ai][0][m][nn][j], uu = acc[ai][1][m][nn][j];
                        a[nn * 4 + j] = g * __builtin_amdgcn_rcpf(1.0f + __builtin_amdgcn_exp2f(-g * LOG2E)) * uu * wgt; }
                u32x4 w; w.x = pk2(a[0], a[1]); w.y = pk2(a[2], a[3]); w.z = pk2(a[4], a[5]); w.w = pk2(a[6], a[7]);
                *(GAS u32x4*)(ACT + (size_t)(u.pm * 256 + rr) * D + colb) = w; }
    }
};
struct ProbDown {
    static constexpr bool GATHER = false;
    const GAS char* A; const GAS char* W2; int K, ldb; size_t hstepA, hstepB; pg8::Order ord; MoeTab tb;
    __device__ __forceinline__ bool next(int i, pg8::Unit& u) const { return ord.next(i, u); }
    template <int NH> __device__ __forceinline__ void a_off(const pg8::Unit& u, int tid, unsigned (&v)[NH][2]) const {
        int R0, C0, R1, C1; pg8::stage_rc(tid * 16, R0, C0); pg8::stage_rc(tid * 16 + 8192, R1, C1);
        v[0][0] = (unsigned)((u.pm * 256 + R0) * D + C0) * 2u; v[0][1] = (unsigned)((u.pm * 256 + R1) * D + C1) * 2u;
    }
    __device__ __forceinline__ const GAS char* b_tile(const pg8::Unit& u, int t) const {
        const int cls = __builtin_amdgcn_readfirstlane(tb.tcls[u.pm]); int ea, eb; moe_pair(cls, ea, eb); const int e = t < 8 ? ea : eb;
        return W2 + (((size_t)e * 1024 + u.pn * 256) * DEXP + (size_t)(t & 7) * 64) * 2;
    }
};
template <bool LAST> struct EpiDown {
    static constexpr bool PERM = true; static constexpr int NSTORES = 0;
    GAS bf16_t* XB; GAS float* out; const GAS float* gate; const GAS int* perm; MoeTab tb;
    __device__ __forceinline__ void operator()(const f32x4 (&acc)[2][2][4][2], const pg8::Unit& u, int wr, int wc, int fr, int fq) const {
        const int cls = __builtin_amdgcn_readfirstlane(tb.tcls[u.pm]), tr = __builtin_amdgcn_readfirstlane(tb.trow[u.pm]), n = __builtin_amdgcn_readfirstlane(tb.ccnt[cls]);
        const GAS int* pp = perm + (size_t)cls * MTOT + tr;
        const int col0 = u.pn * 256 + wc * 32 + 8 * fq;
#pragma unroll
        for (int ai = 0; ai < 2; ++ai)
#pragma unroll
            for (int m = 0; m < 4; ++m) { int frx = fr; asm volatile("" : "+v"(frx)); const int rr = ai * 128 + wr * 64 + m * 16 + frx;
                if (tr + rr < n) { const int tok = pp[rr]; const int b = tok < NLAT ? (tok >> 11) : 32;
                    GAS bf16_t* xr = XB + (size_t)tok * D + col0; const GAS float* gp = gate + (size_t)b * ADA + col0;
#pragma unroll
                    for (int bj = 0; bj < 2; ++bj) { const u32x4 w = *(const GAS u32x4*)(xr + bj * 128);
                        const f32x4 g0 = *(const GAS f32x4*)(gp + bj * 128), g1 = *(const GAS f32x4*)(gp + bj * 128 + 4);
                        const f32x4 x0 = (f32x4){bflo(w.x), bfhi(w.x), bflo(w.y), bfhi(w.y)} + g0 * acc[ai][bj][m][0], x1 = (f32x4){bflo(w.z), bfhi(w.z), bflo(w.w), bfhi(w.w)} + g1 * acc[ai][bj][m][1];
                        if (LAST) { GAS float* op = out + (size_t)tok * D + col0 + bj * 128; *(GAS f32x4*)op = x0; *(GAS f32x4*)(op + 4) = x1; }
                        else { u32x4 o; o.x = pk2(x0[0], x0[1]); o.y = pk2(x0[2], x0[3]); o.z = pk2(x1[0], x1[1]); o.w = pk2(x1[2], x1[3]); *(GAS u32x4*)(xr + bj * 128) = o; } } } }
    }
};

constexpr int NPHASE = 1 + 8 * DEPTH;
__global__ void __launch_bounds__(NWAVES * 64, 2) mk_fwd(Args args) {
    extern __shared__ __attribute__((aligned(16))) unsigned char lds_raw[];
    Frame F;
    F.lds = (LAS unsigned char*)lds_raw;
    volatile LAS unsigned* MISC = (volatile LAS unsigned*)(F.lds + MISC_OFF);
    F.tid = threadIdx.x; F.lane = F.tid & 63; F.wave = __builtin_amdgcn_readfirstlane(F.tid >> 6); F.G = gridDim.x; F.bx = blockIdx.x;
    const bool t0 = F.tid == 0;
    F.ws = (GAS unsigned char*)args.ws; F.out = (GAS float*)args.out; F.ka = (kptr_t)__builtin_amdgcn_kernarg_segment_ptr();
    for (int u = F.tid; u < (LDS_BYTES - MISC_OFF) / 4; u += NWAVES * 64) ((LAS unsigned*)(F.lds + MISC_OFF))[u] = 0u;
    __syncthreads();
    XcdBarrier bar; bar.bar = (unsigned*)(CTL(F) + CW_BAR); bar.x = 0; bar.st = nullptr;
    if (args.use_bar) bar = xcd_barrier_post((unsigned*)(CTL(F) + CW_BAR), MISC + 8, t0);
    const int lo = args.ph_lo, hi = args.ph_hi;
#define IN(k) (lo <= (k) && (k) < hi)
#ifndef MK_BAR_REP
#define MK_BAR_REP 1
#endif
#define SEAM(k) do { if (IN(k) && IN((k) + 1)) { for (int br_ = 0; br_ < MK_BAR_REP; ++br_) { refresh(F); xcd_barrier(bar, F.tid == 0); } } } while (0)
#ifndef MK_PHMASK
#define MK_PHMASK 0x1ff
#endif
#define EN(k) ((MK_PHMASK >> (k)) & 1)
#ifndef MK_SEPARATE_QKPREP
#define MK_SEPARATE_QKPREP 0
#endif
#ifndef MK_DOUBLE
#define MK_DOUBLE -1
#endif
#define REP(k) for (int rep_ = 0; rep_ < ((MK_DOUBLE == (k)) ? 2 : 1); ++rep_)
#define XB_P ((GAS bf16_t*)(F.ws + WS_XB))
#define MOD_P ((const GAS float*)(F.ws + WS_MOD))
    if (EN(0) && IN(0)) { REP(0) prologue_phase(F); SEAM(0); }
    for (int L0 = 0; L0 < DEPTH; ++L0) {
        const int pb = 1 + 8 * L0;
        if (EN(1) && IN(pb + 0)) { int L = L0; OPAQUE_S(L); refresh(F);
            REP(1) norm_phase<false>(F, L, MTOT, L == 0, INP(6) + L * D, 0, 1024); SEAM(pb + 0); }
        if (EN(2) && IN(pb + 1)) { int L = L0; OPAQUE_S(L); refresh(F);
            ProbPlain P; P.A = (const GAS char*)(F.ws + WS_H); P.Bt = (const GAS char*)(F.ws + WS_WIN) + (size_t)L * DIN * D * 2; P.K = D; P.lda = D; P.ldb = D; P.hstepA = (size_t)128 * D * 2; P.hstepB = (size_t)128 * D * 2; P.ord.init(MTOT / 256, DIN / 256, F.G, F.bx);
            EpiQK E; E.U = (GAS bf16_t*)(F.ws + WS_U); E.tab = (const GAS float*)(F.ws + WS_TAB); E.gwin = INP(9) + L * 128; E.gna = INP(10) + L * 128; E.gdiff = INP(11) + L * 64; E.ggqa = INP(12) + L * 128;
            E.X = (LAS float*)(F.lds + MOE_OFF);
            E.vscale = 1.0f;
            REP(2) pg8::gemm_phase<EpiQK, ProbPlain>(F.lds, P, E, F.tid);
            SEAM(pb + 1);
        }
        if (MK_SEPARATE_QKPREP && EN(3) && IN(pb + 2)) { REP(3) qkprep_phase(F, L0, (MK_DOUBLE != 3) || rep_ == 1 || args.pad != 0); SEAM(pb + 2); }
        if (EN(4) && IN(pb + 3)) { REP(4) attn_phase(F, L0, L0 < DEPTH - 1); SEAM(pb + 3); }
        if (EN(5) && IN(pb + 4)) { int L = L0; OPAQUE_S(L); refresh(F);
            const int M2 = L < DEPTH - 1 ? MTOT : NLAT;
            ProbPlain P; P.A = (const GAS char*)(F.ws + WS_Y); P.Bt = (const GAS char*)(F.ws + WS_WOUT) + (size_t)L * D * D * 2; P.K = D; P.lda = D; P.ldb = D; P.hstepA = (size_t)128 * D * 2; P.hstepB = (size_t)128 * D * 2; P.ord.init(M2 / 256, D / 256, F.G, F.bx);
            EpiResid E; E.slat = INP(0); E.sctx = INP(2); E.XB = XB_P; E.first = L == 0; E.gate = MOD_P + (size_t)L * 33 * ADA + 2 * 1024;
#ifdef MK_PROBE_K2
            P.K = 2 * D; E.ascale = 0.5f;
#else
            E.ascale = 1.0f;
#endif
            pg8::gemm_phase<EpiResid, ProbPlain>(F.lds, P, E, F.tid);
            SEAM(pb + 4);
        }
        if (EN(6) && IN(pb + 5)) { int L = L0; OPAQUE_S(L); refresh(F);
#ifdef MK_OLD_NORM2
            REP(6) norm_phase<true>(F, L, L < DEPTH - 1 ? MTOT : NLAT, false, INP(7) + L * D, 3 * 1024, 4 * 1024, (MK_DOUBLE != 6) || rep_ == 1 || args.pad != 0); SEAM(pb + 5); }
#else
            norm2_phase(F, L, L < DEPTH - 1 ? MTOT : NLAT); SEAM(pb + 5); }
#endif
        if (EN(7) && IN(pb + 6)) { int L = L0; OPAQUE_S(L); refresh(F);
            const int T = moe_build_tables(F, L);
            MoeTab tb; tb.tcls = (const LAS int*)(F.lds + MOE_OFF); tb.trow = tb.tcls + 320; tb.ccnt = tb.trow + 320;
            ProbGateUp P; P.A = (const GAS char*)(F.ws + WS_H); P.W1 = (const GAS char*)(F.ws + WS_W1) + (size_t)L * NEXP * 1024 * D * 2; P.perm = (const GAS int*)(F.ws + WS_PERM); P.K = D; P.ldb = D; P.hstepA = 0; P.hstepB = (size_t)128 * D * 2; P.ord.init(T, 8, F.G, F.bx); P.tb = tb;
            EpiGateUp E; E.ACT = (GAS bf16_t*)(F.ws + WS_ACT); E.perm = P.perm; E.RW = (const GAS float*)(F.ws + WS_RW); E.tb = tb;
            REP(7) pg8::gemm_phase<EpiGateUp, ProbGateUp>(F.lds, P, E, F.tid);
            SEAM(pb + 6);
        }
        if (EN(8) && IN(pb + 7)) { int L = L0; OPAQUE_S(L); refresh(F);
            const int T = moe_build_tables(F, L);
            MoeTab tb; tb.tcls = (const LAS int*)(F.lds + MOE_OFF); tb.trow = tb.tcls + 320; tb.ccnt = tb.trow + 320;
            ProbDown P; P.A = (const GAS char*)(F.ws + WS_ACT); P.W2 = (const GAS char*)(F.ws + WS_W2) + (size_t)L * NEXP * 1024 * DEXP * 2; P.K = D; P.ldb = DEXP; P.hstepA = (size_t)128 * D * 2; P.hstepB = (size_t)128 * DEXP * 2; P.ord.init(T, 4, F.G, F.bx); P.tb = tb;
            if (L < DEPTH - 1) { EpiDown<false> E; E.XB = XB_P; E.out = F.out; E.gate = MOD_P + (size_t)L * 33 * ADA + 5 * 1024; E.perm = (const GAS int*)(F.ws + WS_PERM); E.tb = tb;
                pg8::gemm_phase<EpiDown<false>, ProbDown>(F.lds, P, E, F.tid); }
            else { EpiDown<true> E; E.XB = XB_P; E.out = F.out; E.gate = MOD_P + (size_t)L * 33 * ADA + 5 * 1024; E.perm = (const GAS int*)(F.ws + WS_PERM); E.tb = tb;
                pg8::gemm_phase<EpiDown<true>, ProbDown>(F.lds, P, E, F.tid); }
            SEAM(pb + 7);
        }
    }
#undef IN
#undef SEAM
}

#ifndef MK_PER_PHASE
#define MK_PER_PHASE 0
#endif
extern "C" void kernel_launch(void* const* d_in, const int* in_sizes, int n_in, void* d_out, int out_size, void* d_ws, size_t ws_size, hipStream_t stream) {
    static int grid = 0;
    if (grid == 0) {
        if (n_in != 23 || out_size != NLAT * D || ws_size < WS_END) { fprintf(stderr, "kernel_launch: unexpected shapes (n_in %d out %d ws %zu)\n", n_in, out_size, ws_size); grid = -1; return; }
        int dev = 0, cus = 0, per_cu = 0;
        if (hipGetDevice(&dev) != hipSuccess || hipDeviceGetAttribute(&cus, hipDeviceAttributeMultiprocessorCount, dev) != hipSuccess) { grid = -1; return; }
        if (hipFuncSetAttribute((const void*)mk_fwd, hipFuncAttributeMaxDynamicSharedMemorySize, LDS_BYTES) != hipSuccess) { fprintf(stderr, "kernel_launch: hipFuncSetAttribute failed\n"); grid = -1; return; }
        if (hipOccupancyMaxActiveBlocksPerMultiprocessor(&per_cu, (const void*)mk_fwd, NWAVES * 64, LDS_BYTES) != hipSuccess || per_cu < 1) fprintf(stderr, "kernel_launch: occupancy query reports %d\n", per_cu);
        (void)hipGetLastError();
        grid = cus;
    }
    if (grid < 0) return;
    (void)hipMemsetAsync((char*)d_ws + WS_CTL, 0, CTL_ZERO_BYTES, stream);
    Args a{};
    for (int i = 0; i < 23; ++i) a.in[i] = (const float*)d_in[i];
    a.out = (float*)d_out; a.ws = (unsigned char*)d_ws; a.pad = 0;
#if MK_PER_PHASE
    for (int p = 0; p < NPHASE; ++p) { a.ph_lo = p; a.ph_hi = p + 1; a.use_bar = 0; hipLaunchKernelGGL(mk_fwd, dim3(grid), dim3(NWAVES * 64), LDS_BYTES, stream, a); }
#else
    a.ph_lo = 0; a.ph_hi = NPHASE; a.use_bar = 1;
    hipLaunchKernelGGL(mk_fwd, dim3(grid), dim3(NWAVES * 64), LDS_BYTES, stream, a);
#endif
}
```

```cpp
#include <hip/hip_runtime.h>
#include <cstdio>
#include <cstdint>
#define GAS __attribute__((address_space(1)))
#define MK_ILV 15
#define XB_TMO      128
#define XB_XCNT(j)  (256  + 64 * (j))
#define XB_XSUB(j)  (1280 + 64 * (j))
#define XB_XGEN(j)  (2304 + 64 * (j))
#define XB_TOP      3328
#define XB_TOPGEN   3392
#define XCD_BAR_WORDS 3456
#define XB_SPIN_CAP (1u << 18)
#define LAS __attribute__((address_space(3)))

__device__ __forceinline__ unsigned xb_ld(unsigned* p)              { return __hip_atomic_load(p, __ATOMIC_RELAXED, __HIP_MEMORY_SCOPE_AGENT); }
__device__ __forceinline__ unsigned xb_add(unsigned* p, unsigned v) { return __hip_atomic_fetch_add(p, v, __ATOMIC_RELAXED, __HIP_MEMORY_SCOPE_AGENT); }
__device__ __forceinline__ unsigned xb_xcc_id() { return (unsigned)__builtin_amdgcn_s_getreg((3 << 11) | 20) & 0xFu; }
#define XB_SPIN(cond, bar) do { unsigned _sp = 0; while (cond) { __builtin_amdgcn_s_sleep(1); \
    if ((++_sp & 255u) == 0u) { if (xb_ld(&(bar)[XB_TMO])) break; if (_sp > XB_SPIN_CAP) { atomicAdd(&(bar)[XB_TMO], 1u); break; } } } } while (0)

struct XcdBarrier {
    unsigned* bar; unsigned x;
    volatile LAS unsigned* st;
};

__device__ __forceinline__ XcdBarrier xcd_barrier_post(unsigned* bar, volatile LAS unsigned* st, bool t0  ) {
    XcdBarrier b; b.bar = bar; b.x = xb_xcc_id(); b.st = st;
    if (t0) (void)xb_add(&bar[XB_XCNT(b.x)], 1u);
    return b;
}
__device__ __forceinline__ void xcd_barrier_complete(unsigned* bar, unsigned x, unsigned& nloc, unsigned& nx) {
    const unsigned G = gridDim.x * gridDim.y * gridDim.z;
    unsigned sum, cnt, mine, sp = 0u;
    for (;;) {
        sum = 0u; cnt = 0u; mine = 0u;
#pragma unroll
        for (unsigned j = 0; j < 16; ++j) { const unsigned c = xb_ld(&bar[XB_XCNT(j)]); sum += c; cnt += (c > 0u) ? 1u : 0u; mine = (j == x) ? c : mine; }
        if (sum == G) break;
        __builtin_amdgcn_s_sleep(1);
        if ((++sp & 255u) == 0u) { if (xb_ld(&bar[XB_TMO])) break; if (sp > XB_SPIN_CAP) { atomicAdd(&bar[XB_TMO], 1u); break; } }
    }
    nloc = mine > 0u ? mine : 1u; nx = cnt > 0u ? cnt : 1u;
}

__device__ __forceinline__ void xcd_barrier(const XcdBarrier& b, bool t0  ) {
    asm volatile("s_waitcnt vmcnt(0)" ::: "memory");
    __syncthreads();
    if (t0) {
        unsigned* bar = b.bar;
        __builtin_amdgcn_s_waitcnt(0);
        unsigned nloc = b.st[0], nx = b.st[1];
        if (nloc == 0u) { xcd_barrier_complete(bar, b.x, nloc, nx); b.st[0] = nloc; b.st[1] = nx; }
        const unsigned old = xb_add(&bar[XB_XSUB(b.x)], 1u);
        const unsigned gen = old / nloc;
        if (old + 1u == (gen + 1u) * nloc) {
            __builtin_amdgcn_fence(__ATOMIC_RELEASE, "agent");
            asm volatile("s_waitcnt vmcnt(0)" ::: "memory");
            const unsigned og = xb_add(&bar[XB_TOP], 1u);
            const unsigned tg = og / nx;
            if (og + 1u == (tg + 1u) * nx) xb_add(&bar[XB_TOPGEN], 1u);
            else XB_SPIN(xb_ld(&bar[XB_TOPGEN]) == tg, bar);
            __builtin_amdgcn_fence(__ATOMIC_ACQUIRE, "agent");
            xb_add(&bar[XB_XGEN(b.x)], 1u);
            asm volatile("s_waitcnt vmcnt(0)" ::: "memory");
        } else {
            XB_SPIN(xb_ld(&bar[XB_XGEN(b.x)]) == gen, bar);
            __builtin_amdgcn_fence(__ATOMIC_ACQUIRE, "agent");
            asm volatile("s_waitcnt vmcnt(0)" ::: "memory");
        }
    }
    __syncthreads();
}
constexpr int D = 1024, NBATCH = 32, SEQ = 2048, DEPTH = 4, CTXL = 256, NLAT = NBATCH * SEQ, NCTX = NBATCH * CTXL, MTOT = NLAT + NCTX, DIN = 2560;
constexpr int NEXP = 16, DEXP = 512, NCLS = 24, ADA = 6 * D;
constexpr float EPS = 1e-6f, LOG2E = 1.4426950408889634f;
constexpr int QA = 0, KA = 256, VA = 384, QB = 512, KB = 768, VB = 1024, QC = 1280, KC = 1536, VC = 1792, QD = 2048, KD = 2304, VD = 2432;
constexpr size_t MiB = 1u << 20;
constexpr size_t WS_CTL = 0, CTL_ZERO_BYTES = 128 * 1024;
constexpr size_t WS_MOD = 1 * MiB;
constexpr size_t WS_TAB = 4 * MiB + 256 * 1024;
constexpr size_t WS_RW = 4 * MiB + 320 * 1024;
constexpr size_t WS_PERM = 5 * MiB;
constexpr size_t WS_WIN = 12 * MiB;
constexpr size_t WS_WOUT = 32 * MiB;
constexpr size_t WS_W1 = 40 * MiB;
constexpr size_t WS_W2 = 168 * MiB;
constexpr size_t WS_XB = 232 * MiB;
constexpr size_t WS_Y = 376 * MiB;
constexpr size_t WS_U = 520 * MiB;
constexpr size_t WS_ACT = WS_U;
constexpr size_t WS_H = 880 * MiB;
constexpr size_t WS_END = 1024 * MiB;
static_assert(WS_MOD + (size_t)DEPTH * 33 * 6144 * 4 <= WS_TAB && WS_RW + (size_t)MTOT * 8 <= WS_PERM && WS_PERM + (size_t)NCLS * MTOT * 4 <= WS_WIN, "ws map");
constexpr int CW_BAR = 4096;
constexpr int CW_CNT = 16384;
static_assert((CW_CNT + DEPTH * NCLS * 64) * 4 <= (int)CTL_ZERO_BYTES && (CW_BAR + 3456) <= CW_CNT, "ctl");
constexpr int TAB_T64 = 0;
constexpr int TAB_T32 = 2048;
constexpr int TAB_LAM = 3072;
constexpr int NWAVES = 8;
constexpr int LDS_BYTES = 159744;
constexpr int RING_BYTES = 131072;
constexpr int MOE_OFF = 131072;
constexpr int NRM_OFF = 134144;
constexpr int MISC_OFF = 155648;
constexpr int AT_BUFB = 70656, AT_VOFF = 33792, AT_RPB = 141312, AT_GSS = 148992;

typedef unsigned short bf16_t;
typedef short bf16x8 __attribute__((ext_vector_type(8)));
typedef short s16x4 __attribute__((ext_vector_type(4)));
typedef float f32x4 __attribute__((ext_vector_type(4)));
typedef float f32x2 __attribute__((ext_vector_type(2)));
typedef float f32x16 __attribute__((ext_vector_type(16)));
typedef unsigned u32x4 __attribute__((ext_vector_type(4)));
typedef unsigned u32x2 __attribute__((ext_vector_type(2)));
typedef __bf16 bf16x2_t __attribute__((ext_vector_type(2)));

__device__ __forceinline__ unsigned pk2(float lo, float hi) { f32x2 v = {lo, hi}; bf16x2_t b = __builtin_convertvector(v, bf16x2_t); return __builtin_bit_cast(unsigned, b); }
__device__ __forceinline__ float bflo(unsigned w) { return __uint_as_float(w << 16); }
__device__ __forceinline__ float bfhi(unsigned w) { return __uint_as_float(w & 0xffff0000u); }
__device__ __forceinline__ float sx(float v, int lane, int m) { return __int_as_float(__builtin_amdgcn_ds_bpermute((lane ^ m) << 2, __float_as_int(v))); }
__device__ __forceinline__ float x32_sum(float v) { auto rr = __builtin_amdgcn_permlane32_swap(__float_as_uint(v), __float_as_uint(v), false, false); return __uint_as_float(rr[0]) + __uint_as_float(rr[1]); }
__device__ __forceinline__ float x32_max(float v) { auto rr = __builtin_amdgcn_permlane32_swap(__float_as_uint(v), __float_as_uint(v), false, false); return fmaxf(__uint_as_float(rr[0]), __uint_as_float(rr[1])); }
__device__ __forceinline__ float swap32(float v, bool upper_half) { auto rr = __builtin_amdgcn_permlane32_swap(__float_as_uint(v), __float_as_uint(v), false, false); return __uint_as_float(upper_half ? rr[0] : rr[1]); }
__device__ __forceinline__ float wave_sum(float v, int lane) {
#pragma unroll
    for (int o = 1; o < 32; o <<= 1) v += sx(v, lane, o);
    return x32_sum(v);
}
#define LDS_WAIT() asm volatile("s_waitcnt lgkmcnt(0)" ::: "memory")
#define WG_BAR() asm volatile("s_waitcnt lgkmcnt(0)\n\ts_barrier" ::: "memory")

struct Args { const float* in[23]; float* out; unsigned char* ws; int ph_lo, ph_hi, use_bar, pad; };
typedef __attribute__((address_space(4))) const unsigned char* kptr_t;
struct Frame {
    LAS unsigned char* lds;
    GAS unsigned char* ws;
    GAS float* out;
    kptr_t ka;
    int tid, lane, wave, G, bx;
};
#define FARGS Frame& F
typedef const GAS float* cfp_t;
__device__ __forceinline__ const GAS float* inp(const Frame& F, int i) { return *(__attribute__((address_space(4))) const cfp_t*)(F.ka + 8 * i); }
#define INP(i) inp(F, (i))
#define CTL(F) ((GAS unsigned*)((F).ws + WS_CTL))
__device__ __forceinline__ void refresh(Frame& F) {
    unsigned z = 0u; asm volatile("" : "+v"(z));
    const int ln = (int)__builtin_amdgcn_mbcnt_hi(~0u, __builtin_amdgcn_mbcnt_lo(~0u, z));
    F.lane = ln; F.tid = F.wave * 64 + ln;
    asm volatile("" : "+s"(F.ws)); asm volatile("" : "+s"(F.out)); asm volatile("" : "+s"(F.ka));
}
#define OPAQUE_S(x) asm volatile("" : "+s"(x))
namespace pg8 {
#define PG8_LAS __attribute__((address_space(3)))
#define PG8_GAS __attribute__((address_space(1)))
typedef unsigned short bf16_t;
typedef short bf16x8 __attribute__((ext_vector_type(8)));
typedef float f32x4 __attribute__((ext_vector_type(4)));
typedef unsigned u32x4 __attribute__((ext_vector_type(4)));
#ifndef MK_WGM
#define MK_WGM 8
#endif
constexpr int BM = 256, BK = 64, HALF = 128, HTB = HALF * BK * 2, STAGE_BYTES = 8 * HTB, NXCD = 8, WGM = MK_WGM;

__host__ __device__ __forceinline__ int lds_byte(int r, int c) { const int st = (r >> 4) * 2 + (c >> 5), rr = r & 15, cc = c & 31, ob = rr * 64 + cc * 2; return st * 1024 + (ob ^ (((ob >> 9) & 1) << 5)); }
__host__ __device__ __forceinline__ void stage_rc(int b, int& R, int& C) { const int st = b / 1024, sb = b % 1024, swz = sb ^ (((sb >> 9) & 1) << 5); R = (st >> 1) * 16 + swz / 64; C = (st & 1) * 32 + (swz % 64) / 2; }
__host__ __device__ __forceinline__ int perm32(int rho) { const int n = rho >> 4, i = rho & 15; return 8 * (i >> 2) + 4 * n + (i & 3); }

struct Unit { int pm, pn; };

struct Order {
    int nM, nN, nwg, G, c;
    __device__ __forceinline__ void init(int nM_, int nN_, int G_, int c_) { nM = nM_; nN = nN_; nwg = nM * nN; G = G_; c = c_; }
    __device__ __forceinline__ bool next(int i, Unit& u) const {
        const long L = (long)i * G + c; if (L >= nwg) return false;
        int wgid = (int)L; { const int q = nwg / NXCD, r = nwg % NXCD, xcd = wgid % NXCD, off = wgid / NXCD; wgid = (xcd < r ? xcd * (q + 1) : r * (q + 1) + (xcd - r) * q) + off; }
        const int nig = WGM * nN, gid = wgid / nig, fm = gid * WGM, gsz = (nM - fm) < WGM ? (nM - fm) : WGM;
        u.pm = __builtin_amdgcn_readfirstlane(fm + ((wgid % nig) % gsz)); u.pn = __builtin_amdgcn_readfirstlane((wgid % nig) / gsz); return true;
    }
};

__device__ __forceinline__ unsigned cvt_pk_bf16(float lo, float hi) { unsigned r; asm volatile("v_cvt_pk_bf16_f32 %0, %1, %2" : "=v"(r) : "v"(lo), "v"(hi)); return r; }

template <class Epi, class Prob>
__device__ __forceinline__ void gemm_phase(PG8_LAS unsigned char* lds, const Prob& P, const Epi& E, int tid) {
    const int wid = __builtin_amdgcn_readfirstlane(tid >> 6), lane = tid & 63, wr = wid >> 2, wc = wid & 3, fr = lane & 15, fq = lane >> 4;
    const int nt = P.K / BK;
#ifndef MK_EPISTAG
#define MK_EPISTAG 0
#endif
#ifndef MK_EPISTAG_CYC
#define MK_EPISTAG_CYC 50000
#endif
    if (MK_EPISTAG) {
        const int nwg_ = P.ord.nwg, G_ = P.ord.G, c_ = P.ord.c, cmax = (nwg_ + G_ - 1) / G_, cnt = c_ < nwg_ ? (nwg_ - c_ + G_ - 1) / G_ : 0, nfull = nwg_ - (cmax - 1) * G_;
        if (cnt < cmax && cnt > 0) {
            const int nslack = G_ - nfull, parts = nslack >= 3 * nfull ? 3 : (nslack >= nfull ? 1 : 0);
            if (parts > 0) {
                const unsigned delay = (unsigned)(MK_EPISTAG_CYC / (parts + 1)) * (unsigned)(1 + (c_ - nfull) % parts);
                const unsigned t0_ = (unsigned)__builtin_amdgcn_s_memtime();
                while ((unsigned)__builtin_amdgcn_s_memtime() - t0_ < delay) __builtin_amdgcn_s_sleep(16);
            }
        }
    }
    unsigned voffB[2];
    { int R0, C0, R1, C1; stage_rc(tid * 16, R0, C0); stage_rc(tid * 16 + 8192, R1, C1); const int Rb0 = Epi::PERM ? ((R0 & ~31) + perm32(R0 & 31)) : R0, Rb1 = Epi::PERM ? ((R1 & ~31) + perm32(R1 & 31)) : R1;
      voffB[0] = (unsigned)(Rb0 * P.ldb + C0) * 2u; voffB[1] = (unsigned)(Rb1 * P.ldb + C1) * 2u; }
    const size_t hstepB = P.hstepB;
    const unsigned ldsw = (unsigned)wid * 1024u;
    const int aoff = lds_byte(wr * 64 + fr, fq * 8), boff = lds_byte(wc * 32 + fr, fq * 8);
#define PG8_SA(b, h) (((b) * 2 + (h)) * HTB)
#define PG8_SB(b, h) ((4 + (b) * 2 + (h)) * HTB)
#define PG8_STAGE(bufoff, gbase, voff) do { _Pragma("unroll") for (int _i = 0; _i < 2; ++_i) \
        __builtin_amdgcn_global_load_lds((const PG8_GAS unsigned*)((const PG8_GAS char*)(gbase) + (voff)[_i]), (PG8_LAS unsigned*)(lds + (bufoff) + ldsw + _i * 8192), 16, 0, 0); } while (0)
#define PG8_LDA(dst, b, h) do { _Pragma("unroll") for (int m = 0; m < 4; ++m) _Pragma("unroll") for (int k = 0; k < 2; ++k) dst[m][k] = *(const PG8_LAS bf16x8*)(lds + PG8_SA(b, h) + aoff + m * 2048 + k * 1024); } while (0)
#define PG8_LDB(dst, b, h) do { _Pragma("unroll") for (int n = 0; n < 2; ++n) _Pragma("unroll") for (int k = 0; k < 2; ++k) dst[n][k] = *(const PG8_LAS bf16x8*)(lds + PG8_SB(b, h) + boff + n * 2048 + k * 1024); } while (0)
#define PG8_MMA(ai, bj, At, Bt) do { __builtin_amdgcn_s_setprio(1); _Pragma("unroll") for (int m = 0; m < 4; ++m) _Pragma("unroll") for (int n = 0; n < 2; ++n) _Pragma("unroll") for (int k = 0; k < 2; ++k) \
        acc[ai][bj][m][n] = __builtin_amdgcn_mfma_f32_16x16x32_bf16(Bt[n][k], At[m][k], acc[ai][bj][m][n], 0, 0, 0); __builtin_amdgcn_s_setprio(0); } while (0)
#define PG8_WAIT_V(n) asm volatile("s_waitcnt vmcnt(" #n ")" ::: "memory")
#define PG8_WAIT_L(n) asm volatile("s_waitcnt lgkmcnt(" #n ")" ::: "memory")
#define PG8_BAR __builtin_amdgcn_s_barrier()
#define PG8_SCHED __builtin_amdgcn_sched_barrier(0)
    Unit cur, nxt; int ui = 0;
    if (!P.next(0, cur)) return;
    float zf = 0.f; asm volatile("" : "+v"(zf));
    f32x4 acc[2][2][4][2];
#pragma unroll
    for (int a = 0; a < 2; ++a)
#pragma unroll
        for (int b = 0; b < 2; ++b)
#pragma unroll
            for (int m = 0; m < 4; ++m)
#pragma unroll
                for (int n = 0; n < 2; ++n) acc[a][b][m][n] = (f32x4){zf, zf, zf, zf};
    bf16x8 At[4][2], B0[2][2], B1[2][2];
    constexpr int NH = Prob::GATHER ? 2 : 1;
    unsigned voC[NH][2];
    P.template a_off<NH>(cur, tid, voC);
    const PG8_GAS char* const Ab = P.A;
    const size_t hstepA = Prob::GATHER ? (size_t)0 : P.hstepA;
#define PG8_STAGE_A(bufoff, h, kbyte, VO) PG8_STAGE(bufoff, Ab + (kbyte) + ((h) ? hstepA : (size_t)0), VO[Prob::GATHER ? (h) : 0])
    { const PG8_GAS char* b0 = P.b_tile(cur, 0); const PG8_GAS char* b1 = P.b_tile(cur, 1);
      PG8_STAGE(PG8_SB(0, 0), b0, voffB); PG8_STAGE(PG8_SB(0, 1), b0 + hstepB, voffB); PG8_STAGE_A(PG8_SA(0, 0), 0, (size_t)0, voC); PG8_STAGE_A(PG8_SA(0, 1), 1, (size_t)0, voC);
      if (wr == 1) PG8_BAR;
      PG8_WAIT_V(2); PG8_BAR;
      PG8_STAGE(PG8_SB(1, 0), b1, voffB); PG8_STAGE_A(PG8_SA(1, 0), 0, (size_t)128, voC); PG8_STAGE(PG8_SB(1, 1), b1 + hstepB, voffB);
      PG8_WAIT_V(6); PG8_BAR; }
#ifdef MK_GSTAMP
#define GSEG(k) do { if (Epi::SID == MK_GSTAMP) { __builtin_amdgcn_sched_barrier(0); const unsigned now_ = (unsigned)__builtin_amdgcn_s_memtime(); __builtin_amdgcn_sched_barrier(0); \
    if (tid == MK_GSTAMP_TID) { PG8_LAS unsigned* m_ = (PG8_LAS unsigned*)(lds + MISC_OFF); if ((k) == MK_GSTAMP_SEG || MK_GSTAMP_SEG == 9) m_[16] += now_ - m_[18]; m_[18] = now_; if ((k) == 2) m_[17] += 1; } } } while (0)
    if (Epi::SID == MK_GSTAMP) { const unsigned now_ = (unsigned)__builtin_amdgcn_s_memtime(); if (tid == MK_GSTAMP_TID) ((PG8_LAS unsigned*)(lds + MISC_OFF))[18] = now_; }
#else
#define GSEG(k) do {} while (0)
#endif
    for (;;) {
        const bool has_next = P.next(ui + 1, nxt);
        if (!has_next) nxt = cur;
        for (int t = 0; t < nt; t += 2) {
            const bool last = (t == nt - 2);
            const size_t k1 = (size_t)(t + 1) * 128, k2 = last ? (size_t)0 : (size_t)(t + 2) * 128, k3 = k2 + 128;
            const PG8_GAS char* b2 = last ? P.b_tile(nxt, 0) : P.b_tile(cur, t + 2);
            const PG8_GAS char* b3 = last ? P.b_tile(nxt, 1) : P.b_tile(cur, t + 3);
#ifndef MK_RELAX
#define MK_RELAX 0
#endif
            int fz_ = __builtin_amdgcn_readfirstlane((MK_RELAX && (t == 0) && (ui > 0)) ? 1 : 0); asm volatile("" : "+s"(fz_));
            const bool fresh = fz_ != 0;
#define PG8_WAIT_VR() do { if (fresh) { if constexpr (Epi::NSTORES == 32) PG8_WAIT_V(40); else if constexpr (Epi::NSTORES == 16) PG8_WAIT_V(24); else PG8_WAIT_V(8); } else PG8_WAIT_V(8); } while (0)
            PG8_LDB(B0, 0, 0); PG8_LDB(B1, 0, 1); PG8_SCHED; PG8_LDA(At, 0, 0); if (!fresh) PG8_STAGE_A(PG8_SA(1, 1), 1, k1, voC);
            PG8_WAIT_VR(); PG8_WAIT_L(0); PG8_BAR; PG8_MMA(0, 0, At, B0); PG8_MMA(0, 1, At, B1); PG8_BAR; PG8_SCHED;
            if (last) {
                P.template a_off<NH>(nxt, tid, voC);
            }
            PG8_LDA(At, 0, 1); PG8_STAGE(PG8_SB(0, 0), b2, voffB); PG8_STAGE(PG8_SB(0, 1), b2 + hstepB, voffB); PG8_STAGE_A(PG8_SA(0, 0), 0, k2, voC);
            PG8_WAIT_VR(); PG8_WAIT_L(0); PG8_BAR; PG8_MMA(1, 0, At, B0); PG8_MMA(1, 1, At, B1); PG8_BAR; PG8_SCHED;
            PG8_LDB(B0, 1, 0); PG8_LDB(B1, 1, 1); PG8_SCHED; PG8_LDA(At, 1, 0); PG8_STAGE_A(PG8_SA(0, 1), 1, k2, voC);
            PG8_WAIT_VR(); PG8_WAIT_L(0); PG8_BAR; PG8_MMA(0, 0, At, B0); PG8_MMA(0, 1, At, B1); PG8_BAR; PG8_SCHED;
            PG8_LDA(At, 1, 1); PG8_STAGE(PG8_SB(1, 0), b3, voffB); PG8_STAGE(PG8_SB(1, 1), b3 + hstepB, voffB); PG8_STAGE_A(PG8_SA(1, 0), 0, k3, voC);
            PG8_WAIT_V(8); PG8_WAIT_L(0); PG8_BAR; PG8_MMA(1, 0, At, B0); PG8_MMA(1, 1, At, B1); PG8_BAR; PG8_SCHED;
        }
        if (MK_RELAX) PG8_STAGE_A(PG8_SA(1, 1), 1, (size_t)128, voC);
#ifndef MK_ALIGN
#define MK_ALIGN 1
#endif
        GSEG(0);
        if (MK_ALIGN && wr == 0) PG8_BAR;
        { Unit eu = cur; asm volatile("" : "+s"(eu.pm), "+s"(eu.pn));
          GSEG(1);
          E(acc, eu, wr, wc, fr, fq); }
        GSEG(2);
        if (!has_next) break;
#pragma unroll
        for (int a = 0; a < 2; ++a)
#pragma unroll
            for (int b = 0; b < 2; ++b)
#pragma unroll
                for (int m = 0; m < 4; ++m)
#pragma unroll
                    for (int n = 0; n < 2; ++n) acc[a][b][m][n] = (f32x4){zf, zf, zf, zf};
        cur = nxt; ++ui;
        if (MK_ALIGN && wr == 1) PG8_BAR;
    }
    PG8_WAIT_V(0);
    if (!MK_ALIGN && wr == 0) PG8_BAR;
    PG8_BAR;
#undef PG8_SA
#undef PG8_SB
#undef PG8_STAGE
#undef PG8_STAGE_A
#undef PG8_WAIT_VR
#undef PG8_LDA
#undef PG8_LDB
#undef PG8_MMA
#undef PG8_WAIT_V
#undef PG8_WAIT_L
#undef PG8_BAR
#undef PG8_SCHED
}
}
__device__ __forceinline__ void transpose_item(const GAS float* W, int N, int k0, int n0, GAS bf16_t* dst, int ldd, const GAS float* kscale, LAS float* scr, int lane) {
    const int kq = lane >> 4, n4 = (lane & 15) * 4;
#pragma unroll
    for (int i = 0; i < 16; ++i) { const int kk = 4 * i + kq; f32x4 v = *(const GAS f32x4*)(W + (size_t)(k0 + kk) * N + n0 + n4); if (kscale) v = v * kscale[k0 + kk];
        LAS float* p = scr + kk * 65 + n4; p[0] = v.x; p[1] = v.y; p[2] = v.z; p[3] = v.w; }
    LDS_WAIT(); asm volatile("" ::: "memory");
    const int c = lane & 7;
#pragma unroll
    for (int j = 0; j < 8; ++j) { const int n = (lane >> 3) + 8 * j; const LAS float* s = scr + (8 * c) * 65 + n;
        u32x4 o; o.x = pk2(s[0 * 65], s[1 * 65]); o.y = pk2(s[2 * 65], s[3 * 65]); o.z = pk2(s[4 * 65], s[5 * 65]); o.w = pk2(s[6 * 65], s[7 * 65]);
        *(GAS u32x4*)(dst + (size_t)n * ldd + k0 + 8 * c) = o; }
    LDS_WAIT(); asm volatile("" ::: "memory");
}

__device__ __forceinline__ void ada_unit(FARGS, int unit) {
    const GAS float* c = INP(1); const GAS float* c_ctx = INP(3); const GAS float* ada_w = INP(4); const GAS float* ada_b = INP(5);
    GAS float* mod = (GAS float*)(F.ws + WS_MOD);
    LAS float* S = (LAS float*)F.lds;
    const int L = unit / 48, cb = unit % 48, tid = F.tid;
    for (int i = tid; i < 33 * 1024; i += 512) { const int r = i >> 10, k = i & 1023; const float v = (r < 32) ? c[r * 1024 + k] : c_ctx[k]; S[i] = v / (1.f + expf(-v)); }
    __syncthreads();
    const int cq = tid & 31, kg = tid >> 5;
    f32x4 acc[33];
#pragma unroll
    for (int r = 0; r < 33; ++r) acc[r] = (f32x4){0.f, 0.f, 0.f, 0.f};
    const GAS float* wp = ada_w + ((size_t)L * 1024 + kg * 64) * ADA + cb * 128 + 4 * cq;
#pragma unroll 2
    for (int k4 = 0; k4 < 16; ++k4) {
        const f32x4 w0 = *(const GAS f32x4*)(wp + (size_t)(k4 * 4 + 0) * ADA), w1 = *(const GAS f32x4*)(wp + (size_t)(k4 * 4 + 1) * ADA), w2 = *(const GAS f32x4*)(wp + (size_t)(k4 * 4 + 2) * ADA), w3 = *(const GAS f32x4*)(wp + (size_t)(k4 * 4 + 3) * ADA);
        const LAS f32x4* sp = (const LAS f32x4*)(S + kg * 64 + k4 * 4);
#pragma unroll
        for (int r = 0; r < 33; ++r) { const f32x4 s4 = sp[r * 256]; acc[r] = acc[r] + (w0 * s4.x + w1 * s4.y) + (w2 * s4.z + w3 * s4.w); }
    }
    __syncthreads();
    LAS float* R = S;
    { const int w = F.wave;
#pragma unroll
      for (int r = 0; r < 33; ++r) { f32x4 v; v.x = x32_sum(acc[r].x); v.y = x32_sum(acc[r].y); v.z = x32_sum(acc[r].z); v.w = x32_sum(acc[r].w);
          if (F.lane < 32) *(LAS f32x4*)(R + (w * 33 + r) * 128 + 4 * cq) = v; } }
    __syncthreads();
    for (int i = tid; i < 33 * 128; i += 512) { const int r = i >> 7, cc = i & 127, n = cb * 128 + cc;
        float v = 0.f;
#pragma unroll
        for (int w = 0; w < 8; ++w) v += R[(w * 33 + r) * 128 + cc];
        mod[((size_t)L * 33 + r) * ADA + n] = v + ada_b[L * ADA + n]; }
    __syncthreads();
}

__device__ __forceinline__ void tables_unit(FARGS) {
    GAS float* tab = (GAS float*)(F.ws + WS_TAB);
    const int tid = F.tid;
    for (int i = tid; i < 64 * 16; i += 512) { const int p = i >> 4, f = i & 15; const float inv = expf(-(float)f * (1.f / 16.f) * 9.210340371976184f); const float a = (float)p * inv; tab[TAB_T64 + 2 * i] = cosf(a); tab[TAB_T64 + 2 * i + 1] = sinf(a); }
    for (int i = tid; i < 64 * 8; i += 512) { const int p = i >> 3, f = i & 7; const float inv = expf(-(float)f * (1.f / 8.f) * 9.210340371976184f); const float a = (float)p * inv; tab[TAB_T32 + 2 * i] = cosf(a); tab[TAB_T32 + 2 * i + 1] = sinf(a); }
    if (tid < DEPTH) { const GAS float* lp = INP(15) + tid * 4 * 32; float s01 = 0.f, s23 = 0.f;
        for (int i = 0; i < 32; ++i) { s01 += lp[i] * lp[32 + i]; s23 += lp[64 + i] * lp[96 + i]; }
        const float li = 0.8f - 0.6f * expf(-0.3f * (float)tid);
        tab[TAB_LAM + tid] = expf(s01) - expf(s23) + li; tab[TAB_LAM + DEPTH + tid] = 1.f - li; }
}

__device__ __forceinline__ void prologue_phase(FARGS) {
    refresh(F);
    if (F.bx < 192) ada_unit(F, F.bx);
    else if (F.bx == 192) tables_unit(F);
    __syncthreads();
    LAS float* scr = (LAS float*)(F.lds + F.wave * 16640);
    const int gw = F.bx * NWAVES + F.wave, NGW = F.G * NWAVES;
    GAS bf16_t* WIN = (GAS bf16_t*)(F.ws + WS_WIN); GAS bf16_t* WOUT = (GAS bf16_t*)(F.ws + WS_WOUT); GAS bf16_t* W1 = (GAS bf16_t*)(F.ws + WS_W1); GAS bf16_t* W2 = (GAS bf16_t*)(F.ws + WS_W2);
    constexpr int I_IN = 16 * 40, I_OUT = 16 * 16, I_G = 16 * 8, I_D = 8 * 16;
    constexpr int N_IN = DEPTH * I_IN, N_OUT = DEPTH * I_OUT, N_G = DEPTH * NEXP * I_G, N_D = DEPTH * NEXP * I_D;
    constexpr int NITEMS = N_IN + N_OUT + 2 * N_G + N_D;
    for (int it = gw; it < NITEMS; it += NGW) {
        int r = it;
        if (r < N_IN) { const int L = r / I_IN, q = r % I_IN, kb = q / 40, nb = q % 40;
            transpose_item(INP(8) + (size_t)L * D * DIN, DIN, kb * 64, nb * 64, WIN + ((size_t)L * DIN + nb * 64) * D, D, nullptr, scr, F.lane); continue; } r -= N_IN;
        if (r < N_OUT) { const int L = r / I_OUT, q = r % I_OUT, kb = q / 16, nb = q % 16;
            transpose_item(INP(17) + (size_t)L * D * D, D, kb * 64, nb * 64, WOUT + ((size_t)L * D + nb * 64) * D, D, INP(16) + L * D, scr, F.lane); continue; } r -= N_OUT;
        if (r < 2 * N_G) { const int up = r >= N_G; if (up) r -= N_G; const int le = r / I_G, q = r % I_G, kb = q / 8, nb = q % 8, n0 = nb * 64;
            const int drow = (n0 >> 7) * 256 + (n0 & 127) + (up ? 128 : 0);
            transpose_item((up ? INP(21) : INP(20)) + (size_t)le * D * DEXP, DEXP, kb * 64, n0, W1 + ((size_t)le * 1024 + drow) * D, D, nullptr, scr, F.lane); continue; } r -= 2 * N_G;
        { const int le = r / I_D, q = r % I_D, kb = q / 16, nb = q % 16;
            transpose_item(INP(22) + (size_t)le * DEXP * D, D, kb * 64, nb * 64, W2 + ((size_t)le * 1024 + nb * 64) * DEXP, DEXP, nullptr, scr, F.lane); }
    }
    __syncthreads();
}

__device__ __forceinline__ void top2of4(float x0, float x1, float x2, float x3, int& i1, int& i2, float& m1, float& m2) {
    i1 = 0; m1 = x0; if (x1 > m1) { m1 = x1; i1 = 1; } if (x2 > m1) { m1 = x2; i1 = 2; } if (x3 > m1) { m1 = x3; i1 = 3; }
    i2 = -1; m2 = -3.0e38f;
    if (i1 != 0 && x0 > m2) { m2 = x0; i2 = 0; } if (i1 != 1 && x1 > m2) { m2 = x1; i2 = 1; } if (i1 != 2 && x2 > m2) { m2 = x2; i2 = 2; } if (i1 != 3 && x3 > m2) { m2 = x3; i2 = 3; }
}
template <bool ROUTER>
__device__ __forceinline__ void norm_phase(FARGS, int L, int M, bool first, const GAS float* g, int shift_off, int scale_off, bool live = true) {
    refresh(F); OPAQUE_S(L); OPAQUE_S(M);
    const GAS float* mod = (const GAS float*)(F.ws + WS_MOD) + (size_t)L * 33 * ADA;
    GAS bf16_t* H = (GAS bf16_t*)(F.ws + WS_H);
    const GAS bf16_t* XB = (const GAS bf16_t*)(F.ws + WS_XB);
    const GAS float* xlat = INP(0); const GAS float* xctx = INP(2);
    const int lane = F.lane, gw = F.bx * NWAVES + F.wave, NGW = F.G * NWAVES, rpw = (M + NGW - 1) / NGW;
    const int r0 = gw * rpw, r1 = (r0 + rpw < M) ? r0 + rpw : M;
    constexpr int RB = ROUTER ? 1 : 4;
    LAS float* RWT = (LAS float*)F.lds;
    LAS float* LG = (LAS float*)(F.lds + 65536) + F.wave * 640;
    LAS int* hist = (LAS int*)(F.lds + NRM_OFF); LAS int* base = hist + 32;
    if (ROUTER) {
        const GAS float* rw = INP(18);
        for (int i = F.tid; i < 16 * 1024; i += 512) { const int k = i >> 4, e = i & 15; RWT[e * 1024 + k] = rw[i]; }
        if (F.tid < 32) hist[F.tid] = 0;
        __syncthreads();
    }
    int curb = -1; f32x4 gm[4], sh[4];
    u32x4 nraw[RB][2];
    if (!first) {
#pragma unroll
        for (int r = 0; r < RB; ++r)
#pragma unroll
            for (int jj = 0; jj < 2; ++jj) nraw[r][jj] = *(const GAS u32x4*)(XB + (size_t)(r0 + r) * D + 8 * lane + 512 * jj);
    }
#pragma unroll 1
    for (int row = r0; row < r1; row += RB) {
        const int b = row < NLAT ? (row >> 11) : 32;
        if (b != curb) { curb = b;
#pragma unroll
            for (int j = 0; j < 4; ++j) { const int c0 = 8 * lane + 512 * (j >> 1) + 4 * (j & 1); const f32x4 gg = *(const GAS f32x4*)(g + c0), sc = *(const GAS f32x4*)(mod + b * ADA + scale_off + c0);
                gm[j] = gg * (sc + 1.0f); sh[j] = *(const GAS f32x4*)(mod + b * ADA + shift_off + c0); } }
        const GAS float* xr = row < NLAT ? xlat + (size_t)row * D : xctx + (size_t)(row - NLAT) * D;
        f32x4 v[RB][4]; float ss[RB];
        if (first) {
#pragma unroll
            for (int r = 0; r < RB; ++r)
#pragma unroll
                for (int jj = 0; jj < 2; ++jj) { v[r][2 * jj] = *(const GAS f32x4*)(xr + (size_t)r * D + 8 * lane + 512 * jj); v[r][2 * jj + 1] = *(const GAS f32x4*)(xr + (size_t)r * D + 8 * lane + 512 * jj + 4); }
        } else {
            u32x4 raw[RB][2];
#pragma unroll
            for (int r = 0; r < RB; ++r)
#pragma unroll
                for (int jj = 0; jj < 2; ++jj) raw[r][jj] = nraw[r][jj];
            if (row + RB < r1) {
#pragma unroll
                for (int r = 0; r < RB; ++r)
#pragma unroll
                    for (int jj = 0; jj < 2; ++jj) nraw[r][jj] = *(const GAS u32x4*)(XB + (size_t)(row + RB + r) * D + 8 * lane + 512 * jj);
            }
#pragma unroll
            for (int r = 0; r < RB; ++r)
#pragma unroll
                for (int jj = 0; jj < 2; ++jj) { const u32x4 w = raw[r][jj];
                    v[r][2 * jj] = (f32x4){bflo(w.x), bfhi(w.x), bflo(w.y), bfhi(w.y)}; v[r][2 * jj + 1] = (f32x4){bflo(w.z), bfhi(w.z), bflo(w.w), bfhi(w.w)}; }
        }
#pragma unroll
        for (int r = 0; r < RB; ++r) { float s = 0.f;
#pragma unroll
            for (int j = 0; j < 4; ++j) s += (v[r][j].x * v[r][j].x + v[r][j].y * v[r][j].y) + (v[r][j].z * v[r][j].z + v[r][j].w * v[r][j].w);
            ss[r] = s; }
#pragma unroll
        for (int o = 1; o < 32; o <<= 1) {
#pragma unroll
            for (int r = 0; r < RB; ++r) ss[r] += sx(ss[r], lane, o); }
#pragma unroll
        for (int r = 0; r < RB; ++r) { const float rstd = __builtin_amdgcn_rsqf(x32_sum(ss[r]) * (1.f / D) + EPS);
#pragma unroll
            for (int j = 0; j < 4; ++j) v[r][j] = v[r][j] * rstd * gm[j] + sh[j];
#pragma unroll
            for (int jj = 0; jj < 2; ++jj) { u32x4 o; o.x = pk2(v[r][2 * jj].x, v[r][2 * jj].y); o.y = pk2(v[r][2 * jj].z, v[r][2 * jj].w); o.z = pk2(v[r][2 * jj + 1].x, v[r][2 * jj + 1].y); o.w = pk2(v[r][2 * jj + 1].z, v[r][2 * jj + 1].w);
                if (live) *(GAS u32x4*)(H + (size_t)(row + r) * D + 8 * lane + 512 * jj) = o; } }
        if (ROUTER) {
            float p[RB][16];
#pragma unroll
            for (int e = 0; e < 16; ++e) {
#pragma unroll
                for (int r = 0; r < RB; ++r) p[r][e] = 0.f;
#pragma unroll
                for (int j = 0; j < 4; ++j) { const f32x4 w = *(const LAS f32x4*)(RWT + e * 1024 + 8 * lane + 512 * (j >> 1) + 4 * (j & 1));
#pragma unroll
                    for (int r = 0; r < RB; ++r) p[r][e] += (v[r][j].x * w.x + v[r][j].y * w.y) + (v[r][j].z * w.z + v[r][j].w * w.w); } }
            const bool h32 = lane & 32, h16 = lane & 16, h8 = lane & 8, h4 = lane & 4;
#pragma unroll
            for (int r = 0; r < RB; ++r) {
                float a8[8], b4[4], c2[2], d1;
#pragma unroll
                for (int e = 0; e < 8; ++e) { const float send = h32 ? p[r][e] : p[r][e + 8], keep = h32 ? p[r][e + 8] : p[r][e]; a8[e] = keep + sx(send, lane, 32); }
#pragma unroll
                for (int e = 0; e < 4; ++e) { const float send = h16 ? a8[e] : a8[e + 4], keep = h16 ? a8[e + 4] : a8[e]; b4[e] = keep + sx(send, lane, 16); }
#pragma unroll
                for (int e = 0; e < 2; ++e) { const float send = h8 ? b4[e] : b4[e + 2], keep = h8 ? b4[e + 2] : b4[e]; c2[e] = keep + sx(send, lane, 8); }
                { const float send = h4 ? c2[0] : c2[1], keep = h4 ? c2[1] : c2[0]; d1 = keep + sx(send, lane, 4); }
                d1 += sx(d1, lane, 2); d1 += sx(d1, lane, 1);
                if ((lane & 3) == 0) LG[(row + r - r0) * 16 + (lane >> 2)] = d1;
            }
        }
    }
    if (ROUTER) {
        LDS_WAIT();
        int cls = 0, ls = 0; const bool mine = r0 + lane < r1;
        { const LAS f32x4* lp = (const LAS f32x4*)(LG + (mine ? lane : 0) * 16);
          const f32x4 q0 = lp[0], q1 = lp[1], q2 = lp[2], q3 = lp[3];
          const float lg[16] = {q0.x, q0.y, q0.z, q0.w, q1.x, q1.y, q1.z, q1.w, q2.x, q2.y, q2.z, q2.w, q3.x, q3.y, q3.z, q3.w};
          float sc[16], sel[16];
#pragma unroll
          for (int e = 0; e < 16; ++e) { sc[e] = 1.0f / (1.0f + __builtin_amdgcn_exp2f(-lg[e] * LOG2E)); sel[e] = sc[e] + INP(19)[e]; }
          float gs[4];
#pragma unroll
          for (int q = 0; q < 4; ++q) { int i1, i2; float m1, m2; top2of4(sel[4 * q], sel[4 * q + 1], sel[4 * q + 2], sel[4 * q + 3], i1, i2, m1, m2); gs[q] = m1 + m2; }
          int gi = 0; float gmx = gs[0]; if (gs[1] > gmx) { gmx = gs[1]; gi = 1; } if (gs[2] > gmx) { gmx = gs[2]; gi = 2; } if (gs[3] > gmx) { gmx = gs[3]; gi = 3; }
          float x4[4], s4[4];
#pragma unroll
          for (int i = 0; i < 4; ++i) { x4[i] = gi == 0 ? sel[i] : gi == 1 ? sel[4 + i] : gi == 2 ? sel[8 + i] : sel[12 + i]; s4[i] = gi == 0 ? sc[i] : gi == 1 ? sc[4 + i] : gi == 2 ? sc[8 + i] : sc[12 + i]; }
          int i1, i2; float m1, m2; top2of4(x4[0], x4[1], x4[2], x4[3], i1, i2, m1, m2);
          const int lo = i1 < i2 ? i1 : i2, hi = i1 < i2 ? i2 : i1;
          const int pr = lo == 0 ? hi - 1 : (lo == 1 ? hi + 1 : 5);
          const float slo = lo == 0 ? s4[0] : lo == 1 ? s4[1] : s4[2], shi = hi == 1 ? s4[1] : hi == 2 ? s4[2] : s4[3];
          const float inv = 1.0f / (slo + shi);
          cls = gi * 6 + pr;
          if (mine && live) { ls = __hip_atomic_fetch_add(&hist[cls], 1, __ATOMIC_RELAXED, __HIP_MEMORY_SCOPE_WORKGROUP);
              f32x2 w2 = {slo * inv, shi * inv}; *(GAS f32x2*)((GAS float*)(F.ws + WS_RW) + (size_t)(r0 + lane) * 2) = w2; }
        }
        __syncthreads();
        if (F.tid < NCLS && live) base[F.tid] = (int)__hip_atomic_fetch_add(CTL(F) + CW_CNT + (L * NCLS + F.tid) * 64, (unsigned)hist[F.tid], __ATOMIC_RELAXED, __HIP_MEMORY_SCOPE_AGENT);
        __syncthreads();
        GAS int* perm = (GAS int*)(F.ws + WS_PERM);
        if (mine && live) perm[(size_t)cls * MTOT + base[cls] + ls] = r0 + lane;
        __syncthreads();
    }
}

__device__ __forceinline__ void norm2_phase(FARGS, int L, int M) {
    refresh(F); OPAQUE_S(L); OPAQUE_S(M);
    constexpr int SG = 2064;
    constexpr int GT_BYTES = 32 * SG, C_OFF = 2 * GT_BYTES, RS_OFF = C_OFF + 256, RI_OFF = RS_OFF + 8 * 40 * 4, HB_OFF = RI_OFF + 8 * 40 * 4;
    static_assert(HB_OFF + 256 <= MISC_OFF, "norm2 LDS map");
    const GAS float* mod = (const GAS float*)(F.ws + WS_MOD) + (size_t)L * 33 * ADA;
    const GAS float* g2 = INP(7) + L * D; const GAS float* Wr = INP(18);
    GAS bf16_t* H = (GAS bf16_t*)(F.ws + WS_H);
    const GAS bf16_t* XB = (const GAS bf16_t*)(F.ws + WS_XB);
    const int lane = F.lane, tid = F.tid, w = F.wave, l31 = lane & 31, hi = lane >> 5;
    const int NGW = F.G * NWAVES, rpw = (M + NGW - 1) / NGW;
    const int R0 = F.bx * NWAVES * rpw, R1 = (R0 + NWAVES * rpw < M) ? R0 + NWAVES * rpw : M;
    const int r0 = R0 + w * rpw < M ? R0 + w * rpw : M, r1 = (r0 + rpw < M) ? r0 + rpw : M;
    LAS unsigned char* GT = F.lds; LAS float* Ctab = (LAS float*)(F.lds + C_OFF); LAS float* RS = (LAS float*)(F.lds + RS_OFF) + w * 40; LAS int* RI = (LAS int*)(F.lds + RI_OFF) + w * 40;
    LAS int* hist = (LAS int*)(F.lds + HB_OFF); LAS int* base = hist + 32;
    if (tid < 32) hist[tid] = 0;
    const int bfirst = R0 < NLAT ? (R0 >> 11) : 32, blast = (R1 - 1) < NLAT ? ((R1 - 1) >> 11) : 32;
    for (int s = 0; s <= (blast != bfirst ? 1 : 0); ++s) {
        const int b = s == 0 ? bfirst : blast;
        const GAS float* sc = mod + (size_t)b * ADA + 4 * 1024; const GAS float* shp = mod + (size_t)b * ADA + 3 * 1024;
        LAS unsigned char* gt = GT + s * GT_BYTES;
        for (int k = tid; k < D; k += 512) {
            const float gmk = g2[k] * (1.0f + sc[k]);
            const f32x4 w0 = *(const GAS f32x4*)(Wr + k * 16), w1 = *(const GAS f32x4*)(Wr + k * 16 + 4), w2 = *(const GAS f32x4*)(Wr + k * 16 + 8), w3 = *(const GAS f32x4*)(Wr + k * 16 + 12);
            const float wr_[16] = {w0.x, w0.y, w0.z, w0.w, w1.x, w1.y, w1.z, w1.w, w2.x, w2.y, w2.z, w2.w, w3.x, w3.y, w3.z, w3.w};
#pragma unroll
            for (int e = 0; e < 16; ++e) { const float G = gmk * wr_[e]; const unsigned hb = pk2(G, 0.f) & 0xffffu; const float lo = G - __uint_as_float(hb << 16); const unsigned lb = pk2(lo, 0.f) & 0xffffu;
                *(LAS bf16_t*)(gt + e * SG + k * 2) = (bf16_t)hb; *(LAS bf16_t*)(gt + (16 + e) * SG + k * 2) = (bf16_t)lb; }
        }
#pragma unroll
        for (int ee = 0; ee < 2; ++ee) { const int e = 2 * w + ee; float p = 0.f;
            for (int k = lane; k < D; k += 64) p += shp[k] * Wr[k * 16 + e];
            p = wave_sum(p, lane); if (lane == 0) Ctab[s * 16 + e] = p; }
    }
    __syncthreads();
    for (int cur = r0; cur < r1; ) {
        const int bcur = cur < NLAT ? (cur >> 11) : 32;
        int cnt = r1 - cur; if (cnt > 32) cnt = 32;
        if (cur < NLAT) { const int bnd = ((cur >> 11) + 1) << 11; if (bnd - cur < cnt) cnt = bnd - cur; }
        const int s = bcur == bfirst ? 0 : 1;
        const int row = cur + (l31 < cnt ? l31 : cnt - 1);
        const GAS bf16_t* xp = XB + (size_t)row * D + 8 * hi;
        const LAS unsigned char* gp = GT + s * GT_BYTES + l31 * SG + 16 * hi;
        f32x16 acc = f32x16{}; float ss = 0.f;
#pragma unroll 1
        for (int kg = 0; kg < 8; ++kg) {
            bf16x8 xf[8];
#pragma unroll
            for (int j = 0; j < 8; ++j) xf[j] = *(const GAS bf16x8*)(xp + (kg * 8 + j) * 16);
#pragma unroll
            for (int j = 0; j < 8; ++j) {
                const bf16x8 gf = *(const LAS bf16x8*)(gp + (kg * 8 + j) * 32);
                const u32x4 wv = __builtin_bit_cast(u32x4, xf[j]);
                const float a0 = bflo(wv.x), a1 = bfhi(wv.x), a2 = bflo(wv.y), a3 = bfhi(wv.y), a4 = bflo(wv.z), a5 = bfhi(wv.z), a6 = bflo(wv.w), a7 = bfhi(wv.w);
                ss += (a0 * a0 + a1 * a1) + (a2 * a2 + a3 * a3) + (a4 * a4 + a5 * a5) + (a6 * a6 + a7 * a7);
                acc = __builtin_amdgcn_mfma_f32_32x32x16_bf16(gf, xf[j], acc, 0, 0, 0);
            }
        }
        const float rstd = __builtin_amdgcn_rsqf(x32_sum(ss) * (1.f / D) + EPS);
        float mine[8], oth[8];
#pragma unroll
        for (int i = 0; i < 8; ++i) { mine[i] = acc[i] + acc[i + 8]; oth[i] = swap32(mine[i], hi != 0); }
        float lg[16];
#pragma unroll
        for (int i = 0; i < 4; ++i) { lg[i] = hi ? oth[i] : mine[i]; lg[4 + i] = hi ? mine[i] : oth[i]; lg[8 + i] = hi ? oth[4 + i] : mine[4 + i]; lg[12 + i] = hi ? mine[4 + i] : oth[4 + i]; }
        float sc_[16], sel[16];
#pragma unroll
        for (int e = 0; e < 16; ++e) { const float z = rstd * lg[e] + Ctab[s * 16 + e]; sc_[e] = __builtin_amdgcn_rcpf(1.0f + __builtin_amdgcn_exp2f(-z * LOG2E)); sel[e] = sc_[e] + INP(19)[e]; }
        float gs[4];
#pragma unroll
        for (int q = 0; q < 4; ++q) { int i1, i2; float m1, m2; top2of4(sel[4 * q], sel[4 * q + 1], sel[4 * q + 2], sel[4 * q + 3], i1, i2, m1, m2); gs[q] = m1 + m2; }
        int gi = 0; float gmx = gs[0]; if (gs[1] > gmx) { gmx = gs[1]; gi = 1; } if (gs[2] > gmx) { gmx = gs[2]; gi = 2; } if (gs[3] > gmx) { gmx = gs[3]; gi = 3; }
        float x4[4], s4[4];
#pragma unroll
        for (int i = 0; i < 4; ++i) { x4[i] = gi == 0 ? sel[i] : gi == 1 ? sel[4 + i] : gi == 2 ? sel[8 + i] : sel[12 + i]; s4[i] = gi == 0 ? sc_[i] : gi == 1 ? sc_[4 + i] : gi == 2 ? sc_[8 + i] : sc_[12 + i]; }
        int i1, i2; float m1, m2; top2of4(x4[0], x4[1], x4[2], x4[3], i1, i2, m1, m2);
        const int lo_ = i1 < i2 ? i1 : i2, hi_ = i1 < i2 ? i2 : i1;
        const int pr = lo_ == 0 ? hi_ - 1 : (lo_ == 1 ? hi_ + 1 : 5);
        const float slo = lo_ == 0 ? s4[0] : lo_ == 1 ? s4[1] : s4[2], shi = hi_ == 1 ? s4[1] : hi_ == 2 ? s4[2] : s4[3];
        const float inv = __builtin_amdgcn_rcpf(slo + shi);
        const int cls = gi * 6 + pr;
        if (hi == 0 && l31 < cnt) { const int ls = __hip_atomic_fetch_add(&hist[cls], 1, __ATOMIC_RELAXED, __HIP_MEMORY_SCOPE_WORKGROUP);
            const int ri = cur - r0 + l31; RS[ri] = rstd; RI[ri] = cls | (ls << 8);
            f32x2 w2 = {slo * inv, shi * inv}; *(GAS f32x2*)((GAS float*)(F.ws + WS_RW) + (size_t)(cur + l31) * 2) = w2; }
        cur += cnt;
    }
    LDS_WAIT();
    { int curb = -1; f32x4 gm[4], sh[4];
#pragma unroll 1
      for (int row = r0; row < r1; row += 4) {
        const int b = row < NLAT ? (row >> 11) : 32;
        if (b != curb) { curb = b;
#pragma unroll
            for (int j = 0; j < 4; ++j) { const int c0 = 8 * lane + 512 * (j >> 1) + 4 * (j & 1); const f32x4 gg = *(const GAS f32x4*)(g2 + c0), sc = *(const GAS f32x4*)(mod + b * ADA + 4 * 1024 + c0);
                gm[j] = gg * (sc + 1.0f); sh[j] = *(const GAS f32x4*)(mod + b * ADA + 3 * 1024 + c0); } }
        u32x4 raw[4][2];
#pragma unroll
        for (int r = 0; r < 4; ++r)
#pragma unroll
            for (int jj = 0; jj < 2; ++jj) raw[r][jj] = *(const GAS u32x4*)(XB + (size_t)(row + r) * D + 8 * lane + 512 * jj);
#pragma unroll
        for (int r = 0; r < 4; ++r) { const float rstd = RS[row - r0 + r];
#pragma unroll
            for (int jj = 0; jj < 2; ++jj) { const u32x4 wv = raw[r][jj];
                const f32x4 v0 = (f32x4){bflo(wv.x), bfhi(wv.x), bflo(wv.y), bfhi(wv.y)} * rstd * gm[2 * jj] + sh[2 * jj], v1 = (f32x4){bflo(wv.z), bfhi(wv.z), bflo(wv.w), bfhi(wv.w)} * rstd * gm[2 * jj + 1] + sh[2 * jj + 1];
                u32x4 o; o.x = pk2(v0.x, v0.y); o.y = pk2(v0.z, v0.w); o.z = pk2(v1.x, v1.y); o.w = pk2(v1.z, v1.w);
                *(GAS u32x4*)(H + (size_t)(row + r) * D + 8 * lane + 512 * jj) = o; } }
      } }
    __syncthreads();
    if (tid < NCLS) base[tid] = (int)__hip_atomic_fetch_add(CTL(F) + CW_CNT + (L * NCLS + tid) * 64, (unsigned)hist[tid], __ATOMIC_RELAXED, __HIP_MEMORY_SCOPE_AGENT);
    __syncthreads();
    { GAS int* perm = (GAS int*)(F.ws + WS_PERM);
      if (r0 + lane < r1) { const int ri = RI[lane], cls = ri & 255, ls = ri >> 8; perm[(size_t)cls * MTOT + base[cls] + ls] = r0 + lane; } }
    __syncthreads();
}

__device__ __forceinline__ void qkprep_phase(FARGS, int L, bool live = true) {
    refresh(F); OPAQUE_S(L);
    GAS bf16_t* U = (GAS bf16_t*)(F.ws + WS_U);
    const GAS float* tab = (const GAS float*)(F.ws + WS_TAB);
    const int lane = F.lane, gw = F.bx * NWAVES + F.wave, NGW = F.G * NWAVES, rpw = (MTOT + NGW - 1) / NGW;
    const int r0 = gw * rpw, r1 = (r0 + rpw < MTOT) ? r0 + rpw : MTOT;
    int ccol[4]; bool seg32[4], dorope[4], valid[4]; float qs[4]; f32x4 g0[4], g1[4];
#pragma unroll
    for (int i = 0; i < 4; ++i) {
        const int c = lane + 64 * i; valid[i] = c < 224;
        int col, isq; const GAS float* gp; bool s32 = false, rp = true; float sc = 0.125f * LOG2E;
        if (c < 48) { col = 8 * c; isq = c < 32; gp = INP(9) + L * 128 + (isq ? 0 : 64) + ((8 * c) & 63); }
        else if (c < 112) { const int cc = c - 48; col = QB + 8 * cc; isq = cc < 32; gp = INP(10) + L * 128 + (isq ? 0 : 64) + ((8 * cc) & 63); rp = false; }
        else if (c < 176) { const int cc = c - 112; col = QC + 8 * cc; isq = cc < 32; gp = INP(11) + L * 64 + (isq ? 0 : 32) + ((8 * cc) & 31); s32 = true; sc = 0.17677669529663687f * LOG2E; }
        else { const int cc = (c < 224 ? c : 223) - 176; col = QD + 8 * cc; isq = cc < 32; gp = INP(12) + L * 128 + (isq ? 0 : 64) + ((8 * cc) & 63); }
        ccol[i] = col; seg32[i] = s32; dorope[i] = rp; qs[i] = isq ? sc : 1.0f; g0[i] = *(const GAS f32x4*)gp; g1[i] = *(const GAS f32x4*)(gp + 4);
    }
#pragma unroll 1
    for (int row4 = r0; row4 < r1; row4 += 4) {
        u32x4 wv[4][4];
#pragma unroll
        for (int r = 0; r < 4; ++r)
#pragma unroll
            for (int i = 0; i < 4; ++i) wv[r][i] = *(const GAS u32x4*)(U + (size_t)(row4 + r) * DIN + ccol[i]);
#pragma unroll
        for (int r = 0; r < 4; ++r) {
        const int row = row4 + r;
        const bool lat = row < NLAT; const int s = row & 2047, prow = s >> 6, pcol = s & 63;
#pragma unroll
        for (int i = 0; i < 4; ++i) {
            GAS bf16_t* p = U + (size_t)row * DIN + ccol[i];
            const u32x4 w = wv[r][i];
            float x[8] = {bflo(w.x), bfhi(w.x), bflo(w.y), bfhi(w.y), bflo(w.z), bfhi(w.z), bflo(w.w), bfhi(w.w)};
            float ss = 0.f;
#pragma unroll
            for (int e = 0; e < 8; ++e) ss += x[e] * x[e];
            ss += sx(ss, lane, 1); ss += sx(ss, lane, 2); const float ss8 = ss + sx(ss, lane, 4);
            const float rstd = seg32[i] ? __builtin_amdgcn_rsqf(ss * (1.f / 32.f) + EPS) : __builtin_amdgcn_rsqf(ss8 * (1.f / 64.f) + EPS);
            const float gg[8] = {g0[i].x, g0[i].y, g0[i].z, g0[i].w, g1[i].x, g1[i].y, g1[i].z, g1[i].w};
#pragma unroll
            for (int e = 0; e < 8; ++e) x[e] = x[e] * rstd * gg[e];
            const int j = seg32[i] ? (lane & 3) : (lane & 7);
            const int pxor = seg32[i] ? 1 : 2;
            const bool first = seg32[i] ? !(j & 1) : !(j & 2);
            const int pos = seg32[i] ? ((j < 2) ? prow : pcol) : ((j < 4) ? prow : pcol);
            const GAS float* tp = seg32[i] ? tab + TAB_T32 + (pos * 8) * 2 : tab + TAB_T64 + (pos * 16 + 8 * (j & 1)) * 2;
            const bool rp = dorope[i] && lat;
#pragma unroll
            for (int e2 = 0; e2 < 4; ++e2) {
                const f32x4 cs = *(const GAS f32x4*)(tp + 4 * e2);
                const float pa = sx(x[2 * e2], lane, pxor), pb = sx(x[2 * e2 + 1], lane, pxor);
                if (rp) {
                    x[2 * e2] = first ? x[2 * e2] * cs.x - pa * cs.y : pa * cs.y + x[2 * e2] * cs.x;
                    x[2 * e2 + 1] = first ? x[2 * e2 + 1] * cs.z - pb * cs.w : pb * cs.w + x[2 * e2 + 1] * cs.z;
                }
            }
            u32x4 o; o.x = pk2(x[0] * qs[i], x[1] * qs[i]); o.y = pk2(x[2] * qs[i], x[3] * qs[i]); o.z = pk2(x[4] * qs[i], x[5] * qs[i]); o.w = pk2(x[6] * qs[i], x[7] * qs[i]);
            if (valid[i] && live) *(GAS u32x4*)p = o;
        }
        }
    }
}
#ifdef MK_USE_SB
#define MK_SB() __builtin_amdgcn_sched_barrier(0)
#else
#define MK_SB() do {} while (0)
#endif
#ifndef MK_DUAL
#define MK_DUAL 1
#endif
#ifndef MK_MIDBAR
#define MK_MIDBAR 0
#endif
#ifndef MK_ILV
#define MK_ILV 15
#endif
#ifndef MK_CHP
#define MK_CHP 1
#endif
template <int MIX> struct MixCfg;
template <> struct MixCfg<0> { static constexpr int QCOL = QA, KCOL = KA, VCOL = VA, CK = 128, CV = 128; static constexpr bool GQA = true;  };
template <> struct MixCfg<1> { static constexpr int QCOL = QB, KCOL = KB, VCOL = VB, CK = 256, CV = 256; static constexpr bool GQA = false; };
template <> struct MixCfg<2> { static constexpr int QCOL = QC, KCOL = KC, VCOL = VC, CK = MK_CHP ? 128 : 256, CV = MK_CHP ? 128 : 256; static constexpr bool GQA = false; };
template <> struct MixCfg<3> { static constexpr int QCOL = QD, KCOL = KD, VCOL = VD, CK = 128, CV = 128; static constexpr bool GQA = true;  };

__device__ __forceinline__ int crow16(int r, int hi) { return (r & 3) + 8 * (r >> 2) + 4 * hi; }
__device__ __forceinline__ s16x4 vtr(const LAS unsigned char* p) { return __builtin_bit_cast(s16x4, __builtin_amdgcn_ds_read_tr16_b64_v4i16((LAS s16x4*)p)); }

__device__ __forceinline__ void softmax_tile(f32x16& p0, f32x16& p1, float& l, bf16x8 (&pa)[4]) {
    float s0 = 0.f, s1 = 0.f;
#pragma unroll
    for (int r = 0; r < 16; ++r) { p0[r] = __builtin_amdgcn_exp2f(p0[r]); p1[r] = __builtin_amdgcn_exp2f(p1[r]); s0 += p0[r]; s1 += p1[r]; }
    l += s0 + s1;
#pragma unroll
    for (int sI = 0; sI < 4; ++sI) {
        u32x4 w;
        if (sI < 2) { const int o_ = 8 * sI; w.x = pk2(p0[o_], p0[o_ + 1]); w.y = pk2(p0[o_ + 2], p0[o_ + 3]); w.z = pk2(p0[o_ + 4], p0[o_ + 5]); w.w = pk2(p0[o_ + 6], p0[o_ + 7]); }
        else { const int o_ = 8 * (sI - 2); w.x = pk2(p1[o_], p1[o_ + 1]); w.y = pk2(p1[o_ + 2], p1[o_ + 3]); w.z = pk2(p1[o_ + 4], p1[o_ + 5]); w.w = pk2(p1[o_ + 6], p1[o_ + 7]); }
        pa[sI] = __builtin_bit_cast(bf16x8, w);
    }
}

template <int MIX>
__device__ __forceinline__ void attn_unit(FARGS, int L, int b, int qb, bool isctx, int hp) {
    typedef MixCfg<MIX> C;
    refresh(F); OPAQUE_S(L);
#ifdef MK_STAMP
#define STAMP_NOW_(v) __builtin_amdgcn_sched_barrier(0); const unsigned v = (unsigned)__builtin_amdgcn_s_memtime(); __builtin_amdgcn_sched_barrier(0)
#define SEG0() do { if (MIX == MK_STAMP) { STAMP_NOW_(now_); if (F.tid == MK_STAMP_TID) { LAS unsigned* m_ = (LAS unsigned*)(F.lds + MISC_OFF); m_[21] = now_; } } } while (0)
#define SEG(k) do { if (MIX == MK_STAMP && (MK_STAMP_SEG == 9 ? (k) == 3 : ((k) == MK_STAMP_SEG || (k) == (MK_STAMP_SEG + 3) % 4))) { STAMP_NOW_(now_); if (F.tid == MK_STAMP_TID) { LAS unsigned* m_ = (LAS unsigned*)(F.lds + MISC_OFF); \
    if ((k) == MK_STAMP_SEG || MK_STAMP_SEG == 9) m_[20] += now_ - m_[21]; m_[21] = now_; } } } while (0)
#else
#define SEG0() do {} while (0)
#define SEG(k) do {} while (0)
#endif
    constexpr int SK = C::CK * 2 + 16, SV = C::CV * 2 + 64, NKC = C::CK / 64, NVC = C::CV / 64;
    constexpr bool DIFF = (MIX == 2);
    constexpr bool DUAL = (MIX == 3) && MK_DUAL;
    constexpr bool TWO = DIFF || DUAL;
    constexpr bool HP = DIFF && MK_CHP;
    constexpr int UQ = (DUAL || HP) ? 128 : 64;
    static_assert(C::CK == C::CV, "K and V tiles share the per-thread load offsets");
    const GAS bf16_t* U = (const GAS bf16_t*)(F.ws + WS_U);
    GAS bf16_t* Y = (GAS bf16_t*)(F.ws + WS_Y);
    const GAS float* tab = (const GAS float*)(F.ws + WS_TAB);
    const int tid = F.tid, lane = F.lane, w = F.wave, l31 = lane & 31, hi = lane >> 5;
    const int hq = DUAL ? 2 * (w >> 2) : (HP ? 2 * hp + (w >> 2) : (w >> 1)), rs = (DUAL || HP) ? (w & 3) : (w & 1);
    const int hk = (DUAL || HP) ? (w >> 2) : (C::GQA ? (hq >> 1) : hq);
    const int kcolb = C::KCOL + (HP ? hp * 128 : 0), vcolb = C::VCOL + (HP ? hp * 128 : 0);
    const int qrow = isctx ? NLAT + b * CTXL + qb * UQ + rs * 32 + l31 : b * SEQ + qb * UQ + rs * 32 + l31;
    int nloc, loc0;
    if (isctx) { nloc = 0; loc0 = 0; }
    else if (MIX == 0) { const int t0 = DUAL ? 2 * qb - 2 : qb - 2, t1 = DUAL ? 2 * qb + 3 : qb + 2; loc0 = t0 < 0 ? 0 : t0; const int hiT = t1 > 31 ? 31 : t1; nloc = hiT - loc0 + 1; }
    else if (MIX == 1) { loc0 = qb - 4 < 0 ? 0 : (qb - 4 > 24 ? 24 : qb - 4); nloc = 8; }
    else { loc0 = 0; nloc = 32; }
    const int NT = nloc + 4;
    const int lrow0 = b * SEQ, crow0 = NLAT + b * CTXL;
    bf16x8 qf[4], qg[DUAL ? 4 : 1];
    { const GAS bf16_t* qp = U + (size_t)qrow * DIN + C::QCOL + hq * 64 + hi * 8;
#pragma unroll
      for (int d0 = 0; d0 < 4; ++d0) { qf[d0] = *(const GAS bf16x8*)(qp + d0 * 16); if (DUAL) qg[DUAL ? d0 : 0] = *(const GAS bf16x8*)(qp + 64 + d0 * 16); } }
    float l0 = 0.f, l1 = 0.f;
    if (MIX == 0) { l0 = hi == 0 ? __builtin_amdgcn_exp2f(INP(13)[L * 4 + hq] * LOG2E) : 0.f;
        if (DUAL) l1 = hi == 0 ? __builtin_amdgcn_exp2f(INP(13)[L * 4 + hq + 1] * LOG2E) : 0.f; }
    f32x16 o0[2], o1[2];
#pragma unroll
    for (int i = 0; i < 2; ++i) { o0[i] = f32x16{}; o1[i] = f32x16{}; }
    u32x4 kreg[NKC], vreg[NVC];
    auto tile_row = [&](int t) -> int { return t < nloc ? lrow0 + (loc0 + t) * 64 : crow0 + (t - nloc) * 64; };
    unsigned goff[NKC];
#pragma unroll
    for (int i = 0; i < NKC; ++i) { const int c = tid + 512 * i, r = c / (C::CK / 8), cc = c % (C::CK / 8); goff[i] = (unsigned)(r * DIN + cc * 8) * 2u; }
    auto issueK = [&](int t) { const GAS char* tb = (const GAS char*)(U + (size_t)tile_row(t) * DIN + kcolb);
#pragma unroll
        for (int i = 0; i < NKC; ++i) kreg[i] = *(const GAS u32x4*)(tb + goff[i]); };
    auto issueV = [&](int t) { const GAS char* tb = (const GAS char*)(U + (size_t)tile_row(t) * DIN + vcolb);
#pragma unroll
        for (int i = 0; i < NVC; ++i) vreg[i] = *(const GAS u32x4*)(tb + goff[i]); };
    constexpr bool ILV = ((MK_ILV) >> MIX) & 1;
    constexpr bool MID = ILV && (!TWO || HP) && (C::CK == 128) && (((MK_MIDBAR) >> MIX) & 1);
    constexpr int K3SZ = 64 * SK, V3SZ = 64 * SV, V3BASE = 34816;
    static_assert(!MID || (2 * K3SZ <= V3BASE && V3BASE + 3 * V3SZ <= AT_RPB), "ring");
    auto KB = [&](int t) -> int { return MID ? (t & 1) * K3SZ : (t & 1) * AT_BUFB; };
    auto VB = [&](int t) -> int { return MID ? V3BASE + (int)((unsigned)t % 3u) * V3SZ : (t & 1) * AT_BUFB + AT_VOFF; };
    auto stashK = [&](int t) { LAS unsigned char* Kw = F.lds + KB(t);
#pragma unroll
        for (int i = 0; i < NKC; ++i) { const int c = tid + 512 * i, r = c / (C::CK / 8), cc = c % (C::CK / 8); *(LAS u32x4*)(Kw + r * SK + cc * 16) = kreg[i]; } };
    auto stashV = [&](int t) { LAS unsigned char* Vw = F.lds + VB(t);
#pragma unroll
        for (int i = 0; i < NVC; ++i) { const int c = tid + 512 * i, r = c / (C::CV / 8), cc = c % (C::CV / 8); *(LAS u32x4*)(Vw + r * SV + cc * 16) = vreg[i]; } };
    const int kboff = l31 * SK + (hk * 64 + hi * 8) * 2;
    const int vboff = (4 * hi + ((lane & 15) >> 2)) * SV + (hk * 64 + 16 * ((lane >> 4) & 1) + 4 * (lane & 3)) * 2;
    bf16x8 kf[8];
    auto loadkf = [&](int t) { const LAS unsigned char* kb = F.lds + KB(t) + kboff;
#pragma unroll
        for (int d0 = 0; d0 < 4; ++d0) { kf[2 * d0] = *(const LAS bf16x8*)(kb + d0 * 32); kf[2 * d0 + 1] = *(const LAS bf16x8*)(kb + 32 * SK + d0 * 32); } };
    bf16x8 pa0[4], pa1[4];
#pragma unroll
    for (int i = 0; i < 4; ++i) { pa0[i] = bf16x8{}; pa1[i] = bf16x8{}; }
    constexpr int VPRE = DUAL ? 1 : (TWO ? 2 : 4);
    bf16x8 vf[2 * VPRE];
    auto readvf = [&](int t, int sI, int dh) -> bf16x8 {
        const LAS unsigned char* vp = F.lds + VB(t) + vboff + (16 * sI) * SV + dh * 64;
        const s16x4 lo = vtr(vp), hi4 = vtr(vp + 8 * SV);
        return (bf16x8){lo[0], lo[1], lo[2], lo[3], hi4[0], hi4[1], hi4[2], hi4[3]}; };
    auto loadvf = [&](int t) {
#pragma unroll
        for (int sI = 0; sI < VPRE; ++sI)
#pragma unroll
            for (int dh = 0; dh < 2; ++dh) vf[2 * sI + dh] = readvf(t, sI, dh); };
    auto pv = [&](int t) {
#pragma unroll
        for (int sI = 0; sI < 4; ++sI)
#pragma unroll
            for (int dh = 0; dh < 2; ++dh) {
                const bf16x8 v = sI < VPRE ? vf[2 * (sI < VPRE ? sI : 0) + dh] : readvf(t, sI, dh);
                o0[dh] = __builtin_amdgcn_mfma_f32_32x32x16_bf16(v, pa0[sI], o0[dh], 0, 0, 0);
                if (TWO) o1[dh] = __builtin_amdgcn_mfma_f32_32x32x16_bf16(v, pa1[sI], o1[dh], 0, 0, 0);
            } };
    const int qpos = qb * UQ + rs * 32 + l31;
    const int qc = rs * 32 + l31, cs = qc - 8 < 0 ? 0 : (qc - 8 > 48 ? 48 : qc - 8);
    const LAS float* rpb = (const LAS float*)(F.lds + AT_RPB) + hq * 465;
    issueK(0); stashK(0); issueK(1); issueV(0);
    WG_BAR();
    constexpr bool KHOLD = !TWO || HP;
    if (KHOLD) loadkf(0);
    if (ILV) {
#define SBAR() __builtin_amdgcn_sched_barrier(0)
    auto loadkf1 = [&](int t, int j) { const LAS unsigned char* kb = F.lds + KB(t) + kboff; kf[j] = *(const LAS bf16x8*)(kb + (j & 1) * 32 * SK + (j >> 1) * 32); };
    constexpr int NB = TWO ? 2 : 4;
    constexpr int NG = TWO ? 16 : 8;
    bf16x8 vr[NB];
    auto stage = [&](int t) {
        if (t + 1 < NT) stashK(t + 1);
        stashV(t);
        if (t + 2 < NT) issueK(t + 2);
        if (t + 1 < NT) issueV(t + 1); };
    auto qk = [&](int t, f32x16& p0, f32x16& p1, f32x16& r0_, f32x16& r1_) {
        if (DUAL) {
            const LAS unsigned char* kb = F.lds + KB(t) + kboff;
            bf16x8 kr[2][2];
#pragma unroll
            for (int d0 = 0; d0 < 2; ++d0) { kr[d0][0] = *(const LAS bf16x8*)(kb + d0 * 32); kr[d0][1] = *(const LAS bf16x8*)(kb + 32 * SK + d0 * 32); }
#pragma unroll
            for (int d0 = 0; d0 < 4; ++d0) {
                SBAR();
                p0 = __builtin_amdgcn_mfma_f32_32x32x16_bf16(kr[d0 & 1][0], qf[d0], p0, 0, 0, 0); p1 = __builtin_amdgcn_mfma_f32_32x32x16_bf16(kr[d0 & 1][1], qf[d0], p1, 0, 0, 0);
                r0_ = __builtin_amdgcn_mfma_f32_32x32x16_bf16(kr[d0 & 1][0], qg[DUAL ? d0 : 0], r0_, 0, 0, 0); r1_ = __builtin_amdgcn_mfma_f32_32x32x16_bf16(kr[d0 & 1][1], qg[DUAL ? d0 : 0], r1_, 0, 0, 0);
                if (d0 + 2 < 4) { kr[d0 & 1][0] = *(const LAS bf16x8*)(kb + (d0 + 2) * 32); kr[d0 & 1][1] = *(const LAS bf16x8*)(kb + 32 * SK + (d0 + 2) * 32); }
            }
            SBAR();
            return;
        }
#pragma unroll
        for (int d0 = 0; d0 < (DIFF ? 2 : 4); ++d0) { p0 = __builtin_amdgcn_mfma_f32_32x32x16_bf16(kf[2 * d0], qf[d0], p0, 0, 0, 0); p1 = __builtin_amdgcn_mfma_f32_32x32x16_bf16(kf[2 * d0 + 1], qf[d0], p1, 0, 0, 0); }
        if (DIFF) {
#pragma unroll
            for (int d0 = 2; d0 < 4; ++d0) { r0_ = __builtin_amdgcn_mfma_f32_32x32x16_bf16(kf[2 * d0], qf[d0], r0_, 0, 0, 0); r1_ = __builtin_amdgcn_mfma_f32_32x32x16_bf16(kf[2 * d0 + 1], qf[d0], r1_, 0, 0, 0); }
        } };
    auto init_acc = [&](int t, f32x16& p0, f32x16& p1, f32x16& r0_, f32x16& r1_) {
        const bool local = t < nloc;
        p0 = f32x16{}; p1 = f32x16{}; r0_ = f32x16{}; r1_ = f32x16{};
        if (MIX == 0 && local) {
            const int dj = loc0 + t - qb;
            if (dj <= -2 || dj >= 2) {
                const int mb = (loc0 + t) * 64 + 4 * hi - qpos + 128;
#pragma unroll
                for (int r = 0; r < 16; ++r) { const int kc = (r & 3) + 8 * (r >> 2);
                    if ((unsigned)(mb + kc) > 256u) { p0[r] = -INFINITY; if (DUAL) r0_[r] = -INFINITY; } if ((unsigned)(mb + kc + 32) > 256u) { p1[r] = -INFINITY; if (DUAL) r1_[r] = -INFINITY; } }
            }
        }
        if (MIX == 1 && local) {
            const int dr = (loc0 + t) - qb + 7;
            const int kh = 4 * hi - cs; const LAS float* rp = rpb + dr * 31 + 15 - qc + 4 * hi;
            float bb0[16], bb1[16];
#pragma unroll
            for (int r = 0; r < 16; ++r) { const int kc = (r & 3) + 8 * (r >> 2); bb0[r] = rp[kc]; bb1[r] = rp[kc + 32]; }
#pragma unroll
            for (int r = 0; r < 16; ++r) { asm volatile("" : "+v"(bb0[r]), "+v"(bb1[r])); }
#pragma unroll
            for (int r = 0; r < 16; ++r) { const int kc = (r & 3) + 8 * (r >> 2);
                const bool v0 = (unsigned)(kh + kc) < 16u, v1 = (unsigned)(kh + kc + 32) < 16u;
                p0[r] = v0 ? bb0[r] : -INFINITY; p1[r] = v1 ? bb1[r] : -INFINITY; }
        } };
    auto sm_exp = [&](f32x16& a0, f32x16& a1, int q, float& sum) {
#pragma unroll
        for (int j = 0; j < 4; ++j) { const int r = 4 * (q & 3) + j;
            if (q < 4) { a0[r] = __builtin_amdgcn_exp2f(a0[r]); sum += a0[r]; } else { a1[r] = __builtin_amdgcn_exp2f(a1[r]); sum += a1[r]; } } };
    auto sm_cvt = [&](const f32x16& a0, const f32x16& a1, int q, bf16x8 (&pa)[4]) {
        const int r = 4 * (q & 3);
        const unsigned lo = q < 4 ? pk2(a0[r], a0[r + 1]) : pk2(a1[r], a1[r + 1]), hi2 = q < 4 ? pk2(a0[r + 2], a0[r + 3]) : pk2(a1[r + 2], a1[r + 3]);
        u32x4 w = __builtin_bit_cast(u32x4, pa[q >> 1]);
        if (q & 1) { w.z = lo; w.w = hi2; } else { w.x = lo; w.y = hi2; }
        pa[q >> 1] = __builtin_bit_cast(bf16x8, w); };
    {
        if (!KHOLD && !DUAL) loadkf(0);
        stage(0);
        f32x16 p0, p1, r0_, r1_;
        init_acc(0, p0, p1, r0_, r1_);
        qk(0, p0, p1, r0_, r1_);
        softmax_tile(p0, p1, l0, pa0);
        if (TWO) softmax_tile(r0_, r1_, l1, pa1);
        WG_BAR();
        if (KHOLD && 1 < NT) loadkf(1);
    }
    SEG0();
    for (int t = 1; t < NT; ++t) {
#pragma unroll
        for (int f = 0; f < NB; ++f) vr[f] = readvf(t - 1, f >> 1, f & 1);
        if (!KHOLD && !DUAL) loadkf(t);
        stage(t);
        f32x16 p0, p1, r0_, r1_;
        init_acc(t, p0, p1, r0_, r1_);
        SEG(1);
        qk(t, p0, p1, r0_, r1_);
        SEG(0);
#pragma unroll
        for (int g = 0; g < NG; ++g) {
            SBAR();
            if (MID && g == NG / 2) { WG_BAR(); SBAR(); }
            if (MID && !TWO && g >= NG - 4) { loadkf1(t + 1, 2 * (g - (NG - 4))); loadkf1(t + 1, 2 * (g - (NG - 4)) + 1); }
            if (TWO) {
                const int f = g >> 1, h = g & 1, sI = g >> 2, dh = (g >> 1) & 1;
                if (h == 0) o0[dh] = __builtin_amdgcn_mfma_f32_32x32x16_bf16(vr[f % NB], pa0[sI], o0[dh], 0, 0, 0);
                else { o1[dh] = __builtin_amdgcn_mfma_f32_32x32x16_bf16(vr[f % NB], pa1[sI], o1[dh], 0, 0, 0);
                    if (f + NB < 8) vr[f % NB] = readvf(t - 1, (f + NB) >> 1, (f + NB) & 1); }
                if (h == 0) sm_exp(p0, p1, g >> 1, l0); else sm_exp(r0_, r1_, g >> 1, l1);
                if (g >= 3 && ((g - 3) & 3) == 0) { const int k = (g - 3) >> 2; sm_cvt(p0, p1, 2 * k, pa0); sm_cvt(p0, p1, 2 * k + 1, pa0); }
                if (g >= 4 && ((g - 4) & 3) == 0) { const int k = (g - 4) >> 2; sm_cvt(r0_, r1_, 2 * k, pa1); sm_cvt(r0_, r1_, 2 * k + 1, pa1); }
            } else {
                const int f = g, sI = g >> 1, dh = g & 1;
                o0[dh] = __builtin_amdgcn_mfma_f32_32x32x16_bf16(vr[f % NB], pa0[sI], o0[dh], 0, 0, 0);
                if (f + NB < 8) vr[f % NB] = readvf(t - 1, (f + NB) >> 1, (f + NB) & 1);
                sm_exp(p0, p1, g, l0);
                if (g >= 2 && (g & 1) == 0) { const int k = (g - 2) >> 1; sm_cvt(p0, p1, 2 * k, pa0); sm_cvt(p0, p1, 2 * k + 1, pa0); }
            }
        }
        SBAR();
        if (TWO) { sm_cvt(r0_, r1_, 6, pa1); sm_cvt(r0_, r1_, 7, pa1); }
        else { sm_cvt(p0, p1, 6, pa0); sm_cvt(p0, p1, 7, pa0); }
        if (MID && TWO) {
#pragma unroll
            for (int j = 0; j < 8; ++j) loadkf1(t + 1, j); }
        SEG(2);
        if (!MID) WG_BAR();
        SEG(3);
        if (KHOLD && !MID && t + 1 < NT) loadkf(t + 1);
    }
    loadvf(NT - 1); pv(NT - 1);
    } else {
    for (int t = 0; t < NT; ++t) {
        if (t > 0) loadvf(t - 1);
        if (!KHOLD) loadkf(t);
        MK_SB();
        if (t + 1 < NT) stashK(t + 1);
        stashV(t);
        if (t + 2 < NT) issueK(t + 2);
        if (t + 1 < NT) issueV(t + 1);
        const bool local = t < nloc;
        f32x16 p0 = f32x16{}, p1 = f32x16{}, r0_ = f32x16{}, r1_ = f32x16{};
#pragma unroll
        for (int d0 = 0; d0 < (DIFF ? 2 : 4); ++d0) { p0 = __builtin_amdgcn_mfma_f32_32x32x16_bf16(kf[2 * d0], qf[d0], p0, 0, 0, 0); p1 = __builtin_amdgcn_mfma_f32_32x32x16_bf16(kf[2 * d0 + 1], qf[d0], p1, 0, 0, 0); }
        MK_SB();
        if (t > 0) pv(t - 1);
        if (DIFF) {
#pragma unroll
            for (int d0 = 2; d0 < 4; ++d0) { r0_ = __builtin_amdgcn_mfma_f32_32x32x16_bf16(kf[2 * d0], qf[d0], r0_, 0, 0, 0); r1_ = __builtin_amdgcn_mfma_f32_32x32x16_bf16(kf[2 * d0 + 1], qf[d0], r1_, 0, 0, 0); }
        }
        if (DUAL) {
#pragma unroll
            for (int d0 = 0; d0 < 4; ++d0) { r0_ = __builtin_amdgcn_mfma_f32_32x32x16_bf16(kf[2 * d0], qg[DUAL ? d0 : 0], r0_, 0, 0, 0); r1_ = __builtin_amdgcn_mfma_f32_32x32x16_bf16(kf[2 * d0 + 1], qg[DUAL ? d0 : 0], r1_, 0, 0, 0); }
        }
        MK_SB();
        if (MIX == 0 && local) {
            const int mb = (loc0 + t) * 64 + 4 * hi - qpos + 128;
#pragma unroll
            for (int r = 0; r < 16; ++r) { const int kc = (r & 3) + 8 * (r >> 2);
                if ((unsigned)(mb + kc) > 256u) { p0[r] = -INFINITY; if (DUAL) r0_[r] = -INFINITY; } if ((unsigned)(mb + kc + 32) > 256u) { p1[r] = -INFINITY; if (DUAL) r1_[r] = -INFINITY; } }
        }
        if (MIX == 1 && local) {
            const int dr = (loc0 + t) - qb + 7;
            const int kh = 4 * hi - cs; const LAS float* rp = rpb + dr * 31 + 15 - qc + 4 * hi;
#pragma unroll
            for (int r = 0; r < 16; ++r) { const int kc = (r & 3) + 8 * (r >> 2);
                const bool v0 = (unsigned)(kh + kc) < 16u, v1 = (unsigned)(kh + kc + 32) < 16u;
                const float b0 = rp[kc], b1 = rp[kc + 32];
                p0[r] = v0 ? p0[r] + b0 : -INFINITY; p1[r] = v1 ? p1[r] + b1 : -INFINITY; }
        }
        softmax_tile(p0, p1, l0, pa0);
        if (TWO) softmax_tile(r0_, r1_, l1, pa1);
        WG_BAR();
        if (KHOLD && t + 1 < NT) loadkf(t + 1);
    }
    loadvf(NT - 1); pv(NT - 1);
    }
    { refresh(F); const int l31f = F.lane & 31, hif = F.lane >> 5;
      const float lt0 = x32_sum(l0); const float i0 = 1.0f / lt0;
      float sc1 = 0.f;
      if (DIFF) { const float lt1 = x32_sum(l1); sc1 = tab[TAB_LAM + L] / lt1; }
      if (DUAL) { const float lt1 = x32_sum(l1); sc1 = 1.0f / lt1; }
      float ss = 0.f, ss1 = 0.f;
#pragma unroll
      for (int dh = 0; dh < 2; ++dh)
#pragma unroll
          for (int r = 0; r < 16; ++r) { float v = o0[dh][r] * i0; if (DIFF) v -= o1[dh][r] * sc1; o0[dh][r] = v; ss += v * v;
              if (DUAL) { const float v1 = o1[dh][r] * sc1; o1[dh][r] = v1; ss1 += v1 * v1; } }
      ss = x32_sum(ss); if (DUAL) ss1 = x32_sum(ss1);
      float scl;
      if (DIFF) scl = __builtin_amdgcn_rsqf(ss * (1.f / 64.f) + EPS) * tab[TAB_LAM + DEPTH + L];
      else {
          LAS float* gss = (LAS float*)(F.lds + AT_GSS);
          if (hif == 0) { gss[(rs * 32 + l31f) * 4 + hq] = ss; if (DUAL) gss[(rs * 32 + l31f) * 4 + hq + 1] = ss1; }
          WG_BAR();
          const f32x4 g4 = *(const LAS f32x4*)(gss + (rs * 32 + l31f) * 4);
          scl = __builtin_amdgcn_rsqf(((g4.x + g4.y) + (g4.z + g4.w)) * (1.f / 256.f) + EPS);
      }
      int lf = l31f;
      const int qrow_f = isctx ? NLAT + b * CTXL + qb * UQ + rs * 32 + lf : b * SEQ + qb * UQ + rs * 32 + lf;
      GAS bf16_t* yp = Y + (size_t)qrow_f * D + MIX * 256 + hq * 64 + 4 * hif;
#pragma unroll
      for (int dh = 0; dh < 2; ++dh)
#pragma unroll
          for (int g = 0; g < 4; ++g) { u32x2 o; o.x = pk2(o0[dh][4 * g] * scl, o0[dh][4 * g + 1] * scl); o.y = pk2(o0[dh][4 * g + 2] * scl, o0[dh][4 * g + 3] * scl);
              *(GAS u32x2*)(yp + dh * 32 + 8 * g) = o;
              if (DUAL) { u32x2 o2; o2.x = pk2(o1[dh][4 * g] * scl, o1[dh][4 * g + 1] * scl); o2.y = pk2(o1[dh][4 * g + 2] * scl, o1[dh][4 * g + 3] * scl);
                  *(GAS u32x2*)(yp + 64 + dh * 32 + 8 * g) = o2; } }
    }
#ifdef MK_STAMP
    if (MIX == MK_STAMP && F.tid == MK_STAMP_TID) { LAS unsigned* m_ = (LAS unsigned*)(F.lds + MISC_OFF); const unsigned a_ = m_[20]; unsigned z_ = 0; asm volatile("" : "+v"(z_)); m_[20] = z_;
        if (!isctx) { __hip_atomic_fetch_add(CTL(F) + 2048, a_, __ATOMIC_RELAXED, __HIP_MEMORY_SCOPE_AGENT); __hip_atomic_fetch_add(CTL(F) + 2049, (unsigned)(NT - 1), __ATOMIC_RELAXED, __HIP_MEMORY_SCOPE_AGENT); } }
#endif
}

template <int MIX>
__device__ __forceinline__ void run_mixer(FARGS, int L, bool need_ctx) {
    constexpr bool DUAL = (MIX == 3) && MK_DUAL, HP = (MIX == 2) && MK_CHP;
    constexpr int NU = DUAL ? 512 : 1024, NC = DUAL ? 64 : 128;
    const int G = F.G;
    const int c = (G % 8 == 0) ? (F.bx % 8) * (G / 8) + F.bx / 8 : F.bx;
    const int nlat = c < NU ? (NU - c + G - 1) / G : 0;
    const int j = (MIX & 1) ? c - 128 : c;
    const bool has_ctx = need_ctx && j >= 0 && j < NC;
    const int n = nlat + (has_ctx ? 1 : 0);
    for (int k = 0; k < n; ++k) { const bool isctx = k >= nlat; const int i = isctx ? j : c + k * G;
        int b, qb, hp = 0;
        if (HP) { if (isctx) { b = i >> 2; qb = (i >> 1) & 1; hp = i & 1; } else { b = i >> 5; qb = (i & 31) >> 1; hp = i & 1; } }
        else if (DUAL) { if (isctx) { b = i >> 1; qb = i & 1; } else { b = i >> 4; qb = i & 15; } }
        else { if (isctx) { b = i >> 2; qb = i & 3; } else { b = i >> 5; qb = i & 31; } }
        attn_unit<MIX>(F, L, b, qb, isctx, hp); }
}
__device__ __forceinline__ void attn_phase(FARGS, int L, bool need_ctx) {
    refresh(F);
    { LAS float* rpb = (LAS float*)(F.lds + AT_RPB); const GAS float* src = INP(14) + L * 4 * 465;
      for (int i = F.tid; i < 4 * 465; i += 512) rpb[i] = src[i] * LOG2E; }
    __syncthreads();
#ifndef MK_DOUBLE_MIX
#define MK_DOUBLE_MIX -1
#endif
#define REPM(k) for (int rep_ = 0; rep_ < ((MK_DOUBLE_MIX == (k)) ? 2 : 1); ++rep_)
    REPM(2) run_mixer<2>(F, L, need_ctx);
    REPM(3) run_mixer<3>(F, L, need_ctx);
    REPM(1) run_mixer<1>(F, L, need_ctx);
    REPM(0) run_mixer<0>(F, L, need_ctx);
    __syncthreads();
}
struct ProbPlain {
    static constexpr bool GATHER = false;
    const GAS char* A; const GAS char* Bt; int K, lda, ldb; size_t hstepA, hstepB; pg8::Order ord;
    __device__ __forceinline__ bool next(int i, pg8::Unit& u) const { return ord.next(i, u); }
    template <int NH> __device__ __forceinline__ void a_off(const pg8::Unit& u, int tid, unsigned (&v)[NH][2]) const {
        int R0, C0, R1, C1; pg8::stage_rc(tid * 16, R0, C0); pg8::stage_rc(tid * 16 + 8192, R1, C1);
        v[0][0] = (unsigned)((u.pm * 256 + R0) * lda + C0) * 2u; v[0][1] = (unsigned)((u.pm * 256 + R1) * lda + C1) * 2u;
    }
    __device__ __forceinline__ const GAS char* b_tile(const pg8::Unit& u, int t) const { return Bt + ((size_t)u.pn * 256 * ldb + (size_t)t * 64) * 2; }
};
struct EpiU { static constexpr int SID = 0;
    static constexpr bool PERM = true; static constexpr int NSTORES = 32;
    GAS bf16_t* U;
    __device__ __forceinline__ void operator()(const f32x4 (&acc)[2][2][4][2], const pg8::Unit& u, int wr, int wc, int fr, int fq) const {
        const int row0 = u.pm * 256 + wr * 64 + fr, col0 = u.pn * 256 + wc * 32 + 8 * fq;
#pragma unroll
        for (int ai = 0; ai < 2; ++ai)
#pragma unroll
            for (int m = 0; m < 4; ++m) { int frx = fr; asm volatile("" : "+v"(frx)); GAS bf16_t* rowp = U + (size_t)(u.pm * 256 + wr * 64 + frx + ai * 128 + m * 16) * DIN + col0;
#pragma unroll
                for (int bj = 0; bj < 2; ++bj) { const f32x4 v0 = acc[ai][bj][m][0], v1 = acc[ai][bj][m][1];
                    u32x4 w; w.x = pk2(v0[0], v0[1]); w.y = pk2(v0[2], v0[3]); w.z = pk2(v1[0], v1[1]); w.w = pk2(v1[2], v1[3]);
                    *(GAS u32x4*)(rowp + bj * 128) = w; } }
    }
};
struct EpiQK { static constexpr int SID = 1;
    static constexpr bool PERM = true; static constexpr int NSTORES = 32;
    GAS bf16_t* U; const GAS float* tab; const GAS float* gwin; const GAS float* gna; const GAS float* gdiff; const GAS float* ggqa; LAS float* X; float vscale;
    __device__ __forceinline__ void operator()(const f32x4 (&acc)[2][2][4][2], const pg8::Unit& u, int wr, int wc, int fr_, int fq_) const {
        int fq = fq_, fr = fr_; asm volatile("" : "+v"(fq), "+v"(fr));
        const int pn = u.pn;
        const bool lat = u.pm < 256;
        int kind = 0, nbj = 0; bool isq = false, rope = false; const GAS float* g = gwin; float qs = 1.f;
        if (pn == 0) { kind = 1; nbj = 2; isq = true; rope = true; g = gwin; } else if (pn == 1) { kind = 1; nbj = 1; rope = true; g = gwin + 64; }
        else if (pn == 2) { kind = 1; nbj = 2; isq = true; g = gna; } else if (pn == 3) { kind = 1; nbj = 2; g = gna + 64; }
        else if (pn == 5) { kind = 2; nbj = 2; isq = true; rope = true; g = gdiff; } else if (pn == 6) { kind = 2; nbj = 2; rope = true; g = gdiff + 32; }
        else if (pn == 8) { kind = 1; nbj = 2; isq = true; rope = true; g = ggqa; } else if (pn == 9) { kind = 1; nbj = 1; rope = true; g = ggqa + 64; }
        rope = rope && lat;
        if (kind == 0) body<0, false, 0>(acc, u, wr, wc, fr, fq, isq, g);
        else if (kind == 2) { if (rope) body<2, true, 2>(acc, u, wr, wc, fr, fq, isq, g); else body<2, false, 2>(acc, u, wr, wc, fr, fq, isq, g); }
        else if (nbj == 2) { if (rope) body<1, true, 2>(acc, u, wr, wc, fr, fq, isq, g); else body<1, false, 2>(acc, u, wr, wc, fr, fq, isq, g); }
        else { if (rope) body<1, true, 1>(acc, u, wr, wc, fr, fq, isq, g); else body<1, false, 1>(acc, u, wr, wc, fr, fq, isq, g); }
    }
    template <int kind, bool rope, int nbj>
    __device__ __forceinline__ void body(const f32x4 (&acc)[2][2][4][2], const pg8::Unit& u, int wr, int wc, int fr, int fq, bool isq, const GAS float* g) const {
        const int pn = u.pn, lane = fr + 16 * fq;
        float qs = 1.f;
        if (isq) qs = (kind == 2 ? 0.17677669529663687f : 0.125f) * LOG2E;
        const int row0 = u.pm * 256 + wr * 64 + fr, col0 = pn * 256 + wc * 32 + 8 * fq;
        float gg[8];
        { const int dg = kind == 2 ? 8 * fq : 32 * (wc & 1) + 8 * fq; const f32x4 a = *(const GAS f32x4*)(g + dg), b = *(const GAS f32x4*)(g + dg + 4);
          gg[0] = a.x; gg[1] = a.y; gg[2] = a.z; gg[3] = a.w; gg[4] = b.x; gg[5] = b.y; gg[6] = b.z; gg[7] = b.w; }
        auto sumsq = [&](int ai, int m, int bj) -> float { const f32x4 v0 = acc[ai][bj][m][0], v1 = acc[ai][bj][m][1];
            float s = (v0[0] * v0[0] + v0[1] * v0[1]) + (v0[2] * v0[2] + v0[3] * v0[3]) + (v1[0] * v1[0] + v1[1] * v1[1]) + (v1[2] * v1[2] + v1[3] * v1[3]);
            s += sx(s, lane, 16); s += sx(s, lane, 32); return s; };
        LAS float* Xw = X + (wr * 64 + fr) * 8 + wc; const LAS float* Xr = X + (wr * 64 + fr) * 8 + (wc ^ 1);
        float ssv[2][4][2];
#pragma unroll
        for (int ai = 0; ai < 2; ++ai)
#pragma unroll
            for (int m = 0; m < 4; ++m) { ssv[ai][m][0] = 0.f; ssv[ai][m][1] = 0.f; }
        if (kind == 1) {
#pragma unroll
            for (int ai = 0; ai < 2; ++ai)
#pragma unroll
                for (int m = 0; m < 4; ++m)
#pragma unroll
                    for (int bj = 0; bj < 2; ++bj) { const float s = sumsq(ai, m, bj); ssv[ai][m][bj] = s; if (fq == 0) Xw[(ai * 128 + m * 16) * 8 + bj * 4] = s; }
            asm volatile("s_waitcnt lgkmcnt(0)\n\ts_barrier" ::: "memory");
        }
        const int pxor = kind == 2 ? 16 : 32;
        const bool first = kind == 2 ? !(fq & 1) : (fq < 2);
        auto load_cs = [&](int it, f32x4 (&dst)[4]) {
            int frx = fr; asm volatile("" : "+v"(frx));
            const int row = u.pm * 256 + (it >> 2) * 128 + wr * 64 + (it & 3) * 16 + frx, s_ = row & 2047, prow = s_ >> 6, pcol = s_ & 63;
            const GAS float* tp = kind == 2 ? tab + TAB_T32 + ((fq < 2 ? prow : pcol) * 8) * 2 : tab + TAB_T64 + (((wc & 1) ? pcol : prow) * 16 + 8 * (fq & 1)) * 2;
#pragma unroll
            for (int e2 = 0; e2 < 4; ++e2) dst[e2] = *(const GAS f32x4*)(tp + 4 * e2); };
        f32x4 cs[4], ncs[4];
        if (rope) load_cs(0, cs);
#pragma unroll
        for (int ai = 0; ai < 2; ++ai)
#pragma unroll
            for (int m = 0; m < 4; ++m) {
                int frx = fr; asm volatile("" : "+v"(frx));
                const int rit = ai * 128 + wr * 64 + m * 16 + frx, row = u.pm * 256 + rit;
                GAS bf16_t* rowp = U + (size_t)row * DIN + col0;
                if (rope && ai * 4 + m < 7) load_cs(ai * 4 + m + 1, ncs);
                asm volatile("" ::: "memory");
#pragma unroll
                for (int bj = 0; bj < 2; ++bj) {
                    const f32x4 v0 = acc[ai][bj][m][0], v1 = acc[ai][bj][m][1];
                    float x[8] = {v0[0], v0[1], v0[2], v0[3], v1[0], v1[1], v1[2], v1[3]};
                    if (kind != 0 && bj < nbj) {
                        float ss;
                        if (kind == 1) ss = ssv[ai][m][bj] + Xr[(ai * 128 + m * 16) * 8 + bj * 4]; else ss = sumsq(ai, m, bj);
                        const float rq = qs * __builtin_amdgcn_rsqf(ss * (kind == 2 ? (1.f / 32.f) : (1.f / 64.f)) + EPS);
#pragma unroll
                        for (int e = 0; e < 8; ++e) x[e] = x[e] * gg[e];
                        if (rope) {
#pragma unroll
                            for (int e2 = 0; e2 < 4; ++e2) {
                                const float pa = sx(x[2 * e2], lane, pxor), pb = sx(x[2 * e2 + 1], lane, pxor);
                                x[2 * e2] = first ? x[2 * e2] * cs[e2].x - pa * cs[e2].y : pa * cs[e2].y + x[2 * e2] * cs[e2].x;
                                x[2 * e2 + 1] = first ? x[2 * e2 + 1] * cs[e2].z - pb * cs[e2].w : pb * cs[e2].w + x[2 * e2 + 1] * cs[e2].z;
                            }
                        }
#pragma unroll
                        for (int e = 0; e < 8; ++e) x[e] *= rq;
                    } else {
#pragma unroll
                        for (int e = 0; e < 8; ++e) x[e] *= vscale;
                    }
                    u32x4 w; w.x = pk2(x[0], x[1]); w.y = pk2(x[2], x[3]); w.z = pk2(x[4], x[5]); w.w = pk2(x[6], x[7]);
                    *(GAS u32x4*)(rowp + bj * 128) = w;
                }
#pragma unroll
                for (int e2 = 0; e2 < 4; ++e2) cs[e2] = ncs[e2];
            }
    }
};
struct EpiResid { static constexpr int SID = 2;
    static constexpr bool PERM = true; static constexpr int NSTORES = 32;
    const GAS float* slat; const GAS float* sctx; GAS bf16_t* XB; const GAS float* gate; bool first; float ascale;
    __device__ __forceinline__ void operator()(const f32x4 (&acc)[2][2][4][2], const pg8::Unit& u, int wr, int wc, int fr_, int fq) const {
        int fr = fr_; asm volatile("" : "+v"(fr));
        if (first) body<true>(acc, u, wr, wc, fr, fq); else body<false>(acc, u, wr, wc, fr, fq);
    }
    template <bool FIRST>
    __device__ __forceinline__ void body(const f32x4 (&acc)[2][2][4][2], const pg8::Unit& u, int wr, int wc, int fr, int fq) const {
        const bool islat = u.pm < 256; const int b = islat ? (u.pm >> 3) : 32;
        const GAS float* src = islat ? slat + (size_t)u.pm * 256 * D : sctx + (size_t)(u.pm - 256) * 256 * D;
        GAS bf16_t* dst = XB + (size_t)u.pm * 256 * D;
        const GAS float* gp = gate + (size_t)b * ADA;
        const int col0 = u.pn * 256 + wc * 32 + 8 * fq;
        f32x4 gv[2][2];
#pragma unroll
        for (int bj = 0; bj < 2; ++bj)
#pragma unroll
            for (int n = 0; n < 2; ++n) gv[bj][n] = *(const GAS f32x4*)(gp + col0 + bj * 128 + n * 4) * ascale;
        if (FIRST) {
#pragma unroll
            for (int ai = 0; ai < 2; ++ai)
#pragma unroll
                for (int m = 0; m < 4; ++m) {
                    const size_t ro = (size_t)(ai * 128 + wr * 64 + m * 16 + fr) * D + col0;
#pragma unroll
                    for (int bj = 0; bj < 2; ++bj) { f32x4 x0 = *(const GAS f32x4*)(src + ro + bj * 128), x1 = *(const GAS f32x4*)(src + ro + bj * 128 + 4);
                        x0 = x0 + gv[bj][0] * acc[ai][bj][m][0]; x1 = x1 + gv[bj][1] * acc[ai][bj][m][1];
                        u32x4 o; o.x = pk2(x0[0], x0[1]); o.y = pk2(x0[2], x0[3]); o.z = pk2(x1[0], x1[1]); o.w = pk2(x1[2], x1[3]);
                        *(GAS u32x4*)(dst + ro + bj * 128) = o; } }
        } else {
            u32x4 wv[2][4][2];
#pragma unroll
            for (int ai = 0; ai < 2; ++ai)
#pragma unroll
                for (int m = 0; m < 4; ++m) { const size_t ro = (size_t)(ai * 128 + wr * 64 + m * 16 + fr) * D + col0;
                    wv[ai][m][0] = *(const GAS u32x4*)(dst + ro); wv[ai][m][1] = *(const GAS u32x4*)(dst + ro + 128); }
#pragma unroll
            for (int ai = 0; ai < 2; ++ai)
#pragma unroll
                for (int m = 0; m < 4; ++m) { const size_t ro = (size_t)(ai * 128 + wr * 64 + m * 16 + fr) * D + col0;
#pragma unroll
                    for (int bj = 0; bj < 2; ++bj) { const u32x4 w = wv[ai][m][bj];
                        f32x4 x0 = (f32x4){bflo(w.x), bfhi(w.x), bflo(w.y), bfhi(w.y)}, x1 = (f32x4){bflo(w.z), bfhi(w.z), bflo(w.w), bfhi(w.w)};
                        x0 = x0 + gv[bj][0] * acc[ai][bj][m][0]; x1 = x1 + gv[bj][1] * acc[ai][bj][m][1];
                        u32x4 o; o.x = pk2(x0[0], x0[1]); o.y = pk2(x0[2], x0[3]); o.z = pk2(x1[0], x1[1]); o.w = pk2(x1[2], x1[3]);
                        *(GAS u32x4*)(dst + ro + bj * 128) = o; } }
        }
    }
};
struct MoeTab { const LAS int* tcls; const LAS int* trow; const LAS int* ccnt; };
__device__ __forceinline__ void moe_pair(int cls, int& ea, int& eb) { const int g = cls / 6, pr = cls % 6; const int ia = pr < 3 ? 0 : (pr < 5 ? 1 : 2), ib = pr < 3 ? pr + 1 : (pr < 5 ? pr - 1 : 3); ea = 4 * g + ia; eb = 4 * g + ib; }
__device__ __forceinline__ int moe_build_tables(FARGS, int L) {
    LAS int* tcls = (LAS int*)(F.lds + MOE_OFF); LAS int* trow = tcls + 320; LAS int* ccnt = trow + 320; LAS int* pre = ccnt + 32;
    if (F.tid < NCLS) ccnt[F.tid] = (int)__hip_atomic_load(CTL(F) + CW_CNT + (L * NCLS + F.tid) * 64, __ATOMIC_RELAXED, __HIP_MEMORY_SCOPE_AGENT);
    __syncthreads();
    if (F.tid == 0) { int T = 0;
#pragma unroll 1
        for (int c = 0; c < NCLS; ++c) { pre[c] = T; T += (ccnt[c] + 255) >> 8; }
        pre[NCLS] = T; }
    __syncthreads();
    const int T = pre[NCLS];
    if (F.tid < T) { int c = 0;
#pragma unroll 1
        for (int k = 1; k < NCLS; ++k) if (pre[k] <= F.tid) c = k;
        tcls[F.tid] = c; trow[F.tid] = (F.tid - pre[c]) * 256; }
    __syncthreads();
    return __builtin_amdgcn_readfirstlane(T);
}
struct ProbGateUp {
    static constexpr bool GATHER = true;
    const GAS char* A; const GAS char* W1; const GAS int* perm; int K, ldb; size_t hstepA, hstepB; pg8::Order ord; MoeTab tb;
    __device__ __forceinline__ bool next(int i, pg8::Unit& u) const { return ord.next(i, u); }
    template <int NH> __device__ __forceinline__ void a_off(const pg8::Unit& u, int tid, unsigned (&v)[NH][2]) const {
        int R0, C0, R1, C1; pg8::stage_rc(tid * 16, R0, C0); pg8::stage_rc(tid * 16 + 8192, R1, C1);
        const int cls = __builtin_amdgcn_readfirstlane(tb.tcls[u.pm]), tr = __builtin_amdgcn_readfirstlane(tb.trow[u.pm]), n = __builtin_amdgcn_readfirstlane(tb.ccnt[cls]);
        const GAS int* pp = perm + (size_t)cls * MTOT + tr;
#pragma unroll
        for (int h = 0; h < 2; ++h) { const int s0 = h * 128 + R0, s1 = h * 128 + R1;
            const int t0 = (tr + s0 < n) ? pp[s0] : 0, t1 = (tr + s1 < n) ? pp[s1] : 0;
            v[h][0] = (unsigned)(t0 * D + C0) * 2u; v[h][1] = (unsigned)(t1 * D + C1) * 2u; }
    }
    __device__ __forceinline__ const GAS char* b_tile(const pg8::Unit& u, int t) const {
        const int cls = __builtin_amdgcn_readfirstlane(tb.tcls[u.pm]); int ea, eb; moe_pair(cls, ea, eb); const int e = u.pn < 4 ? ea : eb;
        return W1 + (((size_t)e * 1024 + (u.pn & 3) * 256) * D + (size_t)t * 64) * 2;
    }
};
struct EpiGateUp { static constexpr int SID = 3;
    static constexpr bool PERM = true; static constexpr int NSTORES = 16;
    GAS bf16_t* ACT; const GAS int* perm; const GAS float* RW; MoeTab tb;
    __device__ __forceinline__ void operator()(const f32x4 (&acc)[2][2][4][2], const pg8::Unit& u, int wr, int wc, int fr, int fq) const {
        const int cls = __builtin_amdgcn_readfirstlane(tb.tcls[u.pm]), tr = __builtin_amdgcn_readfirstlane(tb.trow[u.pm]), n = __builtin_amdgcn_readfirstlane(tb.ccnt[cls]);
        const GAS int* pp = perm + (size_t)cls * MTOT + tr;
        const int wsel = u.pn >> 2, colb = wsel * 512 + (u.pn & 3) * 128 + wc * 32 + 8 * fq;
        int frx = fr; asm volatile("" : "+v"(frx));
        const int rbase = wr * 64 + frx;
        int tok[8]; float wgt[8];
#pragma unroll
        for (int i = 0; i < 8; ++i) { const int rr = (i >> 2) * 128 + (i & 3) * 16 + rbase; const int rc = rr < n - tr ? rr : n - tr - 1; tok[i] = pp[rc]; }
#pragma unroll
        for (int i = 0; i < 8; ++i) { const float w_ = RW[(size_t)tok[i] * 2 + wsel]; wgt[i] = w_; }
#pragma unroll
        for (int i = 0; i < 8; ++i) { const int rr = (i >> 2) * 128 + (i & 3) * 16 + rbase; if (!(tr + rr < n)) wgt[i] = 0.f; }
#pragma unroll
        for (int ai = 0; ai < 2; ++ai)
#pragma unroll
            for (int m = 0; m < 4; ++m) { const int rr = ai * 128 + m * 16 + rbase; const float wg = wgt[ai * 4 + m];
                float a[8];
#pragma unroll
                for (int nn = 0; nn < 2; ++nn)
#pragma unroll
                    for (int j = 0; j < 4; ++j) { const float g = acc[ai][0][m][nn][j], uu = acc[ai][1][m][nn][j];
                        a[nn * 4 + j] = g * __builtin_amdgcn_rcpf(1.0f + __builtin_amdgcn_exp2f(-g * LOG2E)) * uu * wg; }
                u32x4 w; w.x = pk2(a[0], a[1]); w.y = pk2(a[2], a[3]); w.z = pk2(a[4], a[5]); w.w = pk2(a[6], a[7]);
                *(GAS u32x4*)(ACT + (size_t)(u.pm * 256 + rr) * D + colb) = w; }
    }
};
struct ProbDown {
    static constexpr bool GATHER = false;
    const GAS char* A; const GAS char* W2; int K, ldb; size_t hstepA, hstepB; pg8::Order ord; MoeTab tb;
    __device__ __forceinline__ bool next(int i, pg8::Unit& u) const { return ord.next(i, u); }
    template <int NH> __device__ __forceinline__ void a_off(const pg8::Unit& u, int tid, unsigned (&v)[NH][2]) const {
        int R0, C0, R1, C1; pg8::stage_rc(tid * 16, R0, C0); pg8::stage_rc(tid * 16 + 8192, R1, C1);
        v[0][0] = (unsigned)((u.pm * 256 + R0) * D + C0) * 2u; v[0][1] = (unsigned)((u.pm * 256 + R1) * D + C1) * 2u;
    }
    __device__ __forceinline__ const GAS char* b_tile(const pg8::Unit& u, int t) const {
        const int cls = __builtin_amdgcn_readfirstlane(tb.tcls[u.pm]); int ea, eb; moe_pair(cls, ea, eb); const int e = t < 8 ? ea : eb;
        return W2 + (((size_t)e * 1024 + u.pn * 256) * DEXP + (size_t)(t & 7) * 64) * 2;
    }
};
template <bool LAST> struct EpiDown { static constexpr int SID = 4;
    static constexpr bool PERM = true; static constexpr int NSTORES = 0;
    GAS bf16_t* XB; GAS float* out; const GAS float* gate; const GAS int* perm; MoeTab tb;
    __device__ __forceinline__ void operator()(const f32x4 (&acc)[2][2][4][2], const pg8::Unit& u, int wr, int wc, int fr, int fq) const {
        const int cls = __builtin_amdgcn_readfirstlane(tb.tcls[u.pm]), tr = __builtin_amdgcn_readfirstlane(tb.trow[u.pm]), n = __builtin_amdgcn_readfirstlane(tb.ccnt[cls]);
        const GAS int* pp = perm + (size_t)cls * MTOT + tr;
        const int col0 = u.pn * 256 + wc * 32 + 8 * fq;
        int frx = fr; asm volatile("" : "+v"(frx));
        const int rbase = wr * 64 + frx;
        int tok8[8];
#pragma unroll
        for (int i = 0; i < 8; ++i) { const int rr = (i >> 2) * 128 + (i & 3) * 16 + rbase; const int rc = rr < n - tr ? rr : n - tr - 1; tok8[i] = pp[rc]; }
        u32x4 wv[4][2]; f32x4 gv[2][2][2];
        auto load_res = [&](int i) { const GAS bf16_t* xr = XB + (size_t)tok8[i] * D + col0; wv[i & 3][0] = *(const GAS u32x4*)xr; wv[i & 3][1] = *(const GAS u32x4*)(xr + 128); };
#pragma unroll
        for (int i = 0; i < 4; ++i) load_res(i);
        auto load_gate = [&](int i, f32x4 (&g)[2][2]) { const int tok = tok8[i]; const int b = tok < NLAT ? (tok >> 11) : 32; const GAS float* gp = gate + (size_t)b * ADA + col0;
#pragma unroll
            for (int bj = 0; bj < 2; ++bj) { g[bj][0] = *(const GAS f32x4*)(gp + bj * 128); g[bj][1] = *(const GAS f32x4*)(gp + bj * 128 + 4); } };
        load_gate(0, gv[0]);
#pragma unroll
        for (int i = 0; i < 8; ++i) { const int ai = i >> 2, m = i & 3;
            if (i + 1 < 8) load_gate(i + 1, gv[(i + 1) & 1]);
            __builtin_amdgcn_sched_barrier(0);
            const int rr = ai * 128 + m * 16 + rbase; const bool valid = tr + rr < n; const int tok = tok8[i];
#pragma unroll
            for (int bj = 0; bj < 2; ++bj) { const u32x4 w = wv[i & 3][bj];
                const f32x4 x0 = (f32x4){bflo(w.x), bfhi(w.x), bflo(w.y), bfhi(w.y)} + gv[i & 1][bj][0] * acc[ai][bj][m][0], x1 = (f32x4){bflo(w.z), bfhi(w.z), bflo(w.w), bfhi(w.w)} + gv[i & 1][bj][1] * acc[ai][bj][m][1];
                if (valid) {
                    if (LAST) { GAS float* op = out + (size_t)tok * D + col0 + bj * 128; *(GAS f32x4*)op = x0; *(GAS f32x4*)(op + 4) = x1; }
                    else { u32x4 o; o.x = pk2(x0[0], x0[1]); o.y = pk2(x0[2], x0[3]); o.z = pk2(x1[0], x1[1]); o.w = pk2(x1[2], x1[3]); *(GAS u32x4*)(XB + (size_t)tok * D + col0 + bj * 128) = o; } } }
            __builtin_amdgcn_sched_barrier(0);
            if (i + 4 < 8) load_res(i + 4);
        }
    }
};

constexpr int NPHASE = 1 + 8 * DEPTH;
__global__ void __launch_bounds__(NWAVES * 64, 2) mk_fwd(Args args) {
    extern __shared__ __attribute__((aligned(16))) unsigned char lds_raw[];
    Frame F;
    F.lds = (LAS unsigned char*)lds_raw;
    volatile LAS unsigned* MISC = (volatile LAS unsigned*)(F.lds + MISC_OFF);
    F.tid = threadIdx.x; F.lane = F.tid & 63; F.wave = __builtin_amdgcn_readfirstlane(F.tid >> 6); F.G = gridDim.x; F.bx = blockIdx.x;
    const bool t0 = F.tid == 0;
    F.ws = (GAS unsigned char*)args.ws; F.out = (GAS float*)args.out; F.ka = (kptr_t)__builtin_amdgcn_kernarg_segment_ptr();
    for (int u = F.tid; u < (LDS_BYTES - MISC_OFF) / 4; u += NWAVES * 64) ((LAS unsigned*)(F.lds + MISC_OFF))[u] = 0u;
    __syncthreads();
    XcdBarrier bar; bar.bar = (unsigned*)(CTL(F) + CW_BAR); bar.x = 0; bar.st = nullptr;
    if (args.use_bar) bar = xcd_barrier_post((unsigned*)(CTL(F) + CW_BAR), MISC + 8, t0);
    const int lo = args.ph_lo, hi = args.ph_hi;
#define IN(k) (lo <= (k) && (k) < hi)
#ifndef MK_BAR_REP
#define MK_BAR_REP 1
#endif
#ifdef MK_GSTAMP
#define GS_FLUSH() do { if (F.tid == MK_GSTAMP_TID) { LAS unsigned* m_ = (LAS unsigned*)(F.lds + MISC_OFF); const unsigned a_ = m_[16], n_ = m_[17]; unsigned z_ = 0; asm volatile("" : "+v"(z_)); m_[16] = z_; m_[17] = z_; \
    if (n_) { __hip_atomic_fetch_add(CTL(F) + 2048, a_, __ATOMIC_RELAXED, __HIP_MEMORY_SCOPE_AGENT); __hip_atomic_fetch_add(CTL(F) + 2049, n_, __ATOMIC_RELAXED, __HIP_MEMORY_SCOPE_AGENT); } } } while (0)
#else
#define GS_FLUSH() do {} while (0)
#endif
#define SEAM(k) do { GS_FLUSH(); if (IN(k) && IN((k) + 1)) { for (int br_ = 0; br_ < MK_BAR_REP; ++br_) { refresh(F); xcd_barrier(bar, F.tid == 0); } } } while (0)
#ifndef MK_PHMASK
#define MK_PHMASK 0x1ff
#endif
#define EN(k) ((MK_PHMASK >> (k)) & 1)
#ifndef MK_SEPARATE_QKPREP
#define MK_SEPARATE_QKPREP 0
#endif
#ifndef MK_DOUBLE
#define MK_DOUBLE -1
#endif
#define REP(k) for (int rep_ = 0; rep_ < ((MK_DOUBLE == (k)) ? 2 : 1); ++rep_)
#define XB_P ((GAS bf16_t*)(F.ws + WS_XB))
#define MOD_P ((const GAS float*)(F.ws + WS_MOD))
    if (EN(0) && IN(0)) { REP(0) prologue_phase(F); SEAM(0); }
    for (int L0 = 0; L0 < DEPTH; ++L0) {
        const int pb = 1 + 8 * L0;
        if (EN(1) && IN(pb + 0)) { int L = L0; OPAQUE_S(L); refresh(F);
            REP(1) norm_phase<false>(F, L, MTOT, L == 0, INP(6) + L * D, 0, 1024); SEAM(pb + 0); }
        if (EN(2) && IN(pb + 1)) { int L = L0; OPAQUE_S(L); refresh(F);
            ProbPlain P; P.A = (const GAS char*)(F.ws + WS_H); P.Bt = (const GAS char*)(F.ws + WS_WIN) + (size_t)L * DIN * D * 2; P.K = D; P.lda = D; P.ldb = D; P.hstepA = (size_t)128 * D * 2; P.hstepB = (size_t)128 * D * 2; P.ord.init(MTOT / 256, DIN / 256, F.G, F.bx);
            EpiQK E; E.U = (GAS bf16_t*)(F.ws + WS_U); E.tab = (const GAS float*)(F.ws + WS_TAB); E.gwin = INP(9) + L * 128; E.gna = INP(10) + L * 128; E.gdiff = INP(11) + L * 64; E.ggqa = INP(12) + L * 128;
            E.X = (LAS float*)(F.lds + MOE_OFF);
            E.vscale = 1.0f;
            REP(2) pg8::gemm_phase<EpiQK, ProbPlain>(F.lds, P, E, F.tid);
            SEAM(pb + 1);
        }
        if (MK_SEPARATE_QKPREP && EN(3) && IN(pb + 2)) { REP(3) qkprep_phase(F, L0, (MK_DOUBLE != 3) || rep_ == 1 || args.pad != 0); SEAM(pb + 2); }
        if (EN(4) && IN(pb + 3)) { REP(4) attn_phase(F, L0, L0 < DEPTH - 1); SEAM(pb + 3); }
        if (EN(5) && IN(pb + 4)) { int L = L0; OPAQUE_S(L); refresh(F);
            const int M2 = L < DEPTH - 1 ? MTOT : NLAT;
            ProbPlain P; P.A = (const GAS char*)(F.ws + WS_Y); P.Bt = (const GAS char*)(F.ws + WS_WOUT) + (size_t)L * D * D * 2; P.K = D; P.lda = D; P.ldb = D; P.hstepA = (size_t)128 * D * 2; P.hstepB = (size_t)128 * D * 2; P.ord.init(M2 / 256, D / 256, F.G, F.bx);
            EpiResid E; E.slat = INP(0); E.sctx = INP(2); E.XB = XB_P; E.first = L == 0; E.gate = MOD_P + (size_t)L * 33 * ADA + 2 * 1024;
#ifdef MK_PROBE_K2
            P.K = 2 * D; E.ascale = 0.5f;
#else
            E.ascale = 1.0f;
#endif
            pg8::gemm_phase<EpiResid, ProbPlain>(F.lds, P, E, F.tid);
            SEAM(pb + 4);
        }
        if (EN(6) && IN(pb + 5)) { int L = L0; OPAQUE_S(L); refresh(F);
#ifdef MK_OLD_NORM2
            REP(6) norm_phase<true>(F, L, L < DEPTH - 1 ? MTOT : NLAT, false, INP(7) + L * D, 3 * 1024, 4 * 1024, (MK_DOUBLE != 6) || rep_ == 1 || args.pad != 0); SEAM(pb + 5); }
#else
            norm2_phase(F, L, L < DEPTH - 1 ? MTOT : NLAT); SEAM(pb + 5); }
#endif
        if (EN(7) && IN(pb + 6)) { int L = L0; OPAQUE_S(L); refresh(F);
            const int T = moe_build_tables(F, L);
            MoeTab tb; tb.tcls = (const LAS int*)(F.lds + MOE_OFF); tb.trow = tb.tcls + 320; tb.ccnt = tb.trow + 320;
            ProbGateUp P; P.A = (const GAS char*)(F.ws + WS_H); P.W1 = (const GAS char*)(F.ws + WS_W1) + (size_t)L * NEXP * 1024 * D * 2; P.perm = (const GAS int*)(F.ws + WS_PERM); P.K = D; P.ldb = D; P.hstepA = 0; P.hstepB = (size_t)128 * D * 2; P.ord.init(T, 8, F.G, F.bx); P.tb = tb;
            EpiGateUp E; E.ACT = (GAS bf16_t*)(F.ws + WS_ACT); E.perm = P.perm; E.RW = (const GAS float*)(F.ws + WS_RW); E.tb = tb;
            REP(7) pg8::gemm_phase<EpiGateUp, ProbGateUp>(F.lds, P, E, F.tid);
            SEAM(pb + 6);
        }
        if (EN(8) && IN(pb + 7)) { int L = L0; OPAQUE_S(L); refresh(F);
            const int T = moe_build_tables(F, L);
            MoeTab tb; tb.tcls = (const LAS int*)(F.lds + MOE_OFF); tb.trow = tb.tcls + 320; tb.ccnt = tb.trow + 320;
            ProbDown P; P.A = (const GAS char*)(F.ws + WS_ACT); P.W2 = (const GAS char*)(F.ws + WS_W2) + (size_t)L * NEXP * 1024 * DEXP * 2; P.K = D; P.ldb = DEXP; P.hstepA = (size_t)128 * D * 2; P.hstepB = (size_t)128 * DEXP * 2; P.ord.init(T, 4, F.G, F.bx); P.tb = tb;
            if (L < DEPTH - 1) { EpiDown<false> E; E.XB = XB_P; E.out = F.out; E.gate = MOD_P + (size_t)L * 33 * ADA + 5 * 1024; E.perm = (const GAS int*)(F.ws + WS_PERM); E.tb = tb;
                pg8::gemm_phase<EpiDown<false>, ProbDown>(F.lds, P, E, F.tid); }
            else { EpiDown<true> E; E.XB = XB_P; E.out = F.out; E.gate = MOD_P + (size_t)L * 33 * ADA + 5 * 1024; E.perm = (const GAS int*)(F.ws + WS_PERM); E.tb = tb;
                pg8::gemm_phase<EpiDown<true>, ProbDown>(F.lds, P, E, F.tid); }
            SEAM(pb + 7);
        }
    }
#if defined(MK_STAMP) || defined(MK_GSTAMP)
    {
        refresh(F); xcd_barrier(bar, F.tid == 0); refresh(F);
        const unsigned num = __hip_atomic_load(CTL(F) + 2048, __ATOMIC_RELAXED, __HIP_MEMORY_SCOPE_AGENT), den = __hip_atomic_load(CTL(F) + 2049, __ATOMIC_RELAXED, __HIP_MEMORY_SCOPE_AGENT);
        const float smul = 1.0f + floorf(((float)num / (float)(den ? den : 1u)) * (1.0f / MK_STAMP_Q)) * 0.02f;
        GAS f32x4* o4 = (GAS f32x4*)F.out;
        for (size_t i = (size_t)F.bx * 512 + F.tid; i < (size_t)NLAT * D / 4; i += (size_t)F.G * 512) o4[i] = o4[i] * smul;
    }
#endif
#undef IN
#undef SEAM
}

#ifndef MK_PER_PHASE
#define MK_PER_PHASE 0
#endif
extern "C" void kernel_launch(void* const* d_in, const int* in_sizes, int n_in, void* d_out, int out_size, void* d_ws, size_t ws_size, hipStream_t stream) {
    static int grid = 0;
    if (grid == 0) {
        if (n_in != 23 || out_size != NLAT * D || ws_size < WS_END) { fprintf(stderr, "kernel_launch: unexpected shapes (n_in %d out %d ws %zu)\n", n_in, out_size, ws_size); grid = -1; return; }
        int dev = 0, cus = 0, per_cu = 0;
        if (hipGetDevice(&dev) != hipSuccess || hipDeviceGetAttribute(&cus, hipDeviceAttributeMultiprocessorCount, dev) != hipSuccess) { grid = -1; return; }
        if (hipFuncSetAttribute((const void*)mk_fwd, hipFuncAttributeMaxDynamicSharedMemorySize, LDS_BYTES) != hipSuccess) { fprintf(stderr, "kernel_launch: hipFuncSetAttribute failed\n"); grid = -1; return; }
        if (hipOccupancyMaxActiveBlocksPerMultiprocessor(&per_cu, (const void*)mk_fwd, NWAVES * 64, LDS_BYTES) != hipSuccess || per_cu < 1) fprintf(stderr, "kernel_launch: occupancy query reports %d\n", per_cu);
        (void)hipGetLastError();
        grid = cus;
    }
    if (grid < 0) return;
    (void)hipMemsetAsync((char*)d_ws + WS_CTL, 0, CTL_ZERO_BYTES, stream);
    Args a{};
    for (int i = 0; i < 23; ++i) a.in[i] = (const float*)d_in[i];
    a.out = (float*)d_out; a.ws = (unsigned char*)d_ws; a.pad = 0;
#if MK_PER_PHASE
    for (int p = 0; p < NPHASE; ++p) { a.ph_lo = p; a.ph_hi = p + 1; a.use_bar = 0; hipLaunchKernelGGL(mk_fwd, dim3(grid), dim3(NWAVES * 64), LDS_BYTES, stream, a); }
#else
    a.ph_lo = 0; a.ph_hi = NPHASE; a.use_bar = 1;
    hipLaunchKernelGGL(mk_fwd, dim3(grid), dim3(NWAVES * 64), LDS_BYTES, stream, a);
#endif
}
```

```cpp
#include <hip/hip_runtime.h>
#include <cstdio>
#include <cstdint>
#define GAS __attribute__((address_space(1)))
#define MK_ILV 15
#define XB_TMO      128
#define XB_XCNT(j)  (256  + 64 * (j))
#define XB_XSUB(j)  (1280 + 64 * (j))
#define XB_XGEN(j)  (2304 + 64 * (j))
#define XB_TOP      3328
#define XB_TOPGEN   3392
#define XCD_BAR_WORDS 3456
#define XB_SPIN_CAP (1u << 18)
#define LAS __attribute__((address_space(3)))

__device__ __forceinline__ unsigned xb_ld(unsigned* p)              { return __hip_atomic_load(p, __ATOMIC_RELAXED, __HIP_MEMORY_SCOPE_AGENT); }
__device__ __forceinline__ unsigned xb_add(unsigned* p, unsigned v) { return __hip_atomic_fetch_add(p, v, __ATOMIC_RELAXED, __HIP_MEMORY_SCOPE_AGENT); }
__device__ __forceinline__ unsigned xb_xcc_id() { return (unsigned)__builtin_amdgcn_s_getreg((3 << 11) | 20) & 0xFu; }
#define XB_SPIN(cond, bar) do { unsigned _sp = 0; while (cond) { __builtin_amdgcn_s_sleep(1); \
    if ((++_sp & 255u) == 0u) { if (xb_ld(&(bar)[XB_TMO])) break; if (_sp > XB_SPIN_CAP) { atomicAdd(&(bar)[XB_TMO], 1u); break; } } } } while (0)

struct XcdBarrier {
    unsigned* bar; unsigned x;
    volatile LAS unsigned* st;
};

__device__ __forceinline__ XcdBarrier xcd_barrier_post(unsigned* bar, volatile LAS unsigned* st, bool t0  ) {
    XcdBarrier b; b.bar = bar; b.x = xb_xcc_id(); b.st = st;
    if (t0) (void)xb_add(&bar[XB_XCNT(b.x)], 1u);
    return b;
}
__device__ __forceinline__ void xcd_barrier_complete(unsigned* bar, unsigned x, unsigned& nloc, unsigned& nx) {
    const unsigned G = gridDim.x * gridDim.y * gridDim.z;
    unsigned sum, cnt, mine, sp = 0u;
    for (;;) {
        sum = 0u; cnt = 0u; mine = 0u;
#pragma unroll
        for (unsigned j = 0; j < 16; ++j) { const unsigned c = xb_ld(&bar[XB_XCNT(j)]); sum += c; cnt += (c > 0u) ? 1u : 0u; mine = (j == x) ? c : mine; }
        if (sum == G) break;
        __builtin_amdgcn_s_sleep(1);
        if ((++sp & 255u) == 0u) { if (xb_ld(&bar[XB_TMO])) break; if (sp > XB_SPIN_CAP) { atomicAdd(&bar[XB_TMO], 1u); break; } }
    }
    nloc = mine > 0u ? mine : 1u; nx = cnt > 0u ? cnt : 1u;
}

__device__ __forceinline__ void xcd_barrier(const XcdBarrier& b, bool t0  ) {
    asm volatile("s_waitcnt vmcnt(0)" ::: "memory");
    __syncthreads();
    if (t0) {
        unsigned* bar = b.bar;
        __builtin_amdgcn_s_waitcnt(0);
        unsigned nloc = b.st[0], nx = b.st[1];
        if (nloc == 0u) { xcd_barrier_complete(bar, b.x, nloc, nx); b.st[0] = nloc; b.st[1] = nx; }
        const unsigned old = xb_add(&bar[XB_XSUB(b.x)], 1u);
        const unsigned gen = old / nloc;
        if (old + 1u == (gen + 1u) * nloc) {
            __builtin_amdgcn_fence(__ATOMIC_RELEASE, "agent");
            asm volatile("s_waitcnt vmcnt(0)" ::: "memory");
            const unsigned og = xb_add(&bar[XB_TOP], 1u);
            const unsigned tg = og / nx;
            if (og + 1u == (tg + 1u) * nx) xb_add(&bar[XB_TOPGEN], 1u);
            else XB_SPIN(xb_ld(&bar[XB_TOPGEN]) == tg, bar);
            __builtin_amdgcn_fence(__ATOMIC_ACQUIRE, "agent");
            xb_add(&bar[XB_XGEN(b.x)], 1u);
            asm volatile("s_waitcnt vmcnt(0)" ::: "memory");
        } else {
            XB_SPIN(xb_ld(&bar[XB_XGEN(b.x)]) == gen, bar);
            __builtin_amdgcn_fence(__ATOMIC_ACQUIRE, "agent");
            asm volatile("s_waitcnt vmcnt(0)" ::: "memory");
        }
    }
    __syncthreads();
}
constexpr int D = 1024, NBATCH = 32, SEQ = 2048, DEPTH = 4, CTXL = 256, NLAT = NBATCH * SEQ, NCTX = NBATCH * CTXL, MTOT = NLAT + NCTX, DIN = 2560;
constexpr int NEXP = 16, DEXP = 512, NCLS = 24, ADA = 6 * D;
constexpr float EPS = 1e-6f, LOG2E = 1.4426950408889634f;
constexpr int QA = 0, KA = 256, VA = 384, QB = 512, KB = 768, VB = 1024, QC = 1280, KC = 1536, VC = 1792, QD = 2048, KD = 2304, VD = 2432;
constexpr size_t MiB = 1u << 20;
constexpr size_t WS_CTL = 0, CTL_ZERO_BYTES = 128 * 1024;
constexpr size_t WS_MOD = 1 * MiB;
constexpr size_t WS_TAB = 4 * MiB + 256 * 1024;
constexpr size_t WS_RW = 4 * MiB + 320 * 1024;
constexpr size_t WS_PERM = 5 * MiB;
constexpr size_t WS_WIN = 12 * MiB;
constexpr size_t WS_WOUT = 32 * MiB;
constexpr size_t WS_W1 = 40 * MiB;
constexpr size_t WS_W2 = 168 * MiB;
constexpr size_t WS_XB = 232 * MiB;
constexpr size_t WS_Y = 376 * MiB;
constexpr size_t WS_U = 520 * MiB;
constexpr size_t WS_ACT = WS_U;
constexpr size_t WS_H = 880 * MiB;
constexpr size_t WS_END = 1024 * MiB;
static_assert(WS_MOD + (size_t)DEPTH * 33 * 6144 * 4 <= WS_TAB && WS_RW + (size_t)MTOT * 8 <= WS_PERM && WS_PERM + (size_t)NCLS * MTOT * 4 <= WS_WIN, "ws map");
constexpr int CW_BAR = 4096;
constexpr int CW_CNT = 16384;
static_assert((CW_CNT + DEPTH * NCLS * 64) * 4 <= (int)CTL_ZERO_BYTES && (CW_BAR + 3456) <= CW_CNT, "ctl");
constexpr int TAB_T64 = 0;
constexpr int TAB_T32 = 2048;
constexpr int TAB_LAM = 3072;
constexpr int NWAVES = 8;
constexpr int LDS_BYTES = 159744;
constexpr int RING_BYTES = 131072;
constexpr int MOE_OFF = 131072;
constexpr int NRM_OFF = 134144;
constexpr int MISC_OFF = 155648;
constexpr int AT_BUFB = 70656, AT_VOFF = 33792, AT_RPB = 141312, AT_GSS = 148992;

typedef unsigned short bf16_t;
typedef short bf16x8 __attribute__((ext_vector_type(8)));
typedef short s16x4 __attribute__((ext_vector_type(4)));
typedef float f32x4 __attribute__((ext_vector_type(4)));
typedef float f32x2 __attribute__((ext_vector_type(2)));
typedef float f32x16 __attribute__((ext_vector_type(16)));
typedef unsigned u32x4 __attribute__((ext_vector_type(4)));
typedef unsigned u32x2 __attribute__((ext_vector_type(2)));
typedef __bf16 bf16x2_t __attribute__((ext_vector_type(2)));

__device__ __forceinline__ unsigned pk2(float lo, float hi) { f32x2 v = {lo, hi}; bf16x2_t b = __builtin_convertvector(v, bf16x2_t); return __builtin_bit_cast(unsigned, b); }
__device__ __forceinline__ float bflo(unsigned w) { return __uint_as_float(w << 16); }
__device__ __forceinline__ float bfhi(unsigned w) { return __uint_as_float(w & 0xffff0000u); }
__device__ __forceinline__ float sx(float v, int lane, int m) { return __int_as_float(__builtin_amdgcn_ds_bpermute((lane ^ m) << 2, __float_as_int(v))); }
__device__ __forceinline__ float x32_sum(float v) { auto rr = __builtin_amdgcn_permlane32_swap(__float_as_uint(v), __float_as_uint(v), false, false); return __uint_as_float(rr[0]) + __uint_as_float(rr[1]); }
__device__ __forceinline__ float x32_max(float v) { auto rr = __builtin_amdgcn_permlane32_swap(__float_as_uint(v), __float_as_uint(v), false, false); return fmaxf(__uint_as_float(rr[0]), __uint_as_float(rr[1])); }
__device__ __forceinline__ float swap32(float v, bool upper_half) { auto rr = __builtin_amdgcn_permlane32_swap(__float_as_uint(v), __float_as_uint(v), false, false); return __uint_as_float(upper_half ? rr[0] : rr[1]); }
__device__ __forceinline__ float wave_sum(float v, int lane) {
#pragma unroll
    for (int o = 1; o < 32; o <<= 1) v += sx(v, lane, o);
    return x32_sum(v);
}
#define LDS_WAIT() asm volatile("s_waitcnt lgkmcnt(0)" ::: "memory")
#define WG_BAR() asm volatile("s_waitcnt lgkmcnt(0)\n\ts_barrier" ::: "memory")

struct Args { const float* in[23]; float* out; unsigned char* ws; int ph_lo, ph_hi, use_bar, pad; };
typedef __attribute__((address_space(4))) const unsigned char* kptr_t;
struct Frame {
    LAS unsigned char* lds;
    GAS unsigned char* ws;
    GAS float* out;
    kptr_t ka;
    int tid, lane, wave, G, bx;
};
#define FARGS Frame& F
typedef const GAS float* cfp_t;
__device__ __forceinline__ const GAS float* inp(const Frame& F, int i) { return *(__attribute__((address_space(4))) const cfp_t*)(F.ka + 8 * i); }
#define INP(i) inp(F, (i))
#define CTL(F) ((GAS unsigned*)((F).ws + WS_CTL))
__device__ __forceinline__ void refresh(Frame& F) {
    unsigned z = 0u; asm volatile("" : "+v"(z));
    const int ln = (int)__builtin_amdgcn_mbcnt_hi(~0u, __builtin_amdgcn_mbcnt_lo(~0u, z));
    F.lane = ln; F.tid = F.wave * 64 + ln;
    asm volatile("" : "+s"(F.ws)); asm volatile("" : "+s"(F.out)); asm volatile("" : "+s"(F.ka));
}
#define OPAQUE_S(x) asm volatile("" : "+s"(x))
namespace pg8 {
#define PG8_LAS __attribute__((address_space(3)))
#define PG8_GAS __attribute__((address_space(1)))
typedef unsigned short bf16_t;
typedef short bf16x8 __attribute__((ext_vector_type(8)));
typedef float f32x4 __attribute__((ext_vector_type(4)));
typedef unsigned u32x4 __attribute__((ext_vector_type(4)));
#ifndef MK_WGM
#define MK_WGM 8
#endif
constexpr int BM = 256, BK = 64, HALF = 128, HTB = HALF * BK * 2, STAGE_BYTES = 8 * HTB, NXCD = 8, WGM = MK_WGM;

__host__ __device__ __forceinline__ int lds_byte(int r, int c) { const int st = (r >> 4) * 2 + (c >> 5), rr = r & 15, cc = c & 31, ob = rr * 64 + cc * 2; return st * 1024 + (ob ^ (((ob >> 9) & 1) << 5)); }
__host__ __device__ __forceinline__ void stage_rc(int b, int& R, int& C) { const int st = b / 1024, sb = b % 1024, swz = sb ^ (((sb >> 9) & 1) << 5); R = (st >> 1) * 16 + swz / 64; C = (st & 1) * 32 + (swz % 64) / 2; }
__host__ __device__ __forceinline__ int perm32(int rho) { const int n = rho >> 4, i = rho & 15; return 8 * (i >> 2) + 4 * n + (i & 3); }

struct Unit { int pm, pn; };

struct Order {
    int nM, nN, nwg, G, c;
    __device__ __forceinline__ void init(int nM_, int nN_, int G_, int c_) { nM = nM_; nN = nN_; nwg = nM * nN; G = G_; c = c_; }
    __device__ __forceinline__ bool next(int i, Unit& u) const {
        const long L = (long)i * G + c; if (L >= nwg) return false;
        int wgid = (int)L; { const int q = nwg / NXCD, r = nwg % NXCD, xcd = wgid % NXCD, off = wgid / NXCD; wgid = (xcd < r ? xcd * (q + 1) : r * (q + 1) + (xcd - r) * q) + off; }
        const int nig = WGM * nN, gid = wgid / nig, fm = gid * WGM, gsz = (nM - fm) < WGM ? (nM - fm) : WGM;
        u.pm = __builtin_amdgcn_readfirstlane(fm + ((wgid % nig) % gsz)); u.pn = __builtin_amdgcn_readfirstlane((wgid % nig) / gsz); return true;
    }
};

__device__ __forceinline__ unsigned cvt_pk_bf16(float lo, float hi) { unsigned r; asm volatile("v_cvt_pk_bf16_f32 %0, %1, %2" : "=v"(r) : "v"(lo), "v"(hi)); return r; }

template <class Epi, class Prob>
__device__ __forceinline__ void gemm_phase(PG8_LAS unsigned char* lds, const Prob& P, const Epi& E, int tid) {
    const int wid = __builtin_amdgcn_readfirstlane(tid >> 6), lane = tid & 63, wr = wid >> 2, wc = wid & 3, fr = lane & 15, fq = lane >> 4;
    const int nt = P.K / BK;
#ifndef MK_EPISTAG
#define MK_EPISTAG 0
#endif
#ifndef MK_EPISTAG_CYC
#define MK_EPISTAG_CYC 50000
#endif
    if (MK_EPISTAG) {
        const int nwg_ = P.ord.nwg, G_ = P.ord.G, c_ = P.ord.c, cmax = (nwg_ + G_ - 1) / G_, cnt = c_ < nwg_ ? (nwg_ - c_ + G_ - 1) / G_ : 0, nfull = nwg_ - (cmax - 1) * G_;
        if (cnt < cmax && cnt > 0) {
            const int nslack = G_ - nfull, parts = nslack >= 3 * nfull ? 3 : (nslack >= nfull ? 1 : 0);
            if (parts > 0) {
                const unsigned delay = (unsigned)(MK_EPISTAG_CYC / (parts + 1)) * (unsigned)(1 + (c_ - nfull) % parts);
                const unsigned t0_ = (unsigned)__builtin_amdgcn_s_memtime();
                while ((unsigned)__builtin_amdgcn_s_memtime() - t0_ < delay) __builtin_amdgcn_s_sleep(16);
            }
        }
    }
    unsigned voffB[2];
    { int R0, C0, R1, C1; stage_rc(tid * 16, R0, C0); stage_rc(tid * 16 + 8192, R1, C1); const int Rb0 = Epi::PERM ? ((R0 & ~31) + perm32(R0 & 31)) : R0, Rb1 = Epi::PERM ? ((R1 & ~31) + perm32(R1 & 31)) : R1;
      voffB[0] = (unsigned)(Rb0 * P.ldb + C0) * 2u; voffB[1] = (unsigned)(Rb1 * P.ldb + C1) * 2u; }
    const size_t hstepB = P.hstepB;
    const unsigned ldsw = (unsigned)wid * 1024u;
    const int aoff = lds_byte(wr * 64 + fr, fq * 8), boff = lds_byte(wc * 32 + fr, fq * 8);
#define PG8_SA(b, h) (((b) * 2 + (h)) * HTB)
#define PG8_SB(b, h) ((4 + (b) * 2 + (h)) * HTB)
#define PG8_STAGE(bufoff, gbase, voff) do { _Pragma("unroll") for (int _i = 0; _i < 2; ++_i) \
        __builtin_amdgcn_global_load_lds((const PG8_GAS unsigned*)((const PG8_GAS char*)(gbase) + (voff)[_i]), (PG8_LAS unsigned*)(lds + (bufoff) + ldsw + _i * 8192), 16, 0, 0); } while (0)
#define PG8_LDA(dst, b, h) do { _Pragma("unroll") for (int m = 0; m < 4; ++m) _Pragma("unroll") for (int k = 0; k < 2; ++k) dst[m][k] = *(const PG8_LAS bf16x8*)(lds + PG8_SA(b, h) + aoff + m * 2048 + k * 1024); } while (0)
#define PG8_LDB(dst, b, h) do { _Pragma("unroll") for (int n = 0; n < 2; ++n) _Pragma("unroll") for (int k = 0; k < 2; ++k) dst[n][k] = *(const PG8_LAS bf16x8*)(lds + PG8_SB(b, h) + boff + n * 2048 + k * 1024); } while (0)
#define PG8_MMA(ai, bj, At, Bt) do { __builtin_amdgcn_s_setprio(1); _Pragma("unroll") for (int m = 0; m < 4; ++m) _Pragma("unroll") for (int n = 0; n < 2; ++n) _Pragma("unroll") for (int k = 0; k < 2; ++k) \
        acc[ai][bj][m][n] = __builtin_amdgcn_mfma_f32_16x16x32_bf16(Bt[n][k], At[m][k], acc[ai][bj][m][n], 0, 0, 0); __builtin_amdgcn_s_setprio(0); } while (0)
#define PG8_WAIT_V(n) asm volatile("s_waitcnt vmcnt(" #n ")" ::: "memory")
#define PG8_WAIT_L(n) asm volatile("s_waitcnt lgkmcnt(" #n ")" ::: "memory")
#define PG8_BAR __builtin_amdgcn_s_barrier()
#define PG8_SCHED __builtin_amdgcn_sched_barrier(0)
    Unit cur, nxt; int ui = 0;
    if (!P.next(0, cur)) return;
    float zf = 0.f; asm volatile("" : "+v"(zf));
    f32x4 acc[2][2][4][2];
#pragma unroll
    for (int a = 0; a < 2; ++a)
#pragma unroll
        for (int b = 0; b < 2; ++b)
#pragma unroll
            for (int m = 0; m < 4; ++m)
#pragma unroll
                for (int n = 0; n < 2; ++n) acc[a][b][m][n] = (f32x4){zf, zf, zf, zf};
    bf16x8 At[4][2], B0[2][2], B1[2][2];
    constexpr int NH = Prob::GATHER ? 2 : 1;
    unsigned voC[NH][2];
    P.template a_off<NH>(cur, tid, voC);
    const PG8_GAS char* const Ab = P.A;
    const size_t hstepA = Prob::GATHER ? (size_t)0 : P.hstepA;
#define PG8_STAGE_A(bufoff, h, kbyte, VO) PG8_STAGE(bufoff, Ab + (kbyte) + ((h) ? hstepA : (size_t)0), VO[Prob::GATHER ? (h) : 0])
    { const PG8_GAS char* b0 = P.b_tile(cur, 0); const PG8_GAS char* b1 = P.b_tile(cur, 1);
      PG8_STAGE(PG8_SB(0, 0), b0, voffB); PG8_STAGE(PG8_SB(0, 1), b0 + hstepB, voffB); PG8_STAGE_A(PG8_SA(0, 0), 0, (size_t)0, voC); PG8_STAGE_A(PG8_SA(0, 1), 1, (size_t)0, voC);
      if (wr == 1) PG8_BAR;
      PG8_WAIT_V(2); PG8_BAR;
      PG8_STAGE(PG8_SB(1, 0), b1, voffB); PG8_STAGE_A(PG8_SA(1, 0), 0, (size_t)128, voC); PG8_STAGE(PG8_SB(1, 1), b1 + hstepB, voffB);
      PG8_WAIT_V(6); PG8_BAR; }
#ifdef MK_GSTAMP
#define GSEG(k) do { if (Epi::SID == MK_GSTAMP) { __builtin_amdgcn_sched_barrier(0); const unsigned now_ = (unsigned)__builtin_amdgcn_s_memtime(); __builtin_amdgcn_sched_barrier(0); \
    if (tid == MK_GSTAMP_TID) { PG8_LAS unsigned* m_ = (PG8_LAS unsigned*)(lds + MISC_OFF); if ((k) == MK_GSTAMP_SEG || MK_GSTAMP_SEG == 9) m_[16] += now_ - m_[18]; m_[18] = now_; if ((k) == 2) m_[17] += 1; } } } while (0)
    if (Epi::SID == MK_GSTAMP) { const unsigned now_ = (unsigned)__builtin_amdgcn_s_memtime(); if (tid == MK_GSTAMP_TID) ((PG8_LAS unsigned*)(lds + MISC_OFF))[18] = now_; }
#else
#define GSEG(k) do {} while (0)
#endif
    for (;;) {
        const bool has_next = P.next(ui + 1, nxt);
        if (!has_next) nxt = cur;
        for (int t = 0; t < nt; t += 2) {
            const bool last = (t == nt - 2);
            const size_t k1 = (size_t)(t + 1) * 128, k2 = last ? (size_t)0 : (size_t)(t + 2) * 128, k3 = k2 + 128;
            const PG8_GAS char* b2 = last ? P.b_tile(nxt, 0) : P.b_tile(cur, t + 2);
            const PG8_GAS char* b3 = last ? P.b_tile(nxt, 1) : P.b_tile(cur, t + 3);
#ifndef MK_RELAX
#define MK_RELAX 0
#endif
            int fz_ = __builtin_amdgcn_readfirstlane((MK_RELAX && (t == 0) && (ui > 0)) ? 1 : 0); asm volatile("" : "+s"(fz_));
            const bool fresh = fz_ != 0;
#define PG8_WAIT_VR() do { if (fresh) { if constexpr (Epi::NSTORES == 32) PG8_WAIT_V(40); else if constexpr (Epi::NSTORES == 16) PG8_WAIT_V(24); else PG8_WAIT_V(8); } else PG8_WAIT_V(8); } while (0)
            PG8_LDB(B0, 0, 0); PG8_LDB(B1, 0, 1); PG8_SCHED; PG8_LDA(At, 0, 0); if (!fresh) PG8_STAGE_A(PG8_SA(1, 1), 1, k1, voC);
            PG8_WAIT_VR(); PG8_WAIT_L(0); PG8_BAR; PG8_MMA(0, 0, At, B0); PG8_MMA(0, 1, At, B1); PG8_BAR; PG8_SCHED;
            if (last) {
                P.template a_off<NH>(nxt, tid, voC);
            }
            PG8_LDA(At, 0, 1); PG8_STAGE(PG8_SB(0, 0), b2, voffB); PG8_STAGE(PG8_SB(0, 1), b2 + hstepB, voffB); PG8_STAGE_A(PG8_SA(0, 0), 0, k2, voC);
            PG8_WAIT_VR(); PG8_WAIT_L(0); PG8_BAR; PG8_MMA(1, 0, At, B0); PG8_MMA(1, 1, At, B1); PG8_BAR; PG8_SCHED;
            PG8_LDB(B0, 1, 0); PG8_LDB(B1, 1, 1); PG8_SCHED; PG8_LDA(At, 1, 0); PG8_STAGE_A(PG8_SA(0, 1), 1, k2, voC);
            PG8_WAIT_VR(); PG8_WAIT_L(0); PG8_BAR; PG8_MMA(0, 0, At, B0); PG8_MMA(0, 1, At, B1); PG8_BAR; PG8_SCHED;
            PG8_LDA(At, 1, 1); PG8_STAGE(PG8_SB(1, 0), b3, voffB); PG8_STAGE(PG8_SB(1, 1), b3 + hstepB, voffB); PG8_STAGE_A(PG8_SA(1, 0), 0, k3, voC);
            PG8_WAIT_V(8); PG8_WAIT_L(0); PG8_BAR; PG8_MMA(1, 0, At, B0); PG8_MMA(1, 1, At, B1); PG8_BAR; PG8_SCHED;
        }
        if (MK_RELAX) PG8_STAGE_A(PG8_SA(1, 1), 1, (size_t)128, voC);
#ifndef MK_ALIGN
#define MK_ALIGN 1
#endif
        GSEG(0);
        if (MK_ALIGN && wr == 0) PG8_BAR;
        { Unit eu = cur; asm volatile("" : "+s"(eu.pm), "+s"(eu.pn));
          GSEG(1);
          E(acc, eu, wr, wc, fr, fq); }
        GSEG(2);
        if (!has_next) break;
#pragma unroll
        for (int a = 0; a < 2; ++a)
#pragma unroll
            for (int b = 0; b < 2; ++b)
#pragma unroll
                for (int m = 0; m < 4; ++m)
#pragma unroll
                    for (int n = 0; n < 2; ++n) acc[a][b][m][n] = (f32x4){zf, zf, zf, zf};
        cur = nxt; ++ui;
        if (MK_ALIGN && wr == 1) PG8_BAR;
    }
    PG8_WAIT_V(0);
    if (!MK_ALIGN && wr == 0) PG8_BAR;
    PG8_BAR;
#undef PG8_SA
#undef PG8_SB
#undef PG8_STAGE
#undef PG8_STAGE_A
#undef PG8_WAIT_VR
#undef PG8_LDA
#undef PG8_LDB
#undef PG8_MMA
#undef PG8_WAIT_V
#undef PG8_WAIT_L
#undef PG8_BAR
#undef PG8_SCHED
}
}
__device__ __forceinline__ void transpose_item(const GAS float* W, int N, int k0, int n0, GAS bf16_t* dst, int ldd, const GAS float* kscale, LAS float* scr, int lane) {
    const int kq = lane >> 4, n4 = (lane & 15) * 4;
#pragma unroll
    for (int i = 0; i < 16; ++i) { const int kk = 4 * i + kq; f32x4 v = *(const GAS f32x4*)(W + (size_t)(k0 + kk) * N + n0 + n4); if (kscale) v = v * kscale[k0 + kk];
        LAS float* p = scr + kk * 65 + n4; p[0] = v.x; p[1] = v.y; p[2] = v.z; p[3] = v.w; }
    LDS_WAIT(); asm volatile("" ::: "memory");
    const int c = lane & 7;
#pragma unroll
    for (int j = 0; j < 8; ++j) { const int n = (lane >> 3) + 8 * j; const LAS float* s = scr + (8 * c) * 65 + n;
        u32x4 o; o.x = pk2(s[0 * 65], s[1 * 65]); o.y = pk2(s[2 * 65], s[3 * 65]); o.z = pk2(s[4 * 65], s[5 * 65]); o.w = pk2(s[6 * 65], s[7 * 65]);
        *(GAS u32x4*)(dst + (size_t)n * ldd + k0 + 8 * c) = o; }
    LDS_WAIT(); asm volatile("" ::: "memory");
}

__device__ __forceinline__ void ada_unit(FARGS, int unit) {
    const GAS float* c = INP(1); const GAS float* c_ctx = INP(3); const GAS float* ada_w = INP(4); const GAS float* ada_b = INP(5);
    GAS float* mod = (GAS float*)(F.ws + WS_MOD);
    LAS float* S = (LAS float*)F.lds;
    const int L = unit / 48, cb = unit % 48, tid = F.tid;
    for (int i = tid; i < 33 * 1024; i += 512) { const int r = i >> 10, k = i & 1023; const float v = (r < 32) ? c[r * 1024 + k] : c_ctx[k]; S[i] = v / (1.f + expf(-v)); }
    __syncthreads();
    const int cq = tid & 31, kg = tid >> 5;
    f32x4 acc[33];
#pragma unroll
    for (int r = 0; r < 33; ++r) acc[r] = (f32x4){0.f, 0.f, 0.f, 0.f};
    const GAS float* wp = ada_w + ((size_t)L * 1024 + kg * 64) * ADA + cb * 128 + 4 * cq;
#pragma unroll 2
    for (int k4 = 0; k4 < 16; ++k4) {
        const f32x4 w0 = *(const GAS f32x4*)(wp + (size_t)(k4 * 4 + 0) * ADA), w1 = *(const GAS f32x4*)(wp + (size_t)(k4 * 4 + 1) * ADA), w2 = *(const GAS f32x4*)(wp + (size_t)(k4 * 4 + 2) * ADA), w3 = *(const GAS f32x4*)(wp + (size_t)(k4 * 4 + 3) * ADA);
        const LAS f32x4* sp = (const LAS f32x4*)(S + kg * 64 + k4 * 4);
#pragma unroll
        for (int r = 0; r < 33; ++r) { const f32x4 s4 = sp[r * 256]; acc[r] = acc[r] + (w0 * s4.x + w1 * s4.y) + (w2 * s4.z + w3 * s4.w); }
    }
    __syncthreads();
    LAS float* R = S;
    { const int w = F.wave;
#pragma unroll
      for (int r = 0; r < 33; ++r) { f32x4 v; v.x = x32_sum(acc[r].x); v.y = x32_sum(acc[r].y); v.z = x32_sum(acc[r].z); v.w = x32_sum(acc[r].w);
          if (F.lane < 32) *(LAS f32x4*)(R + (w * 33 + r) * 128 + 4 * cq) = v; } }
    __syncthreads();
    for (int i = tid; i < 33 * 128; i += 512) { const int r = i >> 7, cc = i & 127, n = cb * 128 + cc;
        float v = 0.f;
#pragma unroll
        for (int w = 0; w < 8; ++w) v += R[(w * 33 + r) * 128 + cc];
        mod[((size_t)L * 33 + r) * ADA + n] = v + ada_b[L * ADA + n]; }
    __syncthreads();
}

__device__ __forceinline__ void tables_unit(FARGS) {
    GAS float* tab = (GAS float*)(F.ws + WS_TAB);
    const int tid = F.tid;
    for (int i = tid; i < 64 * 16; i += 512) { const int p = i >> 4, f = i & 15; const float inv = expf(-(float)f * (1.f / 16.f) * 9.210340371976184f); const float a = (float)p * inv; tab[TAB_T64 + 2 * i] = cosf(a); tab[TAB_T64 + 2 * i + 1] = sinf(a); }
    for (int i = tid; i < 64 * 8; i += 512) { const int p = i >> 3, f = i & 7; const float inv = expf(-(float)f * (1.f / 8.f) * 9.210340371976184f); const float a = (float)p * inv; tab[TAB_T32 + 2 * i] = cosf(a); tab[TAB_T32 + 2 * i + 1] = sinf(a); }
    if (tid < DEPTH) { const GAS float* lp = INP(15) + tid * 4 * 32; float s01 = 0.f, s23 = 0.f;
        for (int i = 0; i < 32; ++i) { s01 += lp[i] * lp[32 + i]; s23 += lp[64 + i] * lp[96 + i]; }
        const float li = 0.8f - 0.6f * expf(-0.3f * (float)tid);
        tab[TAB_LAM + tid] = expf(s01) - expf(s23) + li; tab[TAB_LAM + DEPTH + tid] = 1.f - li; }
}

__device__ __forceinline__ void prologue_phase(FARGS) {
    refresh(F);
    if (F.bx < 192) ada_unit(F, F.bx);
    else if (F.bx == 192) tables_unit(F);
    __syncthreads();
    LAS float* scr = (LAS float*)(F.lds + F.wave * 16640);
    const int gw = F.bx * NWAVES + F.wave, NGW = F.G * NWAVES;
    GAS bf16_t* WIN = (GAS bf16_t*)(F.ws + WS_WIN); GAS bf16_t* WOUT = (GAS bf16_t*)(F.ws + WS_WOUT); GAS bf16_t* W1 = (GAS bf16_t*)(F.ws + WS_W1); GAS bf16_t* W2 = (GAS bf16_t*)(F.ws + WS_W2);
    constexpr int I_IN = 16 * 40, I_OUT = 16 * 16, I_G = 16 * 8, I_D = 8 * 16;
    constexpr int N_IN = DEPTH * I_IN, N_OUT = DEPTH * I_OUT, N_G = DEPTH * NEXP * I_G, N_D = DEPTH * NEXP * I_D;
    constexpr int NITEMS = N_IN + N_OUT + 2 * N_G + N_D;
    for (int it = gw; it < NITEMS; it += NGW) {
        int r = it;
        if (r < N_IN) { const int L = r / I_IN, q = r % I_IN, kb = q / 40, nb = q % 40;
            transpose_item(INP(8) + (size_t)L * D * DIN, DIN, kb * 64, nb * 64, WIN + ((size_t)L * DIN + nb * 64) * D, D, nullptr, scr, F.lane); continue; } r -= N_IN;
        if (r < N_OUT) { const int L = r / I_OUT, q = r % I_OUT, kb = q / 16, nb = q % 16;
            transpose_item(INP(17) + (size_t)L * D * D, D, kb * 64, nb * 64, WOUT + ((size_t)L * D + nb * 64) * D, D, INP(16) + L * D, scr, F.lane); continue; } r -= N_OUT;
        if (r < 2 * N_G) { const int up = r >= N_G; if (up) r -= N_G; const int le = r / I_G, q = r % I_G, kb = q / 8, nb = q % 8, n0 = nb * 64;
            const int drow = (n0 >> 7) * 256 + (n0 & 127) + (up ? 128 : 0);
            transpose_item((up ? INP(21) : INP(20)) + (size_t)le * D * DEXP, DEXP, kb * 64, n0, W1 + ((size_t)le * 1024 + drow) * D, D, nullptr, scr, F.lane); continue; } r -= 2 * N_G;
        { const int le = r / I_D, q = r % I_D, kb = q / 16, nb = q % 16;
            transpose_item(INP(22) + (size_t)le * DEXP * D, D, kb * 64, nb * 64, W2 + ((size_t)le * 1024 + nb * 64) * DEXP, DEXP, nullptr, scr, F.lane); }
    }
    __syncthreads();
}

__device__ __forceinline__ void top2of4(float x0, float x1, float x2, float x3, int& i1, int& i2, float& m1, float& m2) {
    i1 = 0; m1 = x0; if (x1 > m1) { m1 = x1; i1 = 1; } if (x2 > m1) { m1 = x2; i1 = 2; } if (x3 > m1) { m1 = x3; i1 = 3; }
    i2 = -1; m2 = -3.0e38f;
    if (i1 != 0 && x0 > m2) { m2 = x0; i2 = 0; } if (i1 != 1 && x1 > m2) { m2 = x1; i2 = 1; } if (i1 != 2 && x2 > m2) { m2 = x2; i2 = 2; } if (i1 != 3 && x3 > m2) { m2 = x3; i2 = 3; }
}
template <bool ROUTER>
__device__ __forceinline__ void norm_phase(FARGS, int L, int M, bool first, const GAS float* g, int shift_off, int scale_off, bool live = true) {
    refresh(F); OPAQUE_S(L); OPAQUE_S(M);
    const GAS float* mod = (const GAS float*)(F.ws + WS_MOD) + (size_t)L * 33 * ADA;
    GAS bf16_t* H = (GAS bf16_t*)(F.ws + WS_H);
    const GAS bf16_t* XB = (const GAS bf16_t*)(F.ws + WS_XB);
    const GAS float* xlat = INP(0); const GAS float* xctx = INP(2);
    const int lane = F.lane, gw = F.bx * NWAVES + F.wave, NGW = F.G * NWAVES, rpw = (M + NGW - 1) / NGW;
    const int r0 = gw * rpw, r1 = (r0 + rpw < M) ? r0 + rpw : M;
    constexpr int RB = ROUTER ? 1 : 4;
    LAS float* RWT = (LAS float*)F.lds;
    LAS float* LG = (LAS float*)(F.lds + 65536) + F.wave * 640;
    LAS int* hist = (LAS int*)(F.lds + NRM_OFF); LAS int* base = hist + 32;
    if (ROUTER) {
        const GAS float* rw = INP(18);
        for (int i = F.tid; i < 16 * 1024; i += 512) { const int k = i >> 4, e = i & 15; RWT[e * 1024 + k] = rw[i]; }
        if (F.tid < 32) hist[F.tid] = 0;
        __syncthreads();
    }
    int curb = -1; f32x4 gm[4], sh[4];
    u32x4 nraw[RB][2];
    if (!first) {
#pragma unroll
        for (int r = 0; r < RB; ++r)
#pragma unroll
            for (int jj = 0; jj < 2; ++jj) nraw[r][jj] = *(const GAS u32x4*)(XB + (size_t)(r0 + r) * D + 8 * lane + 512 * jj);
    }
#pragma unroll 1
    for (int row = r0; row < r1; row += RB) {
        const int b = row < NLAT ? (row >> 11) : 32;
        if (b != curb) { curb = b;
#pragma unroll
            for (int j = 0; j < 4; ++j) { const int c0 = 8 * lane + 512 * (j >> 1) + 4 * (j & 1); const f32x4 gg = *(const GAS f32x4*)(g + c0), sc = *(const GAS f32x4*)(mod + b * ADA + scale_off + c0);
                gm[j] = gg * (sc + 1.0f); sh[j] = *(const GAS f32x4*)(mod + b * ADA + shift_off + c0); } }
        const GAS float* xr = row < NLAT ? xlat + (size_t)row * D : xctx + (size_t)(row - NLAT) * D;
        f32x4 v[RB][4]; float ss[RB];
        if (first) {
#pragma unroll
            for (int r = 0; r < RB; ++r)
#pragma unroll
                for (int jj = 0; jj < 2; ++jj) { v[r][2 * jj] = *(const GAS f32x4*)(xr + (size_t)r * D + 8 * lane + 512 * jj); v[r][2 * jj + 1] = *(const GAS f32x4*)(xr + (size_t)r * D + 8 * lane + 512 * jj + 4); }
        } else {
            u32x4 raw[RB][2];
#pragma unroll
            for (int r = 0; r < RB; ++r)
#pragma unroll
                for (int jj = 0; jj < 2; ++jj) raw[r][jj] = nraw[r][jj];
            if (row + RB < r1) {
#pragma unroll
                for (int r = 0; r < RB; ++r)
#pragma unroll
                    for (int jj = 0; jj < 2; ++jj) nraw[r][jj] = *(const GAS u32x4*)(XB + (size_t)(row + RB + r) * D + 8 * lane + 512 * jj);
            }
#pragma unroll
            for (int r = 0; r < RB; ++r)
#pragma unroll
                for (int jj = 0; jj < 2; ++jj) { const u32x4 w = raw[r][jj];
                    v[r][2 * jj] = (f32x4){bflo(w.x), bfhi(w.x), bflo(w.y), bfhi(w.y)}; v[r][2 * jj + 1] = (f32x4){bflo(w.z), bfhi(w.z), bflo(w.w), bfhi(w.w)}; }
        }
#pragma unroll
        for (int r = 0; r < RB; ++r) { float s = 0.f;
#pragma unroll
            for (int j = 0; j < 4; ++j) s += (v[r][j].x * v[r][j].x + v[r][j].y * v[r][j].y) + (v[r][j].z * v[r][j].z + v[r][j].w * v[r][j].w);
            ss[r] = s; }
#pragma unroll
        for (int o = 1; o < 32; o <<= 1) {
#pragma unroll
            for (int r = 0; r < RB; ++r) ss[r] += sx(ss[r], lane, o); }
#pragma unroll
        for (int r = 0; r < RB; ++r) { const float rstd = __builtin_amdgcn_rsqf(x32_sum(ss[r]) * (1.f / D) + EPS);
#pragma unroll
            for (int j = 0; j < 4; ++j) v[r][j] = v[r][j] * rstd * gm[j] + sh[j];
#pragma unroll
            for (int jj = 0; jj < 2; ++jj) { u32x4 o; o.x = pk2(v[r][2 * jj].x, v[r][2 * jj].y); o.y = pk2(v[r][2 * jj].z, v[r][2 * jj].w); o.z = pk2(v[r][2 * jj + 1].x, v[r][2 * jj + 1].y); o.w = pk2(v[r][2 * jj + 1].z, v[r][2 * jj + 1].w);
                if (live) *(GAS u32x4*)(H + (size_t)(row + r) * D + 8 * lane + 512 * jj) = o; } }
        if (ROUTER) {
            float p[RB][16];
#pragma unroll
            for (int e = 0; e < 16; ++e) {
#pragma unroll
                for (int r = 0; r < RB; ++r) p[r][e] = 0.f;
#pragma unroll
                for (int j = 0; j < 4; ++j) { const f32x4 w = *(const LAS f32x4*)(RWT + e * 1024 + 8 * lane + 512 * (j >> 1) + 4 * (j & 1));
#pragma unroll
                    for (int r = 0; r < RB; ++r) p[r][e] += (v[r][j].x * w.x + v[r][j].y * w.y) + (v[r][j].z * w.z + v[r][j].w * w.w); } }
            const bool h32 = lane & 32, h16 = lane & 16, h8 = lane & 8, h4 = lane & 4;
#pragma unroll
            for (int r = 0; r < RB; ++r) {
                float a8[8], b4[4], c2[2], d1;
#pragma unroll
                for (int e = 0; e < 8; ++e) { const float send = h32 ? p[r][e] : p[r][e + 8], keep = h32 ? p[r][e + 8] : p[r][e]; a8[e] = keep + sx(send, lane, 32); }
#pragma unroll
                for (int e = 0; e < 4; ++e) { const float send = h16 ? a8[e] : a8[e + 4], keep = h16 ? a8[e + 4] : a8[e]; b4[e] = keep + sx(send, lane, 16); }
#pragma unroll
                for (int e = 0; e < 2; ++e) { const float send = h8 ? b4[e] : b4[e + 2], keep = h8 ? b4[e + 2] : b4[e]; c2[e] = keep + sx(send, lane, 8); }
                { const float send = h4 ? c2[0] : c2[1], keep = h4 ? c2[1] : c2[0]; d1 = keep + sx(send, lane, 4); }
                d1 += sx(d1, lane, 2); d1 += sx(d1, lane, 1);
                if ((lane & 3) == 0) LG[(row + r - r0) * 16 + (lane >> 2)] = d1;
            }
        }
    }
    if (ROUTER) {
        LDS_WAIT();
        int cls = 0, ls = 0; const bool mine = r0 + lane < r1;
        { const LAS f32x4* lp = (const LAS f32x4*)(LG + (mine ? lane : 0) * 16);
          const f32x4 q0 = lp[0], q1 = lp[1], q2 = lp[2], q3 = lp[3];
          const float lg[16] = {q0.x, q0.y, q0.z, q0.w, q1.x, q1.y, q1.z, q1.w, q2.x, q2.y, q2.z, q2.w, q3.x, q3.y, q3.z, q3.w};
          float sc[16], sel[16];
#pragma unroll
          for (int e = 0; e < 16; ++e) { sc[e] = 1.0f / (1.0f + __builtin_amdgcn_exp2f(-lg[e] * LOG2E)); sel[e] = sc[e] + INP(19)[e]; }
          float gs[4];
#pragma unroll
          for (int q = 0; q < 4; ++q) { int i1, i2; float m1, m2; top2of4(sel[4 * q], sel[4 * q + 1], sel[4 * q + 2], sel[4 * q + 3], i1, i2, m1, m2); gs[q] = m1 + m2; }
          int gi = 0; float gmx = gs[0]; if (gs[1] > gmx) { gmx = gs[1]; gi = 1; } if (gs[2] > gmx) { gmx = gs[2]; gi = 2; } if (gs[3] > gmx) { gmx = gs[3]; gi = 3; }
          float x4[4], s4[4];
#pragma unroll
          for (int i = 0; i < 4; ++i) { x4[i] = gi == 0 ? sel[i] : gi == 1 ? sel[4 + i] : gi == 2 ? sel[8 + i] : sel[12 + i]; s4[i] = gi == 0 ? sc[i] : gi == 1 ? sc[4 + i] : gi == 2 ? sc[8 + i] : sc[12 + i]; }
          int i1, i2; float m1, m2; top2of4(x4[0], x4[1], x4[2], x4[3], i1, i2, m1, m2);
          const int lo = i1 < i2 ? i1 : i2, hi = i1 < i2 ? i2 : i1;
          const int pr = lo == 0 ? hi - 1 : (lo == 1 ? hi + 1 : 5);
          const float slo = lo == 0 ? s4[0] : lo == 1 ? s4[1] : s4[2], shi = hi == 1 ? s4[1] : hi == 2 ? s4[2] : s4[3];
          const float inv = 1.0f / (slo + shi);
          cls = gi * 6 + pr;
          if (mine && live) { ls = __hip_atomic_fetch_add(&hist[cls], 1, __ATOMIC_RELAXED, __HIP_MEMORY_SCOPE_WORKGROUP);
              f32x2 w2 = {slo * inv, shi * inv}; *(GAS f32x2*)((GAS float*)(F.ws + WS_RW) + (size_t)(r0 + lane) * 2) = w2; }
        }
        __syncthreads();
        if (F.tid < NCLS && live) base[F.tid] = (int)__hip_atomic_fetch_add(CTL(F) + CW_CNT + (L * NCLS + F.tid) * 64, (unsigned)hist[F.tid], __ATOMIC_RELAXED, __HIP_MEMORY_SCOPE_AGENT);
        __syncthreads();
        GAS int* perm = (GAS int*)(F.ws + WS_PERM);
        if (mine && live) perm[(size_t)cls * MTOT + base[cls] + ls] = r0 + lane;
        __syncthreads();
    }
}

__device__ __forceinline__ void norm2_phase(FARGS, int L, int M) {
    refresh(F); OPAQUE_S(L); OPAQUE_S(M);
    constexpr int SG = 2064;
    constexpr int GT_BYTES = 32 * SG, C_OFF = 2 * GT_BYTES, RS_OFF = C_OFF + 256, RI_OFF = RS_OFF + 8 * 40 * 4, HB_OFF = RI_OFF + 8 * 40 * 4;
    static_assert(HB_OFF + 256 <= MISC_OFF, "norm2 LDS map");
    const GAS float* mod = (const GAS float*)(F.ws + WS_MOD) + (size_t)L * 33 * ADA;
    const GAS float* g2 = INP(7) + L * D; const GAS float* Wr = INP(18);
    GAS bf16_t* H = (GAS bf16_t*)(F.ws + WS_H);
    const GAS bf16_t* XB = (const GAS bf16_t*)(F.ws + WS_XB);
    const int lane = F.lane, tid = F.tid, w = F.wave, l31 = lane & 31, hi = lane >> 5;
    const int NGW = F.G * NWAVES, rpw = (M + NGW - 1) / NGW;
    const int R0 = F.bx * NWAVES * rpw, R1 = (R0 + NWAVES * rpw < M) ? R0 + NWAVES * rpw : M;
    const int r0 = R0 + w * rpw < M ? R0 + w * rpw : M, r1 = (r0 + rpw < M) ? r0 + rpw : M;
    LAS unsigned char* GT = F.lds; LAS float* Ctab = (LAS float*)(F.lds + C_OFF); LAS float* RS = (LAS float*)(F.lds + RS_OFF) + w * 40; LAS int* RI = (LAS int*)(F.lds + RI_OFF) + w * 40;
    LAS int* hist = (LAS int*)(F.lds + HB_OFF); LAS int* base = hist + 32;
    if (tid < 32) hist[tid] = 0;
    const int bfirst = R0 < NLAT ? (R0 >> 11) : 32, blast = (R1 - 1) < NLAT ? ((R1 - 1) >> 11) : 32;
    for (int s = 0; s <= (blast != bfirst ? 1 : 0); ++s) {
        const int b = s == 0 ? bfirst : blast;
        const GAS float* sc = mod + (size_t)b * ADA + 4 * 1024; const GAS float* shp = mod + (size_t)b * ADA + 3 * 1024;
        LAS unsigned char* gt = GT + s * GT_BYTES;
        for (int k = tid; k < D; k += 512) {
            const float gmk = g2[k] * (1.0f + sc[k]);
            const f32x4 w0 = *(const GAS f32x4*)(Wr + k * 16), w1 = *(const GAS f32x4*)(Wr + k * 16 + 4), w2 = *(const GAS f32x4*)(Wr + k * 16 + 8), w3 = *(const GAS f32x4*)(Wr + k * 16 + 12);
            const float wr_[16] = {w0.x, w0.y, w0.z, w0.w, w1.x, w1.y, w1.z, w1.w, w2.x, w2.y, w2.z, w2.w, w3.x, w3.y, w3.z, w3.w};
#pragma unroll
            for (int e = 0; e < 16; ++e) { const float G = gmk * wr_[e]; const unsigned hb = pk2(G, 0.f) & 0xffffu; const float lo = G - __uint_as_float(hb << 16); const unsigned lb = pk2(lo, 0.f) & 0xffffu;
                *(LAS bf16_t*)(gt + e * SG + k * 2) = (bf16_t)hb; *(LAS bf16_t*)(gt + (16 + e) * SG + k * 2) = (bf16_t)lb; }
        }
#pragma unroll
        for (int ee = 0; ee < 2; ++ee) { const int e = 2 * w + ee; float p = 0.f;
            for (int k = lane; k < D; k += 64) p += shp[k] * Wr[k * 16 + e];
            p = wave_sum(p, lane); if (lane == 0) Ctab[s * 16 + e] = p; }
    }
    __syncthreads();
    for (int cur = r0; cur < r1; ) {
        const int bcur = cur < NLAT ? (cur >> 11) : 32;
        int cnt = r1 - cur; if (cnt > 32) cnt = 32;
        if (cur < NLAT) { const int bnd = ((cur >> 11) + 1) << 11; if (bnd - cur < cnt) cnt = bnd - cur; }
        const int s = bcur == bfirst ? 0 : 1;
        const int row = cur + (l31 < cnt ? l31 : cnt - 1);
        const GAS bf16_t* xp = XB + (size_t)row * D + 8 * hi;
        const LAS unsigned char* gp = GT + s * GT_BYTES + l31 * SG + 16 * hi;
        f32x16 acc = f32x16{}; float ss = 0.f;
#pragma unroll 1
        for (int kg = 0; kg < 8; ++kg) {
            bf16x8 xf[8];
#pragma unroll
            for (int j = 0; j < 8; ++j) xf[j] = *(const GAS bf16x8*)(xp + (kg * 8 + j) * 16);
#pragma unroll
            for (int j = 0; j < 8; ++j) {
                const bf16x8 gf = *(const LAS bf16x8*)(gp + (kg * 8 + j) * 32);
                const u32x4 wv = __builtin_bit_cast(u32x4, xf[j]);
                const float a0 = bflo(wv.x), a1 = bfhi(wv.x), a2 = bflo(wv.y), a3 = bfhi(wv.y), a4 = bflo(wv.z), a5 = bfhi(wv.z), a6 = bflo(wv.w), a7 = bfhi(wv.w);
                ss += (a0 * a0 + a1 * a1) + (a2 * a2 + a3 * a3) + (a4 * a4 + a5 * a5) + (a6 * a6 + a7 * a7);
                acc = __builtin_amdgcn_mfma_f32_32x32x16_bf16(gf, xf[j], acc, 0, 0, 0);
            }
        }
        const float rstd = __builtin_amdgcn_rsqf(x32_sum(ss) * (1.f / D) + EPS);
        float mine[8], oth[8];
#pragma unroll
        for (int i = 0; i < 8; ++i) { mine[i] = acc[i] + acc[i + 8]; oth[i] = swap32(mine[i], hi != 0); }
        float lg[16];
#pragma unroll
        for (int i = 0; i < 4; ++i) { lg[i] = hi ? oth[i] : mine[i]; lg[4 + i] = hi ? mine[i] : oth[i]; lg[8 + i] = hi ? oth[4 + i] : mine[4 + i]; lg[12 + i] = hi ? mine[4 + i] : oth[4 + i]; }
        float sc_[16], sel[16];
#pragma unroll
        for (int e = 0; e < 16; ++e) { const float z = rstd * lg[e] + Ctab[s * 16 + e]; sc_[e] = __builtin_amdgcn_rcpf(1.0f + __builtin_amdgcn_exp2f(-z * LOG2E)); sel[e] = sc_[e] + INP(19)[e]; }
        float gs[4];
#pragma unroll
        for (int q = 0; q < 4; ++q) { int i1, i2; float m1, m2; top2of4(sel[4 * q], sel[4 * q + 1], sel[4 * q + 2], sel[4 * q + 3], i1, i2, m1, m2); gs[q] = m1 + m2; }
        int gi = 0; float gmx = gs[0]; if (gs[1] > gmx) { gmx = gs[1]; gi = 1; } if (gs[2] > gmx) { gmx = gs[2]; gi = 2; } if (gs[3] > gmx) { gmx = gs[3]; gi = 3; }
        float x4[4], s4[4];
#pragma unroll
        for (int i = 0; i < 4; ++i) { x4[i] = gi == 0 ? sel[i] : gi == 1 ? sel[4 + i] : gi == 2 ? sel[8 + i] : sel[12 + i]; s4[i] = gi == 0 ? sc_[i] : gi == 1 ? sc_[4 + i] : gi == 2 ? sc_[8 + i] : sc_[12 + i]; }
        int i1, i2; float m1, m2; top2of4(x4[0], x4[1], x4[2], x4[3], i1, i2, m1, m2);
        const int lo_ = i1 < i2 ? i1 : i2, hi_ = i1 < i2 ? i2 : i1;
        const int pr = lo_ == 0 ? hi_ - 1 : (lo_ == 1 ? hi_ + 1 : 5);
        const float slo = lo_ == 0 ? s4[0] : lo_ == 1 ? s4[1] : s4[2], shi = hi_ == 1 ? s4[1] : hi_ == 2 ? s4[2] : s4[3];
        const float inv = __builtin_amdgcn_rcpf(slo + shi);
        const int cls = gi * 6 + pr;
        if (hi == 0 && l31 < cnt) { const int ls = __hip_atomic_fetch_add(&hist[cls], 1, __ATOMIC_RELAXED, __HIP_MEMORY_SCOPE_WORKGROUP);
            const int ri = cur - r0 + l31; RS[ri] = rstd; RI[ri] = cls | (ls << 8);
            f32x2 w2 = {slo * inv, shi * inv}; *(GAS f32x2*)((GAS float*)(F.ws + WS_RW) + (size_t)(cur + l31) * 2) = w2; }
        cur += cnt;
    }
    LDS_WAIT();
    { int curb = -1; f32x4 gm[4], sh[4];
#pragma unroll 1
      for (int row = r0; row < r1; row += 4) {
        const int b = row < NLAT ? (row >> 11) : 32;
        if (b != curb) { curb = b;
#pragma unroll
            for (int j = 0; j < 4; ++j) { const int c0 = 8 * lane + 512 * (j >> 1) + 4 * (j & 1); const f32x4 gg = *(const GAS f32x4*)(g2 + c0), sc = *(const GAS f32x4*)(mod + b * ADA + 4 * 1024 + c0);
                gm[j] = gg * (sc + 1.0f); sh[j] = *(const GAS f32x4*)(mod + b * ADA + 3 * 1024 + c0); } }
        u32x4 raw[4][2];
#pragma unroll
        for (int r = 0; r < 4; ++r)
#pragma unroll
            for (int jj = 0; jj < 2; ++jj) raw[r][jj] = *(const GAS u32x4*)(XB + (size_t)(row + r) * D + 8 * lane + 512 * jj);
#pragma unroll
        for (int r = 0; r < 4; ++r) { const float rstd = RS[row - r0 + r];
#pragma unroll
            for (int jj = 0; jj < 2; ++jj) { const u32x4 wv = raw[r][jj];
                const f32x4 v0 = (f32x4){bflo(wv.x), bfhi(wv.x), bflo(wv.y), bfhi(wv.y)} * rstd * gm[2 * jj] + sh[2 * jj], v1 = (f32x4){bflo(wv.z), bfhi(wv.z), bflo(wv.w), bfhi(wv.w)} * rstd * gm[2 * jj + 1] + sh[2 * jj + 1];
                u32x4 o; o.x = pk2(v0.x, v0.y); o.y = pk2(v0.z, v0.w); o.z = pk2(v1.x, v1.y); o.w = pk2(v1.z, v1.w);
                *(GAS u32x4*)(H + (size_t)(row + r) * D + 8 * lane + 512 * jj) = o; } }
      } }
    __syncthreads();
    if (tid < NCLS) base[tid] = (int)__hip_atomic_fetch_add(CTL(F) + CW_CNT + (L * NCLS + tid) * 64, (unsigned)hist[tid], __ATOMIC_RELAXED, __HIP_MEMORY_SCOPE_AGENT);
    __syncthreads();
    { GAS int* perm = (GAS int*)(F.ws + WS_PERM);
      if (r0 + lane < r1) { const int ri = RI[lane], cls = ri & 255, ls = ri >> 8; perm[(size_t)cls * MTOT + base[cls] + ls] = r0 + lane; } }
    __syncthreads();
}

__device__ __forceinline__ void qkprep_phase(FARGS, int L, bool live = true) {
    refresh(F); OPAQUE_S(L);
    GAS bf16_t* U = (GAS bf16_t*)(F.ws + WS_U);
    const GAS float* tab = (const GAS float*)(F.ws + WS_TAB);
    const int lane = F.lane, gw = F.bx * NWAVES + F.wave, NGW = F.G * NWAVES, rpw = (MTOT + NGW - 1) / NGW;
    const int r0 = gw * rpw, r1 = (r0 + rpw < MTOT) ? r0 + rpw : MTOT;
    int ccol[4]; bool seg32[4], dorope[4], valid[4]; float qs[4]; f32x4 g0[4], g1[4];
#pragma unroll
    for (int i = 0; i < 4; ++i) {
        const int c = lane + 64 * i; valid[i] = c < 224;
        int col, isq; const GAS float* gp; bool s32 = false, rp = true; float sc = 0.125f * LOG2E;
        if (c < 48) { col = 8 * c; isq = c < 32; gp = INP(9) + L * 128 + (isq ? 0 : 64) + ((8 * c) & 63); }
        else if (c < 112) { const int cc = c - 48; col = QB + 8 * cc; isq = cc < 32; gp = INP(10) + L * 128 + (isq ? 0 : 64) + ((8 * cc) & 63); rp = false; }
        else if (c < 176) { const int cc = c - 112; col = QC + 8 * cc; isq = cc < 32; gp = INP(11) + L * 64 + (isq ? 0 : 32) + ((8 * cc) & 31); s32 = true; sc = 0.17677669529663687f * LOG2E; }
        else { const int cc = (c < 224 ? c : 223) - 176; col = QD + 8 * cc; isq = cc < 32; gp = INP(12) + L * 128 + (isq ? 0 : 64) + ((8 * cc) & 63); }
        ccol[i] = col; seg32[i] = s32; dorope[i] = rp; qs[i] = isq ? sc : 1.0f; g0[i] = *(const GAS f32x4*)gp; g1[i] = *(const GAS f32x4*)(gp + 4);
    }
#pragma unroll 1
    for (int row4 = r0; row4 < r1; row4 += 4) {
        u32x4 wv[4][4];
#pragma unroll
        for (int r = 0; r < 4; ++r)
#pragma unroll
            for (int i = 0; i < 4; ++i) wv[r][i] = *(const GAS u32x4*)(U + (size_t)(row4 + r) * DIN + ccol[i]);
#pragma unroll
        for (int r = 0; r < 4; ++r) {
        const int row = row4 + r;
        const bool lat = row < NLAT; const int s = row & 2047, prow = s >> 6, pcol = s & 63;
#pragma unroll
        for (int i = 0; i < 4; ++i) {
            GAS bf16_t* p = U + (size_t)row * DIN + ccol[i];
            const u32x4 w = wv[r][i];
            float x[8] = {bflo(w.x), bfhi(w.x), bflo(w.y), bfhi(w.y), bflo(w.z), bfhi(w.z), bflo(w.w), bfhi(w.w)};
            float ss = 0.f;
#pragma unroll
            for (int e = 0; e < 8; ++e) ss += x[e] * x[e];
            ss += sx(ss, lane, 1); ss += sx(ss, lane, 2); const float ss8 = ss + sx(ss, lane, 4);
            const float rstd = seg32[i] ? __builtin_amdgcn_rsqf(ss * (1.f / 32.f) + EPS) : __builtin_amdgcn_rsqf(ss8 * (1.f / 64.f) + EPS);
            const float gg[8] = {g0[i].x, g0[i].y, g0[i].z, g0[i].w, g1[i].x, g1[i].y, g1[i].z, g1[i].w};
#pragma unroll
            for (int e = 0; e < 8; ++e) x[e] = x[e] * rstd * gg[e];
            const int j = seg32[i] ? (lane & 3) : (lane & 7);
            const int pxor = seg32[i] ? 1 : 2;
            const bool first = seg32[i] ? !(j & 1) : !(j & 2);
            const int pos = seg32[i] ? ((j < 2) ? prow : pcol) : ((j < 4) ? prow : pcol);
            const GAS float* tp = seg32[i] ? tab + TAB_T32 + (pos * 8) * 2 : tab + TAB_T64 + (pos * 16 + 8 * (j & 1)) * 2;
            const bool rp = dorope[i] && lat;
#pragma unroll
            for (int e2 = 0; e2 < 4; ++e2) {
                const f32x4 cs = *(const GAS f32x4*)(tp + 4 * e2);
                const float pa = sx(x[2 * e2], lane, pxor), pb = sx(x[2 * e2 + 1], lane, pxor);
                if (rp) {
                    x[2 * e2] = first ? x[2 * e2] * cs.x - pa * cs.y : pa * cs.y + x[2 * e2] * cs.x;
                    x[2 * e2 + 1] = first ? x[2 * e2 + 1] * cs.z - pb * cs.w : pb * cs.w + x[2 * e2 + 1] * cs.z;
                }
            }
            u32x4 o; o.x = pk2(x[0] * qs[i], x[1] * qs[i]); o.y = pk2(x[2] * qs[i], x[3] * qs[i]); o.z = pk2(x[4] * qs[i], x[5] * qs[i]); o.w = pk2(x[6] * qs[i], x[7] * qs[i]);
            if (valid[i] && live) *(GAS u32x4*)p = o;
        }
        }
    }
}
#ifdef MK_USE_SB
#define MK_SB() __builtin_amdgcn_sched_barrier(0)
#else
#define MK_SB() do {} while (0)
#endif
#ifndef MK_DUAL
#define MK_DUAL 1
#endif
#ifndef MK_MIDBAR
#define MK_MIDBAR 0
#endif
#ifndef MK_QKFIRST
#define MK_QKFIRST 1
#endif
#ifndef MK_ILV
#define MK_ILV 15
#endif
#ifndef MK_CHP
#define MK_CHP 1
#endif
template <int MIX> struct MixCfg;
template <> struct MixCfg<0> { static constexpr int QCOL = QA, KCOL = KA, VCOL = VA, CK = 128, CV = 128; static constexpr bool GQA = true;  };
template <> struct MixCfg<1> { static constexpr int QCOL = QB, KCOL = KB, VCOL = VB, CK = 256, CV = 256; static constexpr bool GQA = false; };
template <> struct MixCfg<2> { static constexpr int QCOL = QC, KCOL = KC, VCOL = VC, CK = MK_CHP ? 128 : 256, CV = MK_CHP ? 128 : 256; static constexpr bool GQA = false; };
template <> struct MixCfg<3> { static constexpr int QCOL = QD, KCOL = KD, VCOL = VD, CK = 128, CV = 128; static constexpr bool GQA = true;  };

__device__ __forceinline__ int crow16(int r, int hi) { return (r & 3) + 8 * (r >> 2) + 4 * hi; }
__device__ __forceinline__ s16x4 vtr(const LAS unsigned char* p) { return __builtin_bit_cast(s16x4, __builtin_amdgcn_ds_read_tr16_b64_v4i16((LAS s16x4*)p)); }

__device__ __forceinline__ void softmax_tile(f32x16& p0, f32x16& p1, float& l, bf16x8 (&pa)[4]) {
    float s0 = 0.f, s1 = 0.f;
#pragma unroll
    for (int r = 0; r < 16; ++r) { p0[r] = __builtin_amdgcn_exp2f(p0[r]); p1[r] = __builtin_amdgcn_exp2f(p1[r]); s0 += p0[r]; s1 += p1[r]; }
    l += s0 + s1;
#pragma unroll
    for (int sI = 0; sI < 4; ++sI) {
        u32x4 w;
        if (sI < 2) { const int o_ = 8 * sI; w.x = pk2(p0[o_], p0[o_ + 1]); w.y = pk2(p0[o_ + 2], p0[o_ + 3]); w.z = pk2(p0[o_ + 4], p0[o_ + 5]); w.w = pk2(p0[o_ + 6], p0[o_ + 7]); }
        else { const int o_ = 8 * (sI - 2); w.x = pk2(p1[o_], p1[o_ + 1]); w.y = pk2(p1[o_ + 2], p1[o_ + 3]); w.z = pk2(p1[o_ + 4], p1[o_ + 5]); w.w = pk2(p1[o_ + 6], p1[o_ + 7]); }
        pa[sI] = __builtin_bit_cast(bf16x8, w);
    }
}

template <int MIX>
__device__ __forceinline__ void attn_unit(FARGS, int L, int b, int qb, bool isctx, int hp) {
    typedef MixCfg<MIX> C;
    refresh(F); OPAQUE_S(L);
#ifdef MK_STAMP
#define STAMP_NOW_(v) __builtin_amdgcn_sched_barrier(0); const unsigned v = (unsigned)__builtin_amdgcn_s_memtime(); __builtin_amdgcn_sched_barrier(0)
#define SEG0() do { if (MIX == MK_STAMP) { STAMP_NOW_(now_); if (F.tid == MK_STAMP_TID) { LAS unsigned* m_ = (LAS unsigned*)(F.lds + MISC_OFF); m_[21] = now_; } } } while (0)
#define SEG(k) do { if (MIX == MK_STAMP && (MK_STAMP_SEG == 9 ? (k) == 3 : ((k) == MK_STAMP_SEG || (k) == (MK_STAMP_SEG + 3) % 4))) { STAMP_NOW_(now_); if (F.tid == MK_STAMP_TID) { LAS unsigned* m_ = (LAS unsigned*)(F.lds + MISC_OFF); \
    if ((k) == MK_STAMP_SEG || MK_STAMP_SEG == 9) m_[20] += now_ - m_[21]; m_[21] = now_; } } } while (0)
#else
#define SEG0() do {} while (0)
#define SEG(k) do {} while (0)
#endif
    constexpr int SK = C::CK * 2 + 16, SV = C::CV * 2 + 64, NKC = C::CK / 64, NVC = C::CV / 64;
    constexpr bool DIFF = (MIX == 2);
    constexpr bool DUAL = (MIX == 3) && MK_DUAL;
    constexpr bool TWO = DIFF || DUAL;
    constexpr bool HP = DIFF && MK_CHP;
    constexpr int UQ = (DUAL || HP) ? 128 : 64;
    static_assert(C::CK == C::CV, "K and V tiles share the per-thread load offsets");
    const GAS bf16_t* U = (const GAS bf16_t*)(F.ws + WS_U);
    GAS bf16_t* Y = (GAS bf16_t*)(F.ws + WS_Y);
    const GAS float* tab = (const GAS float*)(F.ws + WS_TAB);
    const int tid = F.tid, lane = F.lane, w = F.wave, l31 = lane & 31, hi = lane >> 5;
    const int hq = DUAL ? 2 * (w >> 2) : (HP ? 2 * hp + (w >> 2) : (w >> 1)), rs = (DUAL || HP) ? (w & 3) : (w & 1);
    const int hk = (DUAL || HP) ? (w >> 2) : (C::GQA ? (hq >> 1) : hq);
    const int kcolb = C::KCOL + (HP ? hp * 128 : 0), vcolb = C::VCOL + (HP ? hp * 128 : 0);
    const int qrow = isctx ? NLAT + b * CTXL + qb * UQ + rs * 32 + l31 : b * SEQ + qb * UQ + rs * 32 + l31;
    int nloc, loc0;
    if (isctx) { nloc = 0; loc0 = 0; }
    else if (MIX == 0) { const int t0 = DUAL ? 2 * qb - 2 : qb - 2, t1 = DUAL ? 2 * qb + 3 : qb + 2; loc0 = t0 < 0 ? 0 : t0; const int hiT = t1 > 31 ? 31 : t1; nloc = hiT - loc0 + 1; }
    else if (MIX == 1) { loc0 = qb - 4 < 0 ? 0 : (qb - 4 > 24 ? 24 : qb - 4); nloc = 8; }
    else { loc0 = 0; nloc = 32; }
    const int NT = nloc + 4;
    const int lrow0 = b * SEQ, crow0 = NLAT + b * CTXL;
    bf16x8 qf[4], qg[DUAL ? 4 : 1];
    { const GAS bf16_t* qp = U + (size_t)qrow * DIN + C::QCOL + hq * 64 + hi * 8;
#pragma unroll
      for (int d0 = 0; d0 < 4; ++d0) { qf[d0] = *(const GAS bf16x8*)(qp + d0 * 16); if (DUAL) qg[DUAL ? d0 : 0] = *(const GAS bf16x8*)(qp + 64 + d0 * 16); } }
    float l0 = 0.f, l1 = 0.f;
    if (MIX == 0) { l0 = hi == 0 ? __builtin_amdgcn_exp2f(INP(13)[L * 4 + hq] * LOG2E) : 0.f;
        if (DUAL) l1 = hi == 0 ? __builtin_amdgcn_exp2f(INP(13)[L * 4 + hq + 1] * LOG2E) : 0.f; }
    f32x16 o0[2], o1[2];
#pragma unroll
    for (int i = 0; i < 2; ++i) { o0[i] = f32x16{}; o1[i] = f32x16{}; }
    u32x4 kreg[NKC], vreg[NVC];
    auto tile_row = [&](int t) -> int { return t < nloc ? lrow0 + (loc0 + t) * 64 : crow0 + (t - nloc) * 64; };
    unsigned goff[NKC];
#pragma unroll
    for (int i = 0; i < NKC; ++i) { const int c = tid + 512 * i, r = c / (C::CK / 8), cc = c % (C::CK / 8); goff[i] = (unsigned)(r * DIN + cc * 8) * 2u; }
    auto issueK = [&](int t) { const GAS char* tb = (const GAS char*)(U + (size_t)tile_row(t) * DIN + kcolb);
#pragma unroll
        for (int i = 0; i < NKC; ++i) kreg[i] = *(const GAS u32x4*)(tb + goff[i]); };
    auto issueV = [&](int t) { const GAS char* tb = (const GAS char*)(U + (size_t)tile_row(t) * DIN + vcolb);
#pragma unroll
        for (int i = 0; i < NVC; ++i) vreg[i] = *(const GAS u32x4*)(tb + goff[i]); };
    constexpr bool ILV = ((MK_ILV) >> MIX) & 1;
    constexpr bool MID = ILV && (!TWO || HP) && (C::CK == 128) && (((MK_MIDBAR) >> MIX) & 1);
    constexpr int K3SZ = 64 * SK, V3SZ = 64 * SV, V3BASE = 34816;
    static_assert(!MID || (2 * K3SZ <= V3BASE && V3BASE + 3 * V3SZ <= AT_RPB), "ring");
    auto KB = [&](int t) -> int { return MID ? (t & 1) * K3SZ : (t & 1) * AT_BUFB; };
    auto VB = [&](int t) -> int { return MID ? V3BASE + (int)((unsigned)t % 3u) * V3SZ : (t & 1) * AT_BUFB + AT_VOFF; };
    auto stashK = [&](int t) { LAS unsigned char* Kw = F.lds + KB(t);
#pragma unroll
        for (int i = 0; i < NKC; ++i) { const int c = tid + 512 * i, r = c / (C::CK / 8), cc = c % (C::CK / 8); *(LAS u32x4*)(Kw + r * SK + cc * 16) = kreg[i]; } };
    auto stashV = [&](int t) { LAS unsigned char* Vw = F.lds + VB(t);
#pragma unroll
        for (int i = 0; i < NVC; ++i) { const int c = tid + 512 * i, r = c / (C::CV / 8), cc = c % (C::CV / 8); *(LAS u32x4*)(Vw + r * SV + cc * 16) = vreg[i]; } };
    const int kboff = l31 * SK + (hk * 64 + hi * 8) * 2;
    const int vboff = (4 * hi + ((lane & 15) >> 2)) * SV + (hk * 64 + 16 * ((lane >> 4) & 1) + 4 * (lane & 3)) * 2;
    bf16x8 kf[8];
    auto loadkf = [&](int t) { const LAS unsigned char* kb = F.lds + KB(t) + kboff;
#pragma unroll
        for (int d0 = 0; d0 < 4; ++d0) { kf[2 * d0] = *(const LAS bf16x8*)(kb + d0 * 32); kf[2 * d0 + 1] = *(const LAS bf16x8*)(kb + 32 * SK + d0 * 32); } };
    bf16x8 pa0[4], pa1[4];
#pragma unroll
    for (int i = 0; i < 4; ++i) { pa0[i] = bf16x8{}; pa1[i] = bf16x8{}; }
    constexpr int VPRE = DUAL ? 1 : (TWO ? 2 : 4);
    bf16x8 vf[2 * VPRE];
    auto readvf = [&](int t, int sI, int dh) -> bf16x8 {
        const LAS unsigned char* vp = F.lds + VB(t) + vboff + (16 * sI) * SV + dh * 64;
        const s16x4 lo = vtr(vp), hi4 = vtr(vp + 8 * SV);
        return (bf16x8){lo[0], lo[1], lo[2], lo[3], hi4[0], hi4[1], hi4[2], hi4[3]}; };
    auto loadvf = [&](int t) {
#pragma unroll
        for (int sI = 0; sI < VPRE; ++sI)
#pragma unroll
            for (int dh = 0; dh < 2; ++dh) vf[2 * sI + dh] = readvf(t, sI, dh); };
    auto pv = [&](int t) {
#pragma unroll
        for (int sI = 0; sI < 4; ++sI)
#pragma unroll
            for (int dh = 0; dh < 2; ++dh) {
                const bf16x8 v = sI < VPRE ? vf[2 * (sI < VPRE ? sI : 0) + dh] : readvf(t, sI, dh);
                o0[dh] = __builtin_amdgcn_mfma_f32_32x32x16_bf16(v, pa0[sI], o0[dh], 0, 0, 0);
                if (TWO) o1[dh] = __builtin_amdgcn_mfma_f32_32x32x16_bf16(v, pa1[sI], o1[dh], 0, 0, 0);
            } };
    const int qpos = qb * UQ + rs * 32 + l31;
    const int qc = rs * 32 + l31, cs = qc - 8 < 0 ? 0 : (qc - 8 > 48 ? 48 : qc - 8);
    const LAS float* rpb = (const LAS float*)(F.lds + AT_RPB) + hq * 465;
    issueK(0); stashK(0); issueK(1); issueV(0);
    WG_BAR();
    constexpr bool KHOLD = !TWO || HP;
    if (KHOLD) loadkf(0);
    if (ILV) {
#define SBAR() __builtin_amdgcn_sched_barrier(0)
    auto loadkf1 = [&](int t, int j) { const LAS unsigned char* kb = F.lds + KB(t) + kboff; kf[j] = *(const LAS bf16x8*)(kb + (j & 1) * 32 * SK + (j >> 1) * 32); };
    constexpr int NB = TWO ? 2 : 4;
    constexpr int NG = TWO ? 16 : 8;
    bf16x8 vr[NB];
    auto stage = [&](int t) {
        if (t + 1 < NT) stashK(t + 1);
        stashV(t);
        if (t + 2 < NT) issueK(t + 2);
        if (t + 1 < NT) issueV(t + 1); };
    auto qk = [&](int t, f32x16& p0, f32x16& p1, f32x16& r0_, f32x16& r1_) {
        if (DUAL) {
            const LAS unsigned char* kb = F.lds + KB(t) + kboff;
            bf16x8 kr[2][2];
#pragma unroll
            for (int d0 = 0; d0 < 2; ++d0) { kr[d0][0] = *(const LAS bf16x8*)(kb + d0 * 32); kr[d0][1] = *(const LAS bf16x8*)(kb + 32 * SK + d0 * 32); }
#pragma unroll
            for (int d0 = 0; d0 < 4; ++d0) {
                SBAR();
                p0 = __builtin_amdgcn_mfma_f32_32x32x16_bf16(kr[d0 & 1][0], qf[d0], p0, 0, 0, 0); p1 = __builtin_amdgcn_mfma_f32_32x32x16_bf16(kr[d0 & 1][1], qf[d0], p1, 0, 0, 0);
                r0_ = __builtin_amdgcn_mfma_f32_32x32x16_bf16(kr[d0 & 1][0], qg[DUAL ? d0 : 0], r0_, 0, 0, 0); r1_ = __builtin_amdgcn_mfma_f32_32x32x16_bf16(kr[d0 & 1][1], qg[DUAL ? d0 : 0], r1_, 0, 0, 0);
                if (d0 + 2 < 4) { kr[d0 & 1][0] = *(const LAS bf16x8*)(kb + (d0 + 2) * 32); kr[d0 & 1][1] = *(const LAS bf16x8*)(kb + 32 * SK + (d0 + 2) * 32); }
            }
            SBAR();
            return;
        }
#pragma unroll
        for (int d0 = 0; d0 < (DIFF ? 2 : 4); ++d0) { p0 = __builtin_amdgcn_mfma_f32_32x32x16_bf16(kf[2 * d0], qf[d0], p0, 0, 0, 0); p1 = __builtin_amdgcn_mfma_f32_32x32x16_bf16(kf[2 * d0 + 1], qf[d0], p1, 0, 0, 0); }
        if (DIFF) {
#pragma unroll
            for (int d0 = 2; d0 < 4; ++d0) { r0_ = __builtin_amdgcn_mfma_f32_32x32x16_bf16(kf[2 * d0], qf[d0], r0_, 0, 0, 0); r1_ = __builtin_amdgcn_mfma_f32_32x32x16_bf16(kf[2 * d0 + 1], qf[d0], r1_, 0, 0, 0); }
        } };
    auto init_acc = [&](int t, f32x16& p0, f32x16& p1, f32x16& r0_, f32x16& r1_) {
        const bool local = t < nloc;
        p0 = f32x16{}; p1 = f32x16{}; r0_ = f32x16{}; r1_ = f32x16{};
        if (MIX == 0 && local) {
            const int dj = loc0 + t - qb;
            if (dj <= -2 || dj >= 2) {
                const int mb = (loc0 + t) * 64 + 4 * hi - qpos + 128;
#pragma unroll
                for (int r = 0; r < 16; ++r) { const int kc = (r & 3) + 8 * (r >> 2);
                    if ((unsigned)(mb + kc) > 256u) { p0[r] = -INFINITY; if (DUAL) r0_[r] = -INFINITY; } if ((unsigned)(mb + kc + 32) > 256u) { p1[r] = -INFINITY; if (DUAL) r1_[r] = -INFINITY; } }
            }
        }
        if (MIX == 1 && local) {
            const int dr = (loc0 + t) - qb + 7;
            const int kh = 4 * hi - cs; const LAS float* rp = rpb + dr * 31 + 15 - qc + 4 * hi;
            float bb0[16], bb1[16];
#pragma unroll
            for (int r = 0; r < 16; ++r) { const int kc = (r & 3) + 8 * (r >> 2); bb0[r] = rp[kc]; bb1[r] = rp[kc + 32]; }
#pragma unroll
            for (int r = 0; r < 16; ++r) { asm volatile("" : "+v"(bb0[r]), "+v"(bb1[r])); }
#pragma unroll
            for (int r = 0; r < 16; ++r) { const int kc = (r & 3) + 8 * (r >> 2);
                const bool v0 = (unsigned)(kh + kc) < 16u, v1 = (unsigned)(kh + kc + 32) < 16u;
                p0[r] = v0 ? bb0[r] : -INFINITY; p1[r] = v1 ? bb1[r] : -INFINITY; }
        } };
    auto sm_exp = [&](f32x16& a0, f32x16& a1, int q, float& sum) {
#pragma unroll
        for (int j = 0; j < 4; ++j) { const int r = 4 * (q & 3) + j;
            if (q < 4) { a0[r] = __builtin_amdgcn_exp2f(a0[r]); sum += a0[r]; } else { a1[r] = __builtin_amdgcn_exp2f(a1[r]); sum += a1[r]; } } };
    auto sm_cvt = [&](const f32x16& a0, const f32x16& a1, int q, bf16x8 (&pa)[4]) {
        const int r = 4 * (q & 3);
        const unsigned lo = q < 4 ? pk2(a0[r], a0[r + 1]) : pk2(a1[r], a1[r + 1]), hi2 = q < 4 ? pk2(a0[r + 2], a0[r + 3]) : pk2(a1[r + 2], a1[r + 3]);
        u32x4 w = __builtin_bit_cast(u32x4, pa[q >> 1]);
        if (q & 1) { w.z = lo; w.w = hi2; } else { w.x = lo; w.y = hi2; }
        pa[q >> 1] = __builtin_bit_cast(bf16x8, w); };
    {
        if (!KHOLD && !DUAL) loadkf(0);
        stage(0);
        f32x16 p0, p1, r0_, r1_;
        init_acc(0, p0, p1, r0_, r1_);
        qk(0, p0, p1, r0_, r1_);
        softmax_tile(p0, p1, l0, pa0);
        if (TWO) softmax_tile(r0_, r1_, l1, pa1);
        WG_BAR();
        if (KHOLD && 1 < NT) loadkf(1);
    }
    SEG0();
    for (int t = 1; t < NT; ++t) {
        f32x16 p0, p1, r0_, r1_;
        if (MK_QKFIRST) {
            if (!KHOLD && !DUAL) loadkf(t);
            if (MK_QKFIRST == 2) {
#pragma unroll
                for (int f = 0; f < NB; ++f) vr[f] = readvf(t - 1, f >> 1, f & 1); }
            init_acc(t, p0, p1, r0_, r1_);
            qk(t, p0, p1, r0_, r1_);
            if (MK_QKFIRST != 2) {
#pragma unroll
                for (int f = 0; f < NB; ++f) vr[f] = readvf(t - 1, f >> 1, f & 1); }
            stage(t);
        } else {
#pragma unroll
        for (int f = 0; f < NB; ++f) vr[f] = readvf(t - 1, f >> 1, f & 1);
        if (!KHOLD && !DUAL) loadkf(t);
        stage(t);
        init_acc(t, p0, p1, r0_, r1_);
        SEG(1);
        qk(t, p0, p1, r0_, r1_);
        SEG(0);
        }
#pragma unroll
        for (int g = 0; g < NG; ++g) {
            SBAR();
            if (MID && g == NG / 2) { WG_BAR(); SBAR(); }
            if (MID && !TWO && g >= NG - 4) { loadkf1(t + 1, 2 * (g - (NG - 4))); loadkf1(t + 1, 2 * (g - (NG - 4)) + 1); }
            if (TWO) {
                const int f = g >> 1, h = g & 1, sI = g >> 2, dh = (g >> 1) & 1;
                if (h == 0) o0[dh] = __builtin_amdgcn_mfma_f32_32x32x16_bf16(vr[f % NB], pa0[sI], o0[dh], 0, 0, 0);
                else { o1[dh] = __builtin_amdgcn_mfma_f32_32x32x16_bf16(vr[f % NB], pa1[sI], o1[dh], 0, 0, 0);
                    if (f + NB < 8) vr[f % NB] = readvf(t - 1, (f + NB) >> 1, (f + NB) & 1); }
                if (h == 0) sm_exp(p0, p1, g >> 1, l0); else sm_exp(r0_, r1_, g >> 1, l1);
                if (g >= 3 && ((g - 3) & 3) == 0) { const int k = (g - 3) >> 2; sm_cvt(p0, p1, 2 * k, pa0); sm_cvt(p0, p1, 2 * k + 1, pa0); }
                if (g >= 4 && ((g - 4) & 3) == 0) { const int k = (g - 4) >> 2; sm_cvt(r0_, r1_, 2 * k, pa1); sm_cvt(r0_, r1_, 2 * k + 1, pa1); }
            } else {
                const int f = g, sI = g >> 1, dh = g & 1;
                o0[dh] = __builtin_amdgcn_mfma_f32_32x32x16_bf16(vr[f % NB], pa0[sI], o0[dh], 0, 0, 0);
                if (f + NB < 8) vr[f % NB] = readvf(t - 1, (f + NB) >> 1, (f + NB) & 1);
                sm_exp(p0, p1, g, l0);
                if (g >= 2 && (g & 1) == 0) { const int k = (g - 2) >> 1; sm_cvt(p0, p1, 2 * k, pa0); sm_cvt(p0, p1, 2 * k + 1, pa0); }
            }
        }
        SBAR();
        if (TWO) { sm_cvt(r0_, r1_, 6, pa1); sm_cvt(r0_, r1_, 7, pa1); }
        else { sm_cvt(p0, p1, 6, pa0); sm_cvt(p0, p1, 7, pa0); }
        if (MID && TWO) {
#pragma unroll
            for (int j = 0; j < 8; ++j) loadkf1(t + 1, j); }
        SEG(2);
        if (!MID) WG_BAR();
        SEG(3);
        if (KHOLD && !MID && t + 1 < NT) loadkf(t + 1);
    }
    loadvf(NT - 1); pv(NT - 1);
    } else {
    for (int t = 0; t < NT; ++t) {
        if (t > 0) loadvf(t - 1);
        if (!KHOLD) loadkf(t);
        MK_SB();
        if (t + 1 < NT) stashK(t + 1);
        stashV(t);
        if (t + 2 < NT) issueK(t + 2);
        if (t + 1 < NT) issueV(t + 1);
        const bool local = t < nloc;
        f32x16 p0 = f32x16{}, p1 = f32x16{}, r0_ = f32x16{}, r1_ = f32x16{};
#pragma unroll
        for (int d0 = 0; d0 < (DIFF ? 2 : 4); ++d0) { p0 = __builtin_amdgcn_mfma_f32_32x32x16_bf16(kf[2 * d0], qf[d0], p0, 0, 0, 0); p1 = __builtin_amdgcn_mfma_f32_32x32x16_bf16(kf[2 * d0 + 1], qf[d0], p1, 0, 0, 0); }
        MK_SB();
        if (t > 0) pv(t - 1);
        if (DIFF) {
#pragma unroll
            for (int d0 = 2; d0 < 4; ++d0) { r0_ = __builtin_amdgcn_mfma_f32_32x32x16_bf16(kf[2 * d0], qf[d0], r0_, 0, 0, 0); r1_ = __builtin_amdgcn_mfma_f32_32x32x16_bf16(kf[2 * d0 + 1], qf[d0], r1_, 0, 0, 0); }
        }
        if (DUAL) {
#pragma unroll
            for (int d0 = 0; d0 < 4; ++d0) { r0_ = __builtin_amdgcn_mfma_f32_32x32x16_bf16(kf[2 * d0], qg[DUAL ? d0 : 0], r0_, 0, 0, 0); r1_ = __builtin_amdgcn_mfma_f32_32x32x16_bf16(kf[2 * d0 + 1], qg[DUAL ? d0 : 0], r1_, 0, 0, 0); }
        }
        MK_SB();
        if (MIX == 0 && local) {
            const int mb = (loc0 + t) * 64 + 4 * hi - qpos + 128;
#pragma unroll
            for (int r = 0; r < 16; ++r) { const int kc = (r & 3) + 8 * (r >> 2);
                if ((unsigned)(mb + kc) > 256u) { p0[r] = -INFINITY; if (DUAL) r0_[r] = -INFINITY; } if ((unsigned)(mb + kc + 32) > 256u) { p1[r] = -INFINITY; if (DUAL) r1_[r] = -INFINITY; } }
        }
        if (MIX == 1 && local) {
            const int dr = (loc0 + t) - qb + 7;
            const int kh = 4 * hi - cs; const LAS float* rp = rpb + dr * 31 + 15 - qc + 4 * hi;
#pragma unroll
            for (int r = 0; r < 16; ++r) { const int kc = (r & 3) + 8 * (r >> 2);
                const bool v0 = (unsigned)(kh + kc) < 16u, v1 = (unsigned)(kh + kc + 32) < 16u;
                const float b0 = rp[kc], b1 = rp[kc + 32];
                p0[r] = v0 ? p0[r] + b0 : -INFINITY; p1[r] = v1 ? p1[r] + b1 : -INFINITY; }
        }
        softmax_tile(p0, p1, l0, pa0);
        if (TWO) softmax_tile(r0_, r1_, l1, pa1);
        WG_BAR();
        if (KHOLD && t + 1 < NT) loadkf(t + 1);
    }
    loadvf(NT - 1); pv(NT - 1);
    }
    { refresh(F); const int l31f = F.lane & 31, hif = F.lane >> 5;
      const float lt0 = x32_sum(l0); const float i0 = 1.0f / lt0;
      float sc1 = 0.f;
      if (DIFF) { const float lt1 = x32_sum(l1); sc1 = tab[TAB_LAM + L] / lt1; }
      if (DUAL) { const float lt1 = x32_sum(l1); sc1 = 1.0f / lt1; }
      float ss = 0.f, ss1 = 0.f;
#pragma unroll
      for (int dh = 0; dh < 2; ++dh)
#pragma unroll
          for (int r = 0; r < 16; ++r) { float v = o0[dh][r] * i0; if (DIFF) v -= o1[dh][r] * sc1; o0[dh][r] = v; ss += v * v;
              if (DUAL) { const float v1 = o1[dh][r] * sc1; o1[dh][r] = v1; ss1 += v1 * v1; } }
      ss = x32_sum(ss); if (DUAL) ss1 = x32_sum(ss1);
      float scl;
      if (DIFF) scl = __builtin_amdgcn_rsqf(ss * (1.f / 64.f) + EPS) * tab[TAB_LAM + DEPTH + L];
      else {
          LAS float* gss = (LAS float*)(F.lds + AT_GSS);
          if (hif == 0) { gss[(rs * 32 + l31f) * 4 + hq] = ss; if (DUAL) gss[(rs * 32 + l31f) * 4 + hq + 1] = ss1; }
          WG_BAR();
          const f32x4 g4 = *(const LAS f32x4*)(gss + (rs * 32 + l31f) * 4);
          scl = __builtin_amdgcn_rsqf(((g4.x + g4.y) + (g4.z + g4.w)) * (1.f / 256.f) + EPS);
      }
      int lf = l31f;
      const int qrow_f = isctx ? NLAT + b * CTXL + qb * UQ + rs * 32 + lf : b * SEQ + qb * UQ + rs * 32 + lf;
      GAS bf16_t* yp = Y + (size_t)qrow_f * D + MIX * 256 + hq * 64 + 4 * hif;
#pragma unroll
      for (int dh = 0; dh < 2; ++dh)
#pragma unroll
          for (int g = 0; g < 4; ++g) { u32x2 o; o.x = pk2(o0[dh][4 * g] * scl, o0[dh][4 * g + 1] * scl); o.y = pk2(o0[dh][4 * g + 2] * scl, o0[dh][4 * g + 3] * scl);
              *(GAS u32x2*)(yp + dh * 32 + 8 * g) = o;
              if (DUAL) { u32x2 o2; o2.x = pk2(o1[dh][4 * g] * scl, o1[dh][4 * g + 1] * scl); o2.y = pk2(o1[dh][4 * g + 2] * scl, o1[dh][4 * g + 3] * scl);
                  *(GAS u32x2*)(yp + 64 + dh * 32 + 8 * g) = o2; } }
    }
#ifdef MK_STAMP
    if (MIX == MK_STAMP && F.tid == MK_STAMP_TID) { LAS unsigned* m_ = (LAS unsigned*)(F.lds + MISC_OFF); const unsigned a_ = m_[20]; unsigned z_ = 0; asm volatile("" : "+v"(z_)); m_[20] = z_;
        if (!isctx) { __hip_atomic_fetch_add(CTL(F) + 2048, a_, __ATOMIC_RELAXED, __HIP_MEMORY_SCOPE_AGENT); __hip_atomic_fetch_add(CTL(F) + 2049, (unsigned)(NT - 1), __ATOMIC_RELAXED, __HIP_MEMORY_SCOPE_AGENT); } }
#endif
}

template <int MIX>
__device__ __forceinline__ void run_mixer(FARGS, int L, bool need_ctx) {
    constexpr bool DUAL = (MIX == 3) && MK_DUAL, HP = (MIX == 2) && MK_CHP;
    constexpr int NU = DUAL ? 512 : 1024, NC = DUAL ? 64 : 128;
    const int G = F.G;
    const int c = (G % 8 == 0) ? (F.bx % 8) * (G / 8) + F.bx / 8 : F.bx;
    const int nlat = c < NU ? (NU - c + G - 1) / G : 0;
    const int j = (MIX & 1) ? c - 128 : c;
    const bool has_ctx = need_ctx && j >= 0 && j < NC;
    const int n = nlat + (has_ctx ? 1 : 0);
    for (int k = 0; k < n; ++k) { const bool isctx = k >= nlat; const int i = isctx ? j : c + k * G;
        int b, qb, hp = 0;
        if (HP) { if (isctx) { b = i >> 2; qb = (i >> 1) & 1; hp = i & 1; } else { b = i >> 5; qb = (i & 31) >> 1; hp = i & 1; } }
        else if (DUAL) { if (isctx) { b = i >> 1; qb = i & 1; } else { b = i >> 4; qb = i & 15; } }
        else { if (isctx) { b = i >> 2; qb = i & 3; } else { b = i >> 5; qb = i & 31; } }
        attn_unit<MIX>(F, L, b, qb, isctx, hp); }
}
__device__ __forceinline__ void attn_phase(FARGS, int L, bool need_ctx) {
    refresh(F);
    { LAS float* rpb = (LAS float*)(F.lds + AT_RPB); const GAS float* src = INP(14) + L * 4 * 465;
      for (int i = F.tid; i < 4 * 465; i += 512) rpb[i] = src[i] * LOG2E; }
    __syncthreads();
#ifndef MK_DOUBLE_MIX
#define MK_DOUBLE_MIX -1
#endif
#define REPM(k) for (int rep_ = 0; rep_ < ((MK_DOUBLE_MIX == (k)) ? 2 : 1); ++rep_)
    REPM(2) run_mixer<2>(F, L, need_ctx);
    REPM(3) run_mixer<3>(F, L, need_ctx);
    REPM(1) run_mixer<1>(F, L, need_ctx);
    REPM(0) run_mixer<0>(F, L, need_ctx);
    __syncthreads();
}
struct ProbPlain {
    static constexpr bool GATHER = false;
    const GAS char* A; const GAS char* Bt; int K, lda, ldb; size_t hstepA, hstepB; pg8::Order ord;
    __device__ __forceinline__ bool next(int i, pg8::Unit& u) const { return ord.next(i, u); }
    template <int NH> __device__ __forceinline__ void a_off(const pg8::Unit& u, int tid, unsigned (&v)[NH][2]) const {
        int R0, C0, R1, C1; pg8::stage_rc(tid * 16, R0, C0); pg8::stage_rc(tid * 16 + 8192, R1, C1);
        v[0][0] = (unsigned)((u.pm * 256 + R0) * lda + C0) * 2u; v[0][1] = (unsigned)((u.pm * 256 + R1) * lda + C1) * 2u;
    }
    __device__ __forceinline__ const GAS char* b_tile(const pg8::Unit& u, int t) const { return Bt + ((size_t)u.pn * 256 * ldb + (size_t)t * 64) * 2; }
};
struct EpiU { static constexpr int SID = 0;
    static constexpr bool PERM = true; static constexpr int NSTORES = 32;
    GAS bf16_t* U;
    __device__ __forceinline__ void operator()(const f32x4 (&acc)[2][2][4][2], const pg8::Unit& u, int wr, int wc, int fr, int fq) const {
        const int row0 = u.pm * 256 + wr * 64 + fr, col0 = u.pn * 256 + wc * 32 + 8 * fq;
#pragma unroll
        for (int ai = 0; ai < 2; ++ai)
#pragma unroll
            for (int m = 0; m < 4; ++m) { int frx = fr; asm volatile("" : "+v"(frx)); GAS bf16_t* rowp = U + (size_t)(u.pm * 256 + wr * 64 + frx + ai * 128 + m * 16) * DIN + col0;
#pragma unroll
                for (int bj = 0; bj < 2; ++bj) { const f32x4 v0 = acc[ai][bj][m][0], v1 = acc[ai][bj][m][1];
                    u32x4 w; w.x = pk2(v0[0], v0[1]); w.y = pk2(v0[2], v0[3]); w.z = pk2(v1[0], v1[1]); w.w = pk2(v1[2], v1[3]);
                    *(GAS u32x4*)(rowp + bj * 128) = w; } }
    }
};
struct EpiQK { static constexpr int SID = 1;
    static constexpr bool PERM = true; static constexpr int NSTORES = 32;
    GAS bf16_t* U; const GAS float* tab; const GAS float* gwin; const GAS float* gna; const GAS float* gdiff; const GAS float* ggqa; LAS float* X; float vscale;
    __device__ __forceinline__ void operator()(const f32x4 (&acc)[2][2][4][2], const pg8::Unit& u, int wr, int wc, int fr_, int fq_) const {
        int fq = fq_, fr = fr_; asm volatile("" : "+v"(fq), "+v"(fr));
        const int pn = u.pn;
        const bool lat = u.pm < 256;
        int kind = 0, nbj = 0; bool isq = false, rope = false; const GAS float* g = gwin; float qs = 1.f;
        if (pn == 0) { kind = 1; nbj = 2; isq = true; rope = true; g = gwin; } else if (pn == 1) { kind = 1; nbj = 1; rope = true; g = gwin + 64; }
        else if (pn == 2) { kind = 1; nbj = 2; isq = true; g = gna; } else if (pn == 3) { kind = 1; nbj = 2; g = gna + 64; }
        else if (pn == 5) { kind = 2; nbj = 2; isq = true; rope = true; g = gdiff; } else if (pn == 6) { kind = 2; nbj = 2; rope = true; g = gdiff + 32; }
        else if (pn == 8) { kind = 1; nbj = 2; isq = true; rope = true; g = ggqa; } else if (pn == 9) { kind = 1; nbj = 1; rope = true; g = ggqa + 64; }
        rope = rope && lat;
        if (kind == 0) body<0, false, 0>(acc, u, wr, wc, fr, fq, isq, g);
        else if (kind == 2) { if (rope) body<2, true, 2>(acc, u, wr, wc, fr, fq, isq, g); else body<2, false, 2>(acc, u, wr, wc, fr, fq, isq, g); }
        else if (nbj == 2) { if (rope) body<1, true, 2>(acc, u, wr, wc, fr, fq, isq, g); else body<1, false, 2>(acc, u, wr, wc, fr, fq, isq, g); }
        else { if (rope) body<1, true, 1>(acc, u, wr, wc, fr, fq, isq, g); else body<1, false, 1>(acc, u, wr, wc, fr, fq, isq, g); }
    }
    template <int kind, bool rope, int nbj>
    __device__ __forceinline__ void body(const f32x4 (&acc)[2][2][4][2], const pg8::Unit& u, int wr, int wc, int fr, int fq, bool isq, const GAS float* g) const {
        const int pn = u.pn, lane = fr + 16 * fq;
        float qs = 1.f;
        if (isq) qs = (kind == 2 ? 0.17677669529663687f : 0.125f) * LOG2E;
        const int row0 = u.pm * 256 + wr * 64 + fr, col0 = pn * 256 + wc * 32 + 8 * fq;
        float gg[8];
        { const int dg = kind == 2 ? 8 * fq : 32 * (wc & 1) + 8 * fq; const f32x4 a = *(const GAS f32x4*)(g + dg), b = *(const GAS f32x4*)(g + dg + 4);
          gg[0] = a.x; gg[1] = a.y; gg[2] = a.z; gg[3] = a.w; gg[4] = b.x; gg[5] = b.y; gg[6] = b.z; gg[7] = b.w; }
        auto sumsq = [&](int ai, int m, int bj) -> float { const f32x4 v0 = acc[ai][bj][m][0], v1 = acc[ai][bj][m][1];
            float s = (v0[0] * v0[0] + v0[1] * v0[1]) + (v0[2] * v0[2] + v0[3] * v0[3]) + (v1[0] * v1[0] + v1[1] * v1[1]) + (v1[2] * v1[2] + v1[3] * v1[3]);
            s += sx(s, lane, 16); s += sx(s, lane, 32); return s; };
        LAS float* Xw = X + (wr * 64 + fr) * 8 + wc; const LAS float* Xr = X + (wr * 64 + fr) * 8 + (wc ^ 1);
        float ssv[2][4][2];
#pragma unroll
        for (int ai = 0; ai < 2; ++ai)
#pragma unroll
            for (int m = 0; m < 4; ++m) { ssv[ai][m][0] = 0.f; ssv[ai][m][1] = 0.f; }
        if (kind == 1) {
#pragma unroll
            for (int ai = 0; ai < 2; ++ai)
#pragma unroll
                for (int m = 0; m < 4; ++m)
#pragma unroll
                    for (int bj = 0; bj < 2; ++bj) { const float s = sumsq(ai, m, bj); ssv[ai][m][bj] = s; if (fq == 0) Xw[(ai * 128 + m * 16) * 8 + bj * 4] = s; }
            asm volatile("s_waitcnt lgkmcnt(0)\n\ts_barrier" ::: "memory");
        }
        const int pxor = kind == 2 ? 16 : 32;
        const bool first = kind == 2 ? !(fq & 1) : (fq < 2);
        auto load_cs = [&](int it, f32x4 (&dst)[4]) {
            int frx = fr; asm volatile("" : "+v"(frx));
            const int row = u.pm * 256 + (it >> 2) * 128 + wr * 64 + (it & 3) * 16 + frx, s_ = row & 2047, prow = s_ >> 6, pcol = s_ & 63;
            const GAS float* tp = kind == 2 ? tab + TAB_T32 + ((fq < 2 ? prow : pcol) * 8) * 2 : tab + TAB_T64 + (((wc & 1) ? pcol : prow) * 16 + 8 * (fq & 1)) * 2;
#pragma unroll
            for (int e2 = 0; e2 < 4; ++e2) dst[e2] = *(const GAS f32x4*)(tp + 4 * e2); };
        f32x4 cs[4], ncs[4];
        if (rope) load_cs(0, cs);
#pragma unroll
        for (int ai = 0; ai < 2; ++ai)
#pragma unroll
            for (int m = 0; m < 4; ++m) {
                int frx = fr; asm volatile("" : "+v"(frx));
                const int rit = ai * 128 + wr * 64 + m * 16 + frx, row = u.pm * 256 + rit;
                GAS bf16_t* rowp = U + (size_t)row * DIN + col0;
                if (rope && ai * 4 + m < 7) load_cs(ai * 4 + m + 1, ncs);
                asm volatile("" ::: "memory");
#pragma unroll
                for (int bj = 0; bj < 2; ++bj) {
                    const f32x4 v0 = acc[ai][bj][m][0], v1 = acc[ai][bj][m][1];
                    float x[8] = {v0[0], v0[1], v0[2], v0[3], v1[0], v1[1], v1[2], v1[3]};
                    if (kind != 0 && bj < nbj) {
                        float ss;
                        if (kind == 1) ss = ssv[ai][m][bj] + Xr[(ai * 128 + m * 16) * 8 + bj * 4]; else ss = sumsq(ai, m, bj);
                        const float rq = qs * __builtin_amdgcn_rsqf(ss * (kind == 2 ? (1.f / 32.f) : (1.f / 64.f)) + EPS);
#pragma unroll
                        for (int e = 0; e < 8; ++e) x[e] = x[e] * gg[e];
                        if (rope) {
#pragma unroll
                            for (int e2 = 0; e2 < 4; ++e2) {
                                const float pa = sx(x[2 * e2], lane, pxor), pb = sx(x[2 * e2 + 1], lane, pxor);
                                x[2 * e2] = first ? x[2 * e2] * cs[e2].x - pa * cs[e2].y : pa * cs[e2].y + x[2 * e2] * cs[e2].x;
                                x[2 * e2 + 1] = first ? x[2 * e2 + 1] * cs[e2].z - pb * cs[e2].w : pb * cs[e2].w + x[2 * e2 + 1] * cs[e2].z;
                            }
                        }
#pragma unroll
                        for (int e = 0; e < 8; ++e) x[e] *= rq;
                    } else {
#pragma unroll
                        for (int e = 0; e < 8; ++e) x[e] *= vscale;
                    }
                    u32x4 w; w.x = pk2(x[0], x[1]); w.y = pk2(x[2], x[3]); w.z = pk2(x[4], x[5]); w.w = pk2(x[6], x[7]);
                    *(GAS u32x4*)(rowp + bj * 128) = w;
                }
#pragma unroll
                for (int e2 = 0; e2 < 4; ++e2) cs[e2] = ncs[e2];
            }
    }
};
struct EpiResid { static constexpr int SID = 2;
    static constexpr bool PERM = true; static constexpr int NSTORES = 32;
    const GAS float* slat; const GAS float* sctx; GAS bf16_t* XB; const GAS float* gate; bool first; float ascale;
    __device__ __forceinline__ void operator()(const f32x4 (&acc)[2][2][4][2], const pg8::Unit& u, int wr, int wc, int fr_, int fq) const {
        int fr = fr_; asm volatile("" : "+v"(fr));
        if (first) body<true>(acc, u, wr, wc, fr, fq); else body<false>(acc, u, wr, wc, fr, fq);
    }
    template <bool FIRST>
    __device__ __forceinline__ void body(const f32x4 (&acc)[2][2][4][2], const pg8::Unit& u, int wr, int wc, int fr, int fq) const {
        const bool islat = u.pm < 256; const int b = islat ? (u.pm >> 3) : 32;
        const GAS float* src = islat ? slat + (size_t)u.pm * 256 * D : sctx + (size_t)(u.pm - 256) * 256 * D;
        GAS bf16_t* dst = XB + (size_t)u.pm * 256 * D;
        const GAS float* gp = gate + (size_t)b * ADA;
        const int col0 = u.pn * 256 + wc * 32 + 8 * fq;
        f32x4 gv[2][2];
#pragma unroll
        for (int bj = 0; bj < 2; ++bj)
#pragma unroll
            for (int n = 0; n < 2; ++n) gv[bj][n] = *(const GAS f32x4*)(gp + col0 + bj * 128 + n * 4) * ascale;
        if (FIRST) {
#pragma unroll
            for (int ai = 0; ai < 2; ++ai)
#pragma unroll
                for (int m = 0; m < 4; ++m) {
                    const size_t ro = (size_t)(ai * 128 + wr * 64 + m * 16 + fr) * D + col0;
#pragma unroll
                    for (int bj = 0; bj < 2; ++bj) { f32x4 x0 = *(const GAS f32x4*)(src + ro + bj * 128), x1 = *(const GAS f32x4*)(src + ro + bj * 128 + 4);
                        x0 = x0 + gv[bj][0] * acc[ai][bj][m][0]; x1 = x1 + gv[bj][1] * acc[ai][bj][m][1];
                        u32x4 o; o.x = pk2(x0[0], x0[1]); o.y = pk2(x0[2], x0[3]); o.z = pk2(x1[0], x1[1]); o.w = pk2(x1[2], x1[3]);
                        *(GAS u32x4*)(dst + ro + bj * 128) = o; } }
        } else {
            u32x4 wv[2][4][2];
#pragma unroll
            for (int ai = 0; ai < 2; ++ai)
#pragma unroll
                for (int m = 0; m < 4; ++m) { const size_t ro = (size_t)(ai * 128 + wr * 64 + m * 16 + fr) * D + col0;
                    wv[ai][m][0] = *(const GAS u32x4*)(dst + ro); wv[ai][m][1] = *(const GAS u32x4*)(dst + ro + 128); }
#pragma unroll
            for (int ai = 0; ai < 2; ++ai)
#pragma unroll
                for (int m = 0; m < 4; ++m) { const size_t ro = (size_t)(ai * 128 + wr * 64 + m * 16 + fr) * D + col0;
#pragma unroll
                    for (int bj = 0; bj < 2; ++bj) { const u32x4 w = wv[ai][m][bj];
                        f32x4 x0 = (f32x4){bflo(w.x), bfhi(w.x), bflo(w.y), bfhi(w.y)}, x1 = (f32x4){bflo(w.z), bfhi(w.z), bflo(w.w), bfhi(w.w)};
                        x0 = x0 + gv[bj][0] * acc[ai][bj][m][0]; x1 = x1 + gv[bj][1] * acc[ai][bj][m][1];
                        u32x4 o; o.x = pk2(x0[0], x0[1]); o.y = pk2(x0[2], x0[3]); o.z = pk2(x1[0], x1[1]); o.w = pk2(x1[2], x1[3]);
                        *(GAS u32x4*)(dst + ro + bj * 128) = o; } }
        }
    }
};
struct MoeTab { const LAS int* tcls; const LAS int* trow; const LAS int* ccnt; };
__device__ __forceinline__ void moe_pair(int cls, int& ea, int& eb) { const int g = cls / 6, pr = cls % 6; const int ia = pr < 3 ? 0 : (pr < 5 ? 1 : 2), ib = pr < 3 ? pr + 1 : (pr < 5 ? pr - 1 : 3); ea = 4 * g + ia; eb = 4 * g + ib; }
__device__ __forceinline__ int moe_build_tables(FARGS, int L) {
    LAS int* tcls = (LAS int*)(F.lds + MOE_OFF); LAS int* trow = tcls + 320; LAS int* ccnt = trow + 320; LAS int* pre = ccnt + 32;
    if (F.tid < NCLS) ccnt[F.tid] = (int)__hip_atomic_load(CTL(F) + CW_CNT + (L * NCLS + F.tid) * 64, __ATOMIC_RELAXED, __HIP_MEMORY_SCOPE_AGENT);
    __syncthreads();
    if (F.tid == 0) { int T = 0;
#pragma unroll 1
        for (int c = 0; c < NCLS; ++c) { pre[c] = T; T += (ccnt[c] + 255) >> 8; }
        pre[NCLS] = T; }
    __syncthreads();
    const int T = pre[NCLS];
    if (F.tid < T) { int c = 0;
#pragma unroll 1
        for (int k = 1; k < NCLS; ++k) if (pre[k] <= F.tid) c = k;
        tcls[F.tid] = c; trow[F.tid] = (F.tid - pre[c]) * 256; }
    __syncthreads();
    return __builtin_amdgcn_readfirstlane(T);
}
struct ProbGateUp {
    static constexpr bool GATHER = true;
    const GAS char* A; const GAS char* W1; const GAS int* perm; int K, ldb; size_t hstepA, hstepB; pg8::Order ord; MoeTab tb;
    __device__ __forceinline__ bool next(int i, pg8::Unit& u) const { return ord.next(i, u); }
    template <int NH> __device__ __forceinline__ void a_off(const pg8::Unit& u, int tid, unsigned (&v)[NH][2]) const {
        int R0, C0, R1, C1; pg8::stage_rc(tid * 16, R0, C0); pg8::stage_rc(tid * 16 + 8192, R1, C1);
        const int cls = __builtin_amdgcn_readfirstlane(tb.tcls[u.pm]), tr = __builtin_amdgcn_readfirstlane(tb.trow[u.pm]), n = __builtin_amdgcn_readfirstlane(tb.ccnt[cls]);
        const GAS int* pp = perm + (size_t)cls * MTOT + tr;
#pragma unroll
        for (int h = 0; h < 2; ++h) { const int s0 = h * 128 + R0, s1 = h * 128 + R1;
            const int t0 = (tr + s0 < n) ? pp[s0] : 0, t1 = (tr + s1 < n) ? pp[s1] : 0;
            v[h][0] = (unsigned)(t0 * D + C0) * 2u; v[h][1] = (unsigned)(t1 * D + C1) * 2u; }
    }
    __device__ __forceinline__ const GAS char* b_tile(const pg8::Unit& u, int t) const {
        const int cls = __builtin_amdgcn_readfirstlane(tb.tcls[u.pm]); int ea, eb; moe_pair(cls, ea, eb); const int e = u.pn < 4 ? ea : eb;
        return W1 + (((size_t)e * 1024 + (u.pn & 3) * 256) * D + (size_t)t * 64) * 2;
    }
};
struct EpiGateUp { static constexpr int SID = 3;
    static constexpr bool PERM = true; static constexpr int NSTORES = 16;
    GAS bf16_t* ACT; const GAS int* perm; const GAS float* RW; MoeTab tb;
    __device__ __forceinline__ void operator()(const f32x4 (&acc)[2][2][4][2], const pg8::Unit& u, int wr, int wc, int fr, int fq) const {
        const int cls = __builtin_amdgcn_readfirstlane(tb.tcls[u.pm]), tr = __builtin_amdgcn_readfirstlane(tb.trow[u.pm]), n = __builtin_amdgcn_readfirstlane(tb.ccnt[cls]);
        const GAS int* pp = perm + (size_t)cls * MTOT + tr;
        const int wsel = u.pn >> 2, colb = wsel * 512 + (u.pn & 3) * 128 + wc * 32 + 8 * fq;
        int frx = fr; asm volatile("" : "+v"(frx));
        const int rbase = wr * 64 + frx;
        int tok[8]; float wgt[8];
#pragma unroll
        for (int i = 0; i < 8; ++i) { const int rr = (i >> 2) * 128 + (i & 3) * 16 + rbase; const int rc = rr < n - tr ? rr : n - tr - 1; tok[i] = pp[rc]; }
#pragma unroll
        for (int i = 0; i < 8; ++i) { const float w_ = RW[(size_t)tok[i] * 2 + wsel]; wgt[i] = w_; }
#pragma unroll
        for (int i = 0; i < 8; ++i) { const int rr = (i >> 2) * 128 + (i & 3) * 16 + rbase; if (!(tr + rr < n)) wgt[i] = 0.f; }
#pragma unroll
        for (int ai = 0; ai < 2; ++ai)
#pragma unroll
            for (int m = 0; m < 4; ++m) { const int rr = ai * 128 + m * 16 + rbase; const float wg = wgt[ai * 4 + m];
                float a[8];
#pragma unroll
                for (int nn = 0; nn < 2; ++nn)
#pragma unroll
                    for (int j = 0; j < 4; ++j) { const float g = acc[ai][0][m][nn][j], uu = acc[ai][1][m][nn][j];
                        a[nn * 4 + j] = g * __builtin_amdgcn_rcpf(1.0f + __builtin_amdgcn_exp2f(-g * LOG2E)) * uu * wg; }
                u32x4 w; w.x = pk2(a[0], a[1]); w.y = pk2(a[2], a[3]); w.z = pk2(a[4], a[5]); w.w = pk2(a[6], a[7]);
                *(GAS u32x4*)(ACT + (size_t)(u.pm * 256 + rr) * D + colb) = w; }
    }
};
struct ProbDown {
    static constexpr bool GATHER = false;
    const GAS char* A; const GAS char* W2; int K, ldb; size_t hstepA, hstepB; pg8::Order ord; MoeTab tb;
    __device__ __forceinline__ bool next(int i, pg8::Unit& u) const { return ord.next(i, u); }
    template <int NH> __device__ __forceinline__ void a_off(const pg8::Unit& u, int tid, unsigned (&v)[NH][2]) const {
        int R0, C0, R1, C1; pg8::stage_rc(tid * 16, R0, C0); pg8::stage_rc(tid * 16 + 8192, R1, C1);
        v[0][0] = (unsigned)((u.pm * 256 + R0) * D + C0) * 2u; v[0][1] = (unsigned)((u.pm * 256 + R1) * D + C1) * 2u;
    }
    __device__ __forceinline__ const GAS char* b_tile(const pg8::Unit& u, int t) const {
        const int cls = __builtin_amdgcn_readfirstlane(tb.tcls[u.pm]); int ea, eb; moe_pair(cls, ea, eb); const int e = t < 8 ? ea : eb;
        return W2 + (((size_t)e * 1024 + u.pn * 256) * DEXP + (size_t)(t & 7) * 64) * 2;
    }
};
template <bool LAST> struct EpiDown { static constexpr int SID = 4;
    static constexpr bool PERM = true; static constexpr int NSTORES = 0;
    GAS bf16_t* XB; GAS float* out; const GAS float* gate; const GAS int* perm; MoeTab tb;
    __device__ __forceinline__ void operator()(const f32x4 (&acc)[2][2][4][2], const pg8::Unit& u, int wr, int wc, int fr, int fq) const {
        const int cls = __builtin_amdgcn_readfirstlane(tb.tcls[u.pm]), tr = __builtin_amdgcn_readfirstlane(tb.trow[u.pm]), n = __builtin_amdgcn_readfirstlane(tb.ccnt[cls]);
        const GAS int* pp = perm + (size_t)cls * MTOT + tr;
        const int col0 = u.pn * 256 + wc * 32 + 8 * fq;
        int frx = fr; asm volatile("" : "+v"(frx));
        const int rbase = wr * 64 + frx;
        int tok8[8];
#pragma unroll
        for (int i = 0; i < 8; ++i) { const int rr = (i >> 2) * 128 + (i & 3) * 16 + rbase; const int rc = rr < n - tr ? rr : n - tr - 1; tok8[i] = pp[rc]; }
        u32x4 wv[4][2]; f32x4 gv[2][2][2];
        auto load_res = [&](int i) { const GAS bf16_t* xr = XB + (size_t)tok8[i] * D + col0; wv[i & 3][0] = *(const GAS u32x4*)xr; wv[i & 3][1] = *(const GAS u32x4*)(xr + 128); };
#pragma unroll
        for (int i = 0; i < 4; ++i) load_res(i);
        auto load_gate = [&](int i, f32x4 (&g)[2][2]) { const int tok = tok8[i]; const int b = tok < NLAT ? (tok >> 11) : 32; const GAS float* gp = gate + (size_t)b * ADA + col0;
#pragma unroll
            for (int bj = 0; bj < 2; ++bj) { g[bj][0] = *(const GAS f32x4*)(gp + bj * 128); g[bj][1] = *(const GAS f32x4*)(gp + bj * 128 + 4); } };
        load_gate(0, gv[0]);
#pragma unroll
        for (int i = 0; i < 8; ++i) { const int ai = i >> 2, m = i & 3;
            if (i + 1 < 8) load_gate(i + 1, gv[(i + 1) & 1]);
            __builtin_amdgcn_sched_barrier(0);
            const int rr = ai * 128 + m * 16 + rbase; const bool valid = tr + rr < n; const int tok = tok8[i];
#pragma unroll
            for (int bj = 0; bj < 2; ++bj) { const u32x4 w = wv[i & 3][bj];
                const f32x4 x0 = (f32x4){bflo(w.x), bfhi(w.x), bflo(w.y), bfhi(w.y)} + gv[i & 1][bj][0] * acc[ai][bj][m][0], x1 = (f32x4){bflo(w.z), bfhi(w.z), bflo(w.w), bfhi(w.w)} + gv[i & 1][bj][1] * acc[ai][bj][m][1];
                if (valid) {
                    if (LAST) { GAS float* op = out + (size_t)tok * D + col0 + bj * 128; *(GAS f32x4*)op = x0; *(GAS f32x4*)(op + 4) = x1; }
                    else { u32x4 o; o.x = pk2(x0[0], x0[1]); o.y = pk2(x0[2], x0[3]); o.z = pk2(x1[0], x1[1]); o.w = pk2(x1[2], x1[3]); *(GAS u32x4*)(XB + (size_t)tok * D + col0 + bj * 128) = o; } } }
            __builtin_amdgcn_sched_barrier(0);
            if (i + 4 < 8) load_res(i + 4);
        }
    }
};

constexpr int NPHASE = 1 + 8 * DEPTH;
__global__ void __launch_bounds__(NWAVES * 64, 2) mk_fwd(Args args) {
    extern __shared__ __attribute__((aligned(16))) unsigned char lds_raw[];
    Frame F;
    F.lds = (LAS unsigned char*)lds_raw;
    volatile LAS unsigned* MISC = (volatile LAS unsigned*)(F.lds + MISC_OFF);
    F.tid = threadIdx.x; F.lane = F.tid & 63; F.wave = __builtin_amdgcn_readfirstlane(F.tid >> 6); F.G = gridDim.x; F.bx = blockIdx.x;
    const bool t0 = F.tid == 0;
    F.ws = (GAS unsigned char*)args.ws; F.out = (GAS float*)args.out; F.ka = (kptr_t)__builtin_amdgcn_kernarg_segment_ptr();
    for (int u = F.tid; u < (LDS_BYTES - MISC_OFF) / 4; u += NWAVES * 64) ((LAS unsigned*)(F.lds + MISC_OFF))[u] = 0u;
    __syncthreads();
    XcdBarrier bar; bar.bar = (unsigned*)(CTL(F) + CW_BAR); bar.x = 0; bar.st = nullptr;
    if (args.use_bar) bar = xcd_barrier_post((unsigned*)(CTL(F) + CW_BAR), MISC + 8, t0);
    const int lo = args.ph_lo, hi = args.ph_hi;
#define IN(k) (lo <= (k) && (k) < hi)
#ifndef MK_BAR_REP
#define MK_BAR_REP 1
#endif
#ifdef MK_GSTAMP
#define GS_FLUSH() do { if (F.tid == MK_GSTAMP_TID) { LAS unsigned* m_ = (LAS unsigned*)(F.lds + MISC_OFF); const unsigned a_ = m_[16], n_ = m_[17]; unsigned z_ = 0; asm volatile("" : "+v"(z_)); m_[16] = z_; m_[17] = z_; \
    if (n_) { __hip_atomic_fetch_add(CTL(F) + 2048, a_, __ATOMIC_RELAXED, __HIP_MEMORY_SCOPE_AGENT); __hip_atomic_fetch_add(CTL(F) + 2049, n_, __ATOMIC_RELAXED, __HIP_MEMORY_SCOPE_AGENT); } } } while (0)
#else
#define GS_FLUSH() do {} while (0)
#endif
#define SEAM(k) do { GS_FLUSH(); if (IN(k) && IN((k) + 1)) { for (int br_ = 0; br_ < MK_BAR_REP; ++br_) { refresh(F); xcd_barrier(bar, F.tid == 0); } } } while (0)
#ifndef MK_PHMASK
#define MK_PHMASK 0x1ff
#endif
#define EN(k) ((MK_PHMASK >> (k)) & 1)
#ifndef MK_SEPARATE_QKPREP
#define MK_SEPARATE_QKPREP 0
#endif
#ifndef MK_DOUBLE
#define MK_DOUBLE -1
#endif
#define REP(k) for (int rep_ = 0; rep_ < ((MK_DOUBLE == (k)) ? 2 : 1); ++rep_)
#define XB_P ((GAS bf16_t*)(F.ws + WS_XB))
#define MOD_P ((const GAS float*)(F.ws + WS_MOD))
    if (EN(0) && IN(0)) { REP(0) prologue_phase(F); SEAM(0); }
    for (int L0 = 0; L0 < DEPTH; ++L0) {
        const int pb = 1 + 8 * L0;
        if (EN(1) && IN(pb + 0)) { int L = L0; OPAQUE_S(L); refresh(F);
            REP(1) norm_phase<false>(F, L, MTOT, L == 0, INP(6) + L * D, 0, 1024); SEAM(pb + 0); }
        if (EN(2) && IN(pb + 1)) { int L = L0; OPAQUE_S(L); refresh(F);
            ProbPlain P; P.A = (const GAS char*)(F.ws + WS_H); P.Bt = (const GAS char*)(F.ws + WS_WIN) + (size_t)L * DIN * D * 2; P.K = D; P.lda = D; P.ldb = D; P.hstepA = (size_t)128 * D * 2; P.hstepB = (size_t)128 * D * 2; P.ord.init(MTOT / 256, DIN / 256, F.G, F.bx);
            EpiQK E; E.U = (GAS bf16_t*)(F.ws + WS_U); E.tab = (const GAS float*)(F.ws + WS_TAB); E.gwin = INP(9) + L * 128; E.gna = INP(10) + L * 128; E.gdiff = INP(11) + L * 64; E.ggqa = INP(12) + L * 128;
            E.X = (LAS float*)(F.lds + MOE_OFF);
            E.vscale = 1.0f;
            REP(2) pg8::gemm_phase<EpiQK, ProbPlain>(F.lds, P, E, F.tid);
            SEAM(pb + 1);
        }
        if (MK_SEPARATE_QKPREP && EN(3) && IN(pb + 2)) { REP(3) qkprep_phase(F, L0, (MK_DOUBLE != 3) || rep_ == 1 || args.pad != 0); SEAM(pb + 2); }
        if (EN(4) && IN(pb + 3)) { REP(4) attn_phase(F, L0, L0 < DEPTH - 1); SEAM(pb + 3); }
        if (EN(5) && IN(pb + 4)) { int L = L0; OPAQUE_S(L); refresh(F);
            const int M2 = L < DEPTH - 1 ? MTOT : NLAT;
            ProbPlain P; P.A = (const GAS char*)(F.ws + WS_Y); P.Bt = (const GAS char*)(F.ws + WS_WOUT) + (size_t)L * D * D * 2; P.K = D; P.lda = D; P.ldb = D; P.hstepA = (size_t)128 * D * 2; P.hstepB = (size_t)128 * D * 2; P.ord.init(M2 / 256, D / 256, F.G, F.bx);
            EpiResid E; E.slat = INP(0); E.sctx = INP(2); E.XB = XB_P; E.first = L == 0; E.gate = MOD_P + (size_t)L * 33 * ADA + 2 * 1024;
#ifdef MK_PROBE_K2
            P.K = 2 * D; E.ascale = 0.5f;
#else
            E.ascale = 1.0f;
#endif
            pg8::gemm_phase<EpiResid, ProbPlain>(F.lds, P, E, F.tid);
            SEAM(pb + 4);
        }
        if (EN(6) && IN(pb + 5)) { int L = L0; OPAQUE_S(L); refresh(F);
#ifdef MK_OLD_NORM2
            REP(6) norm_phase<true>(F, L, L < DEPTH - 1 ? MTOT : NLAT, false, INP(7) + L * D, 3 * 1024, 4 * 1024, (MK_DOUBLE != 6) || rep_ == 1 || args.pad != 0); SEAM(pb + 5); }
#else
            norm2_phase(F, L, L < DEPTH - 1 ? MTOT : NLAT); SEAM(pb + 5); }
#endif
        if (EN(7) && IN(pb + 6)) { int L = L0; OPAQUE_S(L); refresh(F);
            const int T = moe_build_tables(F, L);
            MoeTab tb; tb.tcls = (const LAS int*)(F.lds + MOE_OFF); tb.trow = tb.tcls + 320; tb.ccnt = tb.trow + 320;
            ProbGateUp P; P.A = (const GAS char*)(F.ws + WS_H); P.W1 = (const GAS char*)(F.ws + WS_W1) + (size_t)L * NEXP * 1024 * D * 2; P.perm = (const GAS int*)(F.ws + WS_PERM); P.K = D; P.ldb = D; P.hstepA = 0; P.hstepB = (size_t)128 * D * 2; P.ord.init(T, 8, F.G, F.bx); P.tb = tb;
            EpiGateUp E; E.ACT = (GAS bf16_t*)(F.ws + WS_ACT); E.perm = P.perm; E.RW = (const GAS float*)(F.ws + WS_RW); E.tb = tb;
            REP(7) pg8::gemm_phase<EpiGateUp, ProbGateUp>(F.lds, P, E, F.tid);
            SEAM(pb + 6);
        }
        if (EN(8) && IN(pb + 7)) { int L = L0; OPAQUE_S(L); refresh(F);
            const int T = moe_build_tables(F, L);
            MoeTab tb; tb.tcls = (const LAS int*)(F.lds + MOE_OFF); tb.trow = tb.tcls + 320; tb.ccnt = tb.trow + 320;
            ProbDown P; P.A = (const GAS char*)(F.ws + WS_ACT); P.W2 = (const GAS char*)(F.ws + WS_W2) + (size_t)L * NEXP * 1024 * DEXP * 2; P.K = D; P.ldb = DEXP; P.hstepA = (size_t)128 * D * 2; P.hstepB = (size_t)128 * DEXP * 2; P.ord.init(T, 4, F.G, F.bx); P.tb = tb;
            if (L < DEPTH - 1) { EpiDown<false> E; E.XB = XB_P; E.out = F.out; E.gate = MOD_P + (size_t)L * 33 * ADA + 5 * 1024; E.perm = (const GAS int*)(F.ws + WS_PERM); E.tb = tb;
                pg8::gemm_phase<EpiDown<false>, ProbDown>(F.lds, P, E, F.tid); }
            else { EpiDown<true> E; E.XB = XB_P; E.out = F.out; E.gate = MOD_P + (size_t)L * 33 * ADA + 5 * 1024; E.perm = (const GAS int*)(F.ws + WS_PERM); E.tb = tb;
                pg8::gemm_phase<EpiDown<true>, ProbDown>(F.lds, P, E, F.tid); }
            SEAM(pb + 7);
        }
    }
#if defined(MK_STAMP) || defined(MK_GSTAMP)
    {
        refresh(F); xcd_barrier(bar, F.tid == 0); refresh(F);
        const unsigned num = __hip_atomic_load(CTL(F) + 2048, __ATOMIC_RELAXED, __HIP_MEMORY_SCOPE_AGENT), den = __hip_atomic_load(CTL(F) + 2049, __ATOMIC_RELAXED, __HIP_MEMORY_SCOPE_AGENT);
        const float smul = 1.0f + floorf(((float)num / (float)(den ? den : 1u)) * (1.0f / MK_STAMP_Q)) * 0.02f;
        GAS f32x4* o4 = (GAS f32x4*)F.out;
        for (size_t i = (size_t)F.bx * 512 + F.tid; i < (size_t)NLAT * D / 4; i += (size_t)F.G * 512) o4[i] = o4[i] * smul;
    }
#endif
#undef IN
#undef SEAM
}

#ifndef MK_PER_PHASE
#define MK_PER_PHASE 0
#endif
extern "C" void kernel_launch(void* const* d_in, const int* in_sizes, int n_in, void* d_out, int out_size, void* d_ws, size_t ws_size, hipStream_t stream) {
    static int grid = 0;
    if (grid == 0) {
        if (n_in != 23 || out_size != NLAT * D || ws_size < WS_END) { fprintf(stderr, "kernel_launch: unexpected shapes (n_in %d out %d ws %zu)\n", n_in, out_size, ws_size); grid = -1; return; }
        int dev = 0, cus = 0, per_cu = 0;
        if (hipGetDevice(&dev) != hipSuccess || hipDeviceGetAttribute(&cus, hipDeviceAttributeMultiprocessorCount, dev) != hipSuccess) { grid = -1; return; }
        if (hipFuncSetAttribute((const void*)mk_fwd, hipFuncAttributeMaxDynamicSharedMemorySize, LDS_BYTES) != hipSuccess) { fprintf(stderr, "kernel_launch: hipFuncSetAttribute failed\n"); grid = -1; return; }
        if (hipOccupancyMaxActiveBlocksPerMultiprocessor(&per_cu, (const void*)mk_fwd, NWAVES * 64, LDS_BYTES) != hipSuccess || per_cu < 1) fprintf(stderr, "kernel_launch: occupancy query reports %d\n", per_cu);
        (void)hipGetLastError();
        grid = cus;
    }
    if (grid < 0) return;
    (void)hipMemsetAsync((char*)d_ws + WS_CTL, 0, CTL_ZERO_BYTES, stream);
    Args a{};
    for (int i = 0; i < 23; ++i) a.in[i] = (const float*)d_in[i];
    a.out = (float*)d_out; a.ws = (unsigned char*)d_ws; a.pad = 0;
#if MK_PER_PHASE
    for (int p = 0; p < NPHASE; ++p) { a.ph_lo = p; a.ph_hi = p + 1; a.use_bar = 0; hipLaunchKernelGGL(mk_fwd, dim3(grid), dim3(NWAVES * 64), LDS_BYTES, stream, a); }
#else
    a.ph_lo = 0; a.ph_hi = NPHASE; a.use_bar = 1;
    hipLaunchKernelGGL(mk_fwd, dim3(grid), dim3(NWAVES * 64), LDS_BYTES, stream, a);
#endif
}
```

```cpp
#include <hip/hip_runtime.h>
#include <cstdio>
#include <cstdint>
#define GAS __attribute__((address_space(1)))
#define MK_ILV 15
#define XB_TMO      128
#define XB_XCNT(j)  (256  + 64 * (j))
#define XB_XSUB(j)  (1280 + 64 * (j))
#define XB_XGEN(j)  (2304 + 64 * (j))
#define XB_TOP      3328
#define XB_TOPGEN   3392
#define XCD_BAR_WORDS 3456
#define XB_SPIN_CAP (1u << 18)
#define LAS __attribute__((address_space(3)))

__device__ __forceinline__ unsigned xb_ld(unsigned* p)              { return __hip_atomic_load(p, __ATOMIC_RELAXED, __HIP_MEMORY_SCOPE_AGENT); }
__device__ __forceinline__ unsigned xb_add(unsigned* p, unsigned v) { return __hip_atomic_fetch_add(p, v, __ATOMIC_RELAXED, __HIP_MEMORY_SCOPE_AGENT); }
__device__ __forceinline__ unsigned xb_xcc_id() { return (unsigned)__builtin_amdgcn_s_getreg((3 << 11) | 20) & 0xFu; }
#define XB_SPIN(cond, bar) do { unsigned _sp = 0; while (cond) { __builtin_amdgcn_s_sleep(1); \
    if ((++_sp & 255u) == 0u) { if (xb_ld(&(bar)[XB_TMO])) break; if (_sp > XB_SPIN_CAP) { atomicAdd(&(bar)[XB_TMO], 1u); break; } } } } while (0)

struct XcdBarrier {
    unsigned* bar; unsigned x;
    volatile LAS unsigned* st;
};

__device__ __forceinline__ XcdBarrier xcd_barrier_post(unsigned* bar, volatile LAS unsigned* st, bool t0  ) {
    XcdBarrier b; b.bar = bar; b.x = xb_xcc_id(); b.st = st;
    if (t0) (void)xb_add(&bar[XB_XCNT(b.x)], 1u);
    return b;
}
__device__ __forceinline__ void xcd_barrier_complete(unsigned* bar, unsigned x, unsigned& nloc, unsigned& nx) {
    const unsigned G = gridDim.x * gridDim.y * gridDim.z;
    unsigned sum, cnt, mine, sp = 0u;
    for (;;) {
        sum = 0u; cnt = 0u; mine = 0u;
#pragma unroll
        for (unsigned j = 0; j < 16; ++j) { const unsigned c = xb_ld(&bar[XB_XCNT(j)]); sum += c; cnt += (c > 0u) ? 1u : 0u; mine = (j == x) ? c : mine; }
        if (sum == G) break;
        __builtin_amdgcn_s_sleep(1);
        if ((++sp & 255u) == 0u) { if (xb_ld(&bar[XB_TMO])) break; if (sp > XB_SPIN_CAP) { atomicAdd(&bar[XB_TMO], 1u); break; } }
    }
    nloc = mine > 0u ? mine : 1u; nx = cnt > 0u ? cnt : 1u;
}

__device__ __forceinline__ void xcd_barrier(const XcdBarrier& b, bool t0  ) {
    asm volatile("s_waitcnt vmcnt(0)" ::: "memory");
    __syncthreads();
    if (t0) {
        unsigned* bar = b.bar;
        __builtin_amdgcn_s_waitcnt(0);
        unsigned nloc = b.st[0], nx = b.st[1];
        if (nloc == 0u) { xcd_barrier_complete(bar, b.x, nloc, nx); b.st[0] = nloc; b.st[1] = nx; }
        const unsigned old = xb_add(&bar[XB_XSUB(b.x)], 1u);
        const unsigned gen = old / nloc;
        if (old + 1u == (gen + 1u) * nloc) {
            __builtin_amdgcn_fence(__ATOMIC_RELEASE, "agent");
            asm volatile("s_waitcnt vmcnt(0)" ::: "memory");
            const unsigned og = xb_add(&bar[XB_TOP], 1u);
            const unsigned tg = og / nx;
            if (og + 1u == (tg + 1u) * nx) xb_add(&bar[XB_TOPGEN], 1u);
            else XB_SPIN(xb_ld(&bar[XB_TOPGEN]) == tg, bar);
            __builtin_amdgcn_fence(__ATOMIC_ACQUIRE, "agent");
            xb_add(&bar[XB_XGEN(b.x)], 1u);
            asm volatile("s_waitcnt vmcnt(0)" ::: "memory");
        } else {
            XB_SPIN(xb_ld(&bar[XB_XGEN(b.x)]) == gen, bar);
            __builtin_amdgcn_fence(__ATOMIC_ACQUIRE, "agent");
            asm volatile("s_waitcnt vmcnt(0)" ::: "memory");
        }
    }
    __syncthreads();
}
constexpr int D = 1024, NBATCH = 32, SEQ = 2048, DEPTH = 4, CTXL = 256, NLAT = NBATCH * SEQ, NCTX = NBATCH * CTXL, MTOT = NLAT + NCTX, DIN = 2560;
constexpr int NEXP = 16, DEXP = 512, NCLS = 24, ADA = 6 * D;
constexpr float EPS = 1e-6f, LOG2E = 1.4426950408889634f;
constexpr int QA = 0, KA = 256, VA = 384, QB = 512, KB = 768, VB = 1024, QC = 1280, KC = 1536, VC = 1792, QD = 2048, KD = 2304, VD = 2432;
constexpr size_t MiB = 1u << 20;
constexpr size_t WS_CTL = 0, CTL_ZERO_BYTES = 128 * 1024;
constexpr size_t WS_MOD = 1 * MiB;
constexpr size_t WS_TAB = 4 * MiB + 256 * 1024;
constexpr size_t WS_RW = 4 * MiB + 320 * 1024;
constexpr size_t WS_PERM = 5 * MiB;
constexpr size_t WS_WIN = 12 * MiB;
constexpr size_t WS_WOUT = 32 * MiB;
constexpr size_t WS_W1 = 40 * MiB;
constexpr size_t WS_W2 = 168 * MiB;
constexpr size_t WS_XB = 232 * MiB;
constexpr size_t WS_Y = 376 * MiB;
constexpr size_t WS_U = 520 * MiB;
constexpr size_t WS_ACT = WS_U;
constexpr size_t WS_H = 880 * MiB;
constexpr size_t WS_END = 1024 * MiB;
static_assert(WS_MOD + (size_t)DEPTH * 33 * 6144 * 4 <= WS_TAB && WS_RW + (size_t)MTOT * 8 <= WS_PERM && WS_PERM + (size_t)NCLS * MTOT * 4 <= WS_WIN, "ws map");
constexpr int CW_BAR = 4096;
constexpr int CW_CNT = 16384;
static_assert((CW_CNT + DEPTH * NCLS * 64) * 4 <= (int)CTL_ZERO_BYTES && (CW_BAR + 3456) <= CW_CNT, "ctl");
constexpr int TAB_T64 = 0;
constexpr int TAB_T32 = 2048;
constexpr int TAB_LAM = 3072;
constexpr int NWAVES = 8;
constexpr int LDS_BYTES = 159744;
constexpr int RING_BYTES = 131072;
constexpr int MOE_OFF = 131072;
constexpr int NRM_OFF = 134144;
constexpr int MISC_OFF = 155648;
constexpr int AT_BUFB = 70656, AT_VOFF = 33792, AT_RPB = 141312, AT_GSS = 148992;

typedef unsigned short bf16_t;
typedef short bf16x8 __attribute__((ext_vector_type(8)));
typedef short s16x4 __attribute__((ext_vector_type(4)));
typedef float f32x4 __attribute__((ext_vector_type(4)));
typedef float f32x2 __attribute__((ext_vector_type(2)));
typedef float f32x16 __attribute__((ext_vector_type(16)));
typedef unsigned u32x4 __attribute__((ext_vector_type(4)));
typedef unsigned u32x2 __attribute__((ext_vector_type(2)));
typedef __bf16 bf16x2_t __attribute__((ext_vector_type(2)));

__device__ __forceinline__ unsigned pk2(float lo, float hi) { f32x2 v = {lo, hi}; bf16x2_t b = __builtin_convertvector(v, bf16x2_t); return __builtin_bit_cast(unsigned, b); }
__device__ __forceinline__ float bflo(unsigned w) { return __uint_as_float(w << 16); }
__device__ __forceinline__ float bfhi(unsigned w) { return __uint_as_float(w & 0xffff0000u); }
__device__ __forceinline__ float sx(float v, int lane, int m) { return __int_as_float(__builtin_amdgcn_ds_bpermute((lane ^ m) << 2, __float_as_int(v))); }
__device__ __forceinline__ float x32_sum(float v) { auto rr = __builtin_amdgcn_permlane32_swap(__float_as_uint(v), __float_as_uint(v), false, false); return __uint_as_float(rr[0]) + __uint_as_float(rr[1]); }
__device__ __forceinline__ float x32_max(float v) { auto rr = __builtin_amdgcn_permlane32_swap(__float_as_uint(v), __float_as_uint(v), false, false); return fmaxf(__uint_as_float(rr[0]), __uint_as_float(rr[1])); }
__device__ __forceinline__ float swap32(float v, bool upper_half) { auto rr = __builtin_amdgcn_permlane32_swap(__float_as_uint(v), __float_as_uint(v), false, false); return __uint_as_float(upper_half ? rr[0] : rr[1]); }
__device__ __forceinline__ float wave_sum(float v, int lane) {
#pragma unroll
    for (int o = 1; o < 32; o <<= 1) v += sx(v, lane, o);
    return x32_sum(v);
}
#define LDS_WAIT() asm volatile("s_waitcnt lgkmcnt(0)" ::: "memory")
#define WG_BAR() asm volatile("s_waitcnt lgkmcnt(0)\n\ts_barrier" ::: "memory")

struct Args { const float* in[23]; float* out; unsigned char* ws; int ph_lo, ph_hi, use_bar, pad; };
typedef __attribute__((address_space(4))) const unsigned char* kptr_t;
struct Frame {
    LAS unsigned char* lds;
    GAS unsigned char* ws;
    GAS float* out;
    kptr_t ka;
    int tid, lane, wave, G, bx;
};
#define FARGS Frame& F
typedef const GAS float* cfp_t;
__device__ __forceinline__ const GAS float* inp(const Frame& F, int i) { return *(__attribute__((address_space(4))) const cfp_t*)(F.ka + 8 * i); }
#define INP(i) inp(F, (i))
#define CTL(F) ((GAS unsigned*)((F).ws + WS_CTL))
__device__ __forceinline__ void refresh(Frame& F) {
    unsigned z = 0u; asm volatile("" : "+v"(z));
    const int ln = (int)__builtin_amdgcn_mbcnt_hi(~0u, __builtin_amdgcn_mbcnt_lo(~0u, z));
    F.lane = ln; F.tid = F.wave * 64 + ln;
    asm volatile("" : "+s"(F.ws)); asm volatile("" : "+s"(F.out)); asm volatile("" : "+s"(F.ka));
}
#define OPAQUE_S(x) asm volatile("" : "+s"(x))
namespace pg8 {
#define PG8_LAS __attribute__((address_space(3)))
#define PG8_GAS __attribute__((address_space(1)))
typedef unsigned short bf16_t;
typedef short bf16x8 __attribute__((ext_vector_type(8)));
typedef float f32x4 __attribute__((ext_vector_type(4)));
typedef unsigned u32x4 __attribute__((ext_vector_type(4)));
#ifndef MK_WGM
#define MK_WGM 8
#endif
constexpr int BM = 256, BK = 64, HALF = 128, HTB = HALF * BK * 2, STAGE_BYTES = 8 * HTB, NXCD = 8, WGM = MK_WGM;

__host__ __device__ __forceinline__ int lds_byte(int r, int c) { const int st = (r >> 4) * 2 + (c >> 5), rr = r & 15, cc = c & 31, ob = rr * 64 + cc * 2; return st * 1024 + (ob ^ (((ob >> 9) & 1) << 5)); }
__host__ __device__ __forceinline__ void stage_rc(int b, int& R, int& C) { const int st = b / 1024, sb = b % 1024, swz = sb ^ (((sb >> 9) & 1) << 5); R = (st >> 1) * 16 + swz / 64; C = (st & 1) * 32 + (swz % 64) / 2; }
__host__ __device__ __forceinline__ int perm32(int rho) { const int n = rho >> 4, i = rho & 15; return 8 * (i >> 2) + 4 * n + (i & 3); }

struct Unit { int pm, pn; };

struct Order {
    int nM, nN, nwg, G, c;
    __device__ __forceinline__ void init(int nM_, int nN_, int G_, int c_) { nM = nM_; nN = nN_; nwg = nM * nN; G = G_; c = c_; }
    __device__ __forceinline__ bool next(int i, Unit& u) const {
        const long L = (long)i * G + c; if (L >= nwg) return false;
        int wgid = (int)L; { const int q = nwg / NXCD, r = nwg % NXCD, xcd = wgid % NXCD, off = wgid / NXCD; wgid = (xcd < r ? xcd * (q + 1) : r * (q + 1) + (xcd - r) * q) + off; }
        const int nig = WGM * nN, gid = wgid / nig, fm = gid * WGM, gsz = (nM - fm) < WGM ? (nM - fm) : WGM;
        u.pm = __builtin_amdgcn_readfirstlane(fm + ((wgid % nig) % gsz)); u.pn = __builtin_amdgcn_readfirstlane((wgid % nig) / gsz); return true;
    }
};

__device__ __forceinline__ unsigned cvt_pk_bf16(float lo, float hi) { unsigned r; asm volatile("v_cvt_pk_bf16_f32 %0, %1, %2" : "=v"(r) : "v"(lo), "v"(hi)); return r; }

template <class Epi, class Prob>
__device__ __forceinline__ void gemm_phase(PG8_LAS unsigned char* lds, const Prob& P, const Epi& E, int tid) {
    const int wid = __builtin_amdgcn_readfirstlane(tid >> 6), lane = tid & 63, wr = wid >> 2, wc = wid & 3, fr = lane & 15, fq = lane >> 4;
    const int nt = P.K / BK;
#ifndef MK_EPISTAG
#define MK_EPISTAG 0
#endif
#ifndef MK_EPISTAG_CYC
#define MK_EPISTAG_CYC 50000
#endif
    if (MK_EPISTAG) {
        const int nwg_ = P.ord.nwg, G_ = P.ord.G, c_ = P.ord.c, cmax = (nwg_ + G_ - 1) / G_, cnt = c_ < nwg_ ? (nwg_ - c_ + G_ - 1) / G_ : 0, nfull = nwg_ - (cmax - 1) * G_;
        if (cnt < cmax && cnt > 0) {
            const int nslack = G_ - nfull, parts = nslack >= 3 * nfull ? 3 : (nslack >= nfull ? 1 : 0);
            if (parts > 0) {
                const unsigned delay = (unsigned)(MK_EPISTAG_CYC / (parts + 1)) * (unsigned)(1 + (c_ - nfull) % parts);
                const unsigned t0_ = (unsigned)__builtin_amdgcn_s_memtime();
                while ((unsigned)__builtin_amdgcn_s_memtime() - t0_ < delay) __builtin_amdgcn_s_sleep(16);
            }
        }
    }
    unsigned voffB[2];
    { int R0, C0, R1, C1; stage_rc(tid * 16, R0, C0); stage_rc(tid * 16 + 8192, R1, C1); const int Rb0 = Epi::PERM ? ((R0 & ~31) + perm32(R0 & 31)) : R0, Rb1 = Epi::PERM ? ((R1 & ~31) + perm32(R1 & 31)) : R1;
      voffB[0] = (unsigned)(Rb0 * P.ldb + C0) * 2u; voffB[1] = (unsigned)(Rb1 * P.ldb + C1) * 2u; }
    const size_t hstepB = P.hstepB;
    const unsigned ldsw = (unsigned)wid * 1024u;
    const int aoff = lds_byte(wr * 64 + fr, fq * 8), boff = lds_byte(wc * 32 + fr, fq * 8);
#define PG8_SA(b, h) (((b) * 2 + (h)) * HTB)
#define PG8_SB(b, h) ((4 + (b) * 2 + (h)) * HTB)
#define PG8_STAGE(bufoff, gbase, voff) do { _Pragma("unroll") for (int _i = 0; _i < 2; ++_i) \
        __builtin_amdgcn_global_load_lds((const PG8_GAS unsigned*)((const PG8_GAS char*)(gbase) + (voff)[_i]), (PG8_LAS unsigned*)(lds + (bufoff) + ldsw + _i * 8192), 16, 0, 0); } while (0)
#define PG8_LDA(dst, b, h) do { _Pragma("unroll") for (int m = 0; m < 4; ++m) _Pragma("unroll") for (int k = 0; k < 2; ++k) dst[m][k] = *(const PG8_LAS bf16x8*)(lds + PG8_SA(b, h) + aoff + m * 2048 + k * 1024); } while (0)
#define PG8_LDB(dst, b, h) do { _Pragma("unroll") for (int n = 0; n < 2; ++n) _Pragma("unroll") for (int k = 0; k < 2; ++k) dst[n][k] = *(const PG8_LAS bf16x8*)(lds + PG8_SB(b, h) + boff + n * 2048 + k * 1024); } while (0)
#define PG8_MMA(ai, bj, At, Bt) do { __builtin_amdgcn_s_setprio(1); _Pragma("unroll") for (int m = 0; m < 4; ++m) _Pragma("unroll") for (int n = 0; n < 2; ++n) _Pragma("unroll") for (int k = 0; k < 2; ++k) \
        acc[ai][bj][m][n] = __builtin_amdgcn_mfma_f32_16x16x32_bf16(Bt[n][k], At[m][k], acc[ai][bj][m][n], 0, 0, 0); __builtin_amdgcn_s_setprio(0); } while (0)
#define PG8_WAIT_V(n) asm volatile("s_waitcnt vmcnt(" #n ")" ::: "memory")
#define PG8_WAIT_L(n) asm volatile("s_waitcnt lgkmcnt(" #n ")" ::: "memory")
#define PG8_BAR __builtin_amdgcn_s_barrier()
#define PG8_SCHED __builtin_amdgcn_sched_barrier(0)
    Unit cur, nxt; int ui = 0;
    if (!P.next(0, cur)) return;
    float zf = 0.f; asm volatile("" : "+v"(zf));
    f32x4 acc[2][2][4][2];
#pragma unroll
    for (int a = 0; a < 2; ++a)
#pragma unroll
        for (int b = 0; b < 2; ++b)
#pragma unroll
            for (int m = 0; m < 4; ++m)
#pragma unroll
                for (int n = 0; n < 2; ++n) acc[a][b][m][n] = (f32x4){zf, zf, zf, zf};
    bf16x8 At[4][2], B0[2][2], B1[2][2];
    constexpr int NH = Prob::GATHER ? 2 : 1;
    unsigned voC[NH][2];
    P.template a_off<NH>(cur, tid, voC);
    const PG8_GAS char* const Ab = P.A;
    const size_t hstepA = Prob::GATHER ? (size_t)0 : P.hstepA;
#define PG8_STAGE_A(bufoff, h, kbyte, VO) PG8_STAGE(bufoff, Ab + (kbyte) + ((h) ? hstepA : (size_t)0), VO[Prob::GATHER ? (h) : 0])
    { const PG8_GAS char* b0 = P.b_tile(cur, 0); const PG8_GAS char* b1 = P.b_tile(cur, 1);
      PG8_STAGE(PG8_SB(0, 0), b0, voffB); PG8_STAGE(PG8_SB(0, 1), b0 + hstepB, voffB); PG8_STAGE_A(PG8_SA(0, 0), 0, (size_t)0, voC); PG8_STAGE_A(PG8_SA(0, 1), 1, (size_t)0, voC);
      if (wr == 1) PG8_BAR;
      PG8_WAIT_V(2); PG8_BAR;
      PG8_STAGE(PG8_SB(1, 0), b1, voffB); PG8_STAGE_A(PG8_SA(1, 0), 0, (size_t)128, voC); PG8_STAGE(PG8_SB(1, 1), b1 + hstepB, voffB);
      PG8_WAIT_V(6); PG8_BAR; }
#ifdef MK_GSTAMP
#define GSEG(k) do { if (Epi::SID == MK_GSTAMP) { __builtin_amdgcn_sched_barrier(0); const unsigned now_ = (unsigned)__builtin_amdgcn_s_memtime(); __builtin_amdgcn_sched_barrier(0); \
    if (tid == MK_GSTAMP_TID) { PG8_LAS unsigned* m_ = (PG8_LAS unsigned*)(lds + MISC_OFF); if ((k) == MK_GSTAMP_SEG || MK_GSTAMP_SEG == 9) m_[16] += now_ - m_[18]; m_[18] = now_; if ((k) == 2) m_[17] += 1; } } } while (0)
    if (Epi::SID == MK_GSTAMP) { const unsigned now_ = (unsigned)__builtin_amdgcn_s_memtime(); if (tid == MK_GSTAMP_TID) ((PG8_LAS unsigned*)(lds + MISC_OFF))[18] = now_; }
#else
#define GSEG(k) do {} while (0)
#endif
    for (;;) {
        const bool has_next = P.next(ui + 1, nxt);
        if (!has_next) nxt = cur;
        for (int t = 0; t < nt; t += 2) {
            const bool last = (t == nt - 2);
            const size_t k1 = (size_t)(t + 1) * 128, k2 = last ? (size_t)0 : (size_t)(t + 2) * 128, k3 = k2 + 128;
            const PG8_GAS char* b2 = last ? P.b_tile(nxt, 0) : P.b_tile(cur, t + 2);
            const PG8_GAS char* b3 = last ? P.b_tile(nxt, 1) : P.b_tile(cur, t + 3);
#ifndef MK_RELAX
#define MK_RELAX 0
#endif
            int fz_ = __builtin_amdgcn_readfirstlane((MK_RELAX && (t == 0) && (ui > 0)) ? 1 : 0); asm volatile("" : "+s"(fz_));
            const bool fresh = fz_ != 0;
#define PG8_WAIT_VR() do { if (fresh) { if constexpr (Epi::NSTORES == 32) PG8_WAIT_V(40); else if constexpr (Epi::NSTORES == 16) PG8_WAIT_V(24); else PG8_WAIT_V(8); } else PG8_WAIT_V(8); } while (0)
            PG8_LDB(B0, 0, 0); PG8_LDB(B1, 0, 1); PG8_SCHED; PG8_LDA(At, 0, 0); if (!fresh) PG8_STAGE_A(PG8_SA(1, 1), 1, k1, voC);
            PG8_WAIT_VR(); PG8_WAIT_L(0); PG8_BAR; PG8_MMA(0, 0, At, B0); PG8_MMA(0, 1, At, B1); PG8_BAR; PG8_SCHED;
            if (last) {
                P.template a_off<NH>(nxt, tid, voC);
            }
            PG8_LDA(At, 0, 1); PG8_STAGE(PG8_SB(0, 0), b2, voffB); PG8_STAGE(PG8_SB(0, 1), b2 + hstepB, voffB); PG8_STAGE_A(PG8_SA(0, 0), 0, k2, voC);
            PG8_WAIT_VR(); PG8_WAIT_L(0); PG8_BAR; PG8_MMA(1, 0, At, B0); PG8_MMA(1, 1, At, B1); PG8_BAR; PG8_SCHED;
            PG8_LDB(B0, 1, 0); PG8_LDB(B1, 1, 1); PG8_SCHED; PG8_LDA(At, 1, 0); PG8_STAGE_A(PG8_SA(0, 1), 1, k2, voC);
            PG8_WAIT_VR(); PG8_WAIT_L(0); PG8_BAR; PG8_MMA(0, 0, At, B0); PG8_MMA(0, 1, At, B1); PG8_BAR; PG8_SCHED;
            PG8_LDA(At, 1, 1); PG8_STAGE(PG8_SB(1, 0), b3, voffB); PG8_STAGE(PG8_SB(1, 1), b3 + hstepB, voffB); PG8_STAGE_A(PG8_SA(1, 0), 0, k3, voC);
            PG8_WAIT_V(8); PG8_WAIT_L(0); PG8_BAR; PG8_MMA(1, 0, At, B0); PG8_MMA(1, 1, At, B1); PG8_BAR; PG8_SCHED;
        }
        if (MK_RELAX) PG8_STAGE_A(PG8_SA(1, 1), 1, (size_t)128, voC);
#ifndef MK_ALIGN
#define MK_ALIGN 1
#endif
        GSEG(0);
        if (MK_ALIGN && wr == 0) PG8_BAR;
        { Unit eu = cur; asm volatile("" : "+s"(eu.pm), "+s"(eu.pn));
          GSEG(1);
          E(acc, eu, wr, wc, fr, fq); }
        GSEG(2);
        if (!has_next) break;
#pragma unroll
        for (int a = 0; a < 2; ++a)
#pragma unroll
            for (int b = 0; b < 2; ++b)
#pragma unroll
                for (int m = 0; m < 4; ++m)
#pragma unroll
                    for (int n = 0; n < 2; ++n) acc[a][b][m][n] = (f32x4){zf, zf, zf, zf};
        cur = nxt; ++ui;
        if (MK_ALIGN && wr == 1) PG8_BAR;
    }
    PG8_WAIT_V(0);
    if (!MK_ALIGN && wr == 0) PG8_BAR;
    PG8_BAR;
#undef PG8_SA
#undef PG8_SB
#undef PG8_STAGE
#undef PG8_STAGE_A
#undef PG8_WAIT_VR
#undef PG8_LDA
#undef PG8_LDB
#undef PG8_MMA
#undef PG8_WAIT_V
#undef PG8_WAIT_L
#undef PG8_BAR
#undef PG8_SCHED
}
}
__device__ __forceinline__ void transpose_item(const GAS float* W, int N, int k0, int n0, GAS bf16_t* dst, int ldd, const GAS float* kscale, LAS float* scr, int lane) {
    const int kq = lane >> 4, n4 = (lane & 15) * 4;
#pragma unroll
    for (int i = 0; i < 16; ++i) { const int kk = 4 * i + kq; f32x4 v = *(const GAS f32x4*)(W + (size_t)(k0 + kk) * N + n0 + n4); if (kscale) v = v * kscale[k0 + kk];
        LAS float* p = scr + kk * 65 + n4; p[0] = v.x; p[1] = v.y; p[2] = v.z; p[3] = v.w; }
    LDS_WAIT(); asm volatile("" ::: "memory");
    const int c = lane & 7;
#pragma unroll
    for (int j = 0; j < 8; ++j) { const int n = (lane >> 3) + 8 * j; const LAS float* s = scr + (8 * c) * 65 + n;
        u32x4 o; o.x = pk2(s[0 * 65], s[1 * 65]); o.y = pk2(s[2 * 65], s[3 * 65]); o.z = pk2(s[4 * 65], s[5 * 65]); o.w = pk2(s[6 * 65], s[7 * 65]);
        *(GAS u32x4*)(dst + (size_t)n * ldd + k0 + 8 * c) = o; }
    LDS_WAIT(); asm volatile("" ::: "memory");
}

__device__ __forceinline__ void ada_unit(FARGS, int unit) {
    const GAS float* c = INP(1); const GAS float* c_ctx = INP(3); const GAS float* ada_w = INP(4); const GAS float* ada_b = INP(5);
    GAS float* mod = (GAS float*)(F.ws + WS_MOD);
    LAS float* S = (LAS float*)F.lds;
    const int L = unit / 48, cb = unit % 48, tid = F.tid;
    for (int i = tid; i < 33 * 1024; i += 512) { const int r = i >> 10, k = i & 1023; const float v = (r < 32) ? c[r * 1024 + k] : c_ctx[k]; S[i] = v / (1.f + expf(-v)); }
    __syncthreads();
    const int cq = tid & 31, kg = tid >> 5;
    f32x4 acc[33];
#pragma unroll
    for (int r = 0; r < 33; ++r) acc[r] = (f32x4){0.f, 0.f, 0.f, 0.f};
    const GAS float* wp = ada_w + ((size_t)L * 1024 + kg * 64) * ADA + cb * 128 + 4 * cq;
#pragma unroll 2
    for (int k4 = 0; k4 < 16; ++k4) {
        const f32x4 w0 = *(const GAS f32x4*)(wp + (size_t)(k4 * 4 + 0) * ADA), w1 = *(const GAS f32x4*)(wp + (size_t)(k4 * 4 + 1) * ADA), w2 = *(const GAS f32x4*)(wp + (size_t)(k4 * 4 + 2) * ADA), w3 = *(const GAS f32x4*)(wp + (size_t)(k4 * 4 + 3) * ADA);
        const LAS f32x4* sp = (const LAS f32x4*)(S + kg * 64 + k4 * 4);
#pragma unroll
        for (int r = 0; r < 33; ++r) { const f32x4 s4 = sp[r * 256]; acc[r] = acc[r] + (w0 * s4.x + w1 * s4.y) + (w2 * s4.z + w3 * s4.w); }
    }
    __syncthreads();
    LAS float* R = S;
    { const int w = F.wave;
#pragma unroll
      for (int r = 0; r < 33; ++r) { f32x4 v; v.x = x32_sum(acc[r].x); v.y = x32_sum(acc[r].y); v.z = x32_sum(acc[r].z); v.w = x32_sum(acc[r].w);
          if (F.lane < 32) *(LAS f32x4*)(R + (w * 33 + r) * 128 + 4 * cq) = v; } }
    __syncthreads();
    for (int i = tid; i < 33 * 128; i += 512) { const int r = i >> 7, cc = i & 127, n = cb * 128 + cc;
        float v = 0.f;
#pragma unroll
        for (int w = 0; w < 8; ++w) v += R[(w * 33 + r) * 128 + cc];
        mod[((size_t)L * 33 + r) * ADA + n] = v + ada_b[L * ADA + n]; }
    __syncthreads();
}

__device__ __forceinline__ void tables_unit(FARGS) {
    GAS float* tab = (GAS float*)(F.ws + WS_TAB);
    const int tid = F.tid;
    for (int i = tid; i < 64 * 16; i += 512) { const int p = i >> 4, f = i & 15; const float inv = expf(-(float)f * (1.f / 16.f) * 9.210340371976184f); const float a = (float)p * inv; tab[TAB_T64 + 2 * i] = cosf(a); tab[TAB_T64 + 2 * i + 1] = sinf(a); }
    for (int i = tid; i < 64 * 8; i += 512) { const int p = i >> 3, f = i & 7; const float inv = expf(-(float)f * (1.f / 8.f) * 9.210340371976184f); const float a = (float)p * inv; tab[TAB_T32 + 2 * i] = cosf(a); tab[TAB_T32 + 2 * i + 1] = sinf(a); }
    if (tid < DEPTH) { const GAS float* lp = INP(15) + tid * 4 * 32; float s01 = 0.f, s23 = 0.f;
        for (int i = 0; i < 32; ++i) { s01 += lp[i] * lp[32 + i]; s23 += lp[64 + i] * lp[96 + i]; }
        const float li = 0.8f - 0.6f * expf(-0.3f * (float)tid);
        tab[TAB_LAM + tid] = expf(s01) - expf(s23) + li; tab[TAB_LAM + DEPTH + tid] = 1.f - li; }
}

__device__ __forceinline__ void prologue_phase(FARGS) {
    refresh(F);
    if (F.bx < 192) ada_unit(F, F.bx);
    else if (F.bx == 192) tables_unit(F);
    __syncthreads();
    LAS float* scr = (LAS float*)(F.lds + F.wave * 16640);
    const int gw = F.bx * NWAVES + F.wave, NGW = F.G * NWAVES;
    GAS bf16_t* WIN = (GAS bf16_t*)(F.ws + WS_WIN); GAS bf16_t* WOUT = (GAS bf16_t*)(F.ws + WS_WOUT); GAS bf16_t* W1 = (GAS bf16_t*)(F.ws + WS_W1); GAS bf16_t* W2 = (GAS bf16_t*)(F.ws + WS_W2);
    constexpr int I_IN = 16 * 40, I_OUT = 16 * 16, I_G = 16 * 8, I_D = 8 * 16;
    constexpr int N_IN = DEPTH * I_IN, N_OUT = DEPTH * I_OUT, N_G = DEPTH * NEXP * I_G, N_D = DEPTH * NEXP * I_D;
    constexpr int NITEMS = N_IN + N_OUT + 2 * N_G + N_D;
    for (int it = gw; it < NITEMS; it += NGW) {
        int r = it;
        if (r < N_IN) { const int L = r / I_IN, q = r % I_IN, kb = q / 40, nb = q % 40;
            transpose_item(INP(8) + (size_t)L * D * DIN, DIN, kb * 64, nb * 64, WIN + ((size_t)L * DIN + nb * 64) * D, D, nullptr, scr, F.lane); continue; } r -= N_IN;
        if (r < N_OUT) { const int L = r / I_OUT, q = r % I_OUT, kb = q / 16, nb = q % 16;
            transpose_item(INP(17) + (size_t)L * D * D, D, kb * 64, nb * 64, WOUT + ((size_t)L * D + nb * 64) * D, D, INP(16) + L * D, scr, F.lane); continue; } r -= N_OUT;
        if (r < 2 * N_G) { const int up = r >= N_G; if (up) r -= N_G; const int le = r / I_G, q = r % I_G, kb = q / 8, nb = q % 8, n0 = nb * 64;
            const int drow = (n0 >> 7) * 256 + (n0 & 127) + (up ? 128 : 0);
            transpose_item((up ? INP(21) : INP(20)) + (size_t)le * D * DEXP, DEXP, kb * 64, n0, W1 + ((size_t)le * 1024 + drow) * D, D, nullptr, scr, F.lane); continue; } r -= 2 * N_G;
        { const int le = r / I_D, q = r % I_D, kb = q / 16, nb = q % 16;
            transpose_item(INP(22) + (size_t)le * DEXP * D, D, kb * 64, nb * 64, W2 + ((size_t)le * 1024 + nb * 64) * DEXP, DEXP, nullptr, scr, F.lane); }
    }
    __syncthreads();
}

__device__ __forceinline__ void top2of4(float x0, float x1, float x2, float x3, int& i1, int& i2, float& m1, float& m2) {
    i1 = 0; m1 = x0; if (x1 > m1) { m1 = x1; i1 = 1; } if (x2 > m1) { m1 = x2; i1 = 2; } if (x3 > m1) { m1 = x3; i1 = 3; }
    i2 = -1; m2 = -3.0e38f;
    if (i1 != 0 && x0 > m2) { m2 = x0; i2 = 0; } if (i1 != 1 && x1 > m2) { m2 = x1; i2 = 1; } if (i1 != 2 && x2 > m2) { m2 = x2; i2 = 2; } if (i1 != 3 && x3 > m2) { m2 = x3; i2 = 3; }
}
template <bool ROUTER>
__device__ __forceinline__ void norm_phase(FARGS, int L, int M, bool first, const GAS float* g, int shift_off, int scale_off, bool live = true) {
    refresh(F); OPAQUE_S(L); OPAQUE_S(M);
    const GAS float* mod = (const GAS float*)(F.ws + WS_MOD) + (size_t)L * 33 * ADA;
    GAS bf16_t* H = (GAS bf16_t*)(F.ws + WS_H);
    const GAS bf16_t* XB = (const GAS bf16_t*)(F.ws + WS_XB);
    const GAS float* xlat = INP(0); const GAS float* xctx = INP(2);
    const int lane = F.lane, gw = F.bx * NWAVES + F.wave, NGW = F.G * NWAVES, rpw = (M + NGW - 1) / NGW;
    const int r0 = gw * rpw, r1 = (r0 + rpw < M) ? r0 + rpw : M;
    constexpr int RB = ROUTER ? 1 : 4;
    LAS float* RWT = (LAS float*)F.lds;
    LAS float* LG = (LAS float*)(F.lds + 65536) + F.wave * 640;
    LAS int* hist = (LAS int*)(F.lds + NRM_OFF); LAS int* base = hist + 32;
    if (ROUTER) {
        const GAS float* rw = INP(18);
        for (int i = F.tid; i < 16 * 1024; i += 512) { const int k = i >> 4, e = i & 15; RWT[e * 1024 + k] = rw[i]; }
        if (F.tid < 32) hist[F.tid] = 0;
        __syncthreads();
    }
    int curb = -1; f32x4 gm[4], sh[4];
    u32x4 nraw[RB][2];
    if (!first) {
#pragma unroll
        for (int r = 0; r < RB; ++r)
#pragma unroll
            for (int jj = 0; jj < 2; ++jj) nraw[r][jj] = *(const GAS u32x4*)(XB + (size_t)(r0 + r) * D + 8 * lane + 512 * jj);
    }
#pragma unroll 1
    for (int row = r0; row < r1; row += RB) {
        const int b = row < NLAT ? (row >> 11) : 32;
        if (b != curb) { curb = b;
#pragma unroll
            for (int j = 0; j < 4; ++j) { const int c0 = 8 * lane + 512 * (j >> 1) + 4 * (j & 1); const f32x4 gg = *(const GAS f32x4*)(g + c0), sc = *(const GAS f32x4*)(mod + b * ADA + scale_off + c0);
                gm[j] = gg * (sc + 1.0f); sh[j] = *(const GAS f32x4*)(mod + b * ADA + shift_off + c0); } }
        const GAS float* xr = row < NLAT ? xlat + (size_t)row * D : xctx + (size_t)(row - NLAT) * D;
        f32x4 v[RB][4]; float ss[RB];
        if (first) {
#pragma unroll
            for (int r = 0; r < RB; ++r)
#pragma unroll
                for (int jj = 0; jj < 2; ++jj) { v[r][2 * jj] = *(const GAS f32x4*)(xr + (size_t)r * D + 8 * lane + 512 * jj); v[r][2 * jj + 1] = *(const GAS f32x4*)(xr + (size_t)r * D + 8 * lane + 512 * jj + 4); }
        } else {
            u32x4 raw[RB][2];
#pragma unroll
            for (int r = 0; r < RB; ++r)
#pragma unroll
                for (int jj = 0; jj < 2; ++jj) raw[r][jj] = nraw[r][jj];
            if (row + RB < r1) {
#pragma unroll
                for (int r = 0; r < RB; ++r)
#pragma unroll
                    for (int jj = 0; jj < 2; ++jj) nraw[r][jj] = *(const GAS u32x4*)(XB + (size_t)(row + RB + r) * D + 8 * lane + 512 * jj);
            }
#pragma unroll
            for (int r = 0; r < RB; ++r)
#pragma unroll
                for (int jj = 0; jj < 2; ++jj) { const u32x4 w = raw[r][jj];
                    v[r][2 * jj] = (f32x4){bflo(w.x), bfhi(w.x), bflo(w.y), bfhi(w.y)}; v[r][2 * jj + 1] = (f32x4){bflo(w.z), bfhi(w.z), bflo(w.w), bfhi(w.w)}; }
        }
#pragma unroll
        for (int r = 0; r < RB; ++r) { float s = 0.f;
#pragma unroll
            for (int j = 0; j < 4; ++j) s += (v[r][j].x * v[r][j].x + v[r][j].y * v[r][j].y) + (v[r][j].z * v[r][j].z + v[r][j].w * v[r][j].w);
            ss[r] = s; }
#pragma unroll
        for (int o = 1; o < 32; o <<= 1) {
#pragma unroll
            for (int r = 0; r < RB; ++r) ss[r] += sx(ss[r], lane, o); }
#pragma unroll
        for (int r = 0; r < RB; ++r) { const float rstd = __builtin_amdgcn_rsqf(x32_sum(ss[r]) * (1.f / D) + EPS);
#pragma unroll
            for (int j = 0; j < 4; ++j) v[r][j] = v[r][j] * rstd * gm[j] + sh[j];
#pragma unroll
            for (int jj = 0; jj < 2; ++jj) { u32x4 o; o.x = pk2(v[r][2 * jj].x, v[r][2 * jj].y); o.y = pk2(v[r][2 * jj].z, v[r][2 * jj].w); o.z = pk2(v[r][2 * jj + 1].x, v[r][2 * jj + 1].y); o.w = pk2(v[r][2 * jj + 1].z, v[r][2 * jj + 1].w);
                if (live) *(GAS u32x4*)(H + (size_t)(row + r) * D + 8 * lane + 512 * jj) = o; } }
        if (ROUTER) {
            float p[RB][16];
#pragma unroll
            for (int e = 0; e < 16; ++e) {
#pragma unroll
                for (int r = 0; r < RB; ++r) p[r][e] = 0.f;
#pragma unroll
                for (int j = 0; j < 4; ++j) { const f32x4 w = *(const LAS f32x4*)(RWT + e * 1024 + 8 * lane + 512 * (j >> 1) + 4 * (j & 1));
#pragma unroll
                    for (int r = 0; r < RB; ++r) p[r][e] += (v[r][j].x * w.x + v[r][j].y * w.y) + (v[r][j].z * w.z + v[r][j].w * w.w); } }
            const bool h32 = lane & 32, h16 = lane & 16, h8 = lane & 8, h4 = lane & 4;
#pragma unroll
            for (int r = 0; r < RB; ++r) {
                float a8[8], b4[4], c2[2], d1;
#pragma unroll
                for (int e = 0; e < 8; ++e) { const float send = h32 ? p[r][e] : p[r][e + 8], keep = h32 ? p[r][e + 8] : p[r][e]; a8[e] = keep + sx(send, lane, 32); }
#pragma unroll
                for (int e = 0; e < 4; ++e) { const float send = h16 ? a8[e] : a8[e + 4], keep = h16 ? a8[e + 4] : a8[e]; b4[e] = keep + sx(send, lane, 16); }
#pragma unroll
                for (int e = 0; e < 2; ++e) { const float send = h8 ? b4[e] : b4[e + 2], keep = h8 ? b4[e + 2] : b4[e]; c2[e] = keep + sx(send, lane, 8); }
                { const float send = h4 ? c2[0] : c2[1], keep = h4 ? c2[1] : c2[0]; d1 = keep + sx(send, lane, 4); }
                d1 += sx(d1, lane, 2); d1 += sx(d1, lane, 1);
                if ((lane & 3) == 0) LG[(row + r - r0) * 16 + (lane >> 2)] = d1;
            }
        }
    }
    if (ROUTER) {
        LDS_WAIT();
        int cls = 0, ls = 0; const bool mine = r0 + lane < r1;
        { const LAS f32x4* lp = (const LAS f32x4*)(LG + (mine ? lane : 0) * 16);
          const f32x4 q0 = lp[0], q1 = lp[1], q2 = lp[2], q3 = lp[3];
          const float lg[16] = {q0.x, q0.y, q0.z, q0.w, q1.x, q1.y, q1.z, q1.w, q2.x, q2.y, q2.z, q2.w, q3.x, q3.y, q3.z, q3.w};
          float sc[16], sel[16];
#pragma unroll
          for (int e = 0; e < 16; ++e) { sc[e] = 1.0f / (1.0f + __builtin_amdgcn_exp2f(-lg[e] * LOG2E)); sel[e] = sc[e] + INP(19)[e]; }
          float gs[4];
#pragma unroll
          for (int q = 0; q < 4; ++q) { int i1, i2; float m1, m2; top2of4(sel[4 * q], sel[4 * q + 1], sel[4 * q + 2], sel[4 * q + 3], i1, i2, m1, m2); gs[q] = m1 + m2; }
          int gi = 0; float gmx = gs[0]; if (gs[1] > gmx) { gmx = gs[1]; gi = 1; } if (gs[2] > gmx) { gmx = gs[2]; gi = 2; } if (gs[3] > gmx) { gmx = gs[3]; gi = 3; }
          float x4[4], s4[4];
#pragma unroll
          for (int i = 0; i < 4; ++i) { x4[i] = gi == 0 ? sel[i] : gi == 1 ? sel[4 + i] : gi == 2 ? sel[8 + i] : sel[12 + i]; s4[i] = gi == 0 ? sc[i] : gi == 1 ? sc[4 + i] : gi == 2 ? sc[8 + i] : sc[12 + i]; }
          int i1, i2; float m1, m2; top2of4(x4[0], x4[1], x4[2], x4[3], i1, i2, m1, m2);
          const int lo = i1 < i2 ? i1 : i2, hi = i1 < i2 ? i2 : i1;
          const int pr = lo == 0 ? hi - 1 : (lo == 1 ? hi + 1 : 5);
          const float slo = lo == 0 ? s4[0] : lo == 1 ? s4[1] : s4[2], shi = hi == 1 ? s4[1] : hi == 2 ? s4[2] : s4[3];
          const float inv = 1.0f / (slo + shi);
          cls = gi * 6 + pr;
          if (mine && live) { ls = __hip_atomic_fetch_add(&hist[cls], 1, __ATOMIC_RELAXED, __HIP_MEMORY_SCOPE_WORKGROUP);
              f32x2 w2 = {slo * inv, shi * inv}; *(GAS f32x2*)((GAS float*)(F.ws + WS_RW) + (size_t)(r0 + lane) * 2) = w2; }
        }
        __syncthreads();
        if (F.tid < NCLS && live) base[F.tid] = (int)__hip_atomic_fetch_add(CTL(F) + CW_CNT + (L * NCLS + F.tid) * 64, (unsigned)hist[F.tid], __ATOMIC_RELAXED, __HIP_MEMORY_SCOPE_AGENT);
        __syncthreads();
        GAS int* perm = (GAS int*)(F.ws + WS_PERM);
        if (mine && live) perm[(size_t)cls * MTOT + base[cls] + ls] = r0 + lane;
        __syncthreads();
    }
}

__device__ __forceinline__ void norm2_phase(FARGS, int L, int M) {
    refresh(F); OPAQUE_S(L); OPAQUE_S(M);
    constexpr int SG = 2064;
    constexpr int GT_BYTES = 32 * SG, C_OFF = 2 * GT_BYTES, RS_OFF = C_OFF + 256, RI_OFF = RS_OFF + 8 * 40 * 4, HB_OFF = RI_OFF + 8 * 40 * 4;
    static_assert(HB_OFF + 256 <= MISC_OFF, "norm2 LDS map");
    const GAS float* mod = (const GAS float*)(F.ws + WS_MOD) + (size_t)L * 33 * ADA;
    const GAS float* g2 = INP(7) + L * D; const GAS float* Wr = INP(18);
    GAS bf16_t* H = (GAS bf16_t*)(F.ws + WS_H);
    const GAS bf16_t* XB = (const GAS bf16_t*)(F.ws + WS_XB);
    const int lane = F.lane, tid = F.tid, w = F.wave, l31 = lane & 31, hi = lane >> 5;
    const int NGW = F.G * NWAVES, rpw = (M + NGW - 1) / NGW;
    const int R0 = F.bx * NWAVES * rpw, R1 = (R0 + NWAVES * rpw < M) ? R0 + NWAVES * rpw : M;
    const int r0 = R0 + w * rpw < M ? R0 + w * rpw : M, r1 = (r0 + rpw < M) ? r0 + rpw : M;
    LAS unsigned char* GT = F.lds; LAS float* Ctab = (LAS float*)(F.lds + C_OFF); LAS float* RS = (LAS float*)(F.lds + RS_OFF) + w * 40; LAS int* RI = (LAS int*)(F.lds + RI_OFF) + w * 40;
    LAS int* hist = (LAS int*)(F.lds + HB_OFF); LAS int* base = hist + 32;
    if (tid < 32) hist[tid] = 0;
    const int bfirst = R0 < NLAT ? (R0 >> 11) : 32, blast = (R1 - 1) < NLAT ? ((R1 - 1) >> 11) : 32;
    for (int s = 0; s <= (blast != bfirst ? 1 : 0); ++s) {
        const int b = s == 0 ? bfirst : blast;
        const GAS float* sc = mod + (size_t)b * ADA + 4 * 1024; const GAS float* shp = mod + (size_t)b * ADA + 3 * 1024;
        LAS unsigned char* gt = GT + s * GT_BYTES;
        for (int k = tid; k < D; k += 512) {
            const float gmk = g2[k] * (1.0f + sc[k]);
            const f32x4 w0 = *(const GAS f32x4*)(Wr + k * 16), w1 = *(const GAS f32x4*)(Wr + k * 16 + 4), w2 = *(const GAS f32x4*)(Wr + k * 16 + 8), w3 = *(const GAS f32x4*)(Wr + k * 16 + 12);
            const float wr_[16] = {w0.x, w0.y, w0.z, w0.w, w1.x, w1.y, w1.z, w1.w, w2.x, w2.y, w2.z, w2.w, w3.x, w3.y, w3.z, w3.w};
#pragma unroll
            for (int e = 0; e < 16; ++e) { const float G = gmk * wr_[e]; const unsigned hb = pk2(G, 0.f) & 0xffffu; const float lo = G - __uint_as_float(hb << 16); const unsigned lb = pk2(lo, 0.f) & 0xffffu;
                *(LAS bf16_t*)(gt + e * SG + k * 2) = (bf16_t)hb; *(LAS bf16_t*)(gt + (16 + e) * SG + k * 2) = (bf16_t)lb; }
        }
#pragma unroll
        for (int ee = 0; ee < 2; ++ee) { const int e = 2 * w + ee; float p = 0.f;
            for (int k = lane; k < D; k += 64) p += shp[k] * Wr[k * 16 + e];
            p = wave_sum(p, lane); if (lane == 0) Ctab[s * 16 + e] = p; }
    }
    __syncthreads();
    for (int cur = r0; cur < r1; ) {
        const int bcur = cur < NLAT ? (cur >> 11) : 32;
        int cnt = r1 - cur; if (cnt > 32) cnt = 32;
        if (cur < NLAT) { const int bnd = ((cur >> 11) + 1) << 11; if (bnd - cur < cnt) cnt = bnd - cur; }
        const int s = bcur == bfirst ? 0 : 1;
        const int row = cur + (l31 < cnt ? l31 : cnt - 1);
        const GAS bf16_t* xp = XB + (size_t)row * D + 8 * hi;
        const LAS unsigned char* gp = GT + s * GT_BYTES + l31 * SG + 16 * hi;
        f32x16 acc = f32x16{}; float ss = 0.f;
#pragma unroll 1
        for (int kg = 0; kg < 8; ++kg) {
            bf16x8 xf[8];
#pragma unroll
            for (int j = 0; j < 8; ++j) xf[j] = *(const GAS bf16x8*)(xp + (kg * 8 + j) * 16);
#pragma unroll
            for (int j = 0; j < 8; ++j) {
                const bf16x8 gf = *(const LAS bf16x8*)(gp + (kg * 8 + j) * 32);
                const u32x4 wv = __builtin_bit_cast(u32x4, xf[j]);
                const float a0 = bflo(wv.x), a1 = bfhi(wv.x), a2 = bflo(wv.y), a3 = bfhi(wv.y), a4 = bflo(wv.z), a5 = bfhi(wv.z), a6 = bflo(wv.w), a7 = bfhi(wv.w);
                ss += (a0 * a0 + a1 * a1) + (a2 * a2 + a3 * a3) + (a4 * a4 + a5 * a5) + (a6 * a6 + a7 * a7);
                acc = __builtin_amdgcn_mfma_f32_32x32x16_bf16(gf, xf[j], acc, 0, 0, 0);
            }
        }
        const float rstd = __builtin_amdgcn_rsqf(x32_sum(ss) * (1.f / D) + EPS);
        float mine[8], oth[8];
#pragma unroll
        for (int i = 0; i < 8; ++i) { mine[i] = acc[i] + acc[i + 8]; oth[i] = swap32(mine[i], hi != 0); }
        float lg[16];
#pragma unroll
        for (int i = 0; i < 4; ++i) { lg[i] = hi ? oth[i] : mine[i]; lg[4 + i] = hi ? mine[i] : oth[i]; lg[8 + i] = hi ? oth[4 + i] : mine[4 + i]; lg[12 + i] = hi ? mine[4 + i] : oth[4 + i]; }
        float sc_[16], sel[16];
#pragma unroll
        for (int e = 0; e < 16; ++e) { const float z = rstd * lg[e] + Ctab[s * 16 + e]; sc_[e] = __builtin_amdgcn_rcpf(1.0f + __builtin_amdgcn_exp2f(-z * LOG2E)); sel[e] = sc_[e] + INP(19)[e]; }
        float gs[4];
#pragma unroll
        for (int q = 0; q < 4; ++q) { int i1, i2; float m1, m2; top2of4(sel[4 * q], sel[4 * q + 1], sel[4 * q + 2], sel[4 * q + 3], i1, i2, m1, m2); gs[q] = m1 + m2; }
        int gi = 0; float gmx = gs[0]; if (gs[1] > gmx) { gmx = gs[1]; gi = 1; } if (gs[2] > gmx) { gmx = gs[2]; gi = 2; } if (gs[3] > gmx) { gmx = gs[3]; gi = 3; }
        float x4[4], s4[4];
#pragma unroll
        for (int i = 0; i < 4; ++i) { x4[i] = gi == 0 ? sel[i] : gi == 1 ? sel[4 + i] : gi == 2 ? sel[8 + i] : sel[12 + i]; s4[i] = gi == 0 ? sc_[i] : gi == 1 ? sc_[4 + i] : gi == 2 ? sc_[8 + i] : sc_[12 + i]; }
        int i1, i2; float m1, m2; top2of4(x4[0], x4[1], x4[2], x4[3], i1, i2, m1, m2);
        const int lo_ = i1 < i2 ? i1 : i2, hi_ = i1 < i2 ? i2 : i1;
        const int pr = lo_ == 0 ? hi_ - 1 : (lo_ == 1 ? hi_ + 1 : 5);
        const float slo = lo_ == 0 ? s4[0] : lo_ == 1 ? s4[1] : s4[2], shi = hi_ == 1 ? s4[1] : hi_ == 2 ? s4[2] : s4[3];
        const float inv = __builtin_amdgcn_rcpf(slo + shi);
        const int cls = gi * 6 + pr;
        if (hi == 0 && l31 < cnt) { const int ls = __hip_atomic_fetch_add(&hist[cls], 1, __ATOMIC_RELAXED, __HIP_MEMORY_SCOPE_WORKGROUP);
            const int ri = cur - r0 + l31; RS[ri] = rstd; RI[ri] = cls | (ls << 8);
            f32x2 w2 = {slo * inv, shi * inv}; *(GAS f32x2*)((GAS float*)(F.ws + WS_RW) + (size_t)(cur + l31) * 2) = w2; }
        cur += cnt;
    }
    LDS_WAIT();
    { int curb = -1; f32x4 gm[4], sh[4];
#pragma unroll 1
      for (int row = r0; row < r1; row += 4) {
        const int b = row < NLAT ? (row >> 11) : 32;
        if (b != curb) { curb = b;
#pragma unroll
            for (int j = 0; j < 4; ++j) { const int c0 = 8 * lane + 512 * (j >> 1) + 4 * (j & 1); const f32x4 gg = *(const GAS f32x4*)(g2 + c0), sc = *(const GAS f32x4*)(mod + b * ADA + 4 * 1024 + c0);
                gm[j] = gg * (sc + 1.0f); sh[j] = *(const GAS f32x4*)(mod + b * ADA + 3 * 1024 + c0); } }
        u32x4 raw[4][2];
#pragma unroll
        for (int r = 0; r < 4; ++r)
#pragma unroll
            for (int jj = 0; jj < 2; ++jj) raw[r][jj] = *(const GAS u32x4*)(XB + (size_t)(row + r) * D + 8 * lane + 512 * jj);
#pragma unroll
        for (int r = 0; r < 4; ++r) { const float rstd = RS[row - r0 + r];
#pragma unroll
            for (int jj = 0; jj < 2; ++jj) { const u32x4 wv = raw[r][jj];
                const f32x4 v0 = (f32x4){bflo(wv.x), bfhi(wv.x), bflo(wv.y), bfhi(wv.y)} * rstd * gm[2 * jj] + sh[2 * jj], v1 = (f32x4){bflo(wv.z), bfhi(wv.z), bflo(wv.w), bfhi(wv.w)} * rstd * gm[2 * jj + 1] + sh[2 * jj + 1];
                u32x4 o; o.x = pk2(v0.x, v0.y); o.y = pk2(v0.z, v0.w); o.z = pk2(v1.x, v1.y); o.w = pk2(v1.z, v1.w);
                *(GAS u32x4*)(H + (size_t)(row + r) * D + 8 * lane + 512 * jj) = o; } }
      } }
    __syncthreads();
    if (tid < NCLS) base[tid] = (int)__hip_atomic_fetch_add(CTL(F) + CW_CNT + (L * NCLS + tid) * 64, (unsigned)hist[tid], __ATOMIC_RELAXED, __HIP_MEMORY_SCOPE_AGENT);
    __syncthreads();
    { GAS int* perm = (GAS int*)(F.ws + WS_PERM);
      if (r0 + lane < r1) { const int ri = RI[lane], cls = ri & 255, ls = ri >> 8; perm[(size_t)cls * MTOT + base[cls] + ls] = r0 + lane; } }
    __syncthreads();
}

__device__ __forceinline__ void qkprep_phase(FARGS, int L, bool live = true) {
    refresh(F); OPAQUE_S(L);
    GAS bf16_t* U = (GAS bf16_t*)(F.ws + WS_U);
    const GAS float* tab = (const GAS float*)(F.ws + WS_TAB);
    const int lane = F.lane, gw = F.bx * NWAVES + F.wave, NGW = F.G * NWAVES, rpw = (MTOT + NGW - 1) / NGW;
    const int r0 = gw * rpw, r1 = (r0 + rpw < MTOT) ? r0 + rpw : MTOT;
    int ccol[4]; bool seg32[4], dorope[4], valid[4]; float qs[4]; f32x4 g0[4], g1[4];
#pragma unroll
    for (int i = 0; i < 4; ++i) {
        const int c = lane + 64 * i; valid[i] = c < 224;
        int col, isq; const GAS float* gp; bool s32 = false, rp = true; float sc = 0.125f * LOG2E;
        if (c < 48) { col = 8 * c; isq = c < 32; gp = INP(9) + L * 128 + (isq ? 0 : 64) + ((8 * c) & 63); }
        else if (c < 112) { const int cc = c - 48; col = QB + 8 * cc; isq = cc < 32; gp = INP(10) + L * 128 + (isq ? 0 : 64) + ((8 * cc) & 63); rp = false; }
        else if (c < 176) { const int cc = c - 112; col = QC + 8 * cc; isq = cc < 32; gp = INP(11) + L * 64 + (isq ? 0 : 32) + ((8 * cc) & 31); s32 = true; sc = 0.17677669529663687f * LOG2E; }
        else { const int cc = (c < 224 ? c : 223) - 176; col = QD + 8 * cc; isq = cc < 32; gp = INP(12) + L * 128 + (isq ? 0 : 64) + ((8 * cc) & 63); }
        ccol[i] = col; seg32[i] = s32; dorope[i] = rp; qs[i] = isq ? sc : 1.0f; g0[i] = *(const GAS f32x4*)gp; g1[i] = *(const GAS f32x4*)(gp + 4);
    }
#pragma unroll 1
    for (int row4 = r0; row4 < r1; row4 += 4) {
        u32x4 wv[4][4];
#pragma unroll
        for (int r = 0; r < 4; ++r)
#pragma unroll
            for (int i = 0; i < 4; ++i) wv[r][i] = *(const GAS u32x4*)(U + (size_t)(row4 + r) * DIN + ccol[i]);
#pragma unroll
        for (int r = 0; r < 4; ++r) {
        const int row = row4 + r;
        const bool lat = row < NLAT; const int s = row & 2047, prow = s >> 6, pcol = s & 63;
#pragma unroll
        for (int i = 0; i < 4; ++i) {
            GAS bf16_t* p = U + (size_t)row * DIN + ccol[i];
            const u32x4 w = wv[r][i];
            float x[8] = {bflo(w.x), bfhi(w.x), bflo(w.y), bfhi(w.y), bflo(w.z), bfhi(w.z), bflo(w.w), bfhi(w.w)};
            float ss = 0.f;
#pragma unroll
            for (int e = 0; e < 8; ++e) ss += x[e] * x[e];
            ss += sx(ss, lane, 1); ss += sx(ss, lane, 2); const float ss8 = ss + sx(ss, lane, 4);
            const float rstd = seg32[i] ? __builtin_amdgcn_rsqf(ss * (1.f / 32.f) + EPS) : __builtin_amdgcn_rsqf(ss8 * (1.f / 64.f) + EPS);
            const float gg[8] = {g0[i].x, g0[i].y, g0[i].z, g0[i].w, g1[i].x, g1[i].y, g1[i].z, g1[i].w};
#pragma unroll
            for (int e = 0; e < 8; ++e) x[e] = x[e] * rstd * gg[e];
            const int j = seg32[i] ? (lane & 3) : (lane & 7);
            const int pxor = seg32[i] ? 1 : 2;
            const bool first = seg32[i] ? !(j & 1) : !(j & 2);
            const int pos = seg32[i] ? ((j < 2) ? prow : pcol) : ((j < 4) ? prow : pcol);
            const GAS float* tp = seg32[i] ? tab + TAB_T32 + (pos * 8) * 2 : tab + TAB_T64 + (pos * 16 + 8 * (j & 1)) * 2;
            const bool rp = dorope[i] && lat;
#pragma unroll
            for (int e2 = 0; e2 < 4; ++e2) {
                const f32x4 cs = *(const GAS f32x4*)(tp + 4 * e2);
                const float pa = sx(x[2 * e2], lane, pxor), pb = sx(x[2 * e2 + 1], lane, pxor);
                if (rp) {
                    x[2 * e2] = first ? x[2 * e2] * cs.x - pa * cs.y : pa * cs.y + x[2 * e2] * cs.x;
                    x[2 * e2 + 1] = first ? x[2 * e2 + 1] * cs.z - pb * cs.w : pb * cs.w + x[2 * e2 + 1] * cs.z;
                }
            }
            u32x4 o; o.x = pk2(x[0] * qs[i], x[1] * qs[i]); o.y = pk2(x[2] * qs[i], x[3] * qs[i]); o.z = pk2(x[4] * qs[i], x[5] * qs[i]); o.w = pk2(x[6] * qs[i], x[7] * qs[i]);
            if (valid[i] && live) *(GAS u32x4*)p = o;
        }
        }
    }
}
#ifdef MK_USE_SB
#define MK_SB() __builtin_amdgcn_sched_barrier(0)
#else
#define MK_SB() do {} while (0)
#endif
#ifndef MK_DUAL
#define MK_DUAL 1
#endif
#ifndef MK_MIDBAR
#define MK_MIDBAR 0
#endif
#ifndef MK_QKFIRST
#define MK_QKFIRST 4
#endif
#ifndef MK_QKSPLIT
#define MK_QKSPLIT 1
#endif
#ifndef MK_ILV
#define MK_ILV 15
#endif
#ifndef MK_CHP
#define MK_CHP 1
#endif
template <int MIX> struct MixCfg;
template <> struct MixCfg<0> { static constexpr int QCOL = QA, KCOL = KA, VCOL = VA, CK = 128, CV = 128; static constexpr bool GQA = true;  };
template <> struct MixCfg<1> { static constexpr int QCOL = QB, KCOL = KB, VCOL = VB, CK = 256, CV = 256; static constexpr bool GQA = false; };
template <> struct MixCfg<2> { static constexpr int QCOL = QC, KCOL = KC, VCOL = VC, CK = MK_CHP ? 128 : 256, CV = MK_CHP ? 128 : 256; static constexpr bool GQA = false; };
template <> struct MixCfg<3> { static constexpr int QCOL = QD, KCOL = KD, VCOL = VD, CK = 128, CV = 128; static constexpr bool GQA = true;  };

__device__ __forceinline__ int crow16(int r, int hi) { return (r & 3) + 8 * (r >> 2) + 4 * hi; }
__device__ __forceinline__ s16x4 vtr(const LAS unsigned char* p) { return __builtin_bit_cast(s16x4, __builtin_amdgcn_ds_read_tr16_b64_v4i16((LAS s16x4*)p)); }

__device__ __forceinline__ void softmax_tile(f32x16& p0, f32x16& p1, float& l, bf16x8 (&pa)[4]) {
    float s0 = 0.f, s1 = 0.f;
#pragma unroll
    for (int r = 0; r < 16; ++r) { p0[r] = __builtin_amdgcn_exp2f(p0[r]); p1[r] = __builtin_amdgcn_exp2f(p1[r]); s0 += p0[r]; s1 += p1[r]; }
    l += s0 + s1;
#pragma unroll
    for (int sI = 0; sI < 4; ++sI) {
        u32x4 w;
        if (sI < 2) { const int o_ = 8 * sI; w.x = pk2(p0[o_], p0[o_ + 1]); w.y = pk2(p0[o_ + 2], p0[o_ + 3]); w.z = pk2(p0[o_ + 4], p0[o_ + 5]); w.w = pk2(p0[o_ + 6], p0[o_ + 7]); }
        else { const int o_ = 8 * (sI - 2); w.x = pk2(p1[o_], p1[o_ + 1]); w.y = pk2(p1[o_ + 2], p1[o_ + 3]); w.z = pk2(p1[o_ + 4], p1[o_ + 5]); w.w = pk2(p1[o_ + 6], p1[o_ + 7]); }
        pa[sI] = __builtin_bit_cast(bf16x8, w);
    }
}

template <int MIX>
__device__ __forceinline__ void attn_unit(FARGS, int L, int b, int qb, bool isctx, int hp) {
    typedef MixCfg<MIX> C;
    refresh(F); OPAQUE_S(L);
#ifdef MK_STAMP
#define STAMP_NOW_(v) __builtin_amdgcn_sched_barrier(0); const unsigned v = (unsigned)__builtin_amdgcn_s_memtime(); __builtin_amdgcn_sched_barrier(0)
#define SEG0() do { if (MIX == MK_STAMP) { STAMP_NOW_(now_); if (F.tid == MK_STAMP_TID) { LAS unsigned* m_ = (LAS unsigned*)(F.lds + MISC_OFF); m_[21] = now_; } } } while (0)
#define SEG(k) do { if (MIX == MK_STAMP && (MK_STAMP_SEG == 9 ? (k) == 3 : ((k) == MK_STAMP_SEG || (k) == (MK_STAMP_SEG + 3) % 4))) { STAMP_NOW_(now_); if (F.tid == MK_STAMP_TID) { LAS unsigned* m_ = (LAS unsigned*)(F.lds + MISC_OFF); \
    if ((k) == MK_STAMP_SEG || MK_STAMP_SEG == 9) m_[20] += now_ - m_[21]; m_[21] = now_; } } } while (0)
#else
#define SEG0() do {} while (0)
#define SEG(k) do {} while (0)
#endif
    constexpr int SK = C::CK * 2 + 16, SV = C::CV * 2 + 64, NKC = C::CK / 64, NVC = C::CV / 64;
    constexpr bool DIFF = (MIX == 2);
    constexpr bool DUAL = (MIX == 3) && MK_DUAL;
    constexpr bool TWO = DIFF || DUAL;
    constexpr bool HP = DIFF && MK_CHP;
    constexpr int UQ = (DUAL || HP) ? 128 : 64;
    static_assert(C::CK == C::CV, "K and V tiles share the per-thread load offsets");
    const GAS bf16_t* U = (const GAS bf16_t*)(F.ws + WS_U);
    GAS bf16_t* Y = (GAS bf16_t*)(F.ws + WS_Y);
    const GAS float* tab = (const GAS float*)(F.ws + WS_TAB);
    const int tid = F.tid, lane = F.lane, w = F.wave, l31 = lane & 31, hi = lane >> 5;
    const int hq = DUAL ? 2 * (w >> 2) : (HP ? 2 * hp + (w >> 2) : (w >> 1)), rs = (DUAL || HP) ? (w & 3) : (w & 1);
    const int hk = (DUAL || HP) ? (w >> 2) : (C::GQA ? (hq >> 1) : hq);
    const int kcolb = C::KCOL + (HP ? hp * 128 : 0), vcolb = C::VCOL + (HP ? hp * 128 : 0);
    const int qrow = isctx ? NLAT + b * CTXL + qb * UQ + rs * 32 + l31 : b * SEQ + qb * UQ + rs * 32 + l31;
    int nloc, loc0;
    if (isctx) { nloc = 0; loc0 = 0; }
    else if (MIX == 0) { const int t0 = DUAL ? 2 * qb - 2 : qb - 2, t1 = DUAL ? 2 * qb + 3 : qb + 2; loc0 = t0 < 0 ? 0 : t0; const int hiT = t1 > 31 ? 31 : t1; nloc = hiT - loc0 + 1; }
    else if (MIX == 1) { loc0 = qb - 4 < 0 ? 0 : (qb - 4 > 24 ? 24 : qb - 4); nloc = 8; }
    else { loc0 = 0; nloc = 32; }
    const int NT = nloc + 4;
    const int lrow0 = b * SEQ, crow0 = NLAT + b * CTXL;
    bf16x8 qf[4], qg[DUAL ? 4 : 1];
    { const GAS bf16_t* qp = U + (size_t)qrow * DIN + C::QCOL + hq * 64 + hi * 8;
#pragma unroll
      for (int d0 = 0; d0 < 4; ++d0) { qf[d0] = *(const GAS bf16x8*)(qp + d0 * 16); if (DUAL) qg[DUAL ? d0 : 0] = *(const GAS bf16x8*)(qp + 64 + d0 * 16); } }
    float l0 = 0.f, l1 = 0.f;
    if (MIX == 0) { l0 = hi == 0 ? __builtin_amdgcn_exp2f(INP(13)[L * 4 + hq] * LOG2E) : 0.f;
        if (DUAL) l1 = hi == 0 ? __builtin_amdgcn_exp2f(INP(13)[L * 4 + hq + 1] * LOG2E) : 0.f; }
    f32x16 o0[2], o1[2];
#pragma unroll
    for (int i = 0; i < 2; ++i) { o0[i] = f32x16{}; o1[i] = f32x16{}; }
    u32x4 kreg[NKC], vreg[NVC];
    auto tile_row = [&](int t) -> int { return t < nloc ? lrow0 + (loc0 + t) * 64 : crow0 + (t - nloc) * 64; };
    unsigned goff[NKC];
#pragma unroll
    for (int i = 0; i < NKC; ++i) { const int c = tid + 512 * i, r = c / (C::CK / 8), cc = c % (C::CK / 8); goff[i] = (unsigned)(r * DIN + cc * 8) * 2u; }
    auto issueK = [&](int t) { const GAS char* tb = (const GAS char*)(U + (size_t)tile_row(t) * DIN + kcolb);
#pragma unroll
        for (int i = 0; i < NKC; ++i) kreg[i] = *(const GAS u32x4*)(tb + goff[i]); };
    auto issueV = [&](int t) { const GAS char* tb = (const GAS char*)(U + (size_t)tile_row(t) * DIN + vcolb);
#pragma unroll
        for (int i = 0; i < NVC; ++i) vreg[i] = *(const GAS u32x4*)(tb + goff[i]); };
    constexpr bool ILV = ((MK_ILV) >> MIX) & 1;
    constexpr bool MID = ILV && (!TWO || HP) && (C::CK == 128) && (((MK_MIDBAR) >> MIX) & 1);
    constexpr int K3SZ = 64 * SK, V3SZ = 64 * SV, V3BASE = 34816;
    static_assert(!MID || (2 * K3SZ <= V3BASE && V3BASE + 3 * V3SZ <= AT_RPB), "ring");
    auto KB = [&](int t) -> int { return MID ? (t & 1) * K3SZ : (t & 1) * AT_BUFB; };
    auto VB = [&](int t) -> int { return MID ? V3BASE + (int)((unsigned)t % 3u) * V3SZ : (t & 1) * AT_BUFB + AT_VOFF; };
    auto stashK = [&](int t) { LAS unsigned char* Kw = F.lds + KB(t);
#pragma unroll
        for (int i = 0; i < NKC; ++i) { const int c = tid + 512 * i, r = c / (C::CK / 8), cc = c % (C::CK / 8); *(LAS u32x4*)(Kw + r * SK + cc * 16) = kreg[i]; } };
    auto stashV = [&](int t) { LAS unsigned char* Vw = F.lds + VB(t);
#pragma unroll
        for (int i = 0; i < NVC; ++i) { const int c = tid + 512 * i, r = c / (C::CV / 8), cc = c % (C::CV / 8); *(LAS u32x4*)(Vw + r * SV + cc * 16) = vreg[i]; } };
    const int kboff = l31 * SK + (hk * 64 + hi * 8) * 2;
    const int vboff = (4 * hi + ((lane & 15) >> 2)) * SV + (hk * 64 + 16 * ((lane >> 4) & 1) + 4 * (lane & 3)) * 2;
    bf16x8 kf[8];
    auto loadkf = [&](int t) { const LAS unsigned char* kb = F.lds + KB(t) + kboff;
#pragma unroll
        for (int d0 = 0; d0 < 4; ++d0) { kf[2 * d0] = *(const LAS bf16x8*)(kb + d0 * 32); kf[2 * d0 + 1] = *(const LAS bf16x8*)(kb + 32 * SK + d0 * 32); } };
    bf16x8 pa0[4], pa1[4];
#pragma unroll
    for (int i = 0; i < 4; ++i) { pa0[i] = bf16x8{}; pa1[i] = bf16x8{}; }
    constexpr int VPRE = DUAL ? 1 : (TWO ? 2 : 4);
    bf16x8 vf[2 * VPRE];
    auto readvf = [&](int t, int sI, int dh) -> bf16x8 {
        const LAS unsigned char* vp = F.lds + VB(t) + vboff + (16 * sI) * SV + dh * 64;
        const s16x4 lo = vtr(vp), hi4 = vtr(vp + 8 * SV);
        return (bf16x8){lo[0], lo[1], lo[2], lo[3], hi4[0], hi4[1], hi4[2], hi4[3]}; };
    auto loadvf = [&](int t) {
#pragma unroll
        for (int sI = 0; sI < VPRE; ++sI)
#pragma unroll
            for (int dh = 0; dh < 2; ++dh) vf[2 * sI + dh] = readvf(t, sI, dh); };
    auto pv = [&](int t) {
#pragma unroll
        for (int sI = 0; sI < 4; ++sI)
#pragma unroll
            for (int dh = 0; dh < 2; ++dh) {
                const bf16x8 v = sI < VPRE ? vf[2 * (sI < VPRE ? sI : 0) + dh] : readvf(t, sI, dh);
                o0[dh] = __builtin_amdgcn_mfma_f32_32x32x16_bf16(v, pa0[sI], o0[dh], 0, 0, 0);
                if (TWO) o1[dh] = __builtin_amdgcn_mfma_f32_32x32x16_bf16(v, pa1[sI], o1[dh], 0, 0, 0);
            } };
    const int qpos = qb * UQ + rs * 32 + l31;
    const int qc = rs * 32 + l31, cs = qc - 8 < 0 ? 0 : (qc - 8 > 48 ? 48 : qc - 8);
    const LAS float* rpb = (const LAS float*)(F.lds + AT_RPB) + hq * 465;
    issueK(0); stashK(0); issueK(1); issueV(0);
    WG_BAR();
    constexpr bool KHOLD = !TWO || HP;
    if (KHOLD) loadkf(0);
    if (ILV) {
#define SBAR() __builtin_amdgcn_sched_barrier(0)
    auto loadkf1 = [&](int t, int j) { const LAS unsigned char* kb = F.lds + KB(t) + kboff; kf[j] = *(const LAS bf16x8*)(kb + (j & 1) * 32 * SK + (j >> 1) * 32); };
    constexpr int NB = TWO ? 2 : 4;
    constexpr int NG = TWO ? 16 : 8;
    bf16x8 vr[NB];
    auto stage = [&](int t) {
        if (t + 1 < NT) stashK(t + 1);
        stashV(t);
        if (t + 2 < NT) issueK(t + 2);
        if (t + 1 < NT) issueV(t + 1); };
    auto qk = [&](int t, f32x16& p0, f32x16& p1, f32x16& r0_, f32x16& r1_) {
        if (DUAL) {
            const LAS unsigned char* kb = F.lds + KB(t) + kboff;
            bf16x8 kr[2][2];
#pragma unroll
            for (int d0 = 0; d0 < 2; ++d0) { kr[d0][0] = *(const LAS bf16x8*)(kb + d0 * 32); kr[d0][1] = *(const LAS bf16x8*)(kb + 32 * SK + d0 * 32); }
#pragma unroll
            for (int d0 = 0; d0 < 4; ++d0) {
                SBAR();
                p0 = __builtin_amdgcn_mfma_f32_32x32x16_bf16(kr[d0 & 1][0], qf[d0], p0, 0, 0, 0); p1 = __builtin_amdgcn_mfma_f32_32x32x16_bf16(kr[d0 & 1][1], qf[d0], p1, 0, 0, 0);
                r0_ = __builtin_amdgcn_mfma_f32_32x32x16_bf16(kr[d0 & 1][0], qg[DUAL ? d0 : 0], r0_, 0, 0, 0); r1_ = __builtin_amdgcn_mfma_f32_32x32x16_bf16(kr[d0 & 1][1], qg[DUAL ? d0 : 0], r1_, 0, 0, 0);
                if (d0 + 2 < 4) { kr[d0 & 1][0] = *(const LAS bf16x8*)(kb + (d0 + 2) * 32); kr[d0 & 1][1] = *(const LAS bf16x8*)(kb + 32 * SK + (d0 + 2) * 32); }
                if (MK_QKFIRST == 4 && t > 0 && d0 == MK_QKSPLIT) {
#pragma unroll
                    for (int f = 0; f < NB; ++f) vr[f] = readvf(t - 1, f >> 1, f & 1);
                    stage(t); }
            }
            SBAR();
            return;
        }
#pragma unroll
        for (int d0 = 0; d0 < (DIFF ? 2 : 4); ++d0) { p0 = __builtin_amdgcn_mfma_f32_32x32x16_bf16(kf[2 * d0], qf[d0], p0, 0, 0, 0); p1 = __builtin_amdgcn_mfma_f32_32x32x16_bf16(kf[2 * d0 + 1], qf[d0], p1, 0, 0, 0); }
        if (DIFF) {
#pragma unroll
            for (int d0 = 2; d0 < 4; ++d0) { r0_ = __builtin_amdgcn_mfma_f32_32x32x16_bf16(kf[2 * d0], qf[d0], r0_, 0, 0, 0); r1_ = __builtin_amdgcn_mfma_f32_32x32x16_bf16(kf[2 * d0 + 1], qf[d0], r1_, 0, 0, 0); }
        } };
    auto init_acc = [&](int t, f32x16& p0, f32x16& p1, f32x16& r0_, f32x16& r1_) {
        const bool local = t < nloc;
        p0 = f32x16{}; p1 = f32x16{}; r0_ = f32x16{}; r1_ = f32x16{};
        if (MIX == 0 && local) {
            const int dj = loc0 + t - qb;
            if (dj <= -2 || dj >= 2) {
                const int mb = (loc0 + t) * 64 + 4 * hi - qpos + 128;
#pragma unroll
                for (int r = 0; r < 16; ++r) { const int kc = (r & 3) + 8 * (r >> 2);
                    if ((unsigned)(mb + kc) > 256u) { p0[r] = -INFINITY; if (DUAL) r0_[r] = -INFINITY; } if ((unsigned)(mb + kc + 32) > 256u) { p1[r] = -INFINITY; if (DUAL) r1_[r] = -INFINITY; } }
            }
        }
        if (MIX == 1 && local) {
            const int dr = (loc0 + t) - qb + 7;
            const int kh = 4 * hi - cs; const LAS float* rp = rpb + dr * 31 + 15 - qc + 4 * hi;
            float bb0[16], bb1[16];
#pragma unroll
            for (int r = 0; r < 16; ++r) { const int kc = (r & 3) + 8 * (r >> 2); bb0[r] = rp[kc]; bb1[r] = rp[kc + 32]; }
#pragma unroll
            for (int r = 0; r < 16; ++r) { asm volatile("" : "+v"(bb0[r]), "+v"(bb1[r])); }
#pragma unroll
            for (int r = 0; r < 16; ++r) { const int kc = (r & 3) + 8 * (r >> 2);
                const bool v0 = (unsigned)(kh + kc) < 16u, v1 = (unsigned)(kh + kc + 32) < 16u;
                p0[r] = v0 ? bb0[r] : -INFINITY; p1[r] = v1 ? bb1[r] : -INFINITY; }
        } };
    auto sm_exp = [&](f32x16& a0, f32x16& a1, int q, float& sum) {
#pragma unroll
        for (int j = 0; j < 4; ++j) { const int r = 4 * (q & 3) + j;
            if (q < 4) { a0[r] = __builtin_amdgcn_exp2f(a0[r]); sum += a0[r]; } else { a1[r] = __builtin_amdgcn_exp2f(a1[r]); sum += a1[r]; } } };
    auto sm_cvt = [&](const f32x16& a0, const f32x16& a1, int q, bf16x8 (&pa)[4]) {
        const int r = 4 * (q & 3);
        const unsigned lo = q < 4 ? pk2(a0[r], a0[r + 1]) : pk2(a1[r], a1[r + 1]), hi2 = q < 4 ? pk2(a0[r + 2], a0[r + 3]) : pk2(a1[r + 2], a1[r + 3]);
        u32x4 w = __builtin_bit_cast(u32x4, pa[q >> 1]);
        if (q & 1) { w.z = lo; w.w = hi2; } else { w.x = lo; w.y = hi2; }
        pa[q >> 1] = __builtin_bit_cast(bf16x8, w); };
    {
        if (!KHOLD && !DUAL) loadkf(0);
        stage(0);
        f32x16 p0, p1, r0_, r1_;
        init_acc(0, p0, p1, r0_, r1_);
        qk(0, p0, p1, r0_, r1_);
        softmax_tile(p0, p1, l0, pa0);
        if (TWO) softmax_tile(r0_, r1_, l1, pa1);
        WG_BAR();
        if (KHOLD && 1 < NT) loadkf(1);
    }
    SEG0();
    for (int t = 1; t < NT; ++t) {
        f32x16 p0, p1, r0_, r1_;
        if (MK_QKFIRST) {
            if (!KHOLD && !DUAL) loadkf(t);
            if (MK_QKFIRST == 2) {
#pragma unroll
                for (int f = 0; f < NB; ++f) vr[f] = readvf(t - 1, f >> 1, f & 1); }
            init_acc(t, p0, p1, r0_, r1_);
            qk(t, p0, p1, r0_, r1_);
            if (MK_QKFIRST != 2 && !(MK_QKFIRST == 4 && DUAL)) {
#pragma unroll
                for (int f = 0; f < NB; ++f) vr[f] = readvf(t - 1, f >> 1, f & 1); }
            if (MK_QKFIRST != 3 && !(MK_QKFIRST == 4 && DUAL)) stage(t);
        } else {
#pragma unroll
        for (int f = 0; f < NB; ++f) vr[f] = readvf(t - 1, f >> 1, f & 1);
        if (!KHOLD && !DUAL) loadkf(t);
        stage(t);
        init_acc(t, p0, p1, r0_, r1_);
        SEG(1);
        qk(t, p0, p1, r0_, r1_);
        SEG(0);
        }
#pragma unroll
        for (int g = 0; g < NG; ++g) {
            SBAR();
            if (MID && g == NG / 2) { WG_BAR(); SBAR(); }
            if (MID && !TWO && g >= NG - 4) { loadkf1(t + 1, 2 * (g - (NG - 4))); loadkf1(t + 1, 2 * (g - (NG - 4)) + 1); }
            if (TWO) {
                const int f = g >> 1, h = g & 1, sI = g >> 2, dh = (g >> 1) & 1;
                if (h == 0) o0[dh] = __builtin_amdgcn_mfma_f32_32x32x16_bf16(vr[f % NB], pa0[sI], o0[dh], 0, 0, 0);
                else { o1[dh] = __builtin_amdgcn_mfma_f32_32x32x16_bf16(vr[f % NB], pa1[sI], o1[dh], 0, 0, 0);
                    if (f + NB < 8) vr[f % NB] = readvf(t - 1, (f + NB) >> 1, (f + NB) & 1); }
                if (h == 0) sm_exp(p0, p1, g >> 1, l0); else sm_exp(r0_, r1_, g >> 1, l1);
                if (g >= 3 && ((g - 3) & 3) == 0) { const int k = (g - 3) >> 2; sm_cvt(p0, p1, 2 * k, pa0); sm_cvt(p0, p1, 2 * k + 1, pa0); }
                if (g >= 4 && ((g - 4) & 3) == 0) { const int k = (g - 4) >> 2; sm_cvt(r0_, r1_, 2 * k, pa1); sm_cvt(r0_, r1_, 2 * k + 1, pa1); }
            } else {
                const int f = g, sI = g >> 1, dh = g & 1;
                o0[dh] = __builtin_amdgcn_mfma_f32_32x32x16_bf16(vr[f % NB], pa0[sI], o0[dh], 0, 0, 0);
                if (f + NB < 8) vr[f % NB] = readvf(t - 1, (f + NB) >> 1, (f + NB) & 1);
                sm_exp(p0, p1, g, l0);
                if (g >= 2 && (g & 1) == 0) { const int k = (g - 2) >> 1; sm_cvt(p0, p1, 2 * k, pa0); sm_cvt(p0, p1, 2 * k + 1, pa0); }
            }
        }
        SBAR();
        if (MK_QKFIRST == 3) stage(t);
        if (TWO) { sm_cvt(r0_, r1_, 6, pa1); sm_cvt(r0_, r1_, 7, pa1); }
        else { sm_cvt(p0, p1, 6, pa0); sm_cvt(p0, p1, 7, pa0); }
        if (MID && TWO) {
#pragma unroll
            for (int j = 0; j < 8; ++j) loadkf1(t + 1, j); }
        SEG(2);
        if (!MID) WG_BAR();
        SEG(3);
        if (KHOLD && !MID && t + 1 < NT) loadkf(t + 1);
    }
    loadvf(NT - 1); pv(NT - 1);
    } else {
    for (int t = 0; t < NT; ++t) {
        if (t > 0) loadvf(t - 1);
        if (!KHOLD) loadkf(t);
        MK_SB();
        if (t + 1 < NT) stashK(t + 1);
        stashV(t);
        if (t + 2 < NT) issueK(t + 2);
        if (t + 1 < NT) issueV(t + 1);
        const bool local = t < nloc;
        f32x16 p0 = f32x16{}, p1 = f32x16{}, r0_ = f32x16{}, r1_ = f32x16{};
#pragma unroll
        for (int d0 = 0; d0 < (DIFF ? 2 : 4); ++d0) { p0 = __builtin_amdgcn_mfma_f32_32x32x16_bf16(kf[2 * d0], qf[d0], p0, 0, 0, 0); p1 = __builtin_amdgcn_mfma_f32_32x32x16_bf16(kf[2 * d0 + 1], qf[d0], p1, 0, 0, 0); }
        MK_SB();
        if (t > 0) pv(t - 1);
        if (DIFF) {
#pragma unroll
            for (int d0 = 2; d0 < 4; ++d0) { r0_ = __builtin_amdgcn_mfma_f32_32x32x16_bf16(kf[2 * d0], qf[d0], r0_, 0, 0, 0); r1_ = __builtin_amdgcn_mfma_f32_32x32x16_bf16(kf[2 * d0 + 1], qf[d0], r1_, 0, 0, 0); }
        }
        if (DUAL) {
#pragma unroll
            for (int d0 = 0; d0 < 4; ++d0) { r0_ = __builtin_amdgcn_mfma_f32_32x32x16_bf16(kf[2 * d0], qg[DUAL ? d0 : 0], r0_, 0, 0, 0); r1_ = __builtin_amdgcn_mfma_f32_32x32x16_bf16(kf[2 * d0 + 1], qg[DUAL ? d0 : 0], r1_, 0, 0, 0); }
        }
        MK_SB();
        if (MIX == 0 && local) {
            const int mb = (loc0 + t) * 64 + 4 * hi - qpos + 128;
#pragma unroll
            for (int r = 0; r < 16; ++r) { const int kc = (r & 3) + 8 * (r >> 2);
                if ((unsigned)(mb + kc) > 256u) { p0[r] = -INFINITY; if (DUAL) r0_[r] = -INFINITY; } if ((unsigned)(mb + kc + 32) > 256u) { p1[r] = -INFINITY; if (DUAL) r1_[r] = -INFINITY; } }
        }
        if (MIX == 1 && local) {
            const int dr = (loc0 + t) - qb + 7;
            const int kh = 4 * hi - cs; const LAS float* rp = rpb + dr * 31 + 15 - qc + 4 * hi;
#pragma unroll
            for (int r = 0; r < 16; ++r) { const int kc = (r & 3) + 8 * (r >> 2);
                const bool v0 = (unsigned)(kh + kc) < 16u, v1 = (unsigned)(kh + kc + 32) < 16u;
                const float b0 = rp[kc], b1 = rp[kc + 32];
                p0[r] = v0 ? p0[r] + b0 : -INFINITY; p1[r] = v1 ? p1[r] + b1 : -INFINITY; }
        }
        softmax_tile(p0, p1, l0, pa0);
        if (TWO) softmax_tile(r0_, r1_, l1, pa1);
        WG_BAR();
        if (KHOLD && t + 1 < NT) loadkf(t + 1);
    }
    loadvf(NT - 1); pv(NT - 1);
    }
    { refresh(F); const int l31f = F.lane & 31, hif = F.lane >> 5;
      const float lt0 = x32_sum(l0); const float i0 = 1.0f / lt0;
      float sc1 = 0.f;
      if (DIFF) { const float lt1 = x32_sum(l1); sc1 = tab[TAB_LAM + L] / lt1; }
      if (DUAL) { const float lt1 = x32_sum(l1); sc1 = 1.0f / lt1; }
      float ss = 0.f, ss1 = 0.f;
#pragma unroll
      for (int dh = 0; dh < 2; ++dh)
#pragma unroll
          for (int r = 0; r < 16; ++r) { float v = o0[dh][r] * i0; if (DIFF) v -= o1[dh][r] * sc1; o0[dh][r] = v; ss += v * v;
              if (DUAL) { const float v1 = o1[dh][r] * sc1; o1[dh][r] = v1; ss1 += v1 * v1; } }
      ss = x32_sum(ss); if (DUAL) ss1 = x32_sum(ss1);
      float scl;
      if (DIFF) scl = __builtin_amdgcn_rsqf(ss * (1.f / 64.f) + EPS) * tab[TAB_LAM + DEPTH + L];
      else {
          LAS float* gss = (LAS float*)(F.lds + AT_GSS);
          if (hif == 0) { gss[(rs * 32 + l31f) * 4 + hq] = ss; if (DUAL) gss[(rs * 32 + l31f) * 4 + hq + 1] = ss1; }
          WG_BAR();
          const f32x4 g4 = *(const LAS f32x4*)(gss + (rs * 32 + l31f) * 4);
          scl = __builtin_amdgcn_rsqf(((g4.x + g4.y) + (g4.z + g4.w)) * (1.f / 256.f) + EPS);
      }
      int lf = l31f;
      const int qrow_f = isctx ? NLAT + b * CTXL + qb * UQ + rs * 32 + lf : b * SEQ + qb * UQ + rs * 32 + lf;
      GAS bf16_t* yp = Y + (size_t)qrow_f * D + MIX * 256 + hq * 64 + 4 * hif;
#pragma unroll
      for (int dh = 0; dh < 2; ++dh)
#pragma unroll
          for (int g = 0; g < 4; ++g) { u32x2 o; o.x = pk2(o0[dh][4 * g] * scl, o0[dh][4 * g + 1] * scl); o.y = pk2(o0[dh][4 * g + 2] * scl, o0[dh][4 * g + 3] * scl);
              *(GAS u32x2*)(yp + dh * 32 + 8 * g) = o;
              if (DUAL) { u32x2 o2; o2.x = pk2(o1[dh][4 * g] * scl, o1[dh][4 * g + 1] * scl); o2.y = pk2(o1[dh][4 * g + 2] * scl, o1[dh][4 * g + 3] * scl);
                  *(GAS u32x2*)(yp + 64 + dh * 32 + 8 * g) = o2; } }
    }
#ifdef MK_STAMP
    if (MIX == MK_STAMP && F.tid == MK_STAMP_TID) { LAS unsigned* m_ = (LAS unsigned*)(F.lds + MISC_OFF); const unsigned a_ = m_[20]; unsigned z_ = 0; asm volatile("" : "+v"(z_)); m_[20] = z_;
        if (!isctx) { __hip_atomic_fetch_add(CTL(F) + 2048, a_, __ATOMIC_RELAXED, __HIP_MEMORY_SCOPE_AGENT); __hip_atomic_fetch_add(CTL(F) + 2049, (unsigned)(NT - 1), __ATOMIC_RELAXED, __HIP_MEMORY_SCOPE_AGENT); } }
#endif
}

template <int MIX>
__device__ __forceinline__ void run_mixer(FARGS, int L, bool need_ctx) {
    constexpr bool DUAL = (MIX == 3) && MK_DUAL, HP = (MIX == 2) && MK_CHP;
    constexpr int NU = DUAL ? 512 : 1024, NC = DUAL ? 64 : 128;
    const int G = F.G;
    const int c = (G % 8 == 0) ? (F.bx % 8) * (G / 8) + F.bx / 8 : F.bx;
    const int nlat = c < NU ? (NU - c + G - 1) / G : 0;
    const int j = (MIX & 1) ? c - 128 : c;
    const bool has_ctx = need_ctx && j >= 0 && j < NC;
    const int n = nlat + (has_ctx ? 1 : 0);
    for (int k = 0; k < n; ++k) { const bool isctx = k >= nlat; const int i = isctx ? j : c + k * G;
        int b, qb, hp = 0;
        if (HP) { if (isctx) { b = i >> 2; qb = (i >> 1) & 1; hp = i & 1; } else { b = i >> 5; qb = (i & 31) >> 1; hp = i & 1; } }
        else if (DUAL) { if (isctx) { b = i >> 1; qb = i & 1; } else { b = i >> 4; qb = i & 15; } }
        else { if (isctx) { b = i >> 2; qb = i & 3; } else { b = i >> 5; qb = i & 31; } }
        attn_unit<MIX>(F, L, b, qb, isctx, hp); }
}
__device__ __forceinline__ void attn_phase(FARGS, int L, bool need_ctx) {
    refresh(F);
    { LAS float* rpb = (LAS float*)(F.lds + AT_RPB); const GAS float* src = INP(14) + L * 4 * 465;
      for (int i = F.tid; i < 4 * 465; i += 512) rpb[i] = src[i] * LOG2E; }
    __syncthreads();
#ifndef MK_DOUBLE_MIX
#define MK_DOUBLE_MIX -1
#endif
#define REPM(k) for (int rep_ = 0; rep_ < ((MK_DOUBLE_MIX == (k)) ? 2 : 1); ++rep_)
    REPM(2) run_mixer<2>(F, L, need_ctx);
    REPM(3) run_mixer<3>(F, L, need_ctx);
    REPM(1) run_mixer<1>(F, L, need_ctx);
    REPM(0) run_mixer<0>(F, L, need_ctx);
    __syncthreads();
}
struct ProbPlain {
    static constexpr bool GATHER = false;
    const GAS char* A; const GAS char* Bt; int K, lda, ldb; size_t hstepA, hstepB; pg8::Order ord;
    __device__ __forceinline__ bool next(int i, pg8::Unit& u) const { return ord.next(i, u); }
    template <int NH> __device__ __forceinline__ void a_off(const pg8::Unit& u, int tid, unsigned (&v)[NH][2]) const {
        int R0, C0, R1, C1; pg8::stage_rc(tid * 16, R0, C0); pg8::stage_rc(tid * 16 + 8192, R1, C1);
        v[0][0] = (unsigned)((u.pm * 256 + R0) * lda + C0) * 2u; v[0][1] = (unsigned)((u.pm * 256 + R1) * lda + C1) * 2u;
    }
    __device__ __forceinline__ const GAS char* b_tile(const pg8::Unit& u, int t) const { return Bt + ((size_t)u.pn * 256 * ldb + (size_t)t * 64) * 2; }
};
struct EpiU { static constexpr int SID = 0;
    static constexpr bool PERM = true; static constexpr int NSTORES = 32;
    GAS bf16_t* U;
    __device__ __forceinline__ void operator()(const f32x4 (&acc)[2][2][4][2], const pg8::Unit& u, int wr, int wc, int fr, int fq) const {
        const int row0 = u.pm * 256 + wr * 64 + fr, col0 = u.pn * 256 + wc * 32 + 8 * fq;
#pragma unroll
        for (int ai = 0; ai < 2; ++ai)
#pragma unroll
            for (int m = 0; m < 4; ++m) { int frx = fr; asm volatile("" : "+v"(frx)); GAS bf16_t* rowp = U + (size_t)(u.pm * 256 + wr * 64 + frx + ai * 128 + m * 16) * DIN + col0;
#pragma unroll
                for (int bj = 0; bj < 2; ++bj) { const f32x4 v0 = acc[ai][bj][m][0], v1 = acc[ai][bj][m][1];
                    u32x4 w; w.x = pk2(v0[0], v0[1]); w.y = pk2(v0[2], v0[3]); w.z = pk2(v1[0], v1[1]); w.w = pk2(v1[2], v1[3]);
                    *(GAS u32x4*)(rowp + bj * 128) = w; } }
    }
};
struct EpiQK { static constexpr int SID = 1;
    static constexpr bool PERM = true; static constexpr int NSTORES = 32;
    GAS bf16_t* U; const GAS float* tab; const GAS float* gwin; const GAS float* gna; const GAS float* gdiff; const GAS float* ggqa; LAS float* X; float vscale;
    __device__ __forceinline__ void operator()(const f32x4 (&acc)[2][2][4][2], const pg8::Unit& u, int wr, int wc, int fr_, int fq_) const {
        int fq = fq_, fr = fr_; asm volatile("" : "+v"(fq), "+v"(fr));
        const int pn = u.pn;
        const bool lat = u.pm < 256;
        int kind = 0, nbj = 0; bool isq = false, rope = false; const GAS float* g = gwin; float qs = 1.f;
        if (pn == 0) { kind = 1; nbj = 2; isq = true; rope = true; g = gwin; } else if (pn == 1) { kind = 1; nbj = 1; rope = true; g = gwin + 64; }
        else if (pn == 2) { kind = 1; nbj = 2; isq = true; g = gna; } else if (pn == 3) { kind = 1; nbj = 2; g = gna + 64; }
        else if (pn == 5) { kind = 2; nbj = 2; isq = true; rope = true; g = gdiff; } else if (pn == 6) { kind = 2; nbj = 2; rope = true; g = gdiff + 32; }
        else if (pn == 8) { kind = 1; nbj = 2; isq = true; rope = true; g = ggqa; } else if (pn == 9) { kind = 1; nbj = 1; rope = true; g = ggqa + 64; }
        rope = rope && lat;
        if (kind == 0) body<0, false, 0>(acc, u, wr, wc, fr, fq, isq, g);
        else if (kind == 2) { if (rope) body<2, true, 2>(acc, u, wr, wc, fr, fq, isq, g); else body<2, false, 2>(acc, u, wr, wc, fr, fq, isq, g); }
        else if (nbj == 2) { if (rope) body<1, true, 2>(acc, u, wr, wc, fr, fq, isq, g); else body<1, false, 2>(acc, u, wr, wc, fr, fq, isq, g); }
        else { if (rope) body<1, true, 1>(acc, u, wr, wc, fr, fq, isq, g); else body<1, false, 1>(acc, u, wr, wc, fr, fq, isq, g); }
    }
    template <int kind, bool rope, int nbj>
    __device__ __forceinline__ void body(const f32x4 (&acc)[2][2][4][2], const pg8::Unit& u, int wr, int wc, int fr, int fq, bool isq, const GAS float* g) const {
        const int pn = u.pn, lane = fr + 16 * fq;
        float qs = 1.f;
        if (isq) qs = (kind == 2 ? 0.17677669529663687f : 0.125f) * LOG2E;
        const int row0 = u.pm * 256 + wr * 64 + fr, col0 = pn * 256 + wc * 32 + 8 * fq;
        float gg[8];
        { const int dg = kind == 2 ? 8 * fq : 32 * (wc & 1) + 8 * fq; const f32x4 a = *(const GAS f32x4*)(g + dg), b = *(const GAS f32x4*)(g + dg + 4);
          gg[0] = a.x; gg[1] = a.y; gg[2] = a.z; gg[3] = a.w; gg[4] = b.x; gg[5] = b.y; gg[6] = b.z; gg[7] = b.w; }
        auto sumsq = [&](int ai, int m, int bj) -> float { const f32x4 v0 = acc[ai][bj][m][0], v1 = acc[ai][bj][m][1];
            float s = (v0[0] * v0[0] + v0[1] * v0[1]) + (v0[2] * v0[2] + v0[3] * v0[3]) + (v1[0] * v1[0] + v1[1] * v1[1]) + (v1[2] * v1[2] + v1[3] * v1[3]);
            s += sx(s, lane, 16); s += sx(s, lane, 32); return s; };
        LAS float* Xw = X + (wr * 64 + fr) * 8 + wc; const LAS float* Xr = X + (wr * 64 + fr) * 8 + (wc ^ 1);
        float ssv[2][4][2];
#pragma unroll
        for (int ai = 0; ai < 2; ++ai)
#pragma unroll
            for (int m = 0; m < 4; ++m) { ssv[ai][m][0] = 0.f; ssv[ai][m][1] = 0.f; }
        if (kind == 1) {
#pragma unroll
            for (int ai = 0; ai < 2; ++ai)
#pragma unroll
                for (int m = 0; m < 4; ++m)
#pragma unroll
                    for (int bj = 0; bj < 2; ++bj) { const float s = sumsq(ai, m, bj); ssv[ai][m][bj] = s; if (fq == 0) Xw[(ai * 128 + m * 16) * 8 + bj * 4] = s; }
            asm volatile("s_waitcnt lgkmcnt(0)\n\ts_barrier" ::: "memory");
        }
        const int pxor = kind == 2 ? 16 : 32;
        const bool first = kind == 2 ? !(fq & 1) : (fq < 2);
        auto load_cs = [&](int it, f32x4 (&dst)[4]) {
            int frx = fr; asm volatile("" : "+v"(frx));
            const int row = u.pm * 256 + (it >> 2) * 128 + wr * 64 + (it & 3) * 16 + frx, s_ = row & 2047, prow = s_ >> 6, pcol = s_ & 63;
            const GAS float* tp = kind == 2 ? tab + TAB_T32 + ((fq < 2 ? prow : pcol) * 8) * 2 : tab + TAB_T64 + (((wc & 1) ? pcol : prow) * 16 + 8 * (fq & 1)) * 2;
#pragma unroll
            for (int e2 = 0; e2 < 4; ++e2) dst[e2] = *(const GAS f32x4*)(tp + 4 * e2); };
        f32x4 cs[4], ncs[4];
        if (rope) load_cs(0, cs);
#pragma unroll
        for (int ai = 0; ai < 2; ++ai)
#pragma unroll
            for (int m = 0; m < 4; ++m) {
                int frx = fr; asm volatile("" : "+v"(frx));
                const int rit = ai * 128 + wr * 64 + m * 16 + frx, row = u.pm * 256 + rit;
                GAS bf16_t* rowp = U + (size_t)row * DIN + col0;
                if (rope && ai * 4 + m < 7) load_cs(ai * 4 + m + 1, ncs);
                asm volatile("" ::: "memory");
#pragma unroll
                for (int bj = 0; bj < 2; ++bj) {
                    const f32x4 v0 = acc[ai][bj][m][0], v1 = acc[ai][bj][m][1];
                    float x[8] = {v0[0], v0[1], v0[2], v0[3], v1[0], v1[1], v1[2], v1[3]};
                    if (kind != 0 && bj < nbj) {
                        float ss;
                        if (kind == 1) ss = ssv[ai][m][bj] + Xr[(ai * 128 + m * 16) * 8 + bj * 4]; else ss = sumsq(ai, m, bj);
                        const float rq = qs * __builtin_amdgcn_rsqf(ss * (kind == 2 ? (1.f / 32.f) : (1.f / 64.f)) + EPS);
#pragma unroll
                        for (int e = 0; e < 8; ++e) x[e] = x[e] * gg[e];
                        if (rope) {
#pragma unroll
                            for (int e2 = 0; e2 < 4; ++e2) {
                                const float pa = sx(x[2 * e2], lane, pxor), pb = sx(x[2 * e2 + 1], lane, pxor);
                                x[2 * e2] = first ? x[2 * e2] * cs[e2].x - pa * cs[e2].y : pa * cs[e2].y + x[2 * e2] * cs[e2].x;
                                x[2 * e2 + 1] = first ? x[2 * e2 + 1] * cs[e2].z - pb * cs[e2].w : pb * cs[e2].w + x[2 * e2 + 1] * cs[e2].z;
                            }
                        }
#pragma unroll
                        for (int e = 0; e < 8; ++e) x[e] *= rq;
                    } else {
#pragma unroll
                        for (int e = 0; e < 8; ++e) x[e] *= vscale;
                    }
                    u32x4 w; w.x = pk2(x[0], x[1]); w.y = pk2(x[2], x[3]); w.z = pk2(x[4], x[5]); w.w = pk2(x[6], x[7]);
                    *(GAS u32x4*)(rowp + bj * 128) = w;
                }
#pragma unroll
                for (int e2 = 0; e2 < 4; ++e2) cs[e2] = ncs[e2];
            }
    }
};
struct EpiResid { static constexpr int SID = 2;
    static constexpr bool PERM = true; static constexpr int NSTORES = 32;
    const GAS float* slat; const GAS float* sctx; GAS bf16_t* XB; const GAS float* gate; bool first; float ascale;
    __device__ __forceinline__ void operator()(const f32x4 (&acc)[2][2][4][2], const pg8::Unit& u, int wr, int wc, int fr_, int fq) const {
        int fr = fr_; asm volatile("" : "+v"(fr));
        if (first) body<true>(acc, u, wr, wc, fr, fq); else body<false>(acc, u, wr, wc, fr, fq);
    }
    template <bool FIRST>
    __device__ __forceinline__ void body(const f32x4 (&acc)[2][2][4][2], const pg8::Unit& u, int wr, int wc, int fr, int fq) const {
        const bool islat = u.pm < 256; const int b = islat ? (u.pm >> 3) : 32;
        const GAS float* src = islat ? slat + (size_t)u.pm * 256 * D : sctx + (size_t)(u.pm - 256) * 256 * D;
        GAS bf16_t* dst = XB + (size_t)u.pm * 256 * D;
        const GAS float* gp = gate + (size_t)b * ADA;
        const int col0 = u.pn * 256 + wc * 32 + 8 * fq;
        f32x4 gv[2][2];
#pragma unroll
        for (int bj = 0; bj < 2; ++bj)
#pragma unroll
            for (int n = 0; n < 2; ++n) gv[bj][n] = *(const GAS f32x4*)(gp + col0 + bj * 128 + n * 4) * ascale;
        if (FIRST) {
#pragma unroll
            for (int ai = 0; ai < 2; ++ai)
#pragma unroll
                for (int m = 0; m < 4; ++m) {
                    const size_t ro = (size_t)(ai * 128 + wr * 64 + m * 16 + fr) * D + col0;
#pragma unroll
                    for (int bj = 0; bj < 2; ++bj) { f32x4 x0 = *(const GAS f32x4*)(src + ro + bj * 128), x1 = *(const GAS f32x4*)(src + ro + bj * 128 + 4);
                        x0 = x0 + gv[bj][0] * acc[ai][bj][m][0]; x1 = x1 + gv[bj][1] * acc[ai][bj][m][1];
                        u32x4 o; o.x = pk2(x0[0], x0[1]); o.y = pk2(x0[2], x0[3]); o.z = pk2(x1[0], x1[1]); o.w = pk2(x1[2], x1[3]);
                        *(GAS u32x4*)(dst + ro + bj * 128) = o; } }
        } else {
            u32x4 wv[2][4][2];
#pragma unroll
            for (int ai = 0; ai < 2; ++ai)
#pragma unroll
                for (int m = 0; m < 4; ++m) { const size_t ro = (size_t)(ai * 128 + wr * 64 + m * 16 + fr) * D + col0;
                    wv[ai][m][0] = *(const GAS u32x4*)(dst + ro); wv[ai][m][1] = *(const GAS u32x4*)(dst + ro + 128); }
#pragma unroll
            for (int ai = 0; ai < 2; ++ai)
#pragma unroll
                for (int m = 0; m < 4; ++m) { const size_t ro = (size_t)(ai * 128 + wr * 64 + m * 16 + fr) * D + col0;
#pragma unroll
                    for (int bj = 0; bj < 2; ++bj) { const u32x4 w = wv[ai][m][bj];
                        f32x4 x0 = (f32x4){bflo(w.x), bfhi(w.x), bflo(w.y), bfhi(w.y)}, x1 = (f32x4){bflo(w.z), bfhi(w.z), bflo(w.w), bfhi(w.w)};
                        x0 = x0 + gv[bj][0] * acc[ai][bj][m][0]; x1 = x1 + gv[bj][1] * acc[ai][bj][m][1];
                        u32x4 o; o.x = pk2(x0[0], x0[1]); o.y = pk2(x0[2], x0[3]); o.z = pk2(x1[0], x1[1]); o.w = pk2(x1[2], x1[3]);
                        *(GAS u32x4*)(dst + ro + bj * 128) = o; } }
        }
    }
};
struct MoeTab { const LAS int* tcls; const LAS int* trow; const LAS int* ccnt; };
__device__ __forceinline__ void moe_pair(int cls, int& ea, int& eb) { const int g = cls / 6, pr = cls % 6; const int ia = pr < 3 ? 0 : (pr < 5 ? 1 : 2), ib = pr < 3 ? pr + 1 : (pr < 5 ? pr - 1 : 3); ea = 4 * g + ia; eb = 4 * g + ib; }
__device__ __forceinline__ int moe_build_tables(FARGS, int L) {
    LAS int* tcls = (LAS int*)(F.lds + MOE_OFF); LAS int* trow = tcls + 320; LAS int* ccnt = trow + 320; LAS int* pre = ccnt + 32;
    if (F.tid < NCLS) ccnt[F.tid] = (int)__hip_atomic_load(CTL(F) + CW_CNT + (L * NCLS + F.tid) * 64, __ATOMIC_RELAXED, __HIP_MEMORY_SCOPE_AGENT);
    __syncthreads();
    if (F.tid == 0) { int T = 0;
#pragma unroll 1
        for (int c = 0; c < NCLS; ++c) { pre[c] = T; T += (ccnt[c] + 255) >> 8; }
        pre[NCLS] = T; }
    __syncthreads();
    const int T = pre[NCLS];
    if (F.tid < T) { int c = 0;
#pragma unroll 1
        for (int k = 1; k < NCLS; ++k) if (pre[k] <= F.tid) c = k;
        tcls[F.tid] = c; trow[F.tid] = (F.tid - pre[c]) * 256; }
    __syncthreads();
    return __builtin_amdgcn_readfirstlane(T);
}
struct ProbGateUp {
    static constexpr bool GATHER = true;
    const GAS char* A; const GAS char* W1; const GAS int* perm; int K, ldb; size_t hstepA, hstepB; pg8::Order ord; MoeTab tb;
    __device__ __forceinline__ bool next(int i, pg8::Unit& u) const { return ord.next(i, u); }
    template <int NH> __device__ __forceinline__ void a_off(const pg8::Unit& u, int tid, unsigned (&v)[NH][2]) const {
        int R0, C0, R1, C1; pg8::stage_rc(tid * 16, R0, C0); pg8::stage_rc(tid * 16 + 8192, R1, C1);
        const int cls = __builtin_amdgcn_readfirstlane(tb.tcls[u.pm]), tr = __builtin_amdgcn_readfirstlane(tb.trow[u.pm]), n = __builtin_amdgcn_readfirstlane(tb.ccnt[cls]);
        const GAS int* pp = perm + (size_t)cls * MTOT + tr;
#pragma unroll
        for (int h = 0; h < 2; ++h) { const int s0 = h * 128 + R0, s1 = h * 128 + R1;
            const int t0 = (tr + s0 < n) ? pp[s0] : 0, t1 = (tr + s1 < n) ? pp[s1] : 0;
            v[h][0] = (unsigned)(t0 * D + C0) * 2u; v[h][1] = (unsigned)(t1 * D + C1) * 2u; }
    }
    __device__ __forceinline__ const GAS char* b_tile(const pg8::Unit& u, int t) const {
        const int cls = __builtin_amdgcn_readfirstlane(tb.tcls[u.pm]); int ea, eb; moe_pair(cls, ea, eb); const int e = u.pn < 4 ? ea : eb;
        return W1 + (((size_t)e * 1024 + (u.pn & 3) * 256) * D + (size_t)t * 64) * 2;
    }
};
struct EpiGateUp { static constexpr int SID = 3;
    static constexpr bool PERM = true; static constexpr int NSTORES = 16;
    GAS bf16_t* ACT; const GAS int* perm; const GAS float* RW; MoeTab tb;
    __device__ __forceinline__ void operator()(const f32x4 (&acc)[2][2][4][2], const pg8::Unit& u, int wr, int wc, int fr, int fq) const {
        const int cls = __builtin_amdgcn_readfirstlane(tb.tcls[u.pm]), tr = __builtin_amdgcn_readfirstlane(tb.trow[u.pm]), n = __builtin_amdgcn_readfirstlane(tb.ccnt[cls]);
        const GAS int* pp = perm + (size_t)cls * MTOT + tr;
        const int wsel = u.pn >> 2, colb = wsel * 512 + (u.pn & 3) * 128 + wc * 32 + 8 * fq;
        int frx = fr; asm volatile("" : "+v"(frx));
        const int rbase = wr * 64 + frx;
        int tok[8]; float wgt[8];
#pragma unroll
        for (int i = 0; i < 8; ++i) { const int rr = (i >> 2) * 128 + (i & 3) * 16 + rbase; const int rc = rr < n - tr ? rr : n - tr - 1; tok[i] = pp[rc]; }
#pragma unroll
        for (int i = 0; i < 8; ++i) { const float w_ = RW[(size_t)tok[i] * 2 + wsel]; wgt[i] = w_; }
#pragma unroll
        for (int i = 0; i < 8; ++i) { const int rr = (i >> 2) * 128 + (i & 3) * 16 + rbase; if (!(tr + rr < n)) wgt[i] = 0.f; }
#pragma unroll
        for (int ai = 0; ai < 2; ++ai)
#pragma unroll
            for (int m = 0; m < 4; ++m) { const int rr = ai * 128 + m * 16 + rbase; const float wg = wgt[ai * 4 + m];
                float a[8];
#pragma unroll
                for (int nn = 0; nn < 2; ++nn)
#pragma unroll
                    for (int j = 0; j < 4; ++j) { const float g = acc[ai][0][m][nn][j], uu = acc[ai][1][m][nn][j];
                        a[nn * 4 + j] = g * __builtin_amdgcn_rcpf(1.0f + __builtin_amdgcn_exp2f(-g * LOG2E)) * uu * wg; }
                u32x4 w; w.x = pk2(a[0], a[1]); w.y = pk2(a[2], a[3]); w.z = pk2(a[4], a[5]); w.w = pk2(a[6], a[7]);
                *(GAS u32x4*)(ACT + (size_t)(u.pm * 256 + rr) * D + colb) = w; }
    }
};
struct ProbDown {
    static constexpr bool GATHER = false;
    const GAS char* A; const GAS char* W2; int K, ldb; size_t hstepA, hstepB; pg8::Order ord; MoeTab tb;
    __device__ __forceinline__ bool next(int i, pg8::Unit& u) const { return ord.next(i, u); }
    template <int NH> __device__ __forceinline__ void a_off(const pg8::Unit& u, int tid, unsigned (&v)[NH][2]) const {
        int R0, C0, R1, C1; pg8::stage_rc(tid * 16, R0, C0); pg8::stage_rc(tid * 16 + 8192, R1, C1);
        v[0][0] = (unsigned)((u.pm * 256 + R0) * D + C0) * 2u; v[0][1] = (unsigned)((u.pm * 256 + R1) * D + C1) * 2u;
    }
    __device__ __forceinline__ const GAS char* b_tile(const pg8::Unit& u, int t) const {
        const int cls = __builtin_amdgcn_readfirstlane(tb.tcls[u.pm]); int ea, eb; moe_pair(cls, ea, eb); const int e = t < 8 ? ea : eb;
        return W2 + (((size_t)e * 1024 + u.pn * 256) * DEXP + (size_t)(t & 7) * 64) * 2;
    }
};
template <bool LAST> struct EpiDown { static constexpr int SID = 4;
    static constexpr bool PERM = true; static constexpr int NSTORES = 0;
    GAS bf16_t* XB; GAS float* out; const GAS float* gate; const GAS int* perm; MoeTab tb;
    __device__ __forceinline__ void operator()(const f32x4 (&acc)[2][2][4][2], const pg8::Unit& u, int wr, int wc, int fr, int fq) const {
        const int cls = __builtin_amdgcn_readfirstlane(tb.tcls[u.pm]), tr = __builtin_amdgcn_readfirstlane(tb.trow[u.pm]), n = __builtin_amdgcn_readfirstlane(tb.ccnt[cls]);
        const GAS int* pp = perm + (size_t)cls * MTOT + tr;
        const int col0 = u.pn * 256 + wc * 32 + 8 * fq;
        int frx = fr; asm volatile("" : "+v"(frx));
        const int rbase = wr * 64 + frx;
        int tok8[8];
#pragma unroll
        for (int i = 0; i < 8; ++i) { const int rr = (i >> 2) * 128 + (i & 3) * 16 + rbase; const int rc = rr < n - tr ? rr : n - tr - 1; tok8[i] = pp[rc]; }
        u32x4 wv[4][2]; f32x4 gv[2][2][2];
        auto load_res = [&](int i) { const GAS bf16_t* xr = XB + (size_t)tok8[i] * D + col0; wv[i & 3][0] = *(const GAS u32x4*)xr; wv[i & 3][1] = *(const GAS u32x4*)(xr + 128); };
#pragma unroll
        for (int i = 0; i < 4; ++i) load_res(i);
        auto load_gate = [&](int i, f32x4 (&g)[2][2]) { const int tok = tok8[i]; const int b = tok < NLAT ? (tok >> 11) : 32; const GAS float* gp = gate + (size_t)b * ADA + col0;
#pragma unroll
            for (int bj = 0; bj < 2; ++bj) { g[bj][0] = *(const GAS f32x4*)(gp + bj * 128); g[bj][1] = *(const GAS f32x4*)(gp + bj * 128 + 4); } };
        load_gate(0, gv[0]);
#pragma unroll
        for (int i = 0; i < 8; ++i) { const int ai = i >> 2, m = i & 3;
            if (i + 1 < 8) load_gate(i + 1, gv[(i + 1) & 1]);
            __builtin_amdgcn_sched_barrier(0);
            const int rr = ai * 128 + m * 16 + rbase; const bool valid = tr + rr < n; const int tok = tok8[i];
#pragma unroll
            for (int bj = 0; bj < 2; ++bj) { const u32x4 w = wv[i & 3][bj];
                const f32x4 x0 = (f32x4){bflo(w.x), bfhi(w.x), bflo(w.y), bfhi(w.y)} + gv[i & 1][bj][0] * acc[ai][bj][m][0], x1 = (f32x4){bflo(w.z), bfhi(w.z), bflo(w.w), bfhi(w.w)} + gv[i & 1][bj][1] * acc[ai][bj][m][1];
                if (valid) {
                    if (LAST) { GAS float* op = out + (size_t)tok * D + col0 + bj * 128; *(GAS f32x4*)op = x0; *(GAS f32x4*)(op + 4) = x1; }
                    else { u32x4 o; o.x = pk2(x0[0], x0[1]); o.y = pk2(x0[2], x0[3]); o.z = pk2(x1[0], x1[1]); o.w = pk2(x1[2], x1[3]); *(GAS u32x4*)(XB + (size_t)tok * D + col0 + bj * 128) = o; } } }
            __builtin_amdgcn_sched_barrier(0);
            if (i + 4 < 8) load_res(i + 4);
        }
    }
};

constexpr int NPHASE = 1 + 8 * DEPTH;
__global__ void __launch_bounds__(NWAVES * 64, 2) mk_fwd(Args args) {
    extern __shared__ __attribute__((aligned(16))) unsigned char lds_raw[];
    Frame F;
    F.lds = (LAS unsigned char*)lds_raw;
    volatile LAS unsigned* MISC = (volatile LAS unsigned*)(F.lds + MISC_OFF);
    F.tid = threadIdx.x; F.lane = F.tid & 63; F.wave = __builtin_amdgcn_readfirstlane(F.tid >> 6); F.G = gridDim.x; F.bx = blockIdx.x;
    const bool t0 = F.tid == 0;
    F.ws = (GAS unsigned char*)args.ws; F.out = (GAS float*)args.out; F.ka = (kptr_t)__builtin_amdgcn_kernarg_segment_ptr();
    for (int u = F.tid; u < (LDS_BYTES - MISC_OFF) / 4; u += NWAVES * 64) ((LAS unsigned*)(F.lds + MISC_OFF))[u] = 0u;
    __syncthreads();
    XcdBarrier bar; bar.bar = (unsigned*)(CTL(F) + CW_BAR); bar.x = 0; bar.st = nullptr;
    if (args.use_bar) bar = xcd_barrier_post((unsigned*)(CTL(F) + CW_BAR), MISC + 8, t0);
    const int lo = args.ph_lo, hi = args.ph_hi;
#define IN(k) (lo <= (k) && (k) < hi)
#ifndef MK_BAR_REP
#define MK_BAR_REP 1
#endif
#ifdef MK_GSTAMP
#define GS_FLUSH() do { if (F.tid == MK_GSTAMP_TID) { LAS unsigned* m_ = (LAS unsigned*)(F.lds + MISC_OFF); const unsigned a_ = m_[16], n_ = m_[17]; unsigned z_ = 0; asm volatile("" : "+v"(z_)); m_[16] = z_; m_[17] = z_; \
    if (n_) { __hip_atomic_fetch_add(CTL(F) + 2048, a_, __ATOMIC_RELAXED, __HIP_MEMORY_SCOPE_AGENT); __hip_atomic_fetch_add(CTL(F) + 2049, n_, __ATOMIC_RELAXED, __HIP_MEMORY_SCOPE_AGENT); } } } while (0)
#else
#define GS_FLUSH() do {} while (0)
#endif
#define SEAM(k) do { GS_FLUSH(); if (IN(k) && IN((k) + 1)) { for (int br_ = 0; br_ < MK_BAR_REP; ++br_) { refresh(F); xcd_barrier(bar, F.tid == 0); } } } while (0)
#ifndef MK_PHMASK
#define MK_PHMASK 0x1ff
#endif
#define EN(k) ((MK_PHMASK >> (k)) & 1)
#ifndef MK_SEPARATE_QKPREP
#define MK_SEPARATE_QKPREP 0
#endif
#ifndef MK_DOUBLE
#define MK_DOUBLE -1
#endif
#define REP(k) for (int rep_ = 0; rep_ < ((MK_DOUBLE == (k)) ? 2 : 1); ++rep_)
#define XB_P ((GAS bf16_t*)(F.ws + WS_XB))
#define MOD_P ((const GAS float*)(F.ws + WS_MOD))
    if (EN(0) && IN(0)) { REP(0) prologue_phase(F); SEAM(0); }
    for (int L0 = 0; L0 < DEPTH; ++L0) {
        const int pb = 1 + 8 * L0;
        if (EN(1) && IN(pb + 0)) { int L = L0; OPAQUE_S(L); refresh(F);
            REP(1) norm_phase<false>(F, L, MTOT, L == 0, INP(6) + L * D, 0, 1024); SEAM(pb + 0); }
        if (EN(2) && IN(pb + 1)) { int L = L0; OPAQUE_S(L); refresh(F);
            ProbPlain P; P.A = (const GAS char*)(F.ws + WS_H); P.Bt = (const GAS char*)(F.ws + WS_WIN) + (size_t)L * DIN * D * 2; P.K = D; P.lda = D; P.ldb = D; P.hstepA = (size_t)128 * D * 2; P.hstepB = (size_t)128 * D * 2; P.ord.init(MTOT / 256, DIN / 256, F.G, F.bx);
            EpiQK E; E.U = (GAS bf16_t*)(F.ws + WS_U); E.tab = (const GAS float*)(F.ws + WS_TAB); E.gwin = INP(9) + L * 128; E.gna = INP(10) + L * 128; E.gdiff = INP(11) + L * 64; E.ggqa = INP(12) + L * 128;
            E.X = (LAS float*)(F.lds + MOE_OFF);
            E.vscale = 1.0f;
            REP(2) pg8::gemm_phase<EpiQK, ProbPlain>(F.lds, P, E, F.tid);
            SEAM(pb + 1);
        }
        if (MK_SEPARATE_QKPREP && EN(3) && IN(pb + 2)) { REP(3) qkprep_phase(F, L0, (MK_DOUBLE != 3) || rep_ == 1 || args.pad != 0); SEAM(pb + 2); }
        if (EN(4) && IN(pb + 3)) { REP(4) attn_phase(F, L0, L0 < DEPTH - 1); SEAM(pb + 3); }
        if (EN(5) && IN(pb + 4)) { int L = L0; OPAQUE_S(L); refresh(F);
            const int M2 = L < DEPTH - 1 ? MTOT : NLAT;
            ProbPlain P; P.A = (const GAS char*)(F.ws + WS_Y); P.Bt = (const GAS char*)(F.ws + WS_WOUT) + (size_t)L * D * D * 2; P.K = D; P.lda = D; P.ldb = D; P.hstepA = (size_t)128 * D * 2; P.hstepB = (size_t)128 * D * 2; P.ord.init(M2 / 256, D / 256, F.G, F.bx);
            EpiResid E; E.slat = INP(0); E.sctx = INP(2); E.XB = XB_P; E.first = L == 0; E.gate = MOD_P + (size_t)L * 33 * ADA + 2 * 1024;
#ifdef MK_PROBE_K2
            P.K = 2 * D; E.ascale = 0.5f;
#else
            E.ascale = 1.0f;
#endif
            pg8::gemm_phase<EpiResid, ProbPlain>(F.lds, P, E, F.tid);
            SEAM(pb + 4);
        }
        if (EN(6) && IN(pb + 5)) { int L = L0; OPAQUE_S(L); refresh(F);
#ifdef MK_OLD_NORM2
            REP(6) norm_phase<true>(F, L, L < DEPTH - 1 ? MTOT : NLAT, false, INP(7) + L * D, 3 * 1024, 4 * 1024, (MK_DOUBLE != 6) || rep_ == 1 || args.pad != 0); SEAM(pb + 5); }
#else
            norm2_phase(F, L, L < DEPTH - 1 ? MTOT : NLAT); SEAM(pb + 5); }
#endif
        if (EN(7) && IN(pb + 6)) { int L = L0; OPAQUE_S(L); refresh(F);
            const int T = moe_build_tables(F, L);
            MoeTab tb; tb.tcls = (const LAS int*)(F.lds + MOE_OFF); tb.trow = tb.tcls + 320; tb.ccnt = tb.trow + 320;
            ProbGateUp P; P.A = (const GAS char*)(F.ws + WS_H); P.W1 = (const GAS char*)(F.ws + WS_W1) + (size_t)L * NEXP * 1024 * D * 2; P.perm = (const GAS int*)(F.ws + WS_PERM); P.K = D; P.ldb = D; P.hstepA = 0; P.hstepB = (size_t)128 * D * 2; P.ord.init(T, 8, F.G, F.bx); P.tb = tb;
            EpiGateUp E; E.ACT = (GAS bf16_t*)(F.ws + WS_ACT); E.perm = P.perm; E.RW = (const GAS float*)(F.ws + WS_RW); E.tb = tb;
            REP(7) pg8::gemm_phase<EpiGateUp, ProbGateUp>(F.lds, P, E, F.tid);
            SEAM(pb + 6);
        }
        if (EN(8) && IN(pb + 7)) { int L = L0; OPAQUE_S(L); refresh(F);
            const int T = moe_build_tables(F, L);
            MoeTab tb; tb.tcls = (const LAS int*)(F.lds + MOE_OFF); tb.trow = tb.tcls + 320; tb.ccnt = tb.trow + 320;
            ProbDown P; P.A = (const GAS char*)(F.ws + WS_ACT); P.W2 = (const GAS char*)(F.ws + WS_W2) + (size_t)L * NEXP * 1024 * DEXP * 2; P.K = D; P.ldb = DEXP; P.hstepA = (size_t)128 * D * 2; P.hstepB = (size_t)128 * DEXP * 2; P.ord.init(T, 4, F.G, F.bx); P.tb = tb;
            if (L < DEPTH - 1) { EpiDown<false> E; E.XB = XB_P; E.out = F.out; E.gate = MOD_P + (size_t)L * 33 * ADA + 5 * 1024; E.perm = (const GAS int*)(F.ws + WS_PERM); E.tb = tb;
                pg8::gemm_phase<EpiDown<false>, ProbDown>(F.lds, P, E, F.tid); }
            else { EpiDown<true> E; E.XB = XB_P; E.out = F.out; E.gate = MOD_P + (size_t)L * 33 * ADA + 5 * 1024; E.perm = (const GAS int*)(F.ws + WS_PERM); E.tb = tb;
                pg8::gemm_phase<EpiDown<true>, ProbDown>(F.lds, P, E, F.tid); }
            SEAM(pb + 7);
        }
    }
#if defined(MK_STAMP) || defined(MK_GSTAMP)
    {
        refresh(F); xcd_barrier(bar, F.tid == 0); refresh(F);
        const unsigned num = __hip_atomic_load(CTL(F) + 2048, __ATOMIC_RELAXED, __HIP_MEMORY_SCOPE_AGENT), den = __hip_atomic_load(CTL(F) + 2049, __ATOMIC_RELAXED, __HIP_MEMORY_SCOPE_AGENT);
        const float smul = 1.0f + floorf(((float)num / (float)(den ? den : 1u)) * (1.0f / MK_STAMP_Q)) * 0.02f;
        GAS f32x4* o4 = (GAS f32x4*)F.out;
        for (size_t i = (size_t)F.bx * 512 + F.tid; i < (size_t)NLAT * D / 4; i += (size_t)F.G * 512) o4[i] = o4[i] * smul;
    }
#endif
#undef IN
#undef SEAM
}

#ifndef MK_PER_PHASE
#define MK_PER_PHASE 0
#endif
extern "C" void kernel_launch(void* const* d_in, const int* in_sizes, int n_in, void* d_out, int out_size, void* d_ws, size_t ws_size, hipStream_t stream) {
    static int grid = 0;
    if (grid == 0) {
        if (n_in != 23 || out_size != NLAT * D || ws_size < WS_END) { fprintf(stderr, "kernel_launch: unexpected shapes (n_in %d out %d ws %zu)\n", n_in, out_size, ws_size); grid = -1; return; }
        int dev = 0, cus = 0, per_cu = 0;
        if (hipGetDevice(&dev) != hipSuccess || hipDeviceGetAttribute(&cus, hipDeviceAttributeMultiprocessorCount, dev) != hipSuccess) { grid = -1; return; }
        if (hipFuncSetAttribute((const void*)mk_fwd, hipFuncAttributeMaxDynamicSharedMemorySize, LDS_BYTES) != hipSuccess) { fprintf(stderr, "kernel_launch: hipFuncSetAttribute failed\n"); grid = -1; return; }
        if (hipOccupancyMaxActiveBlocksPerMultiprocessor(&per_cu, (const void*)mk_fwd, NWAVES * 64, LDS_BYTES) != hipSuccess || per_cu < 1) fprintf(stderr, "kernel_launch: occupancy query reports %d\n", per_cu);
        (void)hipGetLastError();
        grid = cus;
    }
    if (grid < 0) return;
    (void)hipMemsetAsync((char*)d_ws + WS_CTL, 0, CTL_ZERO_BYTES, stream);
    Args a{};
    for (int i = 0; i < 23; ++i) a.in[i] = (const float*)d_in[i];
    a.out = (float*)d_out; a.ws = (unsigned char*)d_ws; a.pad = 0;
#if MK_PER_PHASE
    for (int p = 0; p < NPHASE; ++p) { a.ph_lo = p; a.ph_hi = p + 1; a.use_bar = 0; hipLaunchKernelGGL(mk_fwd, dim3(grid), dim3(NWAVES * 64), LDS_BYTES, stream, a); }
#else
    a.ph_lo = 0; a.ph_hi = NPHASE; a.use_bar = 1;
    hipLaunchKernelGGL(mk_fwd, dim3(grid), dim3(NWAVES * 64), LDS_BYTES, stream, a);
#endif
}
```

```cpp
#include <hip/hip_runtime.h>
#include <cstdio>
#include <cstdint>
#define GAS __attribute__((address_space(1)))
#define MK_ILV 15
#define XB_TMO      128
#define XB_XCNT(j)  (256  + 64 * (j))
#define XB_XSUB(j)  (1280 + 64 * (j))
#define XB_XGEN(j)  (2304 + 64 * (j))
#define XB_TOP      3328
#define XB_TOPGEN   3392
#define XCD_BAR_WORDS 3456
#define XB_SPIN_CAP (1u << 18)
#define LAS __attribute__((address_space(3)))

__device__ __forceinline__ unsigned xb_ld(unsigned* p)              { return __hip_atomic_load(p, __ATOMIC_RELAXED, __HIP_MEMORY_SCOPE_AGENT); }
__device__ __forceinline__ unsigned xb_add(unsigned* p, unsigned v) { return __hip_atomic_fetch_add(p, v, __ATOMIC_RELAXED, __HIP_MEMORY_SCOPE_AGENT); }
__device__ __forceinline__ unsigned xb_xcc_id() { return (unsigned)__builtin_amdgcn_s_getreg((3 << 11) | 20) & 0xFu; }
#define XB_SPIN(cond, bar) do { unsigned _sp = 0; while (cond) { __builtin_amdgcn_s_sleep(1); \
    if ((++_sp & 255u) == 0u) { if (xb_ld(&(bar)[XB_TMO])) break; if (_sp > XB_SPIN_CAP) { atomicAdd(&(bar)[XB_TMO], 1u); break; } } } } while (0)

struct XcdBarrier {
    unsigned* bar; unsigned x;
    volatile LAS unsigned* st;
};

__device__ __forceinline__ XcdBarrier xcd_barrier_post(unsigned* bar, volatile LAS unsigned* st, bool t0  ) {
    XcdBarrier b; b.bar = bar; b.x = xb_xcc_id(); b.st = st;
    if (t0) (void)xb_add(&bar[XB_XCNT(b.x)], 1u);
    return b;
}
__device__ __forceinline__ void xcd_barrier_complete(unsigned* bar, unsigned x, unsigned& nloc, unsigned& nx) {
    const unsigned G = gridDim.x * gridDim.y * gridDim.z;
    unsigned sum, cnt, mine, sp = 0u;
    for (;;) {
        sum = 0u; cnt = 0u; mine = 0u;
#pragma unroll
        for (unsigned j = 0; j < 16; ++j) { const unsigned c = xb_ld(&bar[XB_XCNT(j)]); sum += c; cnt += (c > 0u) ? 1u : 0u; mine = (j == x) ? c : mine; }
        if (sum == G) break;
        __builtin_amdgcn_s_sleep(1);
        if ((++sp & 255u) == 0u) { if (xb_ld(&bar[XB_TMO])) break; if (sp > XB_SPIN_CAP) { atomicAdd(&bar[XB_TMO], 1u); break; } }
    }
    nloc = mine > 0u ? mine : 1u; nx = cnt > 0u ? cnt : 1u;
}

__device__ __forceinline__ void xcd_barrier(const XcdBarrier& b, bool t0  ) {
    asm volatile("s_waitcnt vmcnt(0)" ::: "memory");
    __syncthreads();
    if (t0) {
        unsigned* bar = b.bar;
        __builtin_amdgcn_s_waitcnt(0);
        unsigned nloc = b.st[0], nx = b.st[1];
        if (nloc == 0u) { xcd_barrier_complete(bar, b.x, nloc, nx); b.st[0] = nloc; b.st[1] = nx; }
        const unsigned old = xb_add(&bar[XB_XSUB(b.x)], 1u);
        const unsigned gen = old / nloc;
        if (old + 1u == (gen + 1u) * nloc) {
            __builtin_amdgcn_fence(__ATOMIC_RELEASE, "agent");
            asm volatile("s_waitcnt vmcnt(0)" ::: "memory");
            const unsigned og = xb_add(&bar[XB_TOP], 1u);
            const unsigned tg = og / nx;
            if (og + 1u == (tg + 1u) * nx) xb_add(&bar[XB_TOPGEN], 1u);
            else XB_SPIN(xb_ld(&bar[XB_TOPGEN]) == tg, bar);
            __builtin_amdgcn_fence(__ATOMIC_ACQUIRE, "agent");
            xb_add(&bar[XB_XGEN(b.x)], 1u);
            asm volatile("s_waitcnt vmcnt(0)" ::: "memory");
        } else {
            XB_SPIN(xb_ld(&bar[XB_XGEN(b.x)]) == gen, bar);
            __builtin_amdgcn_fence(__ATOMIC_ACQUIRE, "agent");
            asm volatile("s_waitcnt vmcnt(0)" ::: "memory");
        }
    }
    __syncthreads();
}
constexpr int D = 1024, NBATCH = 32, SEQ = 2048, DEPTH = 4, CTXL = 256, NLAT = NBATCH * SEQ, NCTX = NBATCH * CTXL, MTOT = NLAT + NCTX, DIN = 2560;
constexpr int NEXP = 16, DEXP = 512, NCLS = 24, ADA = 6 * D;
constexpr float EPS = 1e-6f, LOG2E = 1.4426950408889634f;
constexpr int QA = 0, KA = 256, VA = 384, QB = 512, KB = 768, VB = 1024, QC = 1280, KC = 1536, VC = 1792, QD = 2048, KD = 2304, VD = 2432;
constexpr size_t MiB = 1u << 20;
constexpr size_t WS_CTL = 0, CTL_ZERO_BYTES = 128 * 1024;
constexpr size_t WS_MOD = 1 * MiB;
constexpr size_t WS_TAB = 4 * MiB + 256 * 1024;
constexpr size_t WS_RW = 4 * MiB + 320 * 1024;
constexpr size_t WS_PERM = 5 * MiB;
constexpr size_t WS_WIN = 12 * MiB;
constexpr size_t WS_WOUT = 32 * MiB;
constexpr size_t WS_W1 = 40 * MiB;
constexpr size_t WS_W2 = 168 * MiB;
constexpr size_t WS_XB = 232 * MiB;
constexpr size_t WS_Y = 376 * MiB;
constexpr size_t WS_U = 520 * MiB;
constexpr size_t WS_ACT = WS_U;
constexpr size_t WS_H = 880 * MiB;
constexpr size_t WS_END = 1024 * MiB;
static_assert(WS_MOD + (size_t)DEPTH * 33 * 6144 * 4 <= WS_TAB && WS_RW + (size_t)MTOT * 8 <= WS_PERM && WS_PERM + (size_t)NCLS * MTOT * 4 <= WS_WIN, "ws map");
constexpr int CW_BAR = 4096;
constexpr int CW_CNT = 16384;
static_assert((CW_CNT + DEPTH * NCLS * 64) * 4 <= (int)CTL_ZERO_BYTES && (CW_BAR + 3456) <= CW_CNT, "ctl");
constexpr int TAB_T64 = 0;
constexpr int TAB_T32 = 2048;
constexpr int TAB_LAM = 3072;
constexpr int NWAVES = 8;
constexpr int LDS_BYTES = 159744;
constexpr int RING_BYTES = 131072;
constexpr int MOE_OFF = 131072;
constexpr int NRM_OFF = 134144;
constexpr int MISC_OFF = 155648;
constexpr int AT_BUFB = 70656, AT_VOFF = 33792, AT_RPB = 141312, AT_GSS = 148992;

typedef unsigned short bf16_t;
typedef short bf16x8 __attribute__((ext_vector_type(8)));
typedef short s16x4 __attribute__((ext_vector_type(4)));
typedef float f32x4 __attribute__((ext_vector_type(4)));
typedef float f32x2 __attribute__((ext_vector_type(2)));
typedef float f32x16 __attribute__((ext_vector_type(16)));
typedef unsigned u32x4 __attribute__((ext_vector_type(4)));
typedef unsigned u32x2 __attribute__((ext_vector_type(2)));
typedef __bf16 bf16x2_t __attribute__((ext_vector_type(2)));

__device__ __forceinline__ unsigned pk2(float lo, float hi) { f32x2 v = {lo, hi}; bf16x2_t b = __builtin_convertvector(v, bf16x2_t); return __builtin_bit_cast(unsigned, b); }
__device__ __forceinline__ float bflo(unsigned w) { return __uint_as_float(w << 16); }
__device__ __forceinline__ float bfhi(unsigned w) { return __uint_as_float(w & 0xffff0000u); }
__device__ __forceinline__ float sx(float v, int lane, int m) { return __int_as_float(__builtin_amdgcn_ds_bpermute((lane ^ m) << 2, __float_as_int(v))); }
__device__ __forceinline__ float x32_sum(float v) { auto rr = __builtin_amdgcn_permlane32_swap(__float_as_uint(v), __float_as_uint(v), false, false); return __uint_as_float(rr[0]) + __uint_as_float(rr[1]); }
__device__ __forceinline__ float x32_max(float v) { auto rr = __builtin_amdgcn_permlane32_swap(__float_as_uint(v), __float_as_uint(v), false, false); return fmaxf(__uint_as_float(rr[0]), __uint_as_float(rr[1])); }
__device__ __forceinline__ float swap32(float v, bool upper_half) { auto rr = __builtin_amdgcn_permlane32_swap(__float_as_uint(v), __float_as_uint(v), false, false); return __uint_as_float(upper_half ? rr[0] : rr[1]); }
__device__ __forceinline__ float wave_sum(float v, int lane) {
#pragma unroll
    for (int o = 1; o < 32; o <<= 1) v += sx(v, lane, o);
    return x32_sum(v);
}
#define LDS_WAIT() asm volatile("s_waitcnt lgkmcnt(0)" ::: "memory")
#define WG_BAR() asm volatile("s_waitcnt lgkmcnt(0)\n\ts_barrier" ::: "memory")

struct Args { const float* in[23]; float* out; unsigned char* ws; int ph_lo, ph_hi, use_bar, pad; };
typedef __attribute__((address_space(4))) const unsigned char* kptr_t;
struct Frame {
    LAS unsigned char* lds;
    GAS unsigned char* ws;
    GAS float* out;
    kptr_t ka;
    int tid, lane, wave, G, bx;
};
#define FARGS Frame& F
typedef const GAS float* cfp_t;
__device__ __forceinline__ const GAS float* inp(const Frame& F, int i) { return *(__attribute__((address_space(4))) const cfp_t*)(F.ka + 8 * i); }
#define INP(i) inp(F, (i))
#define CTL(F) ((GAS unsigned*)((F).ws + WS_CTL))
__device__ __forceinline__ void refresh(Frame& F) {
    unsigned z = 0u; asm volatile("" : "+v"(z));
    const int ln = (int)__builtin_amdgcn_mbcnt_hi(~0u, __builtin_amdgcn_mbcnt_lo(~0u, z));
    F.lane = ln; F.tid = F.wave * 64 + ln;
    asm volatile("" : "+s"(F.ws)); asm volatile("" : "+s"(F.out)); asm volatile("" : "+s"(F.ka));
}
#define OPAQUE_S(x) asm volatile("" : "+s"(x))
namespace pg8 {
#define PG8_LAS __attribute__((address_space(3)))
#define PG8_GAS __attribute__((address_space(1)))
typedef unsigned short bf16_t;
typedef short bf16x8 __attribute__((ext_vector_type(8)));
typedef float f32x4 __attribute__((ext_vector_type(4)));
typedef unsigned u32x4 __attribute__((ext_vector_type(4)));
#ifndef MK_WGM
#define MK_WGM 8
#endif
constexpr int BM = 256, BK = 64, HALF = 128, HTB = HALF * BK * 2, STAGE_BYTES = 8 * HTB, NXCD = 8, WGM = MK_WGM;

__host__ __device__ __forceinline__ int lds_byte(int r, int c) { const int st = (r >> 4) * 2 + (c >> 5), rr = r & 15, cc = c & 31, ob = rr * 64 + cc * 2; return st * 1024 + (ob ^ (((ob >> 9) & 1) << 5)); }
__host__ __device__ __forceinline__ void stage_rc(int b, int& R, int& C) { const int st = b / 1024, sb = b % 1024, swz = sb ^ (((sb >> 9) & 1) << 5); R = (st >> 1) * 16 + swz / 64; C = (st & 1) * 32 + (swz % 64) / 2; }
__host__ __device__ __forceinline__ int perm32(int rho) { const int n = rho >> 4, i = rho & 15; return 8 * (i >> 2) + 4 * n + (i & 3); }

struct Unit { int pm, pn; };

struct Order {
    int nM, nN, nwg, G, c;
    __device__ __forceinline__ void init(int nM_, int nN_, int G_, int c_) { nM = nM_; nN = nN_; nwg = nM * nN; G = G_; c = c_; }
    __device__ __forceinline__ bool next(int i, Unit& u) const {
        const long L = (long)i * G + c; if (L >= nwg) return false;
        int wgid = (int)L; { const int q = nwg / NXCD, r = nwg % NXCD, xcd = wgid % NXCD, off = wgid / NXCD; wgid = (xcd < r ? xcd * (q + 1) : r * (q + 1) + (xcd - r) * q) + off; }
        const int nig = WGM * nN, gid = wgid / nig, fm = gid * WGM, gsz = (nM - fm) < WGM ? (nM - fm) : WGM;
        u.pm = __builtin_amdgcn_readfirstlane(fm + ((wgid % nig) % gsz)); u.pn = __builtin_amdgcn_readfirstlane((wgid % nig) / gsz); return true;
    }
};

__device__ __forceinline__ unsigned cvt_pk_bf16(float lo, float hi) { unsigned r; asm volatile("v_cvt_pk_bf16_f32 %0, %1, %2" : "=v"(r) : "v"(lo), "v"(hi)); return r; }

template <class Epi, class Prob>
__device__ __forceinline__ void gemm_phase(PG8_LAS unsigned char* lds, const Prob& P, const Epi& E, int tid) {
    const int wid = __builtin_amdgcn_readfirstlane(tid >> 6), lane = tid & 63, wr = wid >> 2, wc = wid & 3, fr = lane & 15, fq = lane >> 4;
    const int nt = P.K / BK;
#ifndef MK_EPISTAG
#define MK_EPISTAG 0
#endif
#ifndef MK_EPISTAG_CYC
#define MK_EPISTAG_CYC 50000
#endif
    if (MK_EPISTAG) {
        const int nwg_ = P.ord.nwg, G_ = P.ord.G, c_ = P.ord.c, cmax = (nwg_ + G_ - 1) / G_, cnt = c_ < nwg_ ? (nwg_ - c_ + G_ - 1) / G_ : 0, nfull = nwg_ - (cmax - 1) * G_;
        if (cnt < cmax && cnt > 0) {
            const int nslack = G_ - nfull, parts = nslack >= 3 * nfull ? 3 : (nslack >= nfull ? 1 : 0);
            if (parts > 0) {
                const unsigned delay = (unsigned)(MK_EPISTAG_CYC / (parts + 1)) * (unsigned)(1 + (c_ - nfull) % parts);
                const unsigned t0_ = (unsigned)__builtin_amdgcn_s_memtime();
                while ((unsigned)__builtin_amdgcn_s_memtime() - t0_ < delay) __builtin_amdgcn_s_sleep(16);
            }
        }
    }
    unsigned voffB[2];
    { int R0, C0, R1, C1; stage_rc(tid * 16, R0, C0); stage_rc(tid * 16 + 8192, R1, C1); const int Rb0 = Epi::PERM ? ((R0 & ~31) + perm32(R0 & 31)) : R0, Rb1 = Epi::PERM ? ((R1 & ~31) + perm32(R1 & 31)) : R1;
      voffB[0] = (unsigned)(Rb0 * P.ldb + C0) * 2u; voffB[1] = (unsigned)(Rb1 * P.ldb + C1) * 2u; }
    const size_t hstepB = P.hstepB;
    const unsigned ldsw = (unsigned)wid * 1024u;
    const int aoff = lds_byte(wr * 64 + fr, fq * 8), boff = lds_byte(wc * 32 + fr, fq * 8);
#define PG8_SA(b, h) (((b) * 2 + (h)) * HTB)
#define PG8_SB(b, h) ((4 + (b) * 2 + (h)) * HTB)
#define PG8_STAGE(bufoff, gbase, voff) do { _Pragma("unroll") for (int _i = 0; _i < 2; ++_i) \
        __builtin_amdgcn_global_load_lds((const PG8_GAS unsigned*)((const PG8_GAS char*)(gbase) + (voff)[_i]), (PG8_LAS unsigned*)(lds + (bufoff) + ldsw + _i * 8192), 16, 0, 0); } while (0)
#define PG8_LDA(dst, b, h) do { _Pragma("unroll") for (int m = 0; m < 4; ++m) _Pragma("unroll") for (int k = 0; k < 2; ++k) dst[m][k] = *(const PG8_LAS bf16x8*)(lds + PG8_SA(b, h) + aoff + m * 2048 + k * 1024); } while (0)
#define PG8_LDB(dst, b, h) do { _Pragma("unroll") for (int n = 0; n < 2; ++n) _Pragma("unroll") for (int k = 0; k < 2; ++k) dst[n][k] = *(const PG8_LAS bf16x8*)(lds + PG8_SB(b, h) + boff + n * 2048 + k * 1024); } while (0)
#define PG8_MMA(ai, bj, At, Bt) do { __builtin_amdgcn_s_setprio(1); _Pragma("unroll") for (int m = 0; m < 4; ++m) _Pragma("unroll") for (int n = 0; n < 2; ++n) _Pragma("unroll") for (int k = 0; k < 2; ++k) \
        acc[ai][bj][m][n] = __builtin_amdgcn_mfma_f32_16x16x32_bf16(Bt[n][k], At[m][k], acc[ai][bj][m][n], 0, 0, 0); __builtin_amdgcn_s_setprio(0); } while (0)
#define PG8_WAIT_V(n) asm volatile("s_waitcnt vmcnt(" #n ")" ::: "memory")
#define PG8_WAIT_L(n) asm volatile("s_waitcnt lgkmcnt(" #n ")" ::: "memory")
#define PG8_BAR __builtin_amdgcn_s_barrier()
#define PG8_SCHED __builtin_amdgcn_sched_barrier(0)
    Unit cur, nxt; int ui = 0;
    if (!P.next(0, cur)) return;
    float zf = 0.f; asm volatile("" : "+v"(zf));
    f32x4 acc[2][2][4][2];
#pragma unroll
    for (int a = 0; a < 2; ++a)
#pragma unroll
        for (int b = 0; b < 2; ++b)
#pragma unroll
            for (int m = 0; m < 4; ++m)
#pragma unroll
                for (int n = 0; n < 2; ++n) acc[a][b][m][n] = (f32x4){zf, zf, zf, zf};
    bf16x8 At[4][2], B0[2][2], B1[2][2];
    constexpr int NH = Prob::GATHER ? 2 : 1;
    unsigned voC[NH][2];
    P.template a_off<NH>(cur, tid, voC);
    const PG8_GAS char* const Ab = P.A;
    const size_t hstepA = Prob::GATHER ? (size_t)0 : P.hstepA;
#define PG8_STAGE_A(bufoff, h, kbyte, VO) PG8_STAGE(bufoff, Ab + (kbyte) + ((h) ? hstepA : (size_t)0), VO[Prob::GATHER ? (h) : 0])
    { const PG8_GAS char* b0 = P.b_tile(cur, 0); const PG8_GAS char* b1 = P.b_tile(cur, 1);
      PG8_STAGE(PG8_SB(0, 0), b0, voffB); PG8_STAGE(PG8_SB(0, 1), b0 + hstepB, voffB); PG8_STAGE_A(PG8_SA(0, 0), 0, (size_t)0, voC); PG8_STAGE_A(PG8_SA(0, 1), 1, (size_t)0, voC);
      if (wr == 1) PG8_BAR;
      PG8_WAIT_V(2); PG8_BAR;
      PG8_STAGE(PG8_SB(1, 0), b1, voffB); PG8_STAGE_A(PG8_SA(1, 0), 0, (size_t)128, voC); PG8_STAGE(PG8_SB(1, 1), b1 + hstepB, voffB);
      PG8_WAIT_V(6); PG8_BAR; }
#ifdef MK_GSTAMP
#define GSEG(k) do { if (Epi::SID == MK_GSTAMP) { __builtin_amdgcn_sched_barrier(0); const unsigned now_ = (unsigned)__builtin_amdgcn_s_memtime(); __builtin_amdgcn_sched_barrier(0); \
    if (tid == MK_GSTAMP_TID) { PG8_LAS unsigned* m_ = (PG8_LAS unsigned*)(lds + MISC_OFF); if ((k) == MK_GSTAMP_SEG || MK_GSTAMP_SEG == 9) m_[16] += now_ - m_[18]; m_[18] = now_; if ((k) == 2) m_[17] += 1; } } } while (0)
    if (Epi::SID == MK_GSTAMP) { const unsigned now_ = (unsigned)__builtin_amdgcn_s_memtime(); if (tid == MK_GSTAMP_TID) ((PG8_LAS unsigned*)(lds + MISC_OFF))[18] = now_; }
#else
#define GSEG(k) do {} while (0)
#endif
    for (;;) {
        const bool has_next = P.next(ui + 1, nxt);
        if (!has_next) nxt = cur;
        for (int t = 0; t < nt; t += 2) {
            const bool last = (t == nt - 2);
            const size_t k1 = (size_t)(t + 1) * 128, k2 = last ? (size_t)0 : (size_t)(t + 2) * 128, k3 = k2 + 128;
            const PG8_GAS char* b2 = last ? P.b_tile(nxt, 0) : P.b_tile(cur, t + 2);
            const PG8_GAS char* b3 = last ? P.b_tile(nxt, 1) : P.b_tile(cur, t + 3);
#ifndef MK_RELAX
#define MK_RELAX 0
#endif
            int fz_ = __builtin_amdgcn_readfirstlane((MK_RELAX && (t == 0) && (ui > 0)) ? 1 : 0); asm volatile("" : "+s"(fz_));
            const bool fresh = fz_ != 0;
#define PG8_WAIT_VR() do { if (fresh) { if constexpr (Epi::NSTORES == 32) PG8_WAIT_V(40); else if constexpr (Epi::NSTORES == 16) PG8_WAIT_V(24); else PG8_WAIT_V(8); } else PG8_WAIT_V(8); } while (0)
            PG8_LDB(B0, 0, 0); PG8_LDB(B1, 0, 1); PG8_SCHED; PG8_LDA(At, 0, 0); if (!fresh) PG8_STAGE_A(PG8_SA(1, 1), 1, k1, voC);
            PG8_WAIT_VR(); PG8_WAIT_L(0); PG8_BAR; PG8_MMA(0, 0, At, B0); PG8_MMA(0, 1, At, B1); PG8_BAR; PG8_SCHED;
            if (last) {
                P.template a_off<NH>(nxt, tid, voC);
            }
            PG8_LDA(At, 0, 1); PG8_STAGE(PG8_SB(0, 0), b2, voffB); PG8_STAGE(PG8_SB(0, 1), b2 + hstepB, voffB); PG8_STAGE_A(PG8_SA(0, 0), 0, k2, voC);
            PG8_WAIT_VR(); PG8_WAIT_L(0); PG8_BAR; PG8_MMA(1, 0, At, B0); PG8_MMA(1, 1, At, B1); PG8_BAR; PG8_SCHED;
            PG8_LDB(B0, 1, 0); PG8_LDB(B1, 1, 1); PG8_SCHED; PG8_LDA(At, 1, 0); PG8_STAGE_A(PG8_SA(0, 1), 1, k2, voC);
            PG8_WAIT_VR(); PG8_WAIT_L(0); PG8_BAR; PG8_MMA(0, 0, At, B0); PG8_MMA(0, 1, At, B1); PG8_BAR; PG8_SCHED;
            PG8_LDA(At, 1, 1); PG8_STAGE(PG8_SB(1, 0), b3, voffB); PG8_STAGE(PG8_SB(1, 1), b3 + hstepB, voffB); PG8_STAGE_A(PG8_SA(1, 0), 0, k3, voC);
            PG8_WAIT_V(8); PG8_WAIT_L(0); PG8_BAR; PG8_MMA(1, 0, At, B0); PG8_MMA(1, 1, At, B1); PG8_BAR; PG8_SCHED;
        }
        if (MK_RELAX) PG8_STAGE_A(PG8_SA(1, 1), 1, (size_t)128, voC);
#ifndef MK_ALIGN
#define MK_ALIGN 1
#endif
        GSEG(0);
        if (MK_ALIGN && wr == 0) PG8_BAR;
        { Unit eu = cur; asm volatile("" : "+s"(eu.pm), "+s"(eu.pn));
          GSEG(1);
          E(acc, eu, wr, wc, fr, fq); }
        GSEG(2);
        if (!has_next) break;
#pragma unroll
        for (int a = 0; a < 2; ++a)
#pragma unroll
            for (int b = 0; b < 2; ++b)
#pragma unroll
                for (int m = 0; m < 4; ++m)
#pragma unroll
                    for (int n = 0; n < 2; ++n) acc[a][b][m][n] = (f32x4){zf, zf, zf, zf};
        cur = nxt; ++ui;
        if (MK_ALIGN && wr == 1) PG8_BAR;
    }
    PG8_WAIT_V(0);
    if (!MK_ALIGN && wr == 0) PG8_BAR;
    PG8_BAR;
#undef PG8_SA
#undef PG8_SB
#undef PG8_STAGE
#undef PG8_STAGE_A
#undef PG8_WAIT_VR
#undef PG8_LDA
#undef PG8_LDB
#undef PG8_MMA
#undef PG8_WAIT_V
#undef PG8_WAIT_L
#undef PG8_BAR
#undef PG8_SCHED
}
}
__device__ __forceinline__ void transpose_item(const GAS float* W, int N, int k0, int n0, GAS bf16_t* dst, int ldd, const GAS float* kscale, LAS float* scr, int lane) {
    const int kq = lane >> 4, n4 = (lane & 15) * 4;
#pragma unroll
    for (int i = 0; i < 16; ++i) { const int kk = 4 * i + kq; f32x4 v = *(const GAS f32x4*)(W + (size_t)(k0 + kk) * N + n0 + n4); if (kscale) v = v * kscale[k0 + kk];
        LAS float* p = scr + kk * 65 + n4; p[0] = v.x; p[1] = v.y; p[2] = v.z; p[3] = v.w; }
    LDS_WAIT(); asm volatile("" ::: "memory");
    const int c = lane & 7;
#pragma unroll
    for (int j = 0; j < 8; ++j) { const int n = (lane >> 3) + 8 * j; const LAS float* s = scr + (8 * c) * 65 + n;
        u32x4 o; o.x = pk2(s[0 * 65], s[1 * 65]); o.y = pk2(s[2 * 65], s[3 * 65]); o.z = pk2(s[4 * 65], s[5 * 65]); o.w = pk2(s[6 * 65], s[7 * 65]);
        *(GAS u32x4*)(dst + (size_t)n * ldd + k0 + 8 * c) = o; }
    LDS_WAIT(); asm volatile("" ::: "memory");
}

__device__ __forceinline__ void ada_unit(FARGS, int unit) {
    const GAS float* c = INP(1); const GAS float* c_ctx = INP(3); const GAS float* ada_w = INP(4); const GAS float* ada_b = INP(5);
    GAS float* mod = (GAS float*)(F.ws + WS_MOD);
    LAS float* S = (LAS float*)F.lds;
    const int L = unit / 48, cb = unit % 48, tid = F.tid;
    for (int i = tid; i < 33 * 1024; i += 512) { const int r = i >> 10, k = i & 1023; const float v = (r < 32) ? c[r * 1024 + k] : c_ctx[k]; S[i] = v / (1.f + expf(-v)); }
    __syncthreads();
    const int cq = tid & 31, kg = tid >> 5;
    f32x4 acc[33];
#pragma unroll
    for (int r = 0; r < 33; ++r) acc[r] = (f32x4){0.f, 0.f, 0.f, 0.f};
    const GAS float* wp = ada_w + ((size_t)L * 1024 + kg * 64) * ADA + cb * 128 + 4 * cq;
#pragma unroll 2
    for (int k4 = 0; k4 < 16; ++k4) {
        const f32x4 w0 = *(const GAS f32x4*)(wp + (size_t)(k4 * 4 + 0) * ADA), w1 = *(const GAS f32x4*)(wp + (size_t)(k4 * 4 + 1) * ADA), w2 = *(const GAS f32x4*)(wp + (size_t)(k4 * 4 + 2) * ADA), w3 = *(const GAS f32x4*)(wp + (size_t)(k4 * 4 + 3) * ADA);
        const LAS f32x4* sp = (const LAS f32x4*)(S + kg * 64 + k4 * 4);
#pragma unroll
        for (int r = 0; r < 33; ++r) { const f32x4 s4 = sp[r * 256]; acc[r] = acc[r] + (w0 * s4.x + w1 * s4.y) + (w2 * s4.z + w3 * s4.w); }
    }
    __syncthreads();
    LAS float* R = S;
    { const int w = F.wave;
#pragma unroll
      for (int r = 0; r < 33; ++r) { f32x4 v; v.x = x32_sum(acc[r].x); v.y = x32_sum(acc[r].y); v.z = x32_sum(acc[r].z); v.w = x32_sum(acc[r].w);
          if (F.lane < 32) *(LAS f32x4*)(R + (w * 33 + r) * 128 + 4 * cq) = v; } }
    __syncthreads();
    for (int i = tid; i < 33 * 128; i += 512) { const int r = i >> 7, cc = i & 127, n = cb * 128 + cc;
        float v = 0.f;
#pragma unroll
        for (int w = 0; w < 8; ++w) v += R[(w * 33 + r) * 128 + cc];
        mod[((size_t)L * 33 + r) * ADA + n] = v + ada_b[L * ADA + n]; }
    __syncthreads();
}

__device__ __forceinline__ void tables_unit(FARGS) {
    GAS float* tab = (GAS float*)(F.ws + WS_TAB);
    const int tid = F.tid;
    for (int i = tid; i < 64 * 16; i += 512) { const int p = i >> 4, f = i & 15; const float inv = expf(-(float)f * (1.f / 16.f) * 9.210340371976184f); const float a = (float)p * inv; tab[TAB_T64 + 2 * i] = cosf(a); tab[TAB_T64 + 2 * i + 1] = sinf(a); }
    for (int i = tid; i < 64 * 8; i += 512) { const int p = i >> 3, f = i & 7; const float inv = expf(-(float)f * (1.f / 8.f) * 9.210340371976184f); const float a = (float)p * inv; tab[TAB_T32 + 2 * i] = cosf(a); tab[TAB_T32 + 2 * i + 1] = sinf(a); }
    if (tid < DEPTH) { const GAS float* lp = INP(15) + tid * 4 * 32; float s01 = 0.f, s23 = 0.f;
        for (int i = 0; i < 32; ++i) { s01 += lp[i] * lp[32 + i]; s23 += lp[64 + i] * lp[96 + i]; }
        const float li = 0.8f - 0.6f * expf(-0.3f * (float)tid);
        tab[TAB_LAM + tid] = expf(s01) - expf(s23) + li; tab[TAB_LAM + DEPTH + tid] = 1.f - li; }
}

__device__ __forceinline__ void prologue_phase(FARGS) {
    refresh(F);
    if (F.bx < 192) ada_unit(F, F.bx);
    else if (F.bx == 192) tables_unit(F);
    __syncthreads();
    LAS float* scr = (LAS float*)(F.lds + F.wave * 16640);
    const int gw = F.bx * NWAVES + F.wave, NGW = F.G * NWAVES;
    GAS bf16_t* WIN = (GAS bf16_t*)(F.ws + WS_WIN); GAS bf16_t* WOUT = (GAS bf16_t*)(F.ws + WS_WOUT); GAS bf16_t* W1 = (GAS bf16_t*)(F.ws + WS_W1); GAS bf16_t* W2 = (GAS bf16_t*)(F.ws + WS_W2);
    constexpr int I_IN = 16 * 40, I_OUT = 16 * 16, I_G = 16 * 8, I_D = 8 * 16;
    constexpr int N_IN = DEPTH * I_IN, N_OUT = DEPTH * I_OUT, N_G = DEPTH * NEXP * I_G, N_D = DEPTH * NEXP * I_D;
    constexpr int NITEMS = N_IN + N_OUT + 2 * N_G + N_D;
    for (int it = gw; it < NITEMS; it += NGW) {
        int r = it;
        if (r < N_IN) { const int L = r / I_IN, q = r % I_IN, kb = q / 40, nb = q % 40;
            transpose_item(INP(8) + (size_t)L * D * DIN, DIN, kb * 64, nb * 64, WIN + ((size_t)L * DIN + nb * 64) * D, D, nullptr, scr, F.lane); continue; } r -= N_IN;
        if (r < N_OUT) { const int L = r / I_OUT, q = r % I_OUT, kb = q / 16, nb = q % 16;
            transpose_item(INP(17) + (size_t)L * D * D, D, kb * 64, nb * 64, WOUT + ((size_t)L * D + nb * 64) * D, D, INP(16) + L * D, scr, F.lane); continue; } r -= N_OUT;
        if (r < 2 * N_G) { const int up = r >= N_G; if (up) r -= N_G; const int le = r / I_G, q = r % I_G, kb = q / 8, nb = q % 8, n0 = nb * 64;
            const int drow = (n0 >> 7) * 256 + (n0 & 127) + (up ? 128 : 0);
            transpose_item((up ? INP(21) : INP(20)) + (size_t)le * D * DEXP, DEXP, kb * 64, n0, W1 + ((size_t)le * 1024 + drow) * D, D, nullptr, scr, F.lane); continue; } r -= 2 * N_G;
        { const int le = r / I_D, q = r % I_D, kb = q / 16, nb = q % 16;
            transpose_item(INP(22) + (size_t)le * DEXP * D, D, kb * 64, nb * 64, W2 + ((size_t)le * 1024 + nb * 64) * DEXP, DEXP, nullptr, scr, F.lane); }
    }
    __syncthreads();
}

__device__ __forceinline__ void top2of4(float x0, float x1, float x2, float x3, int& i1, int& i2, float& m1, float& m2) {
    i1 = 0; m1 = x0; if (x1 > m1) { m1 = x1; i1 = 1; } if (x2 > m1) { m1 = x2; i1 = 2; } if (x3 > m1) { m1 = x3; i1 = 3; }
    i2 = -1; m2 = -3.0e38f;
    if (i1 != 0 && x0 > m2) { m2 = x0; i2 = 0; } if (i1 != 1 && x1 > m2) { m2 = x1; i2 = 1; } if (i1 != 2 && x2 > m2) { m2 = x2; i2 = 2; } if (i1 != 3 && x3 > m2) { m2 = x3; i2 = 3; }
}
template <bool ROUTER>
__device__ __forceinline__ void norm_phase(FARGS, int L, int M, bool first, const GAS float* g, int shift_off, int scale_off, bool live = true) {
    refresh(F); OPAQUE_S(L); OPAQUE_S(M);
    const GAS float* mod = (const GAS float*)(F.ws + WS_MOD) + (size_t)L * 33 * ADA;
    GAS bf16_t* H = (GAS bf16_t*)(F.ws + WS_H);
    const GAS bf16_t* XB = (const GAS bf16_t*)(F.ws + WS_XB);
    const GAS float* xlat = INP(0); const GAS float* xctx = INP(2);
    const int lane = F.lane, gw = F.bx * NWAVES + F.wave, NGW = F.G * NWAVES, rpw = (M + NGW - 1) / NGW;
    const int r0 = gw * rpw, r1 = (r0 + rpw < M) ? r0 + rpw : M;
    constexpr int RB = ROUTER ? 1 : 4;
    LAS float* RWT = (LAS float*)F.lds;
    LAS float* LG = (LAS float*)(F.lds + 65536) + F.wave * 640;
    LAS int* hist = (LAS int*)(F.lds + NRM_OFF); LAS int* base = hist + 32;
    if (ROUTER) {
        const GAS float* rw = INP(18);
        for (int i = F.tid; i < 16 * 1024; i += 512) { const int k = i >> 4, e = i & 15; RWT[e * 1024 + k] = rw[i]; }
        if (F.tid < 32) hist[F.tid] = 0;
        __syncthreads();
    }
    int curb = -1; f32x4 gm[4], sh[4];
    u32x4 nraw[RB][2];
    if (!first) {
#pragma unroll
        for (int r = 0; r < RB; ++r)
#pragma unroll
            for (int jj = 0; jj < 2; ++jj) nraw[r][jj] = *(const GAS u32x4*)(XB + (size_t)(r0 + r) * D + 8 * lane + 512 * jj);
    }
#pragma unroll 1
    for (int row = r0; row < r1; row += RB) {
        const int b = row < NLAT ? (row >> 11) : 32;
        if (b != curb) { curb = b;
#pragma unroll
            for (int j = 0; j < 4; ++j) { const int c0 = 8 * lane + 512 * (j >> 1) + 4 * (j & 1); const f32x4 gg = *(const GAS f32x4*)(g + c0), sc = *(const GAS f32x4*)(mod + b * ADA + scale_off + c0);
                gm[j] = gg * (sc + 1.0f); sh[j] = *(const GAS f32x4*)(mod + b * ADA + shift_off + c0); } }
        const GAS float* xr = row < NLAT ? xlat + (size_t)row * D : xctx + (size_t)(row - NLAT) * D;
        f32x4 v[RB][4]; float ss[RB];
        if (first) {
#pragma unroll
            for (int r = 0; r < RB; ++r)
#pragma unroll
                for (int jj = 0; jj < 2; ++jj) { v[r][2 * jj] = *(const GAS f32x4*)(xr + (size_t)r * D + 8 * lane + 512 * jj); v[r][2 * jj + 1] = *(const GAS f32x4*)(xr + (size_t)r * D + 8 * lane + 512 * jj + 4); }
        } else {
            u32x4 raw[RB][2];
#pragma unroll
            for (int r = 0; r < RB; ++r)
#pragma unroll
                for (int jj = 0; jj < 2; ++jj) raw[r][jj] = nraw[r][jj];
            if (row + RB < r1) {
#pragma unroll
                for (int r = 0; r < RB; ++r)
#pragma unroll
                    for (int jj = 0; jj < 2; ++jj) nraw[r][jj] = *(const GAS u32x4*)(XB + (size_t)(row + RB + r) * D + 8 * lane + 512 * jj);
            }
#pragma unroll
            for (int r = 0; r < RB; ++r)
#pragma unroll
                for (int jj = 0; jj < 2; ++jj) { const u32x4 w = raw[r][jj];
                    v[r][2 * jj] = (f32x4){bflo(w.x), bfhi(w.x), bflo(w.y), bfhi(w.y)}; v[r][2 * jj + 1] = (f32x4){bflo(w.z), bfhi(w.z), bflo(w.w), bfhi(w.w)}; }
        }
#pragma unroll
        for (int r = 0; r < RB; ++r) { float s = 0.f;
#pragma unroll
            for (int j = 0; j < 4; ++j) s += (v[r][j].x * v[r][j].x + v[r][j].y * v[r][j].y) + (v[r][j].z * v[r][j].z + v[r][j].w * v[r][j].w);
            ss[r] = s; }
#pragma unroll
        for (int o = 1; o < 32; o <<= 1) {
#pragma unroll
            for (int r = 0; r < RB; ++r) ss[r] += sx(ss[r], lane, o); }
#pragma unroll
        for (int r = 0; r < RB; ++r) { const float rstd = __builtin_amdgcn_rsqf(x32_sum(ss[r]) * (1.f / D) + EPS);
#pragma unroll
            for (int j = 0; j < 4; ++j) v[r][j] = v[r][j] * rstd * gm[j] + sh[j];
#pragma unroll
            for (int jj = 0; jj < 2; ++jj) { u32x4 o; o.x = pk2(v[r][2 * jj].x, v[r][2 * jj].y); o.y = pk2(v[r][2 * jj].z, v[r][2 * jj].w); o.z = pk2(v[r][2 * jj + 1].x, v[r][2 * jj + 1].y); o.w = pk2(v[r][2 * jj + 1].z, v[r][2 * jj + 1].w);
                if (live) *(GAS u32x4*)(H + (size_t)(row + r) * D + 8 * lane + 512 * jj) = o; } }
        if (ROUTER) {
            float p[RB][16];
#pragma unroll
            for (int e = 0; e < 16; ++e) {
#pragma unroll
                for (int r = 0; r < RB; ++r) p[r][e] = 0.f;
#pragma unroll
                for (int j = 0; j < 4; ++j) { const f32x4 w = *(const LAS f32x4*)(RWT + e * 1024 + 8 * lane + 512 * (j >> 1) + 4 * (j & 1));
#pragma unroll
                    for (int r = 0; r < RB; ++r) p[r][e] += (v[r][j].x * w.x + v[r][j].y * w.y) + (v[r][j].z * w.z + v[r][j].w * w.w); } }
            const bool h32 = lane & 32, h16 = lane & 16, h8 = lane & 8, h4 = lane & 4;
#pragma unroll
            for (int r = 0; r < RB; ++r) {
                float a8[8], b4[4], c2[2], d1;
#pragma unroll
                for (int e = 0; e < 8; ++e) { const float send = h32 ? p[r][e] : p[r][e + 8], keep = h32 ? p[r][e + 8] : p[r][e]; a8[e] = keep + sx(send, lane, 32); }
#pragma unroll
                for (int e = 0; e < 4; ++e) { const float send = h16 ? a8[e] : a8[e + 4], keep = h16 ? a8[e + 4] : a8[e]; b4[e] = keep + sx(send, lane, 16); }
#pragma unroll
                for (int e = 0; e < 2; ++e) { const float send = h8 ? b4[e] : b4[e + 2], keep = h8 ? b4[e + 2] : b4[e]; c2[e] = keep + sx(send, lane, 8); }
                { const float send = h4 ? c2[0] : c2[1], keep = h4 ? c2[1] : c2[0]; d1 = keep + sx(send, lane, 4); }
                d1 += sx(d1, lane, 2); d1 += sx(d1, lane, 1);
                if ((lane & 3) == 0) LG[(row + r - r0) * 16 + (lane >> 2)] = d1;
            }
        }
    }
    if (ROUTER) {
        LDS_WAIT();
        int cls = 0, ls = 0; const bool mine = r0 + lane < r1;
        { const LAS f32x4* lp = (const LAS f32x4*)(LG + (mine ? lane : 0) * 16);
          const f32x4 q0 = lp[0], q1 = lp[1], q2 = lp[2], q3 = lp[3];
          const float lg[16] = {q0.x, q0.y, q0.z, q0.w, q1.x, q1.y, q1.z, q1.w, q2.x, q2.y, q2.z, q2.w, q3.x, q3.y, q3.z, q3.w};
          float sc[16], sel[16];
#pragma unroll
          for (int e = 0; e < 16; ++e) { sc[e] = 1.0f / (1.0f + __builtin_amdgcn_exp2f(-lg[e] * LOG2E)); sel[e] = sc[e] + INP(19)[e]; }
          float gs[4];
#pragma unroll
          for (int q = 0; q < 4; ++q) { int i1, i2; float m1, m2; top2of4(sel[4 * q], sel[4 * q + 1], sel[4 * q + 2], sel[4 * q + 3], i1, i2, m1, m2); gs[q] = m1 + m2; }
          int gi = 0; float gmx = gs[0]; if (gs[1] > gmx) { gmx = gs[1]; gi = 1; } if (gs[2] > gmx) { gmx = gs[2]; gi = 2; } if (gs[3] > gmx) { gmx = gs[3]; gi = 3; }
          float x4[4], s4[4];
#pragma unroll
          for (int i = 0; i < 4; ++i) { x4[i] = gi == 0 ? sel[i] : gi == 1 ? sel[4 + i] : gi == 2 ? sel[8 + i] : sel[12 + i]; s4[i] = gi == 0 ? sc[i] : gi == 1 ? sc[4 + i] : gi == 2 ? sc[8 + i] : sc[12 + i]; }
          int i1, i2; float m1, m2; top2of4(x4[0], x4[1], x4[2], x4[3], i1, i2, m1, m2);
          const int lo = i1 < i2 ? i1 : i2, hi = i1 < i2 ? i2 : i1;
          const int pr = lo == 0 ? hi - 1 : (lo == 1 ? hi + 1 : 5);
          const float slo = lo == 0 ? s4[0] : lo == 1 ? s4[1] : s4[2], shi = hi == 1 ? s4[1] : hi == 2 ? s4[2] : s4[3];
          const float inv = 1.0f / (slo + shi);
          cls = gi * 6 + pr;
          if (mine && live) { ls = __hip_atomic_fetch_add(&hist[cls], 1, __ATOMIC_RELAXED, __HIP_MEMORY_SCOPE_WORKGROUP);
              f32x2 w2 = {slo * inv, shi * inv}; *(GAS f32x2*)((GAS float*)(F.ws + WS_RW) + (size_t)(r0 + lane) * 2) = w2; }
        }
        __syncthreads();
        if (F.tid < NCLS && live) base[F.tid] = (int)__hip_atomic_fetch_add(CTL(F) + CW_CNT + (L * NCLS + F.tid) * 64, (unsigned)hist[F.tid], __ATOMIC_RELAXED, __HIP_MEMORY_SCOPE_AGENT);
        __syncthreads();
        GAS int* perm = (GAS int*)(F.ws + WS_PERM);
        if (mine && live) perm[(size_t)cls * MTOT + base[cls] + ls] = r0 + lane;
        __syncthreads();
    }
}

__device__ __forceinline__ void norm2_phase(FARGS, int L, int M) {
    refresh(F); OPAQUE_S(L); OPAQUE_S(M);
    constexpr int SG = 2064;
    constexpr int GT_BYTES = 32 * SG, C_OFF = 2 * GT_BYTES, RS_OFF = C_OFF + 256, RI_OFF = RS_OFF + 8 * 40 * 4, HB_OFF = RI_OFF + 8 * 40 * 4;
    static_assert(HB_OFF + 256 <= MISC_OFF, "norm2 LDS map");
    const GAS float* mod = (const GAS float*)(F.ws + WS_MOD) + (size_t)L * 33 * ADA;
    const GAS float* g2 = INP(7) + L * D; const GAS float* Wr = INP(18);
    GAS bf16_t* H = (GAS bf16_t*)(F.ws + WS_H);
    const GAS bf16_t* XB = (const GAS bf16_t*)(F.ws + WS_XB);
    const int lane = F.lane, tid = F.tid, w = F.wave, l31 = lane & 31, hi = lane >> 5;
    const int NGW = F.G * NWAVES, rpw = (M + NGW - 1) / NGW;
    const int R0 = F.bx * NWAVES * rpw, R1 = (R0 + NWAVES * rpw < M) ? R0 + NWAVES * rpw : M;
    const int r0 = R0 + w * rpw < M ? R0 + w * rpw : M, r1 = (r0 + rpw < M) ? r0 + rpw : M;
    LAS unsigned char* GT = F.lds; LAS float* Ctab = (LAS float*)(F.lds + C_OFF); LAS float* RS = (LAS float*)(F.lds + RS_OFF) + w * 40; LAS int* RI = (LAS int*)(F.lds + RI_OFF) + w * 40;
    LAS int* hist = (LAS int*)(F.lds + HB_OFF); LAS int* base = hist + 32;
    if (tid < 32) hist[tid] = 0;
    const int bfirst = R0 < NLAT ? (R0 >> 11) : 32, blast = (R1 - 1) < NLAT ? ((R1 - 1) >> 11) : 32;
    for (int s = 0; s <= (blast != bfirst ? 1 : 0); ++s) {
        const int b = s == 0 ? bfirst : blast;
        const GAS float* sc = mod + (size_t)b * ADA + 4 * 1024; const GAS float* shp = mod + (size_t)b * ADA + 3 * 1024;
        LAS unsigned char* gt = GT + s * GT_BYTES;
        for (int k = tid; k < D; k += 512) {
            const float gmk = g2[k] * (1.0f + sc[k]);
            const f32x4 w0 = *(const GAS f32x4*)(Wr + k * 16), w1 = *(const GAS f32x4*)(Wr + k * 16 + 4), w2 = *(const GAS f32x4*)(Wr + k * 16 + 8), w3 = *(const GAS f32x4*)(Wr + k * 16 + 12);
            const float wr_[16] = {w0.x, w0.y, w0.z, w0.w, w1.x, w1.y, w1.z, w1.w, w2.x, w2.y, w2.z, w2.w, w3.x, w3.y, w3.z, w3.w};
#pragma unroll
            for (int e = 0; e < 16; ++e) { const float G = gmk * wr_[e]; const unsigned hb = pk2(G, 0.f) & 0xffffu; const float lo = G - __uint_as_float(hb << 16); const unsigned lb = pk2(lo, 0.f) & 0xffffu;
                *(LAS bf16_t*)(gt + e * SG + k * 2) = (bf16_t)hb; *(LAS bf16_t*)(gt + (16 + e) * SG + k * 2) = (bf16_t)lb; }
        }
#pragma unroll
        for (int ee = 0; ee < 2; ++ee) { const int e = 2 * w + ee; float p = 0.f;
            for (int k = lane; k < D; k += 64) p += shp[k] * Wr[k * 16 + e];
            p = wave_sum(p, lane); if (lane == 0) Ctab[s * 16 + e] = p; }
    }
    __syncthreads();
    for (int cur = r0; cur < r1; ) {
        const int bcur = cur < NLAT ? (cur >> 11) : 32;
        int cnt = r1 - cur; if (cnt > 32) cnt = 32;
        if (cur < NLAT) { const int bnd = ((cur >> 11) + 1) << 11; if (bnd - cur < cnt) cnt = bnd - cur; }
        const int s = bcur == bfirst ? 0 : 1;
        const int row = cur + (l31 < cnt ? l31 : cnt - 1);
        const GAS bf16_t* xp = XB + (size_t)row * D + 8 * hi;
        const LAS unsigned char* gp = GT + s * GT_BYTES + l31 * SG + 16 * hi;
        f32x16 acc = f32x16{}; float ss = 0.f;
#pragma unroll 1
        for (int kg = 0; kg < 8; ++kg) {
            bf16x8 xf[8];
#pragma unroll
            for (int j = 0; j < 8; ++j) xf[j] = *(const GAS bf16x8*)(xp + (kg * 8 + j) * 16);
#pragma unroll
            for (int j = 0; j < 8; ++j) {
                const bf16x8 gf = *(const LAS bf16x8*)(gp + (kg * 8 + j) * 32);
                const u32x4 wv = __builtin_bit_cast(u32x4, xf[j]);
                const float a0 = bflo(wv.x), a1 = bfhi(wv.x), a2 = bflo(wv.y), a3 = bfhi(wv.y), a4 = bflo(wv.z), a5 = bfhi(wv.z), a6 = bflo(wv.w), a7 = bfhi(wv.w);
                ss += (a0 * a0 + a1 * a1) + (a2 * a2 + a3 * a3) + (a4 * a4 + a5 * a5) + (a6 * a6 + a7 * a7);
                acc = __builtin_amdgcn_mfma_f32_32x32x16_bf16(gf, xf[j], acc, 0, 0, 0);
            }
        }
        const float rstd = __builtin_amdgcn_rsqf(x32_sum(ss) * (1.f / D) + EPS);
        float mine[8], oth[8];
#pragma unroll
        for (int i = 0; i < 8; ++i) { mine[i] = acc[i] + acc[i + 8]; oth[i] = swap32(mine[i], hi != 0); }
        float lg[16];
#pragma unroll
        for (int i = 0; i < 4; ++i) { lg[i] = hi ? oth[i] : mine[i]; lg[4 + i] = hi ? mine[i] : oth[i]; lg[8 + i] = hi ? oth[4 + i] : mine[4 + i]; lg[12 + i] = hi ? mine[4 + i] : oth[4 + i]; }
        float sc_[16], sel[16];
#pragma unroll
        for (int e = 0; e < 16; ++e) { const float z = rstd * lg[e] + Ctab[s * 16 + e]; sc_[e] = __builtin_amdgcn_rcpf(1.0f + __builtin_amdgcn_exp2f(-z * LOG2E)); sel[e] = sc_[e] + INP(19)[e]; }
        float gs[4];
#pragma unroll
        for (int q = 0; q < 4; ++q) { int i1, i2; float m1, m2; top2of4(sel[4 * q], sel[4 * q + 1], sel[4 * q + 2], sel[4 * q + 3], i1, i2, m1, m2); gs[q] = m1 + m2; }
        int gi = 0; float gmx = gs[0]; if (gs[1] > gmx) { gmx = gs[1]; gi = 1; } if (gs[2] > gmx) { gmx = gs[2]; gi = 2; } if (gs[3] > gmx) { gmx = gs[3]; gi = 3; }
        float x4[4], s4[4];
#pragma unroll
        for (int i = 0; i < 4; ++i) { x4[i] = gi == 0 ? sel[i] : gi == 1 ? sel[4 + i] : gi == 2 ? sel[8 + i] : sel[12 + i]; s4[i] = gi == 0 ? sc_[i] : gi == 1 ? sc_[4 + i] : gi == 2 ? sc_[8 + i] : sc_[12 + i]; }
        int i1, i2; float m1, m2; top2of4(x4[0], x4[1], x4[2], x4[3], i1, i2, m1, m2);
        const int lo_ = i1 < i2 ? i1 : i2, hi_ = i1 < i2 ? i2 : i1;
        const int pr = lo_ == 0 ? hi_ - 1 : (lo_ == 1 ? hi_ + 1 : 5);
        const float slo = lo_ == 0 ? s4[0] : lo_ == 1 ? s4[1] : s4[2], shi = hi_ == 1 ? s4[1] : hi_ == 2 ? s4[2] : s4[3];
        const float inv = __builtin_amdgcn_rcpf(slo + shi);
        const int cls = gi * 6 + pr;
        if (hi == 0 && l31 < cnt) { const int ls = __hip_atomic_fetch_add(&hist[cls], 1, __ATOMIC_RELAXED, __HIP_MEMORY_SCOPE_WORKGROUP);
            const int ri = cur - r0 + l31; RS[ri] = rstd; RI[ri] = cls | (ls << 8);
            f32x2 w2 = {slo * inv, shi * inv}; *(GAS f32x2*)((GAS float*)(F.ws + WS_RW) + (size_t)(cur + l31) * 2) = w2; }
        cur += cnt;
    }
    LDS_WAIT();
    { int curb = -1; f32x4 gm[4], sh[4];
#pragma unroll 1
      for (int row = r0; row < r1; row += 4) {
        const int b = row < NLAT ? (row >> 11) : 32;
        if (b != curb) { curb = b;
#pragma unroll
            for (int j = 0; j < 4; ++j) { const int c0 = 8 * lane + 512 * (j >> 1) + 4 * (j & 1); const f32x4 gg = *(const GAS f32x4*)(g2 + c0), sc = *(const GAS f32x4*)(mod + b * ADA + 4 * 1024 + c0);
                gm[j] = gg * (sc + 1.0f); sh[j] = *(const GAS f32x4*)(mod + b * ADA + 3 * 1024 + c0); } }
        u32x4 raw[4][2];
#pragma unroll
        for (int r = 0; r < 4; ++r)
#pragma unroll
            for (int jj = 0; jj < 2; ++jj) raw[r][jj] = *(const GAS u32x4*)(XB + (size_t)(row + r) * D + 8 * lane + 512 * jj);
#pragma unroll
        for (int r = 0; r < 4; ++r) { const float rstd = RS[row - r0 + r];
#pragma unroll
            for (int jj = 0; jj < 2; ++jj) { const u32x4 wv = raw[r][jj];
                const f32x4 v0 = (f32x4){bflo(wv.x), bfhi(wv.x), bflo(wv.y), bfhi(wv.y)} * rstd * gm[2 * jj] + sh[2 * jj], v1 = (f32x4){bflo(wv.z), bfhi(wv.z), bflo(wv.w), bfhi(wv.w)} * rstd * gm[2 * jj + 1] + sh[2 * jj + 1];
                u32x4 o; o.x = pk2(v0.x, v0.y); o.y = pk2(v0.z, v0.w); o.z = pk2(v1.x, v1.y); o.w = pk2(v1.z, v1.w);
                *(GAS u32x4*)(H + (size_t)(row + r) * D + 8 * lane + 512 * jj) = o; } }
      } }
    __syncthreads();
    if (tid < NCLS) base[tid] = (int)__hip_atomic_fetch_add(CTL(F) + CW_CNT + (L * NCLS + tid) * 64, (unsigned)hist[tid], __ATOMIC_RELAXED, __HIP_MEMORY_SCOPE_AGENT);
    __syncthreads();
    { GAS int* perm = (GAS int*)(F.ws + WS_PERM);
      if (r0 + lane < r1) { const int ri = RI[lane], cls = ri & 255, ls = ri >> 8; perm[(size_t)cls * MTOT + base[cls] + ls] = r0 + lane; } }
    __syncthreads();
}

__device__ __forceinline__ void qkprep_phase(FARGS, int L, bool live = true) {
    refresh(F); OPAQUE_S(L);
    GAS bf16_t* U = (GAS bf16_t*)(F.ws + WS_U);
    const GAS float* tab = (const GAS float*)(F.ws + WS_TAB);
    const int lane = F.lane, gw = F.bx * NWAVES + F.wave, NGW = F.G * NWAVES, rpw = (MTOT + NGW - 1) / NGW;
    const int r0 = gw * rpw, r1 = (r0 + rpw < MTOT) ? r0 + rpw : MTOT;
    int ccol[4]; bool seg32[4], dorope[4], valid[4]; float qs[4]; f32x4 g0[4], g1[4];
#pragma unroll
    for (int i = 0; i < 4; ++i) {
        const int c = lane + 64 * i; valid[i] = c < 224;
        int col, isq; const GAS float* gp; bool s32 = false, rp = true; float sc = 0.125f * LOG2E;
        if (c < 48) { col = 8 * c; isq = c < 32; gp = INP(9) + L * 128 + (isq ? 0 : 64) + ((8 * c) & 63); }
        else if (c < 112) { const int cc = c - 48; col = QB + 8 * cc; isq = cc < 32; gp = INP(10) + L * 128 + (isq ? 0 : 64) + ((8 * cc) & 63); rp = false; }
        else if (c < 176) { const int cc = c - 112; col = QC + 8 * cc; isq = cc < 32; gp = INP(11) + L * 64 + (isq ? 0 : 32) + ((8 * cc) & 31); s32 = true; sc = 0.17677669529663687f * LOG2E; }
        else { const int cc = (c < 224 ? c : 223) - 176; col = QD + 8 * cc; isq = cc < 32; gp = INP(12) + L * 128 + (isq ? 0 : 64) + ((8 * cc) & 63); }
        ccol[i] = col; seg32[i] = s32; dorope[i] = rp; qs[i] = isq ? sc : 1.0f; g0[i] = *(const GAS f32x4*)gp; g1[i] = *(const GAS f32x4*)(gp + 4);
    }
#pragma unroll 1
    for (int row4 = r0; row4 < r1; row4 += 4) {
        u32x4 wv[4][4];
#pragma unroll
        for (int r = 0; r < 4; ++r)
#pragma unroll
            for (int i = 0; i < 4; ++i) wv[r][i] = *(const GAS u32x4*)(U + (size_t)(row4 + r) * DIN + ccol[i]);
#pragma unroll
        for (int r = 0; r < 4; ++r) {
        const int row = row4 + r;
        const bool lat = row < NLAT; const int s = row & 2047, prow = s >> 6, pcol = s & 63;
#pragma unroll
        for (int i = 0; i < 4; ++i) {
            GAS bf16_t* p = U + (size_t)row * DIN + ccol[i];
            const u32x4 w = wv[r][i];
            float x[8] = {bflo(w.x), bfhi(w.x), bflo(w.y), bfhi(w.y), bflo(w.z), bfhi(w.z), bflo(w.w), bfhi(w.w)};
            float ss = 0.f;
#pragma unroll
            for (int e = 0; e < 8; ++e) ss += x[e] * x[e];
            ss += sx(ss, lane, 1); ss += sx(ss, lane, 2); const float ss8 = ss + sx(ss, lane, 4);
            const float rstd = seg32[i] ? __builtin_amdgcn_rsqf(ss * (1.f / 32.f) + EPS) : __builtin_amdgcn_rsqf(ss8 * (1.f / 64.f) + EPS);
            const float gg[8] = {g0[i].x, g0[i].y, g0[i].z, g0[i].w, g1[i].x, g1[i].y, g1[i].z, g1[i].w};
#pragma unroll
            for (int e = 0; e < 8; ++e) x[e] = x[e] * rstd * gg[e];
            const int j = seg32[i] ? (lane & 3) : (lane & 7);
            const int pxor = seg32[i] ? 1 : 2;
            const bool first = seg32[i] ? !(j & 1) : !(j & 2);
            const int pos = seg32[i] ? ((j < 2) ? prow : pcol) : ((j < 4) ? prow : pcol);
            const GAS float* tp = seg32[i] ? tab + TAB_T32 + (pos * 8) * 2 : tab + TAB_T64 + (pos * 16 + 8 * (j & 1)) * 2;
            const bool rp = dorope[i] && lat;
#pragma unroll
            for (int e2 = 0; e2 < 4; ++e2) {
                const f32x4 cs = *(const GAS f32x4*)(tp + 4 * e2);
                const float pa = sx(x[2 * e2], lane, pxor), pb = sx(x[2 * e2 + 1], lane, pxor);
                if (rp) {
                    x[2 * e2] = first ? x[2 * e2] * cs.x - pa * cs.y : pa * cs.y + x[2 * e2] * cs.x;
                    x[2 * e2 + 1] = first ? x[2 * e2 + 1] * cs.z - pb * cs.w : pb * cs.w + x[2 * e2 + 1] * cs.z;
                }
            }
            u32x4 o; o.x = pk2(x[0] * qs[i], x[1] * qs[i]); o.y = pk2(x[2] * qs[i], x[3] * qs[i]); o.z = pk2(x[4] * qs[i], x[5] * qs[i]); o.w = pk2(x[6] * qs[i], x[7] * qs[i]);
            if (valid[i] && live) *(GAS u32x4*)p = o;
        }
        }
    }
}
#ifdef MK_USE_SB
#define MK_SB() __builtin_amdgcn_sched_barrier(0)
#else
#define MK_SB() do {} while (0)
#endif
#ifndef MK_DUAL
#define MK_DUAL 1
#endif
#ifndef MK_MIDBAR
#define MK_MIDBAR 0
#endif
#ifndef MK_QKFIRST
#define MK_QKFIRST 4
#endif
#ifndef MK_QKSPLIT
#define MK_QKSPLIT 1
#endif
#ifndef MK_QKMID
#define MK_QKMID 4
#endif
#ifndef MK_ILV
#define MK_ILV 15
#endif
#ifndef MK_CHP
#define MK_CHP 1
#endif
template <int MIX> struct MixCfg;
template <> struct MixCfg<0> { static constexpr int QCOL = QA, KCOL = KA, VCOL = VA, CK = 128, CV = 128; static constexpr bool GQA = true;  };
template <> struct MixCfg<1> { static constexpr int QCOL = QB, KCOL = KB, VCOL = VB, CK = 256, CV = 256; static constexpr bool GQA = false; };
template <> struct MixCfg<2> { static constexpr int QCOL = QC, KCOL = KC, VCOL = VC, CK = MK_CHP ? 128 : 256, CV = MK_CHP ? 128 : 256; static constexpr bool GQA = false; };
template <> struct MixCfg<3> { static constexpr int QCOL = QD, KCOL = KD, VCOL = VD, CK = 128, CV = 128; static constexpr bool GQA = true;  };

__device__ __forceinline__ int crow16(int r, int hi) { return (r & 3) + 8 * (r >> 2) + 4 * hi; }
__device__ __forceinline__ s16x4 vtr(const LAS unsigned char* p) { return __builtin_bit_cast(s16x4, __builtin_amdgcn_ds_read_tr16_b64_v4i16((LAS s16x4*)p)); }

__device__ __forceinline__ void softmax_tile(f32x16& p0, f32x16& p1, float& l, bf16x8 (&pa)[4]) {
    float s0 = 0.f, s1 = 0.f;
#pragma unroll
    for (int r = 0; r < 16; ++r) { p0[r] = __builtin_amdgcn_exp2f(p0[r]); p1[r] = __builtin_amdgcn_exp2f(p1[r]); s0 += p0[r]; s1 += p1[r]; }
    l += s0 + s1;
#pragma unroll
    for (int sI = 0; sI < 4; ++sI) {
        u32x4 w;
        if (sI < 2) { const int o_ = 8 * sI; w.x = pk2(p0[o_], p0[o_ + 1]); w.y = pk2(p0[o_ + 2], p0[o_ + 3]); w.z = pk2(p0[o_ + 4], p0[o_ + 5]); w.w = pk2(p0[o_ + 6], p0[o_ + 7]); }
        else { const int o_ = 8 * (sI - 2); w.x = pk2(p1[o_], p1[o_ + 1]); w.y = pk2(p1[o_ + 2], p1[o_ + 3]); w.z = pk2(p1[o_ + 4], p1[o_ + 5]); w.w = pk2(p1[o_ + 6], p1[o_ + 7]); }
        pa[sI] = __builtin_bit_cast(bf16x8, w);
    }
}

template <int MIX>
__device__ __forceinline__ void attn_unit(FARGS, int L, int b, int qb, bool isctx, int hp) {
    typedef MixCfg<MIX> C;
    refresh(F); OPAQUE_S(L);
#ifdef MK_STAMP
#define STAMP_NOW_(v) __builtin_amdgcn_sched_barrier(0); const unsigned v = (unsigned)__builtin_amdgcn_s_memtime(); __builtin_amdgcn_sched_barrier(0)
#define SEG0() do { if (MIX == MK_STAMP) { STAMP_NOW_(now_); if (F.tid == MK_STAMP_TID) { LAS unsigned* m_ = (LAS unsigned*)(F.lds + MISC_OFF); m_[21] = now_; } } } while (0)
#define SEG(k) do { if (MIX == MK_STAMP && (MK_STAMP_SEG == 9 ? (k) == 3 : ((k) == MK_STAMP_SEG || (k) == (MK_STAMP_SEG + 3) % 4))) { STAMP_NOW_(now_); if (F.tid == MK_STAMP_TID) { LAS unsigned* m_ = (LAS unsigned*)(F.lds + MISC_OFF); \
    if ((k) == MK_STAMP_SEG || MK_STAMP_SEG == 9) m_[20] += now_ - m_[21]; m_[21] = now_; } } } while (0)
#else
#define SEG0() do {} while (0)
#define SEG(k) do {} while (0)
#endif
    constexpr int SK = C::CK * 2 + 16, SV = C::CV * 2 + 64, NKC = C::CK / 64, NVC = C::CV / 64;
    constexpr bool DIFF = (MIX == 2);
    constexpr bool DUAL = (MIX == 3) && MK_DUAL;
    constexpr bool TWO = DIFF || DUAL;
    constexpr bool HP = DIFF && MK_CHP;
    constexpr int UQ = (DUAL || HP) ? 128 : 64;
    static_assert(C::CK == C::CV, "K and V tiles share the per-thread load offsets");
    const GAS bf16_t* U = (const GAS bf16_t*)(F.ws + WS_U);
    GAS bf16_t* Y = (GAS bf16_t*)(F.ws + WS_Y);
    const GAS float* tab = (const GAS float*)(F.ws + WS_TAB);
    const int tid = F.tid, lane = F.lane, w = F.wave, l31 = lane & 31, hi = lane >> 5;
    const int hq = DUAL ? 2 * (w >> 2) : (HP ? 2 * hp + (w >> 2) : (w >> 1)), rs = (DUAL || HP) ? (w & 3) : (w & 1);
    const int hk = (DUAL || HP) ? (w >> 2) : (C::GQA ? (hq >> 1) : hq);
    const int kcolb = C::KCOL + (HP ? hp * 128 : 0), vcolb = C::VCOL + (HP ? hp * 128 : 0);
    const int qrow = isctx ? NLAT + b * CTXL + qb * UQ + rs * 32 + l31 : b * SEQ + qb * UQ + rs * 32 + l31;
    int nloc, loc0;
    if (isctx) { nloc = 0; loc0 = 0; }
    else if (MIX == 0) { const int t0 = DUAL ? 2 * qb - 2 : qb - 2, t1 = DUAL ? 2 * qb + 3 : qb + 2; loc0 = t0 < 0 ? 0 : t0; const int hiT = t1 > 31 ? 31 : t1; nloc = hiT - loc0 + 1; }
    else if (MIX == 1) { loc0 = qb - 4 < 0 ? 0 : (qb - 4 > 24 ? 24 : qb - 4); nloc = 8; }
    else { loc0 = 0; nloc = 32; }
    const int NT = nloc + 4;
    const int lrow0 = b * SEQ, crow0 = NLAT + b * CTXL;
    bf16x8 qf[4], qg[DUAL ? 4 : 1];
    { const GAS bf16_t* qp = U + (size_t)qrow * DIN + C::QCOL + hq * 64 + hi * 8;
#pragma unroll
      for (int d0 = 0; d0 < 4; ++d0) { qf[d0] = *(const GAS bf16x8*)(qp + d0 * 16); if (DUAL) qg[DUAL ? d0 : 0] = *(const GAS bf16x8*)(qp + 64 + d0 * 16); } }
    float l0 = 0.f, l1 = 0.f;
    if (MIX == 0) { l0 = hi == 0 ? __builtin_amdgcn_exp2f(INP(13)[L * 4 + hq] * LOG2E) : 0.f;
        if (DUAL) l1 = hi == 0 ? __builtin_amdgcn_exp2f(INP(13)[L * 4 + hq + 1] * LOG2E) : 0.f; }
    f32x16 o0[2], o1[2];
#pragma unroll
    for (int i = 0; i < 2; ++i) { o0[i] = f32x16{}; o1[i] = f32x16{}; }
    u32x4 kreg[NKC], vreg[NVC];
    auto tile_row = [&](int t) -> int { return t < nloc ? lrow0 + (loc0 + t) * 64 : crow0 + (t - nloc) * 64; };
    unsigned goff[NKC];
#pragma unroll
    for (int i = 0; i < NKC; ++i) { const int c = tid + 512 * i, r = c / (C::CK / 8), cc = c % (C::CK / 8); goff[i] = (unsigned)(r * DIN + cc * 8) * 2u; }
    auto issueK = [&](int t) { const GAS char* tb = (const GAS char*)(U + (size_t)tile_row(t) * DIN + kcolb);
#pragma unroll
        for (int i = 0; i < NKC; ++i) kreg[i] = *(const GAS u32x4*)(tb + goff[i]); };
    auto issueV = [&](int t) { const GAS char* tb = (const GAS char*)(U + (size_t)tile_row(t) * DIN + vcolb);
#pragma unroll
        for (int i = 0; i < NVC; ++i) vreg[i] = *(const GAS u32x4*)(tb + goff[i]); };
    constexpr bool ILV = ((MK_ILV) >> MIX) & 1;
    constexpr bool MID = ILV && (!TWO || HP) && (C::CK == 128) && (((MK_MIDBAR) >> MIX) & 1);
    constexpr int K3SZ = 64 * SK, V3SZ = 64 * SV, V3BASE = 34816;
    static_assert(!MID || (2 * K3SZ <= V3BASE && V3BASE + 3 * V3SZ <= AT_RPB), "ring");
    auto KB = [&](int t) -> int { return MID ? (t & 1) * K3SZ : (t & 1) * AT_BUFB; };
    auto VB = [&](int t) -> int { return MID ? V3BASE + (int)((unsigned)t % 3u) * V3SZ : (t & 1) * AT_BUFB + AT_VOFF; };
    auto stashK = [&](int t) { LAS unsigned char* Kw = F.lds + KB(t);
#pragma unroll
        for (int i = 0; i < NKC; ++i) { const int c = tid + 512 * i, r = c / (C::CK / 8), cc = c % (C::CK / 8); *(LAS u32x4*)(Kw + r * SK + cc * 16) = kreg[i]; } };
    auto stashV = [&](int t) { LAS unsigned char* Vw = F.lds + VB(t);
#pragma unroll
        for (int i = 0; i < NVC; ++i) { const int c = tid + 512 * i, r = c / (C::CV / 8), cc = c % (C::CV / 8); *(LAS u32x4*)(Vw + r * SV + cc * 16) = vreg[i]; } };
    const int kboff = l31 * SK + (hk * 64 + hi * 8) * 2;
    const int vboff = (4 * hi + ((lane & 15) >> 2)) * SV + (hk * 64 + 16 * ((lane >> 4) & 1) + 4 * (lane & 3)) * 2;
    bf16x8 kf[8];
    auto loadkf = [&](int t) { const LAS unsigned char* kb = F.lds + KB(t) + kboff;
#pragma unroll
        for (int d0 = 0; d0 < 4; ++d0) { kf[2 * d0] = *(const LAS bf16x8*)(kb + d0 * 32); kf[2 * d0 + 1] = *(const LAS bf16x8*)(kb + 32 * SK + d0 * 32); } };
    bf16x8 pa0[4], pa1[4];
#pragma unroll
    for (int i = 0; i < 4; ++i) { pa0[i] = bf16x8{}; pa1[i] = bf16x8{}; }
    constexpr int VPRE = DUAL ? 1 : (TWO ? 2 : 4);
    bf16x8 vf[2 * VPRE];
    auto readvf = [&](int t, int sI, int dh) -> bf16x8 {
        const LAS unsigned char* vp = F.lds + VB(t) + vboff + (16 * sI) * SV + dh * 64;
        const s16x4 lo = vtr(vp), hi4 = vtr(vp + 8 * SV);
        return (bf16x8){lo[0], lo[1], lo[2], lo[3], hi4[0], hi4[1], hi4[2], hi4[3]}; };
    auto loadvf = [&](int t) {
#pragma unroll
        for (int sI = 0; sI < VPRE; ++sI)
#pragma unroll
            for (int dh = 0; dh < 2; ++dh) vf[2 * sI + dh] = readvf(t, sI, dh); };
    auto pv = [&](int t) {
#pragma unroll
        for (int sI = 0; sI < 4; ++sI)
#pragma unroll
            for (int dh = 0; dh < 2; ++dh) {
                const bf16x8 v = sI < VPRE ? vf[2 * (sI < VPRE ? sI : 0) + dh] : readvf(t, sI, dh);
                o0[dh] = __builtin_amdgcn_mfma_f32_32x32x16_bf16(v, pa0[sI], o0[dh], 0, 0, 0);
                if (TWO) o1[dh] = __builtin_amdgcn_mfma_f32_32x32x16_bf16(v, pa1[sI], o1[dh], 0, 0, 0);
            } };
    const int qpos = qb * UQ + rs * 32 + l31;
    const int qc = rs * 32 + l31, cs = qc - 8 < 0 ? 0 : (qc - 8 > 48 ? 48 : qc - 8);
    const LAS float* rpb = (const LAS float*)(F.lds + AT_RPB) + hq * 465;
    issueK(0); stashK(0); issueK(1); issueV(0);
    WG_BAR();
    constexpr bool KHOLD = !TWO || HP;
    if (KHOLD) loadkf(0);
    if (ILV) {
#define SBAR() __builtin_amdgcn_sched_barrier(0)
    auto loadkf1 = [&](int t, int j) { const LAS unsigned char* kb = F.lds + KB(t) + kboff; kf[j] = *(const LAS bf16x8*)(kb + (j & 1) * 32 * SK + (j >> 1) * 32); };
    constexpr int NB = TWO ? 2 : 4;
    constexpr int NG = TWO ? 16 : 8;
    bf16x8 vr[NB];
    auto stage = [&](int t) {
        if (t + 1 < NT) stashK(t + 1);
        stashV(t);
        if (t + 2 < NT) issueK(t + 2);
        if (t + 1 < NT) issueV(t + 1); };
    auto qk = [&](int t, f32x16& p0, f32x16& p1, f32x16& r0_, f32x16& r1_) {
        if (DUAL) {
            const LAS unsigned char* kb = F.lds + KB(t) + kboff;
            bf16x8 kr[2][2];
#pragma unroll
            for (int d0 = 0; d0 < 2; ++d0) { kr[d0][0] = *(const LAS bf16x8*)(kb + d0 * 32); kr[d0][1] = *(const LAS bf16x8*)(kb + 32 * SK + d0 * 32); }
#pragma unroll
            for (int d0 = 0; d0 < 4; ++d0) {
                SBAR();
                p0 = __builtin_amdgcn_mfma_f32_32x32x16_bf16(kr[d0 & 1][0], qf[d0], p0, 0, 0, 0); p1 = __builtin_amdgcn_mfma_f32_32x32x16_bf16(kr[d0 & 1][1], qf[d0], p1, 0, 0, 0);
                r0_ = __builtin_amdgcn_mfma_f32_32x32x16_bf16(kr[d0 & 1][0], qg[DUAL ? d0 : 0], r0_, 0, 0, 0); r1_ = __builtin_amdgcn_mfma_f32_32x32x16_bf16(kr[d0 & 1][1], qg[DUAL ? d0 : 0], r1_, 0, 0, 0);
                if (d0 + 2 < 4) { kr[d0 & 1][0] = *(const LAS bf16x8*)(kb + (d0 + 2) * 32); kr[d0 & 1][1] = *(const LAS bf16x8*)(kb + 32 * SK + (d0 + 2) * 32); }
                if (MK_QKFIRST == 4 && t > 0 && d0 == MK_QKSPLIT) {
#pragma unroll
                    for (int f = 0; f < NB; ++f) vr[f] = readvf(t - 1, f >> 1, f & 1);
                    stage(t); }
            }
            SBAR();
            return;
        }
#pragma unroll
        for (int d0 = 0; d0 < 2; ++d0) { p0 = __builtin_amdgcn_mfma_f32_32x32x16_bf16(kf[2 * d0], qf[d0], p0, 0, 0, 0); p1 = __builtin_amdgcn_mfma_f32_32x32x16_bf16(kf[2 * d0 + 1], qf[d0], p1, 0, 0, 0); }
        if ((((MK_QKMID) >> MIX) & 1) && MK_QKFIRST == 4 && t > 0) {
            SBAR();
#pragma unroll
            for (int f = 0; f < NB; ++f) vr[f] = readvf(t - 1, f >> 1, f & 1);
            stage(t);
            SBAR();
        }
#pragma unroll
        for (int d0 = 2; d0 < 4; ++d0) {
            if (DIFF) { r0_ = __builtin_amdgcn_mfma_f32_32x32x16_bf16(kf[2 * d0], qf[d0], r0_, 0, 0, 0); r1_ = __builtin_amdgcn_mfma_f32_32x32x16_bf16(kf[2 * d0 + 1], qf[d0], r1_, 0, 0, 0); }
            else { p0 = __builtin_amdgcn_mfma_f32_32x32x16_bf16(kf[2 * d0], qf[d0], p0, 0, 0, 0); p1 = __builtin_amdgcn_mfma_f32_32x32x16_bf16(kf[2 * d0 + 1], qf[d0], p1, 0, 0, 0); } } };
    auto init_acc = [&](int t, f32x16& p0, f32x16& p1, f32x16& r0_, f32x16& r1_) {
        const bool local = t < nloc;
        p0 = f32x16{}; p1 = f32x16{}; r0_ = f32x16{}; r1_ = f32x16{};
        if (MIX == 0 && local) {
            const int dj = loc0 + t - qb;
            if (dj <= -2 || dj >= 2) {
                const int mb = (loc0 + t) * 64 + 4 * hi - qpos + 128;
#pragma unroll
                for (int r = 0; r < 16; ++r) { const int kc = (r & 3) + 8 * (r >> 2);
                    if ((unsigned)(mb + kc) > 256u) { p0[r] = -INFINITY; if (DUAL) r0_[r] = -INFINITY; } if ((unsigned)(mb + kc + 32) > 256u) { p1[r] = -INFINITY; if (DUAL) r1_[r] = -INFINITY; } }
            }
        }
        if (MIX == 1 && local) {
            const int dr = (loc0 + t) - qb + 7;
            const int kh = 4 * hi - cs; const LAS float* rp = rpb + dr * 31 + 15 - qc + 4 * hi;
            float bb0[16], bb1[16];
#pragma unroll
            for (int r = 0; r < 16; ++r) { const int kc = (r & 3) + 8 * (r >> 2); bb0[r] = rp[kc]; bb1[r] = rp[kc + 32]; }
#pragma unroll
            for (int r = 0; r < 16; ++r) { asm volatile("" : "+v"(bb0[r]), "+v"(bb1[r])); }
#pragma unroll
            for (int r = 0; r < 16; ++r) { const int kc = (r & 3) + 8 * (r >> 2);
                const bool v0 = (unsigned)(kh + kc) < 16u, v1 = (unsigned)(kh + kc + 32) < 16u;
                p0[r] = v0 ? bb0[r] : -INFINITY; p1[r] = v1 ? bb1[r] : -INFINITY; }
        } };
    auto sm_exp = [&](f32x16& a0, f32x16& a1, int q, float& sum) {
#pragma unroll
        for (int j = 0; j < 4; ++j) { const int r = 4 * (q & 3) + j;
            if (q < 4) { a0[r] = __builtin_amdgcn_exp2f(a0[r]); sum += a0[r]; } else { a1[r] = __builtin_amdgcn_exp2f(a1[r]); sum += a1[r]; } } };
    auto sm_cvt = [&](const f32x16& a0, const f32x16& a1, int q, bf16x8 (&pa)[4]) {
        const int r = 4 * (q & 3);
        const unsigned lo = q < 4 ? pk2(a0[r], a0[r + 1]) : pk2(a1[r], a1[r + 1]), hi2 = q < 4 ? pk2(a0[r + 2], a0[r + 3]) : pk2(a1[r + 2], a1[r + 3]);
        u32x4 w = __builtin_bit_cast(u32x4, pa[q >> 1]);
        if (q & 1) { w.z = lo; w.w = hi2; } else { w.x = lo; w.y = hi2; }
        pa[q >> 1] = __builtin_bit_cast(bf16x8, w); };
    {
        if (!KHOLD && !DUAL) loadkf(0);
        stage(0);
        f32x16 p0, p1, r0_, r1_;
        init_acc(0, p0, p1, r0_, r1_);
        qk(0, p0, p1, r0_, r1_);
        softmax_tile(p0, p1, l0, pa0);
        if (TWO) softmax_tile(r0_, r1_, l1, pa1);
        WG_BAR();
        if (KHOLD && 1 < NT) loadkf(1);
    }
    SEG0();
    for (int t = 1; t < NT; ++t) {
        f32x16 p0, p1, r0_, r1_;
        if (MK_QKFIRST) {
            if (!KHOLD && !DUAL) loadkf(t);
            if (MK_QKFIRST == 2) {
#pragma unroll
                for (int f = 0; f < NB; ++f) vr[f] = readvf(t - 1, f >> 1, f & 1); }
            init_acc(t, p0, p1, r0_, r1_);
            qk(t, p0, p1, r0_, r1_);
            if (MK_QKFIRST != 2 && !(MK_QKFIRST == 4 && (DUAL || (((MK_QKMID) >> MIX) & 1)))) {
#pragma unroll
                for (int f = 0; f < NB; ++f) vr[f] = readvf(t - 1, f >> 1, f & 1); }
            if (MK_QKFIRST != 3 && !(MK_QKFIRST == 4 && (DUAL || (((MK_QKMID) >> MIX) & 1)))) stage(t);
        } else {
#pragma unroll
        for (int f = 0; f < NB; ++f) vr[f] = readvf(t - 1, f >> 1, f & 1);
        if (!KHOLD && !DUAL) loadkf(t);
        stage(t);
        init_acc(t, p0, p1, r0_, r1_);
        SEG(1);
        qk(t, p0, p1, r0_, r1_);
        SEG(0);
        }
#pragma unroll
        for (int g = 0; g < NG; ++g) {
            SBAR();
            if (MID && g == NG / 2) { WG_BAR(); SBAR(); }
            if (MID && !TWO && g >= NG - 4) { loadkf1(t + 1, 2 * (g - (NG - 4))); loadkf1(t + 1, 2 * (g - (NG - 4)) + 1); }
            if (TWO) {
                const int f = g >> 1, h = g & 1, sI = g >> 2, dh = (g >> 1) & 1;
                if (h == 0) o0[dh] = __builtin_amdgcn_mfma_f32_32x32x16_bf16(vr[f % NB], pa0[sI], o0[dh], 0, 0, 0);
                else { o1[dh] = __builtin_amdgcn_mfma_f32_32x32x16_bf16(vr[f % NB], pa1[sI], o1[dh], 0, 0, 0);
                    if (f + NB < 8) vr[f % NB] = readvf(t - 1, (f + NB) >> 1, (f + NB) & 1); }
                if (h == 0) sm_exp(p0, p1, g >> 1, l0); else sm_exp(r0_, r1_, g >> 1, l1);
                if (g >= 3 && ((g - 3) & 3) == 0) { const int k = (g - 3) >> 2; sm_cvt(p0, p1, 2 * k, pa0); sm_cvt(p0, p1, 2 * k + 1, pa0); }
                if (g >= 4 && ((g - 4) & 3) == 0) { const int k = (g - 4) >> 2; sm_cvt(r0_, r1_, 2 * k, pa1); sm_cvt(r0_, r1_, 2 * k + 1, pa1); }
            } else {
                const int f = g, sI = g >> 1, dh = g & 1;
                o0[dh] = __builtin_amdgcn_mfma_f32_32x32x16_bf16(vr[f % NB], pa0[sI], o0[dh], 0, 0, 0);
                if (f + NB < 8) vr[f % NB] = readvf(t - 1, (f + NB) >> 1, (f + NB) & 1);
                sm_exp(p0, p1, g, l0);
                if (g >= 2 && (g & 1) == 0) { const int k = (g - 2) >> 1; sm_cvt(p0, p1, 2 * k, pa0); sm_cvt(p0, p1, 2 * k + 1, pa0); }
            }
        }
        SBAR();
        if (MK_QKFIRST == 3) stage(t);
        if (TWO) { sm_cvt(r0_, r1_, 6, pa1); sm_cvt(r0_, r1_, 7, pa1); }
        else { sm_cvt(p0, p1, 6, pa0); sm_cvt(p0, p1, 7, pa0); }
        if (MID && TWO) {
#pragma unroll
            for (int j = 0; j < 8; ++j) loadkf1(t + 1, j); }
        SEG(2);
        if (!MID) WG_BAR();
        SEG(3);
        if (KHOLD && !MID && t + 1 < NT) loadkf(t + 1);
    }
    loadvf(NT - 1); pv(NT - 1);
    } else {
    for (int t = 0; t < NT; ++t) {
        if (t > 0) loadvf(t - 1);
        if (!KHOLD) loadkf(t);
        MK_SB();
        if (t + 1 < NT) stashK(t + 1);
        stashV(t);
        if (t + 2 < NT) issueK(t + 2);
        if (t + 1 < NT) issueV(t + 1);
        const bool local = t < nloc;
        f32x16 p0 = f32x16{}, p1 = f32x16{}, r0_ = f32x16{}, r1_ = f32x16{};
#pragma unroll
        for (int d0 = 0; d0 < (DIFF ? 2 : 4); ++d0) { p0 = __builtin_amdgcn_mfma_f32_32x32x16_bf16(kf[2 * d0], qf[d0], p0, 0, 0, 0); p1 = __builtin_amdgcn_mfma_f32_32x32x16_bf16(kf[2 * d0 + 1], qf[d0], p1, 0, 0, 0); }
        MK_SB();
        if (t > 0) pv(t - 1);
        if (DIFF) {
#pragma unroll
            for (int d0 = 2; d0 < 4; ++d0) { r0_ = __builtin_amdgcn_mfma_f32_32x32x16_bf16(kf[2 * d0], qf[d0], r0_, 0, 0, 0); r1_ = __builtin_amdgcn_mfma_f32_32x32x16_bf16(kf[2 * d0 + 1], qf[d0], r1_, 0, 0, 0); }
        }
        if (DUAL) {
#pragma unroll
            for (int d0 = 0; d0 < 4; ++d0) { r0_ = __builtin_amdgcn_mfma_f32_32x32x16_bf16(kf[2 * d0], qg[DUAL ? d0 : 0], r0_, 0, 0, 0); r1_ = __builtin_amdgcn_mfma_f32_32x32x16_bf16(kf[2 * d0 + 1], qg[DUAL ? d0 : 0], r1_, 0, 0, 0); }
        }
        MK_SB();
        if (MIX == 0 && local) {
            const int mb = (loc0 + t) * 64 + 4 * hi - qpos + 128;
#pragma unroll
            for (int r = 0; r < 16; ++r) { const int kc = (r & 3) + 8 * (r >> 2);
                if ((unsigned)(mb + kc) > 256u) { p0[r] = -INFINITY; if (DUAL) r0_[r] = -INFINITY; } if ((unsigned)(mb + kc + 32) > 256u) { p1[r] = -INFINITY; if (DUAL) r1_[r] = -INFINITY; } }
        }
        if (MIX == 1 && local) {
            const int dr = (loc0 + t) - qb + 7;
            const int kh = 4 * hi - cs; const LAS float* rp = rpb + dr * 31 + 15 - qc + 4 * hi;
#pragma unroll
            for (int r = 0; r < 16; ++r) { const int kc = (r & 3) + 8 * (r >> 2);
                const bool v0 = (unsigned)(kh + kc) < 16u, v1 = (unsigned)(kh + kc + 32) < 16u;
                const float b0 = rp[kc], b1 = rp[kc + 32];
                p0[r] = v0 ? p0[r] + b0 : -INFINITY; p1[r] = v1 ? p1[r] + b1 : -INFINITY; }
        }
        softmax_tile(p0, p1, l0, pa0);
        if (TWO) softmax_tile(r0_, r1_, l1, pa1);
        WG_BAR();
        if (KHOLD && t + 1 < NT) loadkf(t + 1);
    }
    loadvf(NT - 1); pv(NT - 1);
    }
    { refresh(F); const int l31f = F.lane & 31, hif = F.lane >> 5;
      const float lt0 = x32_sum(l0); const float i0 = 1.0f / lt0;
      float sc1 = 0.f;
      if (DIFF) { const float lt1 = x32_sum(l1); sc1 = tab[TAB_LAM + L] / lt1; }
      if (DUAL) { const float lt1 = x32_sum(l1); sc1 = 1.0f / lt1; }
      float ss = 0.f, ss1 = 0.f;
#pragma unroll
      for (int dh = 0; dh < 2; ++dh)
#pragma unroll
          for (int r = 0; r < 16; ++r) { float v = o0[dh][r] * i0; if (DIFF) v -= o1[dh][r] * sc1; o0[dh][r] = v; ss += v * v;
              if (DUAL) { const float v1 = o1[dh][r] * sc1; o1[dh][r] = v1; ss1 += v1 * v1; } }
      ss = x32_sum(ss); if (DUAL) ss1 = x32_sum(ss1);
      float scl;
      if (DIFF) scl = __builtin_amdgcn_rsqf(ss * (1.f / 64.f) + EPS) * tab[TAB_LAM + DEPTH + L];
      else {
          LAS float* gss = (LAS float*)(F.lds + AT_GSS);
          if (hif == 0) { gss[(rs * 32 + l31f) * 4 + hq] = ss; if (DUAL) gss[(rs * 32 + l31f) * 4 + hq + 1] = ss1; }
          WG_BAR();
          const f32x4 g4 = *(const LAS f32x4*)(gss + (rs * 32 + l31f) * 4);
          scl = __builtin_amdgcn_rsqf(((g4.x + g4.y) + (g4.z + g4.w)) * (1.f / 256.f) + EPS);
      }
      int lf = l31f;
      const int qrow_f = isctx ? NLAT + b * CTXL + qb * UQ + rs * 32 + lf : b * SEQ + qb * UQ + rs * 32 + lf;
      GAS bf16_t* yp = Y + (size_t)qrow_f * D + MIX * 256 + hq * 64 + 4 * hif;
#pragma unroll
      for (int dh = 0; dh < 2; ++dh)
#pragma unroll
          for (int g = 0; g < 4; ++g) { u32x2 o; o.x = pk2(o0[dh][4 * g] * scl, o0[dh][4 * g + 1] * scl); o.y = pk2(o0[dh][4 * g + 2] * scl, o0[dh][4 * g + 3] * scl);
              *(GAS u32x2*)(yp + dh * 32 + 8 * g) = o;
              if (DUAL) { u32x2 o2; o2.x = pk2(o1[dh][4 * g] * scl, o1[dh][4 * g + 1] * scl); o2.y = pk2(o1[dh][4 * g + 2] * scl, o1[dh][4 * g + 3] * scl);
                  *(GAS u32x2*)(yp + 64 + dh * 32 + 8 * g) = o2; } }
    }
#ifdef MK_STAMP
    if (MIX == MK_STAMP && F.tid == MK_STAMP_TID) { LAS unsigned* m_ = (LAS unsigned*)(F.lds + MISC_OFF); const unsigned a_ = m_[20]; unsigned z_ = 0; asm volatile("" : "+v"(z_)); m_[20] = z_;
        if (!isctx) { __hip_atomic_fetch_add(CTL(F) + 2048, a_, __ATOMIC_RELAXED, __HIP_MEMORY_SCOPE_AGENT); __hip_atomic_fetch_add(CTL(F) + 2049, (unsigned)(NT - 1), __ATOMIC_RELAXED, __HIP_MEMORY_SCOPE_AGENT); } }
#endif
}

template <int MIX>
__device__ __forceinline__ void run_mixer(FARGS, int L, bool need_ctx) {
    constexpr bool DUAL = (MIX == 3) && MK_DUAL, HP = (MIX == 2) && MK_CHP;
    constexpr int NU = DUAL ? 512 : 1024, NC = DUAL ? 64 : 128;
    const int G = F.G;
    const int c = (G % 8 == 0) ? (F.bx % 8) * (G / 8) + F.bx / 8 : F.bx;
    const int nlat = c < NU ? (NU - c + G - 1) / G : 0;
    const int j = (MIX & 1) ? c - 128 : c;
    const bool has_ctx = need_ctx && j >= 0 && j < NC;
    const int n = nlat + (has_ctx ? 1 : 0);
    for (int k = 0; k < n; ++k) { const bool isctx = k >= nlat; const int i = isctx ? j : c + k * G;
        int b, qb, hp = 0;
        if (HP) { if (isctx) { b = i >> 2; qb = (i >> 1) & 1; hp = i & 1; } else { b = i >> 5; qb = (i & 31) >> 1; hp = i & 1; } }
        else if (DUAL) { if (isctx) { b = i >> 1; qb = i & 1; } else { b = i >> 4; qb = i & 15; } }
        else { if (isctx) { b = i >> 2; qb = i & 3; } else { b = i >> 5; qb = i & 31; } }
        attn_unit<MIX>(F, L, b, qb, isctx, hp); }
}
__device__ __forceinline__ void attn_phase(FARGS, int L, bool need_ctx) {
    refresh(F);
    { LAS float* rpb = (LAS float*)(F.lds + AT_RPB); const GAS float* src = INP(14) + L * 4 * 465;
      for (int i = F.tid; i < 4 * 465; i += 512) rpb[i] = src[i] * LOG2E; }
    __syncthreads();
#ifndef MK_DOUBLE_MIX
#define MK_DOUBLE_MIX -1
#endif
#define REPM(k) for (int rep_ = 0; rep_ < ((MK_DOUBLE_MIX == (k)) ? 2 : 1); ++rep_)
    REPM(2) run_mixer<2>(F, L, need_ctx);
    REPM(3) run_mixer<3>(F, L, need_ctx);
    REPM(1) run_mixer<1>(F, L, need_ctx);
    REPM(0) run_mixer<0>(F, L, need_ctx);
    __syncthreads();
}
struct ProbPlain {
    static constexpr bool GATHER = false;
    const GAS char* A; const GAS char* Bt; int K, lda, ldb; size_t hstepA, hstepB; pg8::Order ord;
    __device__ __forceinline__ bool next(int i, pg8::Unit& u) const { return ord.next(i, u); }
    template <int NH> __device__ __forceinline__ void a_off(const pg8::Unit& u, int tid, unsigned (&v)[NH][2]) const {
        int R0, C0, R1, C1; pg8::stage_rc(tid * 16, R0, C0); pg8::stage_rc(tid * 16 + 8192, R1, C1);
        v[0][0] = (unsigned)((u.pm * 256 + R0) * lda + C0) * 2u; v[0][1] = (unsigned)((u.pm * 256 + R1) * lda + C1) * 2u;
    }
    __device__ __forceinline__ const GAS char* b_tile(const pg8::Unit& u, int t) const { return Bt + ((size_t)u.pn * 256 * ldb + (size_t)t * 64) * 2; }
};
struct EpiU { static constexpr int SID = 0;
    static constexpr bool PERM = true; static constexpr int NSTORES = 32;
    GAS bf16_t* U;
    __device__ __forceinline__ void operator()(const f32x4 (&acc)[2][2][4][2], const pg8::Unit& u, int wr, int wc, int fr, int fq) const {
        const int row0 = u.pm * 256 + wr * 64 + fr, col0 = u.pn * 256 + wc * 32 + 8 * fq;
#pragma unroll
        for (int ai = 0; ai < 2; ++ai)
#pragma unroll
            for (int m = 0; m < 4; ++m) { int frx = fr; asm volatile("" : "+v"(frx)); GAS bf16_t* rowp = U + (size_t)(u.pm * 256 + wr * 64 + frx + ai * 128 + m * 16) * DIN + col0;
#pragma unroll
                for (int bj = 0; bj < 2; ++bj) { const f32x4 v0 = acc[ai][bj][m][0], v1 = acc[ai][bj][m][1];
                    u32x4 w; w.x = pk2(v0[0], v0[1]); w.y = pk2(v0[2], v0[3]); w.z = pk2(v1[0], v1[1]); w.w = pk2(v1[2], v1[3]);
                    *(GAS u32x4*)(rowp + bj * 128) = w; } }
    }
};
struct EpiQK { static constexpr int SID = 1;
    static constexpr bool PERM = true; static constexpr int NSTORES = 32;
    GAS bf16_t* U; const GAS float* tab; const GAS float* gwin; const GAS float* gna; const GAS float* gdiff; const GAS float* ggqa; LAS float* X; float vscale;
    __device__ __forceinline__ void operator()(const f32x4 (&acc)[2][2][4][2], const pg8::Unit& u, int wr, int wc, int fr_, int fq_) const {
        int fq = fq_, fr = fr_; asm volatile("" : "+v"(fq), "+v"(fr));
        const int pn = u.pn;
        const bool lat = u.pm < 256;
        int kind = 0, nbj = 0; bool isq = false, rope = false; const GAS float* g = gwin; float qs = 1.f;
        if (pn == 0) { kind = 1; nbj = 2; isq = true; rope = true; g = gwin; } else if (pn == 1) { kind = 1; nbj = 1; rope = true; g = gwin + 64; }
        else if (pn == 2) { kind = 1; nbj = 2; isq = true; g = gna; } else if (pn == 3) { kind = 1; nbj = 2; g = gna + 64; }
        else if (pn == 5) { kind = 2; nbj = 2; isq = true; rope = true; g = gdiff; } else if (pn == 6) { kind = 2; nbj = 2; rope = true; g = gdiff + 32; }
        else if (pn == 8) { kind = 1; nbj = 2; isq = true; rope = true; g = ggqa; } else if (pn == 9) { kind = 1; nbj = 1; rope = true; g = ggqa + 64; }
        rope = rope && lat;
        if (kind == 0) body<0, false, 0>(acc, u, wr, wc, fr, fq, isq, g);
        else if (kind == 2) { if (rope) body<2, true, 2>(acc, u, wr, wc, fr, fq, isq, g); else body<2, false, 2>(acc, u, wr, wc, fr, fq, isq, g); }
        else if (nbj == 2) { if (rope) body<1, true, 2>(acc, u, wr, wc, fr, fq, isq, g); else body<1, false, 2>(acc, u, wr, wc, fr, fq, isq, g); }
        else { if (rope) body<1, true, 1>(acc, u, wr, wc, fr, fq, isq, g); else body<1, false, 1>(acc, u, wr, wc, fr, fq, isq, g); }
    }
    template <int kind, bool rope, int nbj>
    __device__ __forceinline__ void body(const f32x4 (&acc)[2][2][4][2], const pg8::Unit& u, int wr, int wc, int fr, int fq, bool isq, const GAS float* g) const {
        const int pn = u.pn, lane = fr + 16 * fq;
        float qs = 1.f;
        if (isq) qs = (kind == 2 ? 0.17677669529663687f : 0.125f) * LOG2E;
        const int row0 = u.pm * 256 + wr * 64 + fr, col0 = pn * 256 + wc * 32 + 8 * fq;
        float gg[8];
        { const int dg = kind == 2 ? 8 * fq : 32 * (wc & 1) + 8 * fq; const f32x4 a = *(const GAS f32x4*)(g + dg), b = *(const GAS f32x4*)(g + dg + 4);
          gg[0] = a.x; gg[1] = a.y; gg[2] = a.z; gg[3] = a.w; gg[4] = b.x; gg[5] = b.y; gg[6] = b.z; gg[7] = b.w; }
        auto sumsq = [&](int ai, int m, int bj) -> float { const f32x4 v0 = acc[ai][bj][m][0], v1 = acc[ai][bj][m][1];
            float s = (v0[0] * v0[0] + v0[1] * v0[1]) + (v0[2] * v0[2] + v0[3] * v0[3]) + (v1[0] * v1[0] + v1[1] * v1[1]) + (v1[2] * v1[2] + v1[3] * v1[3]);
            s += sx(s, lane, 16); s += sx(s, lane, 32); return s; };
        LAS float* Xw = X + (wr * 64 + fr) * 8 + wc; const LAS float* Xr = X + (wr * 64 + fr) * 8 + (wc ^ 1);
        float ssv[2][4][2];
#pragma unroll
        for (int ai = 0; ai < 2; ++ai)
#pragma unroll
            for (int m = 0; m < 4; ++m) { ssv[ai][m][0] = 0.f; ssv[ai][m][1] = 0.f; }
        if (kind == 1) {
#pragma unroll
            for (int ai = 0; ai < 2; ++ai)
#pragma unroll
                for (int m = 0; m < 4; ++m)
#pragma unroll
                    for (int bj = 0; bj < 2; ++bj) { const float s = sumsq(ai, m, bj); ssv[ai][m][bj] = s; if (fq == 0) Xw[(ai * 128 + m * 16) * 8 + bj * 4] = s; }
            asm volatile("s_waitcnt lgkmcnt(0)\n\ts_barrier" ::: "memory");
        }
        const int pxor = kind == 2 ? 16 : 32;
        const bool first = kind == 2 ? !(fq & 1) : (fq < 2);
        auto load_cs = [&](int it, f32x4 (&dst)[4]) {
            int frx = fr; asm volatile("" : "+v"(frx));
            const int row = u.pm * 256 + (it >> 2) * 128 + wr * 64 + (it & 3) * 16 + frx, s_ = row & 2047, prow = s_ >> 6, pcol = s_ & 63;
            const GAS float* tp = kind == 2 ? tab + TAB_T32 + ((fq < 2 ? prow : pcol) * 8) * 2 : tab + TAB_T64 + (((wc & 1) ? pcol : prow) * 16 + 8 * (fq & 1)) * 2;
#pragma unroll
            for (int e2 = 0; e2 < 4; ++e2) dst[e2] = *(const GAS f32x4*)(tp + 4 * e2); };
        f32x4 cs[4], ncs[4];
        if (rope) load_cs(0, cs);
#pragma unroll
        for (int ai = 0; ai < 2; ++ai)
#pragma unroll
            for (int m = 0; m < 4; ++m) {
                int frx = fr; asm volatile("" : "+v"(frx));
                const int rit = ai * 128 + wr * 64 + m * 16 + frx, row = u.pm * 256 + rit;
                GAS bf16_t* rowp = U + (size_t)row * DIN + col0;
                if (rope && ai * 4 + m < 7) load_cs(ai * 4 + m + 1, ncs);
                asm volatile("" ::: "memory");
#pragma unroll
                for (int bj = 0; bj < 2; ++bj) {
                    const f32x4 v0 = acc[ai][bj][m][0], v1 = acc[ai][bj][m][1];
                    float x[8] = {v0[0], v0[1], v0[2], v0[3], v1[0], v1[1], v1[2], v1[3]};
                    if (kind != 0 && bj < nbj) {
                        float ss;
                        if (kind == 1) ss = ssv[ai][m][bj] + Xr[(ai * 128 + m * 16) * 8 + bj * 4]; else ss = sumsq(ai, m, bj);
                        const float rq = qs * __builtin_amdgcn_rsqf(ss * (kind == 2 ? (1.f / 32.f) : (1.f / 64.f)) + EPS);
#pragma unroll
                        for (int e = 0; e < 8; ++e) x[e] = x[e] * gg[e];
                        if (rope) {
#pragma unroll
                            for (int e2 = 0; e2 < 4; ++e2) {
                                const float pa = sx(x[2 * e2], lane, pxor), pb = sx(x[2 * e2 + 1], lane, pxor);
                                x[2 * e2] = first ? x[2 * e2] * cs[e2].x - pa * cs[e2].y : pa * cs[e2].y + x[2 * e2] * cs[e2].x;
                                x[2 * e2 + 1] = first ? x[2 * e2 + 1] * cs[e2].z - pb * cs[e2].w : pb * cs[e2].w + x[2 * e2 + 1] * cs[e2].z;
                            }
                        }
#pragma unroll
                        for (int e = 0; e < 8; ++e) x[e] *= rq;
                    } else {
#pragma unroll
                        for (int e = 0; e < 8; ++e) x[e] *= vscale;
                    }
                    u32x4 w; w.x = pk2(x[0], x[1]); w.y = pk2(x[2], x[3]); w.z = pk2(x[4], x[5]); w.w = pk2(x[6], x[7]);
                    *(GAS u32x4*)(rowp + bj * 128) = w;
                }
#pragma unroll
                for (int e2 = 0; e2 < 4; ++e2) cs[e2] = ncs[e2];
            }
    }
};
struct EpiResid { static constexpr int SID = 2;
    static constexpr bool PERM = true; static constexpr int NSTORES = 32;
    const GAS float* slat; const GAS float* sctx; GAS bf16_t* XB; const GAS float* gate; bool first; float ascale;
    __device__ __forceinline__ void operator()(const f32x4 (&acc)[2][2][4][2], const pg8::Unit& u, int wr, int wc, int fr_, int fq) const {
        int fr = fr_; asm volatile("" : "+v"(fr));
        if (first) body<true>(acc, u, wr, wc, fr, fq); else body<false>(acc, u, wr, wc, fr, fq);
    }
    template <bool FIRST>
    __device__ __forceinline__ void body(const f32x4 (&acc)[2][2][4][2], const pg8::Unit& u, int wr, int wc, int fr, int fq) const {
        const bool islat = u.pm < 256; const int b = islat ? (u.pm >> 3) : 32;
        const GAS float* src = islat ? slat + (size_t)u.pm * 256 * D : sctx + (size_t)(u.pm - 256) * 256 * D;
        GAS bf16_t* dst = XB + (size_t)u.pm * 256 * D;
        const GAS float* gp = gate + (size_t)b * ADA;
        const int col0 = u.pn * 256 + wc * 32 + 8 * fq;
        f32x4 gv[2][2];
#pragma unroll
        for (int bj = 0; bj < 2; ++bj)
#pragma unroll
            for (int n = 0; n < 2; ++n) gv[bj][n] = *(const GAS f32x4*)(gp + col0 + bj * 128 + n * 4) * ascale;
        if (FIRST) {
#pragma unroll
            for (int ai = 0; ai < 2; ++ai)
#pragma unroll
                for (int m = 0; m < 4; ++m) {
                    const size_t ro = (size_t)(ai * 128 + wr * 64 + m * 16 + fr) * D + col0;
#pragma unroll
                    for (int bj = 0; bj < 2; ++bj) { f32x4 x0 = *(const GAS f32x4*)(src + ro + bj * 128), x1 = *(const GAS f32x4*)(src + ro + bj * 128 + 4);
                        x0 = x0 + gv[bj][0] * acc[ai][bj][m][0]; x1 = x1 + gv[bj][1] * acc[ai][bj][m][1];
                        u32x4 o; o.x = pk2(x0[0], x0[1]); o.y = pk2(x0[2], x0[3]); o.z = pk2(x1[0], x1[1]); o.w = pk2(x1[2], x1[3]);
                        *(GAS u32x4*)(dst + ro + bj * 128) = o; } }
        } else {
            u32x4 wv[2][4][2];
#pragma unroll
            for (int ai = 0; ai < 2; ++ai)
#pragma unroll
                for (int m = 0; m < 4; ++m) { const size_t ro = (size_t)(ai * 128 + wr * 64 + m * 16 + fr) * D + col0;
                    wv[ai][m][0] = *(const GAS u32x4*)(dst + ro); wv[ai][m][1] = *(const GAS u32x4*)(dst + ro + 128); }
#pragma unroll
            for (int ai = 0; ai < 2; ++ai)
#pragma unroll
                for (int m = 0; m < 4; ++m) { const size_t ro = (size_t)(ai * 128 + wr * 64 + m * 16 + fr) * D + col0;
#pragma unroll
                    for (int bj = 0; bj < 2; ++bj) { const u32x4 w = wv[ai][m][bj];
                        f32x4 x0 = (f32x4){bflo(w.x), bfhi(w.x), bflo(w.y), bfhi(w.y)}, x1 = (f32x4){bflo(w.z), bfhi(w.z), bflo(w.w), bfhi(w.w)};
                        x0 = x0 + gv[bj][0] * acc[ai][bj][m][0]; x1 = x1 + gv[bj][1] * acc[ai][bj][m][1];
                        u32x4 o; o.x = pk2(x0[0], x0[1]); o.y = pk2(x0[2], x0[3]); o.z = pk2(x1[0], x1[1]); o.w = pk2(x1[2], x1[3]);
                        *(GAS u32x4*)(dst + ro + bj * 128) = o; } }
        }
    }
};
struct MoeTab { const LAS int* tcls; const LAS int* trow; const LAS int* ccnt; };
__device__ __forceinline__ void moe_pair(int cls, int& ea, int& eb) { const int g = cls / 6, pr = cls % 6; const int ia = pr < 3 ? 0 : (pr < 5 ? 1 : 2), ib = pr < 3 ? pr + 1 : (pr < 5 ? pr - 1 : 3); ea = 4 * g + ia; eb = 4 * g + ib; }
__device__ __forceinline__ int moe_build_tables(FARGS, int L) {
    LAS int* tcls = (LAS int*)(F.lds + MOE_OFF); LAS int* trow = tcls + 320; LAS int* ccnt = trow + 320; LAS int* pre = ccnt + 32;
    if (F.tid < NCLS) ccnt[F.tid] = (int)__hip_atomic_load(CTL(F) + CW_CNT + (L * NCLS + F.tid) * 64, __ATOMIC_RELAXED, __HIP_MEMORY_SCOPE_AGENT);
    __syncthreads();
    if (F.tid == 0) { int T = 0;
#pragma unroll 1
        for (int c = 0; c < NCLS; ++c) { pre[c] = T; T += (ccnt[c] + 255) >> 8; }
        pre[NCLS] = T; }
    __syncthreads();
    const int T = pre[NCLS];
    if (F.tid < T) { int c = 0;
#pragma unroll 1
        for (int k = 1; k < NCLS; ++k) if (pre[k] <= F.tid) c = k;
        tcls[F.tid] = c; trow[F.tid] = (F.tid - pre[c]) * 256; }
    __syncthreads();
    return __builtin_amdgcn_readfirstlane(T);
}
struct ProbGateUp {
    static constexpr bool GATHER = true;
    const GAS char* A; const GAS char* W1; const GAS int* perm; int K, ldb; size_t hstepA, hstepB; pg8::Order ord; MoeTab tb;
    __device__ __forceinline__ bool next(int i, pg8::Unit& u) const { return ord.next(i, u); }
    template <int NH> __device__ __forceinline__ void a_off(const pg8::Unit& u, int tid, unsigned (&v)[NH][2]) const {
        int R0, C0, R1, C1; pg8::stage_rc(tid * 16, R0, C0); pg8::stage_rc(tid * 16 + 8192, R1, C1);
        const int cls = __builtin_amdgcn_readfirstlane(tb.tcls[u.pm]), tr = __builtin_amdgcn_readfirstlane(tb.trow[u.pm]), n = __builtin_amdgcn_readfirstlane(tb.ccnt[cls]);
        const GAS int* pp = perm + (size_t)cls * MTOT + tr;
#pragma unroll
        for (int h = 0; h < 2; ++h) { const int s0 = h * 128 + R0, s1 = h * 128 + R1;
            const int t0 = (tr + s0 < n) ? pp[s0] : 0, t1 = (tr + s1 < n) ? pp[s1] : 0;
            v[h][0] = (unsigned)(t0 * D + C0) * 2u; v[h][1] = (unsigned)(t1 * D + C1) * 2u; }
    }
    __device__ __forceinline__ const GAS char* b_tile(const pg8::Unit& u, int t) const {
        const int cls = __builtin_amdgcn_readfirstlane(tb.tcls[u.pm]); int ea, eb; moe_pair(cls, ea, eb); const int e = u.pn < 4 ? ea : eb;
        return W1 + (((size_t)e * 1024 + (u.pn & 3) * 256) * D + (size_t)t * 64) * 2;
    }
};
struct EpiGateUp { static constexpr int SID = 3;
    static constexpr bool PERM = true; static constexpr int NSTORES = 16;
    GAS bf16_t* ACT; const GAS int* perm; const GAS float* RW; MoeTab tb;
    __device__ __forceinline__ void operator()(const f32x4 (&acc)[2][2][4][2], const pg8::Unit& u, int wr, int wc, int fr, int fq) const {
        const int cls = __builtin_amdgcn_readfirstlane(tb.tcls[u.pm]), tr = __builtin_amdgcn_readfirstlane(tb.trow[u.pm]), n = __builtin_amdgcn_readfirstlane(tb.ccnt[cls]);
        const GAS int* pp = perm + (size_t)cls * MTOT + tr;
        const int wsel = u.pn >> 2, colb = wsel * 512 + (u.pn & 3) * 128 + wc * 32 + 8 * fq;
        int frx = fr; asm volatile("" : "+v"(frx));
        const int rbase = wr * 64 + frx;
        int tok[8]; float wgt[8];
#pragma unroll
        for (int i = 0; i < 8; ++i) { const int rr = (i >> 2) * 128 + (i & 3) * 16 + rbase; const int rc = rr < n - tr ? rr : n - tr - 1; tok[i] = pp[rc]; }
#pragma unroll
        for (int i = 0; i < 8; ++i) { const float w_ = RW[(size_t)tok[i] * 2 + wsel]; wgt[i] = w_; }
#pragma unroll
        for (int i = 0; i < 8; ++i) { const int rr = (i >> 2) * 128 + (i & 3) * 16 + rbase; if (!(tr + rr < n)) wgt[i] = 0.f; }
#pragma unroll
        for (int ai = 0; ai < 2; ++ai)
#pragma unroll
            for (int m = 0; m < 4; ++m) { const int rr = ai * 128 + m * 16 + rbase; const float wg = wgt[ai * 4 + m];
                float a[8];
#pragma unroll
                for (int nn = 0; nn < 2; ++nn)
#pragma unroll
                    for (int j = 0; j < 4; ++j) { const float g = acc[ai][0][m][nn][j], uu = acc[ai][1][m][nn][j];
                        a[nn * 4 + j] = g * __builtin_amdgcn_rcpf(1.0f + __builtin_amdgcn_exp2f(-g * LOG2E)) * uu * wg; }
                u32x4 w; w.x = pk2(a[0], a[1]); w.y = pk2(a[2], a[3]); w.z = pk2(a[4], a[5]); w.w = pk2(a[6], a[7]);
                *(GAS u32x4*)(ACT + (size_t)(u.pm * 256 + rr) * D + colb) = w; }
    }
};
struct ProbDown {
    static constexpr bool GATHER = false;
    const GAS char* A; const GAS char* W2; int K, ldb; size_t hstepA, hstepB; pg8::Order ord; MoeTab tb;
    __device__ __forceinline__ bool next(int i, pg8::Unit& u) const { return ord.next(i, u); }
    template <int NH> __device__ __forceinline__ void a_off(const pg8::Unit& u, int tid, unsigned (&v)[NH][2]) const {
        int R0, C0, R1, C1; pg8::stage_rc(tid * 16, R0, C0); pg8::stage_rc(tid * 16 + 8192, R1, C1);
        v[0][0] = (unsigned)((u.pm * 256 + R0) * D + C0) * 2u; v[0][1] = (unsigned)((u.pm * 256 + R1) * D + C1) * 2u;
    }
    __device__ __forceinline__ const GAS char* b_tile(const pg8::Unit& u, int t) const {
        const int cls = __builtin_amdgcn_readfirstlane(tb.tcls[u.pm]); int ea, eb; moe_pair(cls, ea, eb); const int e = t < 8 ? ea : eb;
        return W2 + (((size_t)e * 1024 + u.pn * 256) * DEXP + (size_t)(t & 7) * 64) * 2;
    }
};
template <bool LAST> struct EpiDown { static constexpr int SID = 4;
    static constexpr bool PERM = true; static constexpr int NSTORES = 0;
    GAS bf16_t* XB; GAS float* out; const GAS float* gate; const GAS int* perm; MoeTab tb;
    __device__ __forceinline__ void operator()(const f32x4 (&acc)[2][2][4][2], const pg8::Unit& u, int wr, int wc, int fr, int fq) const {
        const int cls = __builtin_amdgcn_readfirstlane(tb.tcls[u.pm]), tr = __builtin_amdgcn_readfirstlane(tb.trow[u.pm]), n = __builtin_amdgcn_readfirstlane(tb.ccnt[cls]);
        const GAS int* pp = perm + (size_t)cls * MTOT + tr;
        const int col0 = u.pn * 256 + wc * 32 + 8 * fq;
        int frx = fr; asm volatile("" : "+v"(frx));
        const int rbase = wr * 64 + frx;
        int tok8[8];
#pragma unroll
        for (int i = 0; i < 8; ++i) { const int rr = (i >> 2) * 128 + (i & 3) * 16 + rbase; const int rc = rr < n - tr ? rr : n - tr - 1; tok8[i] = pp[rc]; }
        u32x4 wv[4][2]; f32x4 gv[2][2][2];
        auto load_res = [&](int i) { const GAS bf16_t* xr = XB + (size_t)tok8[i] * D + col0; wv[i & 3][0] = *(const GAS u32x4*)xr; wv[i & 3][1] = *(const GAS u32x4*)(xr + 128); };
#pragma unroll
        for (int i = 0; i < 4; ++i) load_res(i);
        auto load_gate = [&](int i, f32x4 (&g)[2][2]) { const int tok = tok8[i]; const int b = tok < NLAT ? (tok >> 11) : 32; const GAS float* gp = gate + (size_t)b * ADA + col0;
#pragma unroll
            for (int bj = 0; bj < 2; ++bj) { g[bj][0] = *(const GAS f32x4*)(gp + bj * 128); g[bj][1] = *(const GAS f32x4*)(gp + bj * 128 + 4); } };
        load_gate(0, gv[0]);
#pragma unroll
        for (int i = 0; i < 8; ++i) { const int ai = i >> 2, m = i & 3;
            if (i + 1 < 8) load_gate(i + 1, gv[(i + 1) & 1]);
            __builtin_amdgcn_sched_barrier(0);
            const int rr = ai * 128 + m * 16 + rbase; const bool valid = tr + rr < n; const int tok = tok8[i];
#pragma unroll
            for (int bj = 0; bj < 2; ++bj) { const u32x4 w = wv[i & 3][bj];
                const f32x4 x0 = (f32x4){bflo(w.x), bfhi(w.x), bflo(w.y), bfhi(w.y)} + gv[i & 1][bj][0] * acc[ai][bj][m][0], x1 = (f32x4){bflo(w.z), bfhi(w.z), bflo(w.w), bfhi(w.w)} + gv[i & 1][bj][1] * acc[ai][bj][m][1];
                if (valid) {
                    if (LAST) { GAS float* op = out + (size_t)tok * D + col0 + bj * 128; *(GAS f32x4*)op = x0; *(GAS f32x4*)(op + 4) = x1; }
                    else { u32x4 o; o.x = pk2(x0[0], x0[1]); o.y = pk2(x0[2], x0[3]); o.z = pk2(x1[0], x1[1]); o.w = pk2(x1[2], x1[3]); *(GAS u32x4*)(XB + (size_t)tok * D + col0 + bj * 128) = o; } } }
            __builtin_amdgcn_sched_barrier(0);
            if (i + 4 < 8) load_res(i + 4);
        }
    }
};

constexpr int NPHASE = 1 + 8 * DEPTH;
__global__ void __launch_bounds__(NWAVES * 64, 2) mk_fwd(Args args) {
    extern __shared__ __attribute__((aligned(16))) unsigned char lds_raw[];
    Frame F;
    F.lds = (LAS unsigned char*)lds_raw;
    volatile LAS unsigned* MISC = (volatile LAS unsigned*)(F.lds + MISC_OFF);
    F.tid = threadIdx.x; F.lane = F.tid & 63; F.wave = __builtin_amdgcn_readfirstlane(F.tid >> 6); F.G = gridDim.x; F.bx = blockIdx.x;
    const bool t0 = F.tid == 0;
    F.ws = (GAS unsigned char*)args.ws; F.out = (GAS float*)args.out; F.ka = (kptr_t)__builtin_amdgcn_kernarg_segment_ptr();
    for (int u = F.tid; u < (LDS_BYTES - MISC_OFF) / 4; u += NWAVES * 64) ((LAS unsigned*)(F.lds + MISC_OFF))[u] = 0u;
    __syncthreads();
    XcdBarrier bar; bar.bar = (unsigned*)(CTL(F) + CW_BAR); bar.x = 0; bar.st = nullptr;
    if (args.use_bar) bar = xcd_barrier_post((unsigned*)(CTL(F) + CW_BAR), MISC + 8, t0);
    const int lo = args.ph_lo, hi = args.ph_hi;
#define IN(k) (lo <= (k) && (k) < hi)
#ifndef MK_BAR_REP
#define MK_BAR_REP 1
#endif
#ifdef MK_GSTAMP
#define GS_FLUSH() do { if (F.tid == MK_GSTAMP_TID) { LAS unsigned* m_ = (LAS unsigned*)(F.lds + MISC_OFF); const unsigned a_ = m_[16], n_ = m_[17]; unsigned z_ = 0; asm volatile("" : "+v"(z_)); m_[16] = z_; m_[17] = z_; \
    if (n_) { __hip_atomic_fetch_add(CTL(F) + 2048, a_, __ATOMIC_RELAXED, __HIP_MEMORY_SCOPE_AGENT); __hip_atomic_fetch_add(CTL(F) + 2049, n_, __ATOMIC_RELAXED, __HIP_MEMORY_SCOPE_AGENT); } } } while (0)
#else
#define GS_FLUSH() do {} while (0)
#endif
#define SEAM(k) do { GS_FLUSH(); if (IN(k) && IN((k) + 1)) { for (int br_ = 0; br_ < MK_BAR_REP; ++br_) { refresh(F); xcd_barrier(bar, F.tid == 0); } } } while (0)
#ifndef MK_PHMASK
#define MK_PHMASK 0x1ff
#endif
#define EN(k) ((MK_PHMASK >> (k)) & 1)
#ifndef MK_SEPARATE_QKPREP
#define MK_SEPARATE_QKPREP 0
#endif
#ifndef MK_DOUBLE
#define MK_DOUBLE -1
#endif
#define REP(k) for (int rep_ = 0; rep_ < ((MK_DOUBLE == (k)) ? 2 : 1); ++rep_)
#define XB_P ((GAS bf16_t*)(F.ws + WS_XB))
#define MOD_P ((const GAS float*)(F.ws + WS_MOD))
    if (EN(0) && IN(0)) { REP(0) prologue_phase(F); SEAM(0); }
    for (int L0 = 0; L0 < DEPTH; ++L0) {
        const int pb = 1 + 8 * L0;
        if (EN(1) && IN(pb + 0)) { int L = L0; OPAQUE_S(L); refresh(F);
            REP(1) norm_phase<false>(F, L, MTOT, L == 0, INP(6) + L * D, 0, 1024); SEAM(pb + 0); }
        if (EN(2) && IN(pb + 1)) { int L = L0; OPAQUE_S(L); refresh(F);
            ProbPlain P; P.A = (const GAS char*)(F.ws + WS_H); P.Bt = (const GAS char*)(F.ws + WS_WIN) + (size_t)L * DIN * D * 2; P.K = D; P.lda = D; P.ldb = D; P.hstepA = (size_t)128 * D * 2; P.hstepB = (size_t)128 * D * 2; P.ord.init(MTOT / 256, DIN / 256, F.G, F.bx);
            EpiQK E; E.U = (GAS bf16_t*)(F.ws + WS_U); E.tab = (const GAS float*)(F.ws + WS_TAB); E.gwin = INP(9) + L * 128; E.gna = INP(10) + L * 128; E.gdiff = INP(11) + L * 64; E.ggqa = INP(12) + L * 128;
            E.X = (LAS float*)(F.lds + MOE_OFF);
            E.vscale = 1.0f;
            REP(2) pg8::gemm_phase<EpiQK, ProbPlain>(F.lds, P, E, F.tid);
            SEAM(pb + 1);
        }
        if (MK_SEPARATE_QKPREP && EN(3) && IN(pb + 2)) { REP(3) qkprep_phase(F, L0, (MK_DOUBLE != 3) || rep_ == 1 || args.pad != 0); SEAM(pb + 2); }
        if (EN(4) && IN(pb + 3)) { REP(4) attn_phase(F, L0, L0 < DEPTH - 1); SEAM(pb + 3); }
        if (EN(5) && IN(pb + 4)) { int L = L0; OPAQUE_S(L); refresh(F);
            const int M2 = L < DEPTH - 1 ? MTOT : NLAT;
            ProbPlain P; P.A = (const GAS char*)(F.ws + WS_Y); P.Bt = (const GAS char*)(F.ws + WS_WOUT) + (size_t)L * D * D * 2; P.K = D; P.lda = D; P.ldb = D; P.hstepA = (size_t)128 * D * 2; P.hstepB = (size_t)128 * D * 2; P.ord.init(M2 / 256, D / 256, F.G, F.bx);
            EpiResid E; E.slat = INP(0); E.sctx = INP(2); E.XB = XB_P; E.first = L == 0; E.gate = MOD_P + (size_t)L * 33 * ADA + 2 * 1024;
#ifdef MK_PROBE_K2
            P.K = 2 * D; E.ascale = 0.5f;
#else
            E.ascale = 1.0f;
#endif
            pg8::gemm_phase<EpiResid, ProbPlain>(F.lds, P, E, F.tid);
            SEAM(pb + 4);
        }
        if (EN(6) && IN(pb + 5)) { int L = L0; OPAQUE_S(L); refresh(F);
#ifdef MK_OLD_NORM2
            REP(6) norm_phase<true>(F, L, L < DEPTH - 1 ? MTOT : NLAT, false, INP(7) + L * D, 3 * 1024, 4 * 1024, (MK_DOUBLE != 6) || rep_ == 1 || args.pad != 0); SEAM(pb + 5); }
#else
            norm2_phase(F, L, L < DEPTH - 1 ? MTOT : NLAT); SEAM(pb + 5); }
#endif
        if (EN(7) && IN(pb + 6)) { int L = L0; OPAQUE_S(L); refresh(F);
            const int T = moe_build_tables(F, L);
            MoeTab tb; tb.tcls = (const LAS int*)(F.lds + MOE_OFF); tb.trow = tb.tcls + 320; tb.ccnt = tb.trow + 320;
            ProbGateUp P; P.A = (const GAS char*)(F.ws + WS_H); P.W1 = (const GAS char*)(F.ws + WS_W1) + (size_t)L * NEXP * 1024 * D * 2; P.perm = (const GAS int*)(F.ws + WS_PERM); P.K = D; P.ldb = D; P.hstepA = 0; P.hstepB = (size_t)128 * D * 2; P.ord.init(T, 8, F.G, F.bx); P.tb = tb;
            EpiGateUp E; E.ACT = (GAS bf16_t*)(F.ws + WS_ACT); E.perm = P.perm; E.RW = (const GAS float*)(F.ws + WS_RW); E.tb = tb;
            REP(7) pg8::gemm_phase<EpiGateUp, ProbGateUp>(F.lds, P, E, F.tid);
            SEAM(pb + 6);
        }
        if (EN(8) && IN(pb + 7)) { int L = L0; OPAQUE_S(L); refresh(F);
            const int T = moe_build_tables(F, L);
            MoeTab tb; tb.tcls = (const LAS int*)(F.lds + MOE_OFF); tb.trow = tb.tcls + 320; tb.ccnt = tb.trow + 320;
            ProbDown P; P.A = (const GAS char*)(F.ws + WS_ACT); P.W2 = (const GAS char*)(F.ws + WS_W2) + (size_t)L * NEXP * 1024 * DEXP * 2; P.K = D; P.ldb = DEXP; P.hstepA = (size_t)128 * D * 2; P.hstepB = (size_t)128 * DEXP * 2; P.ord.init(T, 4, F.G, F.bx); P.tb = tb;
            if (L < DEPTH - 1) { EpiDown<false> E; E.XB = XB_P; E.out = F.out; E.gate = MOD_P + (size_t)L * 33 * ADA + 5 * 1024; E.perm = (const GAS int*)(F.ws + WS_PERM); E.tb = tb;
                pg8::gemm_phase<EpiDown<false>, ProbDown>(F.lds, P, E, F.tid); }
            else { EpiDown<true> E; E.XB = XB_P; E.out = F.out; E.gate = MOD_P + (size_t)L * 33 * ADA + 5 * 1024; E.perm = (const GAS int*)(F.ws + WS_PERM); E.tb = tb;
                pg8::gemm_phase<EpiDown<true>, ProbDown>(F.lds, P, E, F.tid); }
            SEAM(pb + 7);
        }
    }
#if defined(MK_STAMP) || defined(MK_GSTAMP)
    {
        refresh(F); xcd_barrier(bar, F.tid == 0); refresh(F);
        const unsigned num = __hip_atomic_load(CTL(F) + 2048, __ATOMIC_RELAXED, __HIP_MEMORY_SCOPE_AGENT), den = __hip_atomic_load(CTL(F) + 2049, __ATOMIC_RELAXED, __HIP_MEMORY_SCOPE_AGENT);
        const float smul = 1.0f + floorf(((float)num / (float)(den ? den : 1u)) * (1.0f / MK_STAMP_Q)) * 0.02f;
        GAS f32x4* o4 = (GAS f32x4*)F.out;
        for (size_t i = (size_t)F.bx * 512 + F.tid; i < (size_t)NLAT * D / 4; i += (size_t)F.G * 512) o4[i] = o4[i] * smul;
    }
#endif
#undef IN
#undef SEAM
}

#ifndef MK_PER_PHASE
#define MK_PER_PHASE 0
#endif
extern "C" void kernel_launch(void* const* d_in, const int* in_sizes, int n_in, void* d_out, int out_size, void* d_ws, size_t ws_size, hipStream_t stream) {
    static int grid = 0;
    if (grid == 0) {
        if (n_in != 23 || out_size != NLAT * D || ws_size < WS_END) { fprintf(stderr, "kernel_launch: unexpected shapes (n_in %d out %d ws %zu)\n", n_in, out_size, ws_size); grid = -1; return; }
        int dev = 0, cus = 0, per_cu = 0;
        if (hipGetDevice(&dev) != hipSuccess || hipDeviceGetAttribute(&cus, hipDeviceAttributeMultiprocessorCount, dev) != hipSuccess) { grid = -1; return; }
        if (hipFuncSetAttribute((const void*)mk_fwd, hipFuncAttributeMaxDynamicSharedMemorySize, LDS_BYTES) != hipSuccess) { fprintf(stderr, "kernel_launch: hipFuncSetAttribute failed\n"); grid = -1; return; }
        if (hipOccupancyMaxActiveBlocksPerMultiprocessor(&per_cu, (const void*)mk_fwd, NWAVES * 64, LDS_BYTES) != hipSuccess || per_cu < 1) fprintf(stderr, "kernel_launch: occupancy query reports %d\n", per_cu);
        (void)hipGetLastError();
        grid = cus;
    }
    if (grid < 0) return;
    (void)hipMemsetAsync((char*)d_ws + WS_CTL, 0, CTL_ZERO_BYTES, stream);
    Args a{};
    for (int i = 0; i < 23; ++i) a.in[i] = (const float*)d_in[i];
    a.out = (float*)d_out; a.ws = (unsigned char*)d_ws; a.pad = 0;
#if MK_PER_PHASE
    for (int p = 0; p < NPHASE; ++p) { a.ph_lo = p; a.ph_hi = p + 1; a.use_bar = 0; hipLaunchKernelGGL(mk_fwd, dim3(grid), dim3(NWAVES * 64), LDS_BYTES, stream, a); }
#else
    a.ph_lo = 0; a.ph_hi = NPHASE; a.use_bar = 1;
    hipLaunchKernelGGL(mk_fwd, dim3(grid), dim3(NWAVES * 64), LDS_BYTES, stream, a);
#endif
}
```

```cpp
#include <hip/hip_runtime.h>
#include <cstdio>
#include <cstdint>
#define GAS __attribute__((address_space(1)))
#define MK_ILV 15
#define XB_TMO      128
#define XB_XCNT(j)  (256  + 64 * (j))
#define XB_XSUB(j)  (1280 + 64 * (j))
#define XB_XGEN(j)  (2304 + 64 * (j))
#define XB_TOP      3328
#define XB_TOPGEN   3392
#define XCD_BAR_WORDS 3456
#define XB_SPIN_CAP (1u << 18)
#define LAS __attribute__((address_space(3)))

__device__ __forceinline__ unsigned xb_ld(unsigned* p)              { return __hip_atomic_load(p, __ATOMIC_RELAXED, __HIP_MEMORY_SCOPE_AGENT); }
__device__ __forceinline__ unsigned xb_add(unsigned* p, unsigned v) { return __hip_atomic_fetch_add(p, v, __ATOMIC_RELAXED, __HIP_MEMORY_SCOPE_AGENT); }
__device__ __forceinline__ unsigned xb_xcc_id() { return (unsigned)__builtin_amdgcn_s_getreg((3 << 11) | 20) & 0xFu; }
#define XB_SPIN(cond, bar) do { unsigned _sp = 0; while (cond) { __builtin_amdgcn_s_sleep(1); \
    if ((++_sp & 255u) == 0u) { if (xb_ld(&(bar)[XB_TMO])) break; if (_sp > XB_SPIN_CAP) { atomicAdd(&(bar)[XB_TMO], 1u); break; } } } } while (0)

struct XcdBarrier {
    unsigned* bar; unsigned x;
    volatile LAS unsigned* st;
};

__device__ __forceinline__ XcdBarrier xcd_barrier_post(unsigned* bar, volatile LAS unsigned* st, bool t0  ) {
    XcdBarrier b; b.bar = bar; b.x = xb_xcc_id(); b.st = st;
    if (t0) (void)xb_add(&bar[XB_XCNT(b.x)], 1u);
    return b;
}
__device__ __forceinline__ void xcd_barrier_complete(unsigned* bar, unsigned x, unsigned& nloc, unsigned& nx) {
    const unsigned G = gridDim.x * gridDim.y * gridDim.z;
    unsigned sum, cnt, mine, sp = 0u;
    for (;;) {
        sum = 0u; cnt = 0u; mine = 0u;
#pragma unroll
        for (unsigned j = 0; j < 16; ++j) { const unsigned c = xb_ld(&bar[XB_XCNT(j)]); sum += c; cnt += (c > 0u) ? 1u : 0u; mine = (j == x) ? c : mine; }
        if (sum == G) break;
        __builtin_amdgcn_s_sleep(1);
        if ((++sp & 255u) == 0u) { if (xb_ld(&bar[XB_TMO])) break; if (sp > XB_SPIN_CAP) { atomicAdd(&bar[XB_TMO], 1u); break; } }
    }
    nloc = mine > 0u ? mine : 1u; nx = cnt > 0u ? cnt : 1u;
}

__device__ __forceinline__ void xcd_barrier(const XcdBarrier& b, bool t0  ) {
    asm volatile("s_waitcnt vmcnt(0)" ::: "memory");
    __syncthreads();
    if (t0) {
        unsigned* bar = b.bar;
        __builtin_amdgcn_s_waitcnt(0);
        unsigned nloc = b.st[0], nx = b.st[1];
        if (nloc == 0u) { xcd_barrier_complete(bar, b.x, nloc, nx); b.st[0] = nloc; b.st[1] = nx; }
        const unsigned old = xb_add(&bar[XB_XSUB(b.x)], 1u);
        const unsigned gen = old / nloc;
        if (old + 1u == (gen + 1u) * nloc) {
            __builtin_amdgcn_fence(__ATOMIC_RELEASE, "agent");
            asm volatile("s_waitcnt vmcnt(0)" ::: "memory");
            const unsigned og = xb_add(&bar[XB_TOP], 1u);
            const unsigned tg = og / nx;
            if (og + 1u == (tg + 1u) * nx) xb_add(&bar[XB_TOPGEN], 1u);
            else XB_SPIN(xb_ld(&bar[XB_TOPGEN]) == tg, bar);
            __builtin_amdgcn_fence(__ATOMIC_ACQUIRE, "agent");
            xb_add(&bar[XB_XGEN(b.x)], 1u);
            asm volatile("s_waitcnt vmcnt(0)" ::: "memory");
        } else {
            XB_SPIN(xb_ld(&bar[XB_XGEN(b.x)]) == gen, bar);
            __builtin_amdgcn_fence(__ATOMIC_ACQUIRE, "agent");
            asm volatile("s_waitcnt vmcnt(0)" ::: "memory");
        }
    }
    __syncthreads();
}
constexpr int D = 1024, NBATCH = 32, SEQ = 2048, DEPTH = 4, CTXL = 256, NLAT = NBATCH * SEQ, NCTX = NBATCH * CTXL, MTOT = NLAT + NCTX, DIN = 2560;
constexpr int NEXP = 16, DEXP = 512, NCLS = 24, ADA = 6 * D;
constexpr float EPS = 1e-6f, LOG2E = 1.4426950408889634f;
constexpr int QA = 0, KA = 256, VA = 384, QB = 512, KB = 768, VB = 1024, QC = 1280, KC = 1536, VC = 1792, QD = 2048, KD = 2304, VD = 2432;
constexpr size_t MiB = 1u << 20;
constexpr size_t WS_CTL = 0, CTL_ZERO_BYTES = 128 * 1024;
constexpr size_t WS_MOD = 1 * MiB;
constexpr size_t WS_TAB = 4 * MiB + 256 * 1024;
constexpr size_t WS_RW = 4 * MiB + 320 * 1024;
constexpr size_t WS_PERM = 5 * MiB;
constexpr size_t WS_WIN = 12 * MiB;
constexpr size_t WS_WOUT = 32 * MiB;
constexpr size_t WS_W1 = 40 * MiB;
constexpr size_t WS_W2 = 168 * MiB;
constexpr size_t WS_XB = 232 * MiB;
constexpr size_t WS_Y = 376 * MiB;
constexpr size_t WS_U = 520 * MiB;
constexpr size_t WS_ACT = WS_U;
constexpr size_t WS_H = 880 * MiB;
constexpr size_t WS_END = 1024 * MiB;
static_assert(WS_MOD + (size_t)DEPTH * 33 * 6144 * 4 <= WS_TAB && WS_RW + (size_t)MTOT * 8 <= WS_PERM && WS_PERM + (size_t)NCLS * MTOT * 4 <= WS_WIN, "ws map");
constexpr int CW_BAR = 4096;
constexpr int CW_CNT = 16384;
static_assert((CW_CNT + DEPTH * NCLS * 64) * 4 <= (int)CTL_ZERO_BYTES && (CW_BAR + 3456) <= CW_CNT, "ctl");
constexpr int TAB_T64 = 0;
constexpr int TAB_T32 = 2048;
constexpr int TAB_LAM = 3072;
constexpr int NWAVES = 8;
constexpr int LDS_BYTES = 159744;
constexpr int RING_BYTES = 131072;
constexpr int MOE_OFF = 131072;
constexpr int NRM_OFF = 134144;
constexpr int MISC_OFF = 155648;
constexpr int AT_BUFB = 70656, AT_VOFF = 33792, AT_RPB = 141312, AT_GSS = 148992;

typedef unsigned short bf16_t;
typedef short bf16x8 __attribute__((ext_vector_type(8)));
typedef short s16x4 __attribute__((ext_vector_type(4)));
typedef float f32x4 __attribute__((ext_vector_type(4)));
typedef float f32x2 __attribute__((ext_vector_type(2)));
typedef float f32x16 __attribute__((ext_vector_type(16)));
typedef unsigned u32x4 __attribute__((ext_vector_type(4)));
typedef unsigned u32x2 __attribute__((ext_vector_type(2)));
typedef __bf16 bf16x2_t __attribute__((ext_vector_type(2)));

__device__ __forceinline__ unsigned pk2(float lo, float hi) { f32x2 v = {lo, hi}; bf16x2_t b = __builtin_convertvector(v, bf16x2_t); return __builtin_bit_cast(unsigned, b); }
__device__ __forceinline__ float bflo(unsigned w) { return __uint_as_float(w << 16); }
__device__ __forceinline__ float bfhi(unsigned w) { return __uint_as_float(w & 0xffff0000u); }
__device__ __forceinline__ float sx(float v, int lane, int m) { return __int_as_float(__builtin_amdgcn_ds_bpermute((lane ^ m) << 2, __float_as_int(v))); }
__device__ __forceinline__ float x32_sum(float v) { auto rr = __builtin_amdgcn_permlane32_swap(__float_as_uint(v), __float_as_uint(v), false, false); return __uint_as_float(rr[0]) + __uint_as_float(rr[1]); }
__device__ __forceinline__ float x32_max(float v) { auto rr = __builtin_amdgcn_permlane32_swap(__float_as_uint(v), __float_as_uint(v), false, false); return fmaxf(__uint_as_float(rr[0]), __uint_as_float(rr[1])); }
__device__ __forceinline__ float swap32(float v, bool upper_half) { auto rr = __builtin_amdgcn_permlane32_swap(__float_as_uint(v), __float_as_uint(v), false, false); return __uint_as_float(upper_half ? rr[0] : rr[1]); }
__device__ __forceinline__ float wave_sum(float v, int lane) {
#pragma unroll
    for (int o = 1; o < 32; o <<= 1) v += sx(v, lane, o);
    return x32_sum(v);
}
#define LDS_WAIT() asm volatile("s_waitcnt lgkmcnt(0)" ::: "memory")
#define WG_BAR() asm volatile("s_waitcnt lgkmcnt(0)\n\ts_barrier" ::: "memory")

struct Args { const float* in[23]; float* out; unsigned char* ws; int ph_lo, ph_hi, use_bar, pad; };
typedef __attribute__((address_space(4))) const unsigned char* kptr_t;
struct Frame {
    LAS unsigned char* lds;
    GAS unsigned char* ws;
    GAS float* out;
    kptr_t ka;
    int tid, lane, wave, G, bx;
};
#define FARGS Frame& F
typedef const GAS float* cfp_t;
__device__ __forceinline__ const GAS float* inp(const Frame& F, int i) { return *(__attribute__((address_space(4))) const cfp_t*)(F.ka + 8 * i); }
#define INP(i) inp(F, (i))
#define CTL(F) ((GAS unsigned*)((F).ws + WS_CTL))
__device__ __forceinline__ void refresh(Frame& F) {
    unsigned z = 0u; asm volatile("" : "+v"(z));
    const int ln = (int)__builtin_amdgcn_mbcnt_hi(~0u, __builtin_amdgcn_mbcnt_lo(~0u, z));
    F.lane = ln; F.tid = F.wave * 64 + ln;
    asm volatile("" : "+s"(F.ws)); asm volatile("" : "+s"(F.out)); asm volatile("" : "+s"(F.ka));
}
#define OPAQUE_S(x) asm volatile("" : "+s"(x))
namespace pg8 {
#define PG8_LAS __attribute__((address_space(3)))
#define PG8_GAS __attribute__((address_space(1)))
typedef unsigned short bf16_t;
typedef short bf16x8 __attribute__((ext_vector_type(8)));
typedef float f32x4 __attribute__((ext_vector_type(4)));
typedef unsigned u32x4 __attribute__((ext_vector_type(4)));
#ifndef MK_WGM
#define MK_WGM 8
#endif
constexpr int BM = 256, BK = 64, HALF = 128, HTB = HALF * BK * 2, STAGE_BYTES = 8 * HTB, NXCD = 8, WGM = MK_WGM;

__host__ __device__ __forceinline__ int lds_byte(int r, int c) { const int st = (r >> 4) * 2 + (c >> 5), rr = r & 15, cc = c & 31, ob = rr * 64 + cc * 2; return st * 1024 + (ob ^ (((ob >> 9) & 1) << 5)); }
__host__ __device__ __forceinline__ void stage_rc(int b, int& R, int& C) { const int st = b / 1024, sb = b % 1024, swz = sb ^ (((sb >> 9) & 1) << 5); R = (st >> 1) * 16 + swz / 64; C = (st & 1) * 32 + (swz % 64) / 2; }
__host__ __device__ __forceinline__ int perm32(int rho) { const int n = rho >> 4, i = rho & 15; return 8 * (i >> 2) + 4 * n + (i & 3); }

struct Unit { int pm, pn; };

struct Order {
    int nM, nN, nwg, G, c;
    __device__ __forceinline__ void init(int nM_, int nN_, int G_, int c_) { nM = nM_; nN = nN_; nwg = nM * nN; G = G_; c = c_; }
    __device__ __forceinline__ bool next(int i, Unit& u) const {
        const long L = (long)i * G + c; if (L >= nwg) return false;
        int wgid = (int)L; { const int q = nwg / NXCD, r = nwg % NXCD, xcd = wgid % NXCD, off = wgid / NXCD; wgid = (xcd < r ? xcd * (q + 1) : r * (q + 1) + (xcd - r) * q) + off; }
        const int nig = WGM * nN, gid = wgid / nig, fm = gid * WGM, gsz = (nM - fm) < WGM ? (nM - fm) : WGM;
        u.pm = __builtin_amdgcn_readfirstlane(fm + ((wgid % nig) % gsz)); u.pn = __builtin_amdgcn_readfirstlane((wgid % nig) / gsz); return true;
    }
};

__device__ __forceinline__ unsigned cvt_pk_bf16(float lo, float hi) { unsigned r; asm volatile("v_cvt_pk_bf16_f32 %0, %1, %2" : "=v"(r) : "v"(lo), "v"(hi)); return r; }

template <class Epi, class Prob>
__device__ __forceinline__ void gemm_phase(PG8_LAS unsigned char* lds, const Prob& P, const Epi& E, int tid) {
    const int wid = __builtin_amdgcn_readfirstlane(tid >> 6), lane = tid & 63, wr = wid >> 2, wc = wid & 3, fr = lane & 15, fq = lane >> 4;
    const int nt = P.K / BK;
#ifndef MK_EPISTAG
#define MK_EPISTAG 0
#endif
#ifndef MK_EPISTAG_CYC
#define MK_EPISTAG_CYC 50000
#endif
    if (MK_EPISTAG) {
        const int nwg_ = P.ord.nwg, G_ = P.ord.G, c_ = P.ord.c, cmax = (nwg_ + G_ - 1) / G_, cnt = c_ < nwg_ ? (nwg_ - c_ + G_ - 1) / G_ : 0, nfull = nwg_ - (cmax - 1) * G_;
        if (cnt < cmax && cnt > 0) {
            const int nslack = G_ - nfull, parts = nslack >= 3 * nfull ? 3 : (nslack >= nfull ? 1 : 0);
            if (parts > 0) {
                const unsigned delay = (unsigned)(MK_EPISTAG_CYC / (parts + 1)) * (unsigned)(1 + (c_ - nfull) % parts);
                const unsigned t0_ = (unsigned)__builtin_amdgcn_s_memtime();
                while ((unsigned)__builtin_amdgcn_s_memtime() - t0_ < delay) __builtin_amdgcn_s_sleep(16);
            }
        }
    }
    unsigned voffB[2];
    { int R0, C0, R1, C1; stage_rc(tid * 16, R0, C0); stage_rc(tid * 16 + 8192, R1, C1); const int Rb0 = Epi::PERM ? ((R0 & ~31) + perm32(R0 & 31)) : R0, Rb1 = Epi::PERM ? ((R1 & ~31) + perm32(R1 & 31)) : R1;
      voffB[0] = (unsigned)(Rb0 * P.ldb + C0) * 2u; voffB[1] = (unsigned)(Rb1 * P.ldb + C1) * 2u; }
    const size_t hstepB = P.hstepB;
    const unsigned ldsw = (unsigned)wid * 1024u;
    const int aoff = lds_byte(wr * 64 + fr, fq * 8), boff = lds_byte(wc * 32 + fr, fq * 8);
#define PG8_SA(b, h) (((b) * 2 + (h)) * HTB)
#define PG8_SB(b, h) ((4 + (b) * 2 + (h)) * HTB)
#define PG8_STAGE(bufoff, gbase, voff) do { _Pragma("unroll") for (int _i = 0; _i < 2; ++_i) \
        __builtin_amdgcn_global_load_lds((const PG8_GAS unsigned*)((const PG8_GAS char*)(gbase) + (voff)[_i]), (PG8_LAS unsigned*)(lds + (bufoff) + ldsw + _i * 8192), 16, 0, 0); } while (0)
#define PG8_LDA(dst, b, h) do { _Pragma("unroll") for (int m = 0; m < 4; ++m) _Pragma("unroll") for (int k = 0; k < 2; ++k) dst[m][k] = *(const PG8_LAS bf16x8*)(lds + PG8_SA(b, h) + aoff + m * 2048 + k * 1024); } while (0)
#define PG8_LDB(dst, b, h) do { _Pragma("unroll") for (int n = 0; n < 2; ++n) _Pragma("unroll") for (int k = 0; k < 2; ++k) dst[n][k] = *(const PG8_LAS bf16x8*)(lds + PG8_SB(b, h) + boff + n * 2048 + k * 1024); } while (0)
#define PG8_MMA(ai, bj, At, Bt) do { __builtin_amdgcn_s_setprio(1); _Pragma("unroll") for (int m = 0; m < 4; ++m) _Pragma("unroll") for (int n = 0; n < 2; ++n) _Pragma("unroll") for (int k = 0; k < 2; ++k) \
        acc[ai][bj][m][n] = __builtin_amdgcn_mfma_f32_16x16x32_bf16(Bt[n][k], At[m][k], acc[ai][bj][m][n], 0, 0, 0); __builtin_amdgcn_s_setprio(0); } while (0)
#define PG8_WAIT_V(n) asm volatile("s_waitcnt vmcnt(" #n ")" ::: "memory")
#define PG8_WAIT_L(n) asm volatile("s_waitcnt lgkmcnt(" #n ")" ::: "memory")
#define PG8_BAR __builtin_amdgcn_s_barrier()
#define PG8_SCHED __builtin_amdgcn_sched_barrier(0)
    Unit cur, nxt; int ui = 0;
    if (!P.next(0, cur)) return;
    float zf = 0.f; asm volatile("" : "+v"(zf));
    f32x4 acc[2][2][4][2];
#pragma unroll
    for (int a = 0; a < 2; ++a)
#pragma unroll
        for (int b = 0; b < 2; ++b)
#pragma unroll
            for (int m = 0; m < 4; ++m)
#pragma unroll
                for (int n = 0; n < 2; ++n) acc[a][b][m][n] = (f32x4){zf, zf, zf, zf};
    bf16x8 At[4][2], B0[2][2], B1[2][2];
    constexpr int NH = Prob::GATHER ? 2 : 1;
    unsigned voC[NH][2];
    P.template a_off<NH>(cur, tid, voC);
    const PG8_GAS char* const Ab = P.A;
    const size_t hstepA = Prob::GATHER ? (size_t)0 : P.hstepA;
#define PG8_STAGE_A(bufoff, h, kbyte, VO) PG8_STAGE(bufoff, Ab + (kbyte) + ((h) ? hstepA : (size_t)0), VO[Prob::GATHER ? (h) : 0])
    { const PG8_GAS char* b0 = P.b_tile(cur, 0); const PG8_GAS char* b1 = P.b_tile(cur, 1);
      PG8_STAGE(PG8_SB(0, 0), b0, voffB); PG8_STAGE(PG8_SB(0, 1), b0 + hstepB, voffB); PG8_STAGE_A(PG8_SA(0, 0), 0, (size_t)0, voC); PG8_STAGE_A(PG8_SA(0, 1), 1, (size_t)0, voC);
      if (wr == 1) PG8_BAR;
      PG8_WAIT_V(2); PG8_BAR;
      PG8_STAGE(PG8_SB(1, 0), b1, voffB); PG8_STAGE_A(PG8_SA(1, 0), 0, (size_t)128, voC); PG8_STAGE(PG8_SB(1, 1), b1 + hstepB, voffB);
      PG8_WAIT_V(6); PG8_BAR; }
#ifdef MK_GSTAMP
#define GSEG(k) do { if (Epi::SID == MK_GSTAMP) { __builtin_amdgcn_sched_barrier(0); const unsigned now_ = (unsigned)__builtin_amdgcn_s_memtime(); __builtin_amdgcn_sched_barrier(0); \
    if (tid == MK_GSTAMP_TID) { PG8_LAS unsigned* m_ = (PG8_LAS unsigned*)(lds + MISC_OFF); if ((k) == MK_GSTAMP_SEG || MK_GSTAMP_SEG == 9) m_[16] += now_ - m_[18]; m_[18] = now_; if ((k) == 2) m_[17] += 1; } } } while (0)
    if (Epi::SID == MK_GSTAMP) { const unsigned now_ = (unsigned)__builtin_amdgcn_s_memtime(); if (tid == MK_GSTAMP_TID) ((PG8_LAS unsigned*)(lds + MISC_OFF))[18] = now_; }
#else
#define GSEG(k) do {} while (0)
#endif
    for (;;) {
        const bool has_next = P.next(ui + 1, nxt);
        if (!has_next) nxt = cur;
        for (int t = 0; t < nt; t += 2) {
            const bool last = (t == nt - 2);
            const size_t k1 = (size_t)(t + 1) * 128, k2 = last ? (size_t)0 : (size_t)(t + 2) * 128, k3 = k2 + 128;
            const PG8_GAS char* b2 = last ? P.b_tile(nxt, 0) : P.b_tile(cur, t + 2);
            const PG8_GAS char* b3 = last ? P.b_tile(nxt, 1) : P.b_tile(cur, t + 3);
#ifndef MK_RELAX
#define MK_RELAX 0
#endif
            int fz_ = __builtin_amdgcn_readfirstlane((MK_RELAX && (t == 0) && (ui > 0)) ? 1 : 0); asm volatile("" : "+s"(fz_));
            const bool fresh = fz_ != 0;
#define PG8_WAIT_VR() do { if (fresh) { if constexpr (Epi::NSTORES == 32) PG8_WAIT_V(40); else if constexpr (Epi::NSTORES == 16) PG8_WAIT_V(24); else PG8_WAIT_V(8); } else PG8_WAIT_V(8); } while (0)
            PG8_LDB(B0, 0, 0); PG8_LDB(B1, 0, 1); PG8_SCHED; PG8_LDA(At, 0, 0); if (!fresh) PG8_STAGE_A(PG8_SA(1, 1), 1, k1, voC);
            PG8_WAIT_VR(); PG8_WAIT_L(0); PG8_BAR; PG8_MMA(0, 0, At, B0); PG8_MMA(0, 1, At, B1); PG8_BAR; PG8_SCHED;
            if (last) {
                P.template a_off<NH>(nxt, tid, voC);
            }
            PG8_LDA(At, 0, 1); PG8_STAGE(PG8_SB(0, 0), b2, voffB); PG8_STAGE(PG8_SB(0, 1), b2 + hstepB, voffB); PG8_STAGE_A(PG8_SA(0, 0), 0, k2, voC);
            PG8_WAIT_VR(); PG8_WAIT_L(0); PG8_BAR; PG8_MMA(1, 0, At, B0); PG8_MMA(1, 1, At, B1); PG8_BAR; PG8_SCHED;
            PG8_LDB(B0, 1, 0); PG8_LDB(B1, 1, 1); PG8_SCHED; PG8_LDA(At, 1, 0); PG8_STAGE_A(PG8_SA(0, 1), 1, k2, voC);
            PG8_WAIT_VR(); PG8_WAIT_L(0); PG8_BAR; PG8_MMA(0, 0, At, B0); PG8_MMA(0, 1, At, B1); PG8_BAR; PG8_SCHED;
            PG8_LDA(At, 1, 1); PG8_STAGE(PG8_SB(1, 0), b3, voffB); PG8_STAGE(PG8_SB(1, 1), b3 + hstepB, voffB); PG8_STAGE_A(PG8_SA(1, 0), 0, k3, voC);
            PG8_WAIT_V(8); PG8_WAIT_L(0); PG8_BAR; PG8_MMA(1, 0, At, B0); PG8_MMA(1, 1, At, B1); PG8_BAR; PG8_SCHED;
        }
        if (MK_RELAX) PG8_STAGE_A(PG8_SA(1, 1), 1, (size_t)128, voC);
#ifndef MK_ALIGN
#define MK_ALIGN 1
#endif
        GSEG(0);
        if (MK_ALIGN && wr == 0) PG8_BAR;
        { Unit eu = cur; asm volatile("" : "+s"(eu.pm), "+s"(eu.pn));
          GSEG(1);
          E(acc, eu, wr, wc, fr, fq); }
        GSEG(2);
        if (!has_next) break;
#pragma unroll
        for (int a = 0; a < 2; ++a)
#pragma unroll
            for (int b = 0; b < 2; ++b)
#pragma unroll
                for (int m = 0; m < 4; ++m)
#pragma unroll
                    for (int n = 0; n < 2; ++n) acc[a][b][m][n] = (f32x4){zf, zf, zf, zf};
        cur = nxt; ++ui;
        if (MK_ALIGN && wr == 1) PG8_BAR;
    }
    PG8_WAIT_V(0);
    if (!MK_ALIGN && wr == 0) PG8_BAR;
    PG8_BAR;
#undef PG8_SA
#undef PG8_SB
#undef PG8_STAGE
#undef PG8_STAGE_A
#undef PG8_WAIT_VR
#undef PG8_LDA
#undef PG8_LDB
#undef PG8_MMA
#undef PG8_WAIT_V
#undef PG8_WAIT_L
#undef PG8_BAR
#undef PG8_SCHED
}
}
__device__ __forceinline__ void transpose_item(const GAS float* W, int N, int k0, int n0, GAS bf16_t* dst, int ldd, const GAS float* kscale, LAS float* scr, int lane) {
    const int kq = lane >> 4, n4 = (lane & 15) * 4;
#pragma unroll
    for (int i = 0; i < 16; ++i) { const int kk = 4 * i + kq; f32x4 v = *(const GAS f32x4*)(W + (size_t)(k0 + kk) * N + n0 + n4); if (kscale) v = v * kscale[k0 + kk];
        LAS float* p = scr + kk * 65 + n4; p[0] = v.x; p[1] = v.y; p[2] = v.z; p[3] = v.w; }
    LDS_WAIT(); asm volatile("" ::: "memory");
    const int c = lane & 7;
#pragma unroll
    for (int j = 0; j < 8; ++j) { const int n = (lane >> 3) + 8 * j; const LAS float* s = scr + (8 * c) * 65 + n;
        u32x4 o; o.x = pk2(s[0 * 65], s[1 * 65]); o.y = pk2(s[2 * 65], s[3 * 65]); o.z = pk2(s[4 * 65], s[5 * 65]); o.w = pk2(s[6 * 65], s[7 * 65]);
        *(GAS u32x4*)(dst + (size_t)n * ldd + k0 + 8 * c) = o; }
    LDS_WAIT(); asm volatile("" ::: "memory");
}

__device__ __forceinline__ void ada_unit(FARGS, int unit) {
    const GAS float* c = INP(1); const GAS float* c_ctx = INP(3); const GAS float* ada_w = INP(4); const GAS float* ada_b = INP(5);
    GAS float* mod = (GAS float*)(F.ws + WS_MOD);
    LAS float* S = (LAS float*)F.lds;
    const int L = unit / 48, cb = unit % 48, tid = F.tid;
    for (int i = tid; i < 33 * 1024; i += 512) { const int r = i >> 10, k = i & 1023; const float v = (r < 32) ? c[r * 1024 + k] : c_ctx[k]; S[i] = v / (1.f + expf(-v)); }
    __syncthreads();
    const int cq = tid & 31, kg = tid >> 5;
    f32x4 acc[33];
#pragma unroll
    for (int r = 0; r < 33; ++r) acc[r] = (f32x4){0.f, 0.f, 0.f, 0.f};
    const GAS float* wp = ada_w + ((size_t)L * 1024 + kg * 64) * ADA + cb * 128 + 4 * cq;
#pragma unroll 2
    for (int k4 = 0; k4 < 16; ++k4) {
        const f32x4 w0 = *(const GAS f32x4*)(wp + (size_t)(k4 * 4 + 0) * ADA), w1 = *(const GAS f32x4*)(wp + (size_t)(k4 * 4 + 1) * ADA), w2 = *(const GAS f32x4*)(wp + (size_t)(k4 * 4 + 2) * ADA), w3 = *(const GAS f32x4*)(wp + (size_t)(k4 * 4 + 3) * ADA);
        const LAS f32x4* sp = (const LAS f32x4*)(S + kg * 64 + k4 * 4);
#pragma unroll
        for (int r = 0; r < 33; ++r) { const f32x4 s4 = sp[r * 256]; acc[r] = acc[r] + (w0 * s4.x + w1 * s4.y) + (w2 * s4.z + w3 * s4.w); }
    }
    __syncthreads();
    LAS float* R = S;
    { const int w = F.wave;
#pragma unroll
      for (int r = 0; r < 33; ++r) { f32x4 v; v.x = x32_sum(acc[r].x); v.y = x32_sum(acc[r].y); v.z = x32_sum(acc[r].z); v.w = x32_sum(acc[r].w);
          if (F.lane < 32) *(LAS f32x4*)(R + (w * 33 + r) * 128 + 4 * cq) = v; } }
    __syncthreads();
    for (int i = tid; i < 33 * 128; i += 512) { const int r = i >> 7, cc = i & 127, n = cb * 128 + cc;
        float v = 0.f;
#pragma unroll
        for (int w = 0; w < 8; ++w) v += R[(w * 33 + r) * 128 + cc];
        mod[((size_t)L * 33 + r) * ADA + n] = v + ada_b[L * ADA + n]; }
    __syncthreads();
}

__device__ __forceinline__ void tables_unit(FARGS) {
    GAS float* tab = (GAS float*)(F.ws + WS_TAB);
    const int tid = F.tid;
    for (int i = tid; i < 64 * 16; i += 512) { const int p = i >> 4, f = i & 15; const float inv = expf(-(float)f * (1.f / 16.f) * 9.210340371976184f); const float a = (float)p * inv; tab[TAB_T64 + 2 * i] = cosf(a); tab[TAB_T64 + 2 * i + 1] = sinf(a); }
    for (int i = tid; i < 64 * 8; i += 512) { const int p = i >> 3, f = i & 7; const float inv = expf(-(float)f * (1.f / 8.f) * 9.210340371976184f); const float a = (float)p * inv; tab[TAB_T32 + 2 * i] = cosf(a); tab[TAB_T32 + 2 * i + 1] = sinf(a); }
    if (tid < DEPTH) { const GAS float* lp = INP(15) + tid * 4 * 32; float s01 = 0.f, s23 = 0.f;
        for (int i = 0; i < 32; ++i) { s01 += lp[i] * lp[32 + i]; s23 += lp[64 + i] * lp[96 + i]; }
        const float li = 0.8f - 0.6f * expf(-0.3f * (float)tid);
        tab[TAB_LAM + tid] = expf(s01) - expf(s23) + li; tab[TAB_LAM + DEPTH + tid] = 1.f - li; }
}

__device__ __forceinline__ void prologue_phase(FARGS) {
    refresh(F);
    if (F.bx < 192) ada_unit(F, F.bx);
    else if (F.bx == 192) tables_unit(F);
    __syncthreads();
    LAS float* scr = (LAS float*)(F.lds + F.wave * 16640);
    const int gw = F.bx * NWAVES + F.wave, NGW = F.G * NWAVES;
    GAS bf16_t* WIN = (GAS bf16_t*)(F.ws + WS_WIN); GAS bf16_t* WOUT = (GAS bf16_t*)(F.ws + WS_WOUT); GAS bf16_t* W1 = (GAS bf16_t*)(F.ws + WS_W1); GAS bf16_t* W2 = (GAS bf16_t*)(F.ws + WS_W2);
    constexpr int I_IN = 16 * 40, I_OUT = 16 * 16, I_G = 16 * 8, I_D = 8 * 16;
    constexpr int N_IN = DEPTH * I_IN, N_OUT = DEPTH * I_OUT, N_G = DEPTH * NEXP * I_G, N_D = DEPTH * NEXP * I_D;
    constexpr int NITEMS = N_IN + N_OUT + 2 * N_G + N_D;
    for (int it = gw; it < NITEMS; it += NGW) {
        int r = it;
        if (r < N_IN) { const int L = r / I_IN, q = r % I_IN, kb = q / 40, nb = q % 40;
            transpose_item(INP(8) + (size_t)L * D * DIN, DIN, kb * 64, nb * 64, WIN + ((size_t)L * DIN + nb * 64) * D, D, nullptr, scr, F.lane); continue; } r -= N_IN;
        if (r < N_OUT) { const int L = r / I_OUT, q = r % I_OUT, kb = q / 16, nb = q % 16;
            transpose_item(INP(17) + (size_t)L * D * D, D, kb * 64, nb * 64, WOUT + ((size_t)L * D + nb * 64) * D, D, INP(16) + L * D, scr, F.lane); continue; } r -= N_OUT;
        if (r < 2 * N_G) { const int up = r >= N_G; if (up) r -= N_G; const int le = r / I_G, q = r % I_G, kb = q / 8, nb = q % 8, n0 = nb * 64;
            const int drow = (n0 >> 7) * 256 + (n0 & 127) + (up ? 128 : 0);
            transpose_item((up ? INP(21) : INP(20)) + (size_t)le * D * DEXP, DEXP, kb * 64, n0, W1 + ((size_t)le * 1024 + drow) * D, D, nullptr, scr, F.lane); continue; } r -= 2 * N_G;
        { const int le = r / I_D, q = r % I_D, kb = q / 16, nb = q % 16;
            transpose_item(INP(22) + (size_t)le * DEXP * D, D, kb * 64, nb * 64, W2 + ((size_t)le * 1024 + nb * 64) * DEXP, DEXP, nullptr, scr, F.lane); }
    }
    __syncthreads();
}

__device__ __forceinline__ void top2of4(float x0, float x1, float x2, float x3, int& i1, int& i2, float& m1, float& m2) {
    i1 = 0; m1 = x0; if (x1 > m1) { m1 = x1; i1 = 1; } if (x2 > m1) { m1 = x2; i1 = 2; } if (x3 > m1) { m1 = x3; i1 = 3; }
    i2 = -1; m2 = -3.0e38f;
    if (i1 != 0 && x0 > m2) { m2 = x0; i2 = 0; } if (i1 != 1 && x1 > m2) { m2 = x1; i2 = 1; } if (i1 != 2 && x2 > m2) { m2 = x2; i2 = 2; } if (i1 != 3 && x3 > m2) { m2 = x3; i2 = 3; }
}
template <bool ROUTER>
__device__ __forceinline__ void norm_phase(FARGS, int L, int M, bool first, const GAS float* g, int shift_off, int scale_off, bool live = true) {
    refresh(F); OPAQUE_S(L); OPAQUE_S(M);
    const GAS float* mod = (const GAS float*)(F.ws + WS_MOD) + (size_t)L * 33 * ADA;
    GAS bf16_t* H = (GAS bf16_t*)(F.ws + WS_H);
    const GAS bf16_t* XB = (const GAS bf16_t*)(F.ws + WS_XB);
    const GAS float* xlat = INP(0); const GAS float* xctx = INP(2);
    const int lane = F.lane, gw = F.bx * NWAVES + F.wave, NGW = F.G * NWAVES, rpw = (M + NGW - 1) / NGW;
    const int r0 = gw * rpw, r1 = (r0 + rpw < M) ? r0 + rpw : M;
    constexpr int RB = ROUTER ? 1 : 4;
    LAS float* RWT = (LAS float*)F.lds;
    LAS float* LG = (LAS float*)(F.lds + 65536) + F.wave * 640;
    LAS int* hist = (LAS int*)(F.lds + NRM_OFF); LAS int* base = hist + 32;
    if (ROUTER) {
        const GAS float* rw = INP(18);
        for (int i = F.tid; i < 16 * 1024; i += 512) { const int k = i >> 4, e = i & 15; RWT[e * 1024 + k] = rw[i]; }
        if (F.tid < 32) hist[F.tid] = 0;
        __syncthreads();
    }
    int curb = -1; f32x4 gm[4], sh[4];
    u32x4 nraw[RB][2];
    if (!first) {
#pragma unroll
        for (int r = 0; r < RB; ++r)
#pragma unroll
            for (int jj = 0; jj < 2; ++jj) nraw[r][jj] = *(const GAS u32x4*)(XB + (size_t)(r0 + r) * D + 8 * lane + 512 * jj);
    }
#pragma unroll 1
    for (int row = r0; row < r1; row += RB) {
        const int b = row < NLAT ? (row >> 11) : 32;
        if (b != curb) { curb = b;
#pragma unroll
            for (int j = 0; j < 4; ++j) { const int c0 = 8 * lane + 512 * (j >> 1) + 4 * (j & 1); const f32x4 gg = *(const GAS f32x4*)(g + c0), sc = *(const GAS f32x4*)(mod + b * ADA + scale_off + c0);
                gm[j] = gg * (sc + 1.0f); sh[j] = *(const GAS f32x4*)(mod + b * ADA + shift_off + c0); } }
        const GAS float* xr = row < NLAT ? xlat + (size_t)row * D : xctx + (size_t)(row - NLAT) * D;
        f32x4 v[RB][4]; float ss[RB];
        if (first) {
#pragma unroll
            for (int r = 0; r < RB; ++r)
#pragma unroll
                for (int jj = 0; jj < 2; ++jj) { v[r][2 * jj] = *(const GAS f32x4*)(xr + (size_t)r * D + 8 * lane + 512 * jj); v[r][2 * jj + 1] = *(const GAS f32x4*)(xr + (size_t)r * D + 8 * lane + 512 * jj + 4); }
        } else {
            u32x4 raw[RB][2];
#pragma unroll
            for (int r = 0; r < RB; ++r)
#pragma unroll
                for (int jj = 0; jj < 2; ++jj) raw[r][jj] = nraw[r][jj];
            if (row + RB < r1) {
#pragma unroll
                for (int r = 0; r < RB; ++r)
#pragma unroll
                    for (int jj = 0; jj < 2; ++jj) nraw[r][jj] = *(const GAS u32x4*)(XB + (size_t)(row + RB + r) * D + 8 * lane + 512 * jj);
            }
#pragma unroll
            for (int r = 0; r < RB; ++r)
#pragma unroll
                for (int jj = 0; jj < 2; ++jj) { const u32x4 w = raw[r][jj];
                    v[r][2 * jj] = (f32x4){bflo(w.x), bfhi(w.x), bflo(w.y), bfhi(w.y)}; v[r][2 * jj + 1] = (f32x4){bflo(w.z), bfhi(w.z), bflo(w.w), bfhi(w.w)}; }
        }
#pragma unroll
        for (int r = 0; r < RB; ++r) { float s = 0.f;
#pragma unroll
            for (int j = 0; j < 4; ++j) s += (v[r][j].x * v[r][j].x + v[r][j].y * v[r][j].y) + (v[r][j].z * v[r][j].z + v[r][j].w * v[r][j].w);
            ss[r] = s; }
#pragma unroll
        for (int o = 1; o < 32; o <<= 1) {
#pragma unroll
            for (int r = 0; r < RB; ++r) ss[r] += sx(ss[r], lane, o); }
#pragma unroll
        for (int r = 0; r < RB; ++r) { const float rstd = __builtin_amdgcn_rsqf(x32_sum(ss[r]) * (1.f / D) + EPS);
#pragma unroll
            for (int j = 0; j < 4; ++j) v[r][j] = v[r][j] * rstd * gm[j] + sh[j];
#pragma unroll
            for (int jj = 0; jj < 2; ++jj) { u32x4 o; o.x = pk2(v[r][2 * jj].x, v[r][2 * jj].y); o.y = pk2(v[r][2 * jj].z, v[r][2 * jj].w); o.z = pk2(v[r][2 * jj + 1].x, v[r][2 * jj + 1].y); o.w = pk2(v[r][2 * jj + 1].z, v[r][2 * jj + 1].w);
                if (live) *(GAS u32x4*)(H + (size_t)(row + r) * D + 8 * lane + 512 * jj) = o; } }
        if (ROUTER) {
            float p[RB][16];
#pragma unroll
            for (int e = 0; e < 16; ++e) {
#pragma unroll
                for (int r = 0; r < RB; ++r) p[r][e] = 0.f;
#pragma unroll
                for (int j = 0; j < 4; ++j) { const f32x4 w = *(const LAS f32x4*)(RWT + e * 1024 + 8 * lane + 512 * (j >> 1) + 4 * (j & 1));
#pragma unroll
                    for (int r = 0; r < RB; ++r) p[r][e] += (v[r][j].x * w.x + v[r][j].y * w.y) + (v[r][j].z * w.z + v[r][j].w * w.w); } }
            const bool h32 = lane & 32, h16 = lane & 16, h8 = lane & 8, h4 = lane & 4;
#pragma unroll
            for (int r = 0; r < RB; ++r) {
                float a8[8], b4[4], c2[2], d1;
#pragma unroll
                for (int e = 0; e < 8; ++e) { const float send = h32 ? p[r][e] : p[r][e + 8], keep = h32 ? p[r][e + 8] : p[r][e]; a8[e] = keep + sx(send, lane, 32); }
#pragma unroll
                for (int e = 0; e < 4; ++e) { const float send = h16 ? a8[e] : a8[e + 4], keep = h16 ? a8[e + 4] : a8[e]; b4[e] = keep + sx(send, lane, 16); }
#pragma unroll
                for (int e = 0; e < 2; ++e) { const float send = h8 ? b4[e] : b4[e + 2], keep = h8 ? b4[e + 2] : b4[e]; c2[e] = keep + sx(send, lane, 8); }
                { const float send = h4 ? c2[0] : c2[1], keep = h4 ? c2[1] : c2[0]; d1 = keep + sx(send, lane, 4); }
                d1 += sx(d1, lane, 2); d1 += sx(d1, lane, 1);
                if ((lane & 3) == 0) LG[(row + r - r0) * 16 + (lane >> 2)] = d1;
            }
        }
    }
    if (ROUTER) {
        LDS_WAIT();
        int cls = 0, ls = 0; const bool mine = r0 + lane < r1;
        { const LAS f32x4* lp = (const LAS f32x4*)(LG + (mine ? lane : 0) * 16);
          const f32x4 q0 = lp[0], q1 = lp[1], q2 = lp[2], q3 = lp[3];
          const float lg[16] = {q0.x, q0.y, q0.z, q0.w, q1.x, q1.y, q1.z, q1.w, q2.x, q2.y, q2.z, q2.w, q3.x, q3.y, q3.z, q3.w};
          float sc[16], sel[16];
#pragma unroll
          for (int e = 0; e < 16; ++e) { sc[e] = 1.0f / (1.0f + __builtin_amdgcn_exp2f(-lg[e] * LOG2E)); sel[e] = sc[e] + INP(19)[e]; }
          float gs[4];
#pragma unroll
          for (int q = 0; q < 4; ++q) { int i1, i2; float m1, m2; top2of4(sel[4 * q], sel[4 * q + 1], sel[4 * q + 2], sel[4 * q + 3], i1, i2, m1, m2); gs[q] = m1 + m2; }
          int gi = 0; float gmx = gs[0]; if (gs[1] > gmx) { gmx = gs[1]; gi = 1; } if (gs[2] > gmx) { gmx = gs[2]; gi = 2; } if (gs[3] > gmx) { gmx = gs[3]; gi = 3; }
          float x4[4], s4[4];
#pragma unroll
          for (int i = 0; i < 4; ++i) { x4[i] = gi == 0 ? sel[i] : gi == 1 ? sel[4 + i] : gi == 2 ? sel[8 + i] : sel[12 + i]; s4[i] = gi == 0 ? sc[i] : gi == 1 ? sc[4 + i] : gi == 2 ? sc[8 + i] : sc[12 + i]; }
          int i1, i2; float m1, m2; top2of4(x4[0], x4[1], x4[2], x4[3], i1, i2, m1, m2);
          const int lo = i1 < i2 ? i1 : i2, hi = i1 < i2 ? i2 : i1;
          const int pr = lo == 0 ? hi - 1 : (lo == 1 ? hi + 1 : 5);
          const float slo = lo == 0 ? s4[0] : lo == 1 ? s4[1] : s4[2], shi = hi == 1 ? s4[1] : hi == 2 ? s4[2] : s4[3];
          const float inv = 1.0f / (slo + shi);
          cls = gi * 6 + pr;
          if (mine && live) { ls = __hip_atomic_fetch_add(&hist[cls], 1, __ATOMIC_RELAXED, __HIP_MEMORY_SCOPE_WORKGROUP);
              f32x2 w2 = {slo * inv, shi * inv}; *(GAS f32x2*)((GAS float*)(F.ws + WS_RW) + (size_t)(r0 + lane) * 2) = w2; }
        }
        __syncthreads();
        if (F.tid < NCLS && live) base[F.tid] = (int)__hip_atomic_fetch_add(CTL(F) + CW_CNT + (L * NCLS + F.tid) * 64, (unsigned)hist[F.tid], __ATOMIC_RELAXED, __HIP_MEMORY_SCOPE_AGENT);
        __syncthreads();
        GAS int* perm = (GAS int*)(F.ws + WS_PERM);
        if (mine && live) perm[(size_t)cls * MTOT + base[cls] + ls] = r0 + lane;
        __syncthreads();
    }
}

__device__ __forceinline__ void norm2_phase(FARGS, int L, int M) {
    refresh(F); OPAQUE_S(L); OPAQUE_S(M);
    constexpr int SG = 2064;
    constexpr int GT_BYTES = 32 * SG, C_OFF = 2 * GT_BYTES, RS_OFF = C_OFF + 256, RI_OFF = RS_OFF + 8 * 40 * 4, HB_OFF = RI_OFF + 8 * 40 * 4;
    static_assert(HB_OFF + 256 <= MISC_OFF, "norm2 LDS map");
    const GAS float* mod = (const GAS float*)(F.ws + WS_MOD) + (size_t)L * 33 * ADA;
    const GAS float* g2 = INP(7) + L * D; const GAS float* Wr = INP(18);
    GAS bf16_t* H = (GAS bf16_t*)(F.ws + WS_H);
    const GAS bf16_t* XB = (const GAS bf16_t*)(F.ws + WS_XB);
    const int lane = F.lane, tid = F.tid, w = F.wave, l31 = lane & 31, hi = lane >> 5;
    const int NGW = F.G * NWAVES, rpw = (M + NGW - 1) / NGW;
    const int R0 = F.bx * NWAVES * rpw, R1 = (R0 + NWAVES * rpw < M) ? R0 + NWAVES * rpw : M;
    const int r0 = R0 + w * rpw < M ? R0 + w * rpw : M, r1 = (r0 + rpw < M) ? r0 + rpw : M;
    LAS unsigned char* GT = F.lds; LAS float* Ctab = (LAS float*)(F.lds + C_OFF); LAS float* RS = (LAS float*)(F.lds + RS_OFF) + w * 40; LAS int* RI = (LAS int*)(F.lds + RI_OFF) + w * 40;
    LAS int* hist = (LAS int*)(F.lds + HB_OFF); LAS int* base = hist + 32;
    if (tid < 32) hist[tid] = 0;
    const int bfirst = R0 < NLAT ? (R0 >> 11) : 32, blast = (R1 - 1) < NLAT ? ((R1 - 1) >> 11) : 32;
    for (int s = 0; s <= (blast != bfirst ? 1 : 0); ++s) {
        const int b = s == 0 ? bfirst : blast;
        const GAS float* sc = mod + (size_t)b * ADA + 4 * 1024; const GAS float* shp = mod + (size_t)b * ADA + 3 * 1024;
        LAS unsigned char* gt = GT + s * GT_BYTES;
        for (int k = tid; k < D; k += 512) {
            const float gmk = g2[k] * (1.0f + sc[k]);
            const f32x4 w0 = *(const GAS f32x4*)(Wr + k * 16), w1 = *(const GAS f32x4*)(Wr + k * 16 + 4), w2 = *(const GAS f32x4*)(Wr + k * 16 + 8), w3 = *(const GAS f32x4*)(Wr + k * 16 + 12);
            const float wr_[16] = {w0.x, w0.y, w0.z, w0.w, w1.x, w1.y, w1.z, w1.w, w2.x, w2.y, w2.z, w2.w, w3.x, w3.y, w3.z, w3.w};
#pragma unroll
            for (int e = 0; e < 16; ++e) { const float G = gmk * wr_[e]; const unsigned hb = pk2(G, 0.f) & 0xffffu; const float lo = G - __uint_as_float(hb << 16); const unsigned lb = pk2(lo, 0.f) & 0xffffu;
                *(LAS bf16_t*)(gt + e * SG + k * 2) = (bf16_t)hb; *(LAS bf16_t*)(gt + (16 + e) * SG + k * 2) = (bf16_t)lb; }
        }
#pragma unroll
        for (int ee = 0; ee < 2; ++ee) { const int e = 2 * w + ee; float p = 0.f;
            for (int k = lane; k < D; k += 64) p += shp[k] * Wr[k * 16 + e];
            p = wave_sum(p, lane); if (lane == 0) Ctab[s * 16 + e] = p; }
    }
    __syncthreads();
    for (int cur = r0; cur < r1; ) {
        const int bcur = cur < NLAT ? (cur >> 11) : 32;
        int cnt = r1 - cur; if (cnt > 32) cnt = 32;
        if (cur < NLAT) { const int bnd = ((cur >> 11) + 1) << 11; if (bnd - cur < cnt) cnt = bnd - cur; }
        const int s = bcur == bfirst ? 0 : 1;
        const int row = cur + (l31 < cnt ? l31 : cnt - 1);
        const GAS bf16_t* xp = XB + (size_t)row * D + 8 * hi;
        const LAS unsigned char* gp = GT + s * GT_BYTES + l31 * SG + 16 * hi;
        f32x16 acc = f32x16{}; float ss = 0.f;
#pragma unroll 1
        for (int kg = 0; kg < 8; ++kg) {
            bf16x8 xf[8];
#pragma unroll
            for (int j = 0; j < 8; ++j) xf[j] = *(const GAS bf16x8*)(xp + (kg * 8 + j) * 16);
#pragma unroll
            for (int j = 0; j < 8; ++j) {
                const bf16x8 gf = *(const LAS bf16x8*)(gp + (kg * 8 + j) * 32);
                const u32x4 wv = __builtin_bit_cast(u32x4, xf[j]);
                const float a0 = bflo(wv.x), a1 = bfhi(wv.x), a2 = bflo(wv.y), a3 = bfhi(wv.y), a4 = bflo(wv.z), a5 = bfhi(wv.z), a6 = bflo(wv.w), a7 = bfhi(wv.w);
                ss += (a0 * a0 + a1 * a1) + (a2 * a2 + a3 * a3) + (a4 * a4 + a5 * a5) + (a6 * a6 + a7 * a7);
                acc = __builtin_amdgcn_mfma_f32_32x32x16_bf16(gf, xf[j], acc, 0, 0, 0);
            }
        }
        const float rstd = __builtin_amdgcn_rsqf(x32_sum(ss) * (1.f / D) + EPS);
        float mine[8], oth[8];
#pragma unroll
        for (int i = 0; i < 8; ++i) { mine[i] = acc[i] + acc[i + 8]; oth[i] = swap32(mine[i], hi != 0); }
        float lg[16];
#pragma unroll
        for (int i = 0; i < 4; ++i) { lg[i] = hi ? oth[i] : mine[i]; lg[4 + i] = hi ? mine[i] : oth[i]; lg[8 + i] = hi ? oth[4 + i] : mine[4 + i]; lg[12 + i] = hi ? mine[4 + i] : oth[4 + i]; }
        float sc_[16], sel[16];
#pragma unroll
        for (int e = 0; e < 16; ++e) { const float z = rstd * lg[e] + Ctab[s * 16 + e]; sc_[e] = __builtin_amdgcn_rcpf(1.0f + __builtin_amdgcn_exp2f(-z * LOG2E)); sel[e] = sc_[e] + INP(19)[e]; }
        float gs[4];
#pragma unroll
        for (int q = 0; q < 4; ++q) { int i1, i2; float m1, m2; top2of4(sel[4 * q], sel[4 * q + 1], sel[4 * q + 2], sel[4 * q + 3], i1, i2, m1, m2); gs[q] = m1 + m2; }
        int gi = 0; float gmx = gs[0]; if (gs[1] > gmx) { gmx = gs[1]; gi = 1; } if (gs[2] > gmx) { gmx = gs[2]; gi = 2; } if (gs[3] > gmx) { gmx = gs[3]; gi = 3; }
        float x4[4], s4[4];
#pragma unroll
        for (int i = 0; i < 4; ++i) { x4[i] = gi == 0 ? sel[i] : gi == 1 ? sel[4 + i] : gi == 2 ? sel[8 + i] : sel[12 + i]; s4[i] = gi == 0 ? sc_[i] : gi == 1 ? sc_[4 + i] : gi == 2 ? sc_[8 + i] : sc_[12 + i]; }
        int i1, i2; float m1, m2; top2of4(x4[0], x4[1], x4[2], x4[3], i1, i2, m1, m2);
        const int lo_ = i1 < i2 ? i1 : i2, hi_ = i1 < i2 ? i2 : i1;
        const int pr = lo_ == 0 ? hi_ - 1 : (lo_ == 1 ? hi_ + 1 : 5);
        const float slo = lo_ == 0 ? s4[0] : lo_ == 1 ? s4[1] : s4[2], shi = hi_ == 1 ? s4[1] : hi_ == 2 ? s4[2] : s4[3];
        const float inv = __builtin_amdgcn_rcpf(slo + shi);
        const int cls = gi * 6 + pr;
        if (hi == 0 && l31 < cnt) { const int ls = __hip_atomic_fetch_add(&hist[cls], 1, __ATOMIC_RELAXED, __HIP_MEMORY_SCOPE_WORKGROUP);
            const int ri = cur - r0 + l31; RS[ri] = rstd; RI[ri] = cls | (ls << 8);
            f32x2 w2 = {slo * inv, shi * inv}; *(GAS f32x2*)((GAS float*)(F.ws + WS_RW) + (size_t)(cur + l31) * 2) = w2; }
        cur += cnt;
    }
    LDS_WAIT();
    { int curb = -1; f32x4 gm[4], sh[4];
#pragma unroll 1
      for (int row = r0; row < r1; row += 4) {
        const int b = row < NLAT ? (row >> 11) : 32;
        if (b != curb) { curb = b;
#pragma unroll
            for (int j = 0; j < 4; ++j) { const int c0 = 8 * lane + 512 * (j >> 1) + 4 * (j & 1); const f32x4 gg = *(const GAS f32x4*)(g2 + c0), sc = *(const GAS f32x4*)(mod + b * ADA + 4 * 1024 + c0);
                gm[j] = gg * (sc + 1.0f); sh[j] = *(const GAS f32x4*)(mod + b * ADA + 3 * 1024 + c0); } }
        u32x4 raw[4][2];
#pragma unroll
        for (int r = 0; r < 4; ++r)
#pragma unroll
            for (int jj = 0; jj < 2; ++jj) raw[r][jj] = *(const GAS u32x4*)(XB + (size_t)(row + r) * D + 8 * lane + 512 * jj);
#pragma unroll
        for (int r = 0; r < 4; ++r) { const float rstd = RS[row - r0 + r];
#pragma unroll
            for (int jj = 0; jj < 2; ++jj) { const u32x4 wv = raw[r][jj];
                const f32x4 v0 = (f32x4){bflo(wv.x), bfhi(wv.x), bflo(wv.y), bfhi(wv.y)} * rstd * gm[2 * jj] + sh[2 * jj], v1 = (f32x4){bflo(wv.z), bfhi(wv.z), bflo(wv.w), bfhi(wv.w)} * rstd * gm[2 * jj + 1] + sh[2 * jj + 1];
                u32x4 o; o.x = pk2(v0.x, v0.y); o.y = pk2(v0.z, v0.w); o.z = pk2(v1.x, v1.y); o.w = pk2(v1.z, v1.w);
                *(GAS u32x4*)(H + (size_t)(row + r) * D + 8 * lane + 512 * jj) = o; } }
      } }
    __syncthreads();
    if (tid < NCLS) base[tid] = (int)__hip_atomic_fetch_add(CTL(F) + CW_CNT + (L * NCLS + tid) * 64, (unsigned)hist[tid], __ATOMIC_RELAXED, __HIP_MEMORY_SCOPE_AGENT);
    __syncthreads();
    { GAS int* perm = (GAS int*)(F.ws + WS_PERM);
      if (r0 + lane < r1) { const int ri = RI[lane], cls = ri & 255, ls = ri >> 8; perm[(size_t)cls * MTOT + base[cls] + ls] = r0 + lane; } }
    __syncthreads();
}

__device__ __forceinline__ void qkprep_phase(FARGS, int L, bool live = true) {
    refresh(F); OPAQUE_S(L);
    GAS bf16_t* U = (GAS bf16_t*)(F.ws + WS_U);
    const GAS float* tab = (const GAS float*)(F.ws + WS_TAB);
    const int lane = F.lane, gw = F.bx * NWAVES + F.wave, NGW = F.G * NWAVES, rpw = (MTOT + NGW - 1) / NGW;
    const int r0 = gw * rpw, r1 = (r0 + rpw < MTOT) ? r0 + rpw : MTOT;
    int ccol[4]; bool seg32[4], dorope[4], valid[4]; float qs[4]; f32x4 g0[4], g1[4];
#pragma unroll
    for (int i = 0; i < 4; ++i) {
        const int c = lane + 64 * i; valid[i] = c < 224;
        int col, isq; const GAS float* gp; bool s32 = false, rp = true; float sc = 0.125f * LOG2E;
        if (c < 48) { col = 8 * c; isq = c < 32; gp = INP(9) + L * 128 + (isq ? 0 : 64) + ((8 * c) & 63); }
        else if (c < 112) { const int cc = c - 48; col = QB + 8 * cc; isq = cc < 32; gp = INP(10) + L * 128 + (isq ? 0 : 64) + ((8 * cc) & 63); rp = false; }
        else if (c < 176) { const int cc = c - 112; col = QC + 8 * cc; isq = cc < 32; gp = INP(11) + L * 64 + (isq ? 0 : 32) + ((8 * cc) & 31); s32 = true; sc = 0.17677669529663687f * LOG2E; }
        else { const int cc = (c < 224 ? c : 223) - 176; col = QD + 8 * cc; isq = cc < 32; gp = INP(12) + L * 128 + (isq ? 0 : 64) + ((8 * cc) & 63); }
        ccol[i] = col; seg32[i] = s32; dorope[i] = rp; qs[i] = isq ? sc : 1.0f; g0[i] = *(const GAS f32x4*)gp; g1[i] = *(const GAS f32x4*)(gp + 4);
    }
#pragma unroll 1
    for (int row4 = r0; row4 < r1; row4 += 4) {
        u32x4 wv[4][4];
#pragma unroll
        for (int r = 0; r < 4; ++r)
#pragma unroll
            for (int i = 0; i < 4; ++i) wv[r][i] = *(const GAS u32x4*)(U + (size_t)(row4 + r) * DIN + ccol[i]);
#pragma unroll
        for (int r = 0; r < 4; ++r) {
        const int row = row4 + r;
        const bool lat = row < NLAT; const int s = row & 2047, prow = s >> 6, pcol = s & 63;
#pragma unroll
        for (int i = 0; i < 4; ++i) {
            GAS bf16_t* p = U + (size_t)row * DIN + ccol[i];
            const u32x4 w = wv[r][i];
            float x[8] = {bflo(w.x), bfhi(w.x), bflo(w.y), bfhi(w.y), bflo(w.z), bfhi(w.z), bflo(w.w), bfhi(w.w)};
            float ss = 0.f;
#pragma unroll
            for (int e = 0; e < 8; ++e) ss += x[e] * x[e];
            ss += sx(ss, lane, 1); ss += sx(ss, lane, 2); const float ss8 = ss + sx(ss, lane, 4);
            const float rstd = seg32[i] ? __builtin_amdgcn_rsqf(ss * (1.f / 32.f) + EPS) : __builtin_amdgcn_rsqf(ss8 * (1.f / 64.f) + EPS);
            const float gg[8] = {g0[i].x, g0[i].y, g0[i].z, g0[i].w, g1[i].x, g1[i].y, g1[i].z, g1[i].w};
#pragma unroll
            for (int e = 0; e < 8; ++e) x[e] = x[e] * rstd * gg[e];
            const int j = seg32[i] ? (lane & 3) : (lane & 7);
            const int pxor = seg32[i] ? 1 : 2;
            const bool first = seg32[i] ? !(j & 1) : !(j & 2);
            const int pos = seg32[i] ? ((j < 2) ? prow : pcol) : ((j < 4) ? prow : pcol);
            const GAS float* tp = seg32[i] ? tab + TAB_T32 + (pos * 8) * 2 : tab + TAB_T64 + (pos * 16 + 8 * (j & 1)) * 2;
            const bool rp = dorope[i] && lat;
#pragma unroll
            for (int e2 = 0; e2 < 4; ++e2) {
                const f32x4 cs = *(const GAS f32x4*)(tp + 4 * e2);
                const float pa = sx(x[2 * e2], lane, pxor), pb = sx(x[2 * e2 + 1], lane, pxor);
                if (rp) {
                    x[2 * e2] = first ? x[2 * e2] * cs.x - pa * cs.y : pa * cs.y + x[2 * e2] * cs.x;
                    x[2 * e2 + 1] = first ? x[2 * e2 + 1] * cs.z - pb * cs.w : pb * cs.w + x[2 * e2 + 1] * cs.z;
                }
            }
            u32x4 o; o.x = pk2(x[0] * qs[i], x[1] * qs[i]); o.y = pk2(x[2] * qs[i], x[3] * qs[i]); o.z = pk2(x[4] * qs[i], x[5] * qs[i]); o.w = pk2(x[6] * qs[i], x[7] * qs[i]);
            if (valid[i] && live) *(GAS u32x4*)p = o;
        }
        }
    }
}
#ifdef MK_USE_SB
#define MK_SB() __builtin_amdgcn_sched_barrier(0)
#else
#define MK_SB() do {} while (0)
#endif
#ifndef MK_DUAL
#define MK_DUAL 1
#endif
#ifndef MK_MIDBAR
#define MK_MIDBAR 0
#endif
#ifndef MK_QKFIRST
#define MK_QKFIRST 4
#endif
#ifndef MK_QKSPLIT
#define MK_QKSPLIT 1
#endif
#ifndef MK_UPF
#define MK_UPF 7
#endif
#ifndef MK_QKMID
#define MK_QKMID 4
#endif
#ifndef MK_ILV
#define MK_ILV 15
#endif
#ifndef MK_CHP
#define MK_CHP 1
#endif
template <int MIX> struct MixCfg;
template <> struct MixCfg<0> { static constexpr int QCOL = QA, KCOL = KA, VCOL = VA, CK = 128, CV = 128; static constexpr bool GQA = true;  };
template <> struct MixCfg<1> { static constexpr int QCOL = QB, KCOL = KB, VCOL = VB, CK = 256, CV = 256; static constexpr bool GQA = false; };
template <> struct MixCfg<2> { static constexpr int QCOL = QC, KCOL = KC, VCOL = VC, CK = MK_CHP ? 128 : 256, CV = MK_CHP ? 128 : 256; static constexpr bool GQA = false; };
template <> struct MixCfg<3> { static constexpr int QCOL = QD, KCOL = KD, VCOL = VD, CK = 128, CV = 128; static constexpr bool GQA = true;  };

__device__ __forceinline__ int crow16(int r, int hi) { return (r & 3) + 8 * (r >> 2) + 4 * hi; }
__device__ __forceinline__ s16x4 vtr(const LAS unsigned char* p) { return __builtin_bit_cast(s16x4, __builtin_amdgcn_ds_read_tr16_b64_v4i16((LAS s16x4*)p)); }

__device__ __forceinline__ void softmax_tile(f32x16& p0, f32x16& p1, float& l, bf16x8 (&pa)[4]) {
    float s0 = 0.f, s1 = 0.f;
#pragma unroll
    for (int r = 0; r < 16; ++r) { p0[r] = __builtin_amdgcn_exp2f(p0[r]); p1[r] = __builtin_amdgcn_exp2f(p1[r]); s0 += p0[r]; s1 += p1[r]; }
    l += s0 + s1;
#pragma unroll
    for (int sI = 0; sI < 4; ++sI) {
        u32x4 w;
        if (sI < 2) { const int o_ = 8 * sI; w.x = pk2(p0[o_], p0[o_ + 1]); w.y = pk2(p0[o_ + 2], p0[o_ + 3]); w.z = pk2(p0[o_ + 4], p0[o_ + 5]); w.w = pk2(p0[o_ + 6], p0[o_ + 7]); }
        else { const int o_ = 8 * (sI - 2); w.x = pk2(p1[o_], p1[o_ + 1]); w.y = pk2(p1[o_ + 2], p1[o_ + 3]); w.z = pk2(p1[o_ + 4], p1[o_ + 5]); w.w = pk2(p1[o_ + 6], p1[o_ + 7]); }
        pa[sI] = __builtin_bit_cast(bf16x8, w);
    }
}

template <int MIX> struct AttnPF { bf16x8 qf[4], qg[4]; u32x4 k0[MixCfg<MIX>::CK / 64]; };
struct AttnNext { int b, qb, hp; bool isctx, valid; };
template <int MIX>
__device__ __forceinline__ void attn_unit(FARGS, int L, int b, int qb, bool isctx, int hp, AttnPF<MIX>& pf, bool have_pf, AttnNext nx) {
    typedef MixCfg<MIX> C;
    refresh(F); OPAQUE_S(L);
#ifdef MK_STAMP
#define STAMP_NOW_(v) __builtin_amdgcn_sched_barrier(0); const unsigned v = (unsigned)__builtin_amdgcn_s_memtime(); __builtin_amdgcn_sched_barrier(0)
#define SEG0() do { if (MIX == MK_STAMP) { STAMP_NOW_(now_); if (F.tid == MK_STAMP_TID) { LAS unsigned* m_ = (LAS unsigned*)(F.lds + MISC_OFF); m_[21] = now_; } } } while (0)
#define SEG(k) do { if (MIX == MK_STAMP && (MK_STAMP_SEG == 9 ? (k) == 3 : ((k) == MK_STAMP_SEG || (k) == (MK_STAMP_SEG + 3) % 4))) { STAMP_NOW_(now_); if (F.tid == MK_STAMP_TID) { LAS unsigned* m_ = (LAS unsigned*)(F.lds + MISC_OFF); \
    if ((k) == MK_STAMP_SEG || MK_STAMP_SEG == 9) m_[20] += now_ - m_[21]; m_[21] = now_; } } } while (0)
#else
#define SEG0() do {} while (0)
#define SEG(k) do {} while (0)
#endif
    constexpr int SK = C::CK * 2 + 16, SV = C::CV * 2 + 64, NKC = C::CK / 64, NVC = C::CV / 64;
    constexpr bool DIFF = (MIX == 2);
    constexpr bool DUAL = (MIX == 3) && MK_DUAL;
    constexpr bool TWO = DIFF || DUAL;
    constexpr bool HP = DIFF && MK_CHP;
    constexpr int UQ = (DUAL || HP) ? 128 : 64;
    static_assert(C::CK == C::CV, "K and V tiles share the per-thread load offsets");
    const GAS bf16_t* U = (const GAS bf16_t*)(F.ws + WS_U);
    GAS bf16_t* Y = (GAS bf16_t*)(F.ws + WS_Y);
    const GAS float* tab = (const GAS float*)(F.ws + WS_TAB);
    const int tid = F.tid, lane = F.lane, w = F.wave, l31 = lane & 31, hi = lane >> 5;
    const int hq = DUAL ? 2 * (w >> 2) : (HP ? 2 * hp + (w >> 2) : (w >> 1)), rs = (DUAL || HP) ? (w & 3) : (w & 1);
    const int hk = (DUAL || HP) ? (w >> 2) : (C::GQA ? (hq >> 1) : hq);
    const int kcolb = C::KCOL + (HP ? hp * 128 : 0), vcolb = C::VCOL + (HP ? hp * 128 : 0);
    const int qrow = isctx ? NLAT + b * CTXL + qb * UQ + rs * 32 + l31 : b * SEQ + qb * UQ + rs * 32 + l31;
    int nloc, loc0;
    if (isctx) { nloc = 0; loc0 = 0; }
    else if (MIX == 0) { const int t0 = DUAL ? 2 * qb - 2 : qb - 2, t1 = DUAL ? 2 * qb + 3 : qb + 2; loc0 = t0 < 0 ? 0 : t0; const int hiT = t1 > 31 ? 31 : t1; nloc = hiT - loc0 + 1; }
    else if (MIX == 1) { loc0 = qb - 4 < 0 ? 0 : (qb - 4 > 24 ? 24 : qb - 4); nloc = 8; }
    else { loc0 = 0; nloc = 32; }
    const int NT = nloc + 4;
    const int lrow0 = b * SEQ, crow0 = NLAT + b * CTXL;
    bf16x8 qf[4], qg[DUAL ? 4 : 1];
    if (((MK_UPF >> MIX) & 1) && have_pf) {
#pragma unroll
        for (int d0 = 0; d0 < 4; ++d0) { qf[d0] = pf.qf[d0]; if (DUAL) qg[DUAL ? d0 : 0] = pf.qg[d0]; }
    } else { const GAS bf16_t* qp = U + (size_t)qrow * DIN + C::QCOL + hq * 64 + hi * 8;
#pragma unroll
      for (int d0 = 0; d0 < 4; ++d0) { qf[d0] = *(const GAS bf16x8*)(qp + d0 * 16); if (DUAL) qg[DUAL ? d0 : 0] = *(const GAS bf16x8*)(qp + 64 + d0 * 16); } }
    float l0 = 0.f, l1 = 0.f;
    if (MIX == 0) { l0 = hi == 0 ? __builtin_amdgcn_exp2f(INP(13)[L * 4 + hq] * LOG2E) : 0.f;
        if (DUAL) l1 = hi == 0 ? __builtin_amdgcn_exp2f(INP(13)[L * 4 + hq + 1] * LOG2E) : 0.f; }
    f32x16 o0[2], o1[2];
#pragma unroll
    for (int i = 0; i < 2; ++i) { o0[i] = f32x16{}; o1[i] = f32x16{}; }
    u32x4 kreg[NKC], vreg[NVC];
    auto tile_row = [&](int t) -> int { return t < nloc ? lrow0 + (loc0 + t) * 64 : crow0 + (t - nloc) * 64; };
    unsigned goff[NKC];
#pragma unroll
    for (int i = 0; i < NKC; ++i) { const int c = tid + 512 * i, r = c / (C::CK / 8), cc = c % (C::CK / 8); goff[i] = (unsigned)(r * DIN + cc * 8) * 2u; }
    auto issueK = [&](int t) { const GAS char* tb = (const GAS char*)(U + (size_t)tile_row(t) * DIN + kcolb);
#pragma unroll
        for (int i = 0; i < NKC; ++i) kreg[i] = *(const GAS u32x4*)(tb + goff[i]); };
    auto issueV = [&](int t) { const GAS char* tb = (const GAS char*)(U + (size_t)tile_row(t) * DIN + vcolb);
#pragma unroll
        for (int i = 0; i < NVC; ++i) vreg[i] = *(const GAS u32x4*)(tb + goff[i]); };
    constexpr bool ILV = ((MK_ILV) >> MIX) & 1;
    constexpr bool MID = ILV && (!TWO || HP) && (C::CK == 128) && (((MK_MIDBAR) >> MIX) & 1);
    constexpr int K3SZ = 64 * SK, V3SZ = 64 * SV, V3BASE = 34816;
    static_assert(!MID || (2 * K3SZ <= V3BASE && V3BASE + 3 * V3SZ <= AT_RPB), "ring");
    auto KB = [&](int t) -> int { return MID ? (t & 1) * K3SZ : (t & 1) * AT_BUFB; };
    auto VB = [&](int t) -> int { return MID ? V3BASE + (int)((unsigned)t % 3u) * V3SZ : (t & 1) * AT_BUFB + AT_VOFF; };
    auto stashK = [&](int t) { LAS unsigned char* Kw = F.lds + KB(t);
#pragma unroll
        for (int i = 0; i < NKC; ++i) { const int c = tid + 512 * i, r = c / (C::CK / 8), cc = c % (C::CK / 8); *(LAS u32x4*)(Kw + r * SK + cc * 16) = kreg[i]; } };
    auto stashV = [&](int t) { LAS unsigned char* Vw = F.lds + VB(t);
#pragma unroll
        for (int i = 0; i < NVC; ++i) { const int c = tid + 512 * i, r = c / (C::CV / 8), cc = c % (C::CV / 8); *(LAS u32x4*)(Vw + r * SV + cc * 16) = vreg[i]; } };
    const int kboff = l31 * SK + (hk * 64 + hi * 8) * 2;
    const int vboff = (4 * hi + ((lane & 15) >> 2)) * SV + (hk * 64 + 16 * ((lane >> 4) & 1) + 4 * (lane & 3)) * 2;
    bf16x8 kf[8];
    auto loadkf = [&](int t) { const LAS unsigned char* kb = F.lds + KB(t) + kboff;
#pragma unroll
        for (int d0 = 0; d0 < 4; ++d0) { kf[2 * d0] = *(const LAS bf16x8*)(kb + d0 * 32); kf[2 * d0 + 1] = *(const LAS bf16x8*)(kb + 32 * SK + d0 * 32); } };
    bf16x8 pa0[4], pa1[4];
#pragma unroll
    for (int i = 0; i < 4; ++i) { pa0[i] = bf16x8{}; pa1[i] = bf16x8{}; }
    constexpr int VPRE = DUAL ? 1 : (TWO ? 2 : 4);
    bf16x8 vf[2 * VPRE];
    auto readvf = [&](int t, int sI, int dh) -> bf16x8 {
        const LAS unsigned char* vp = F.lds + VB(t) + vboff + (16 * sI) * SV + dh * 64;
        const s16x4 lo = vtr(vp), hi4 = vtr(vp + 8 * SV);
        return (bf16x8){lo[0], lo[1], lo[2], lo[3], hi4[0], hi4[1], hi4[2], hi4[3]}; };
    auto loadvf = [&](int t) {
#pragma unroll
        for (int sI = 0; sI < VPRE; ++sI)
#pragma unroll
            for (int dh = 0; dh < 2; ++dh) vf[2 * sI + dh] = readvf(t, sI, dh); };
    auto pv = [&](int t) {
#pragma unroll
        for (int sI = 0; sI < 4; ++sI)
#pragma unroll
            for (int dh = 0; dh < 2; ++dh) {
                const bf16x8 v = sI < VPRE ? vf[2 * (sI < VPRE ? sI : 0) + dh] : readvf(t, sI, dh);
                o0[dh] = __builtin_amdgcn_mfma_f32_32x32x16_bf16(v, pa0[sI], o0[dh], 0, 0, 0);
                if (TWO) o1[dh] = __builtin_amdgcn_mfma_f32_32x32x16_bf16(v, pa1[sI], o1[dh], 0, 0, 0);
            } };
    const int qpos = qb * UQ + rs * 32 + l31;
    const int qc = rs * 32 + l31, cs = qc - 8 < 0 ? 0 : (qc - 8 > 48 ? 48 : qc - 8);
    const LAS float* rpb = (const LAS float*)(F.lds + AT_RPB) + hq * 465;
    if (((MK_UPF >> MIX) & 1) && have_pf) {
#pragma unroll
        for (int i = 0; i < NKC; ++i) kreg[i] = pf.k0[i];
    } else issueK(0);
    stashK(0); issueK(1); issueV(0);
    WG_BAR();
    constexpr bool KHOLD = !TWO || HP;
    if (KHOLD) loadkf(0);
    if (ILV) {
#define SBAR() __builtin_amdgcn_sched_barrier(0)
    auto loadkf1 = [&](int t, int j) { const LAS unsigned char* kb = F.lds + KB(t) + kboff; kf[j] = *(const LAS bf16x8*)(kb + (j & 1) * 32 * SK + (j >> 1) * 32); };
    constexpr int NB = TWO ? 2 : 4;
    constexpr int NG = TWO ? 16 : 8;
    bf16x8 vr[NB];
    auto stage = [&](int t) {
        if (t + 1 < NT) stashK(t + 1);
        stashV(t);
        if (t + 2 < NT) issueK(t + 2);
        if (t + 1 < NT) issueV(t + 1); };
    auto qk = [&](int t, f32x16& p0, f32x16& p1, f32x16& r0_, f32x16& r1_) {
        if (DUAL) {
            const LAS unsigned char* kb = F.lds + KB(t) + kboff;
            bf16x8 kr[2][2];
#pragma unroll
            for (int d0 = 0; d0 < 2; ++d0) { kr[d0][0] = *(const LAS bf16x8*)(kb + d0 * 32); kr[d0][1] = *(const LAS bf16x8*)(kb + 32 * SK + d0 * 32); }
#pragma unroll
            for (int d0 = 0; d0 < 4; ++d0) {
                SBAR();
                p0 = __builtin_amdgcn_mfma_f32_32x32x16_bf16(kr[d0 & 1][0], qf[d0], p0, 0, 0, 0); p1 = __builtin_amdgcn_mfma_f32_32x32x16_bf16(kr[d0 & 1][1], qf[d0], p1, 0, 0, 0);
                r0_ = __builtin_amdgcn_mfma_f32_32x32x16_bf16(kr[d0 & 1][0], qg[DUAL ? d0 : 0], r0_, 0, 0, 0); r1_ = __builtin_amdgcn_mfma_f32_32x32x16_bf16(kr[d0 & 1][1], qg[DUAL ? d0 : 0], r1_, 0, 0, 0);
                if (d0 + 2 < 4) { kr[d0 & 1][0] = *(const LAS bf16x8*)(kb + (d0 + 2) * 32); kr[d0 & 1][1] = *(const LAS bf16x8*)(kb + 32 * SK + (d0 + 2) * 32); }
                if (MK_QKFIRST == 4 && t > 0 && d0 == MK_QKSPLIT) {
#pragma unroll
                    for (int f = 0; f < NB; ++f) vr[f] = readvf(t - 1, f >> 1, f & 1);
                    stage(t); }
            }
            SBAR();
            return;
        }
#pragma unroll
        for (int d0 = 0; d0 < 2; ++d0) { p0 = __builtin_amdgcn_mfma_f32_32x32x16_bf16(kf[2 * d0], qf[d0], p0, 0, 0, 0); p1 = __builtin_amdgcn_mfma_f32_32x32x16_bf16(kf[2 * d0 + 1], qf[d0], p1, 0, 0, 0); }
        if ((((MK_QKMID) >> MIX) & 1) && MK_QKFIRST == 4 && t > 0) {
            SBAR();
#pragma unroll
            for (int f = 0; f < NB; ++f) vr[f] = readvf(t - 1, f >> 1, f & 1);
            stage(t);
            SBAR();
        }
#pragma unroll
        for (int d0 = 2; d0 < 4; ++d0) {
            if (DIFF) { r0_ = __builtin_amdgcn_mfma_f32_32x32x16_bf16(kf[2 * d0], qf[d0], r0_, 0, 0, 0); r1_ = __builtin_amdgcn_mfma_f32_32x32x16_bf16(kf[2 * d0 + 1], qf[d0], r1_, 0, 0, 0); }
            else { p0 = __builtin_amdgcn_mfma_f32_32x32x16_bf16(kf[2 * d0], qf[d0], p0, 0, 0, 0); p1 = __builtin_amdgcn_mfma_f32_32x32x16_bf16(kf[2 * d0 + 1], qf[d0], p1, 0, 0, 0); } } };
    auto init_acc = [&](int t, f32x16& p0, f32x16& p1, f32x16& r0_, f32x16& r1_) {
        const bool local = t < nloc;
        p0 = f32x16{}; p1 = f32x16{}; r0_ = f32x16{}; r1_ = f32x16{};
        if (MIX == 0 && local) {
            const int dj = loc0 + t - qb;
            if (dj <= -2 || dj >= 2) {
                const int mb = (loc0 + t) * 64 + 4 * hi - qpos + 128;
#pragma unroll
                for (int r = 0; r < 16; ++r) { const int kc = (r & 3) + 8 * (r >> 2);
                    if ((unsigned)(mb + kc) > 256u) { p0[r] = -INFINITY; if (DUAL) r0_[r] = -INFINITY; } if ((unsigned)(mb + kc + 32) > 256u) { p1[r] = -INFINITY; if (DUAL) r1_[r] = -INFINITY; } }
            }
        }
        if (MIX == 1 && local) {
            const int dr = (loc0 + t) - qb + 7;
            const int kh = 4 * hi - cs; const LAS float* rp = rpb + dr * 31 + 15 - qc + 4 * hi;
            float bb0[16], bb1[16];
#pragma unroll
            for (int r = 0; r < 16; ++r) { const int kc = (r & 3) + 8 * (r >> 2); bb0[r] = rp[kc]; bb1[r] = rp[kc + 32]; }
#pragma unroll
            for (int r = 0; r < 16; ++r) { asm volatile("" : "+v"(bb0[r]), "+v"(bb1[r])); }
#pragma unroll
            for (int r = 0; r < 16; ++r) { const int kc = (r & 3) + 8 * (r >> 2);
                const bool v0 = (unsigned)(kh + kc) < 16u, v1 = (unsigned)(kh + kc + 32) < 16u;
                p0[r] = v0 ? bb0[r] : -INFINITY; p1[r] = v1 ? bb1[r] : -INFINITY; }
        } };
    auto sm_exp = [&](f32x16& a0, f32x16& a1, int q, float& sum) {
#pragma unroll
        for (int j = 0; j < 4; ++j) { const int r = 4 * (q & 3) + j;
            if (q < 4) { a0[r] = __builtin_amdgcn_exp2f(a0[r]); sum += a0[r]; } else { a1[r] = __builtin_amdgcn_exp2f(a1[r]); sum += a1[r]; } } };
    auto sm_cvt = [&](const f32x16& a0, const f32x16& a1, int q, bf16x8 (&pa)[4]) {
        const int r = 4 * (q & 3);
        const unsigned lo = q < 4 ? pk2(a0[r], a0[r + 1]) : pk2(a1[r], a1[r + 1]), hi2 = q < 4 ? pk2(a0[r + 2], a0[r + 3]) : pk2(a1[r + 2], a1[r + 3]);
        u32x4 w = __builtin_bit_cast(u32x4, pa[q >> 1]);
        if (q & 1) { w.z = lo; w.w = hi2; } else { w.x = lo; w.y = hi2; }
        pa[q >> 1] = __builtin_bit_cast(bf16x8, w); };
    {
        if (!KHOLD && !DUAL) loadkf(0);
        stage(0);
        f32x16 p0, p1, r0_, r1_;
        init_acc(0, p0, p1, r0_, r1_);
        qk(0, p0, p1, r0_, r1_);
        softmax_tile(p0, p1, l0, pa0);
        if (TWO) softmax_tile(r0_, r1_, l1, pa1);
        WG_BAR();
        if (KHOLD && 1 < NT) loadkf(1);
    }
    SEG0();
    for (int t = 1; t < NT; ++t) {
        f32x16 p0, p1, r0_, r1_;
        if (MK_QKFIRST) {
            if (!KHOLD && !DUAL) loadkf(t);
            if (MK_QKFIRST == 2) {
#pragma unroll
                for (int f = 0; f < NB; ++f) vr[f] = readvf(t - 1, f >> 1, f & 1); }
            init_acc(t, p0, p1, r0_, r1_);
            qk(t, p0, p1, r0_, r1_);
            if (MK_QKFIRST != 2 && !(MK_QKFIRST == 4 && (DUAL || (((MK_QKMID) >> MIX) & 1)))) {
#pragma unroll
                for (int f = 0; f < NB; ++f) vr[f] = readvf(t - 1, f >> 1, f & 1); }
            if (MK_QKFIRST != 3 && !(MK_QKFIRST == 4 && (DUAL || (((MK_QKMID) >> MIX) & 1)))) stage(t);
        } else {
#pragma unroll
        for (int f = 0; f < NB; ++f) vr[f] = readvf(t - 1, f >> 1, f & 1);
        if (!KHOLD && !DUAL) loadkf(t);
        stage(t);
        init_acc(t, p0, p1, r0_, r1_);
        SEG(1);
        qk(t, p0, p1, r0_, r1_);
        SEG(0);
        }
#pragma unroll
        for (int g = 0; g < NG; ++g) {
            SBAR();
            if (MID && g == NG / 2) { WG_BAR(); SBAR(); }
            if (MID && !TWO && g >= NG - 4) { loadkf1(t + 1, 2 * (g - (NG - 4))); loadkf1(t + 1, 2 * (g - (NG - 4)) + 1); }
            if (TWO) {
                const int f = g >> 1, h = g & 1, sI = g >> 2, dh = (g >> 1) & 1;
                if (h == 0) o0[dh] = __builtin_amdgcn_mfma_f32_32x32x16_bf16(vr[f % NB], pa0[sI], o0[dh], 0, 0, 0);
                else { o1[dh] = __builtin_amdgcn_mfma_f32_32x32x16_bf16(vr[f % NB], pa1[sI], o1[dh], 0, 0, 0);
                    if (f + NB < 8) vr[f % NB] = readvf(t - 1, (f + NB) >> 1, (f + NB) & 1); }
                if (h == 0) sm_exp(p0, p1, g >> 1, l0); else sm_exp(r0_, r1_, g >> 1, l1);
                if (g >= 3 && ((g - 3) & 3) == 0) { const int k = (g - 3) >> 2; sm_cvt(p0, p1, 2 * k, pa0); sm_cvt(p0, p1, 2 * k + 1, pa0); }
                if (g >= 4 && ((g - 4) & 3) == 0) { const int k = (g - 4) >> 2; sm_cvt(r0_, r1_, 2 * k, pa1); sm_cvt(r0_, r1_, 2 * k + 1, pa1); }
            } else {
                const int f = g, sI = g >> 1, dh = g & 1;
                o0[dh] = __builtin_amdgcn_mfma_f32_32x32x16_bf16(vr[f % NB], pa0[sI], o0[dh], 0, 0, 0);
                if (f + NB < 8) vr[f % NB] = readvf(t - 1, (f + NB) >> 1, (f + NB) & 1);
                sm_exp(p0, p1, g, l0);
                if (g >= 2 && (g & 1) == 0) { const int k = (g - 2) >> 1; sm_cvt(p0, p1, 2 * k, pa0); sm_cvt(p0, p1, 2 * k + 1, pa0); }
            }
        }
        SBAR();
        if (MK_QKFIRST == 3) stage(t);
        if (TWO) { sm_cvt(r0_, r1_, 6, pa1); sm_cvt(r0_, r1_, 7, pa1); }
        else { sm_cvt(p0, p1, 6, pa0); sm_cvt(p0, p1, 7, pa0); }
        if (MID && TWO) {
#pragma unroll
            for (int j = 0; j < 8; ++j) loadkf1(t + 1, j); }
        SEG(2);
        if (!MID) WG_BAR();
        SEG(3);
        if (KHOLD && !MID && t + 1 < NT) loadkf(t + 1);
    }
    if (((MK_UPF >> MIX) & 1) && nx.valid) {
        const int hq_n = DUAL ? 2 * (w >> 2) : (HP ? 2 * nx.hp + (w >> 2) : (w >> 1));
        const int qrow_n = nx.isctx ? NLAT + nx.b * CTXL + nx.qb * UQ + rs * 32 + l31 : nx.b * SEQ + nx.qb * UQ + rs * 32 + l31;
        const GAS bf16_t* qp = U + (size_t)qrow_n * DIN + C::QCOL + hq_n * 64 + hi * 8;
#pragma unroll
        for (int d0 = 0; d0 < 4; ++d0) { pf.qf[d0] = *(const GAS bf16x8*)(qp + d0 * 16); if (DUAL) pf.qg[d0] = *(const GAS bf16x8*)(qp + 64 + d0 * 16); }
        int loc0_n = 0; if (MIX == 0) loc0_n = nx.qb - 2 < 0 ? 0 : nx.qb - 2; if (MIX == 1) loc0_n = nx.qb - 4 < 0 ? 0 : (nx.qb - 4 > 24 ? 24 : nx.qb - 4);
        const int row_n = nx.isctx ? NLAT + nx.b * CTXL : nx.b * SEQ + loc0_n * 64;
        const GAS char* tb = (const GAS char*)(U + (size_t)row_n * DIN + C::KCOL + (HP ? nx.hp * 128 : 0));
#pragma unroll
        for (int i = 0; i < NKC; ++i) pf.k0[i] = *(const GAS u32x4*)(tb + goff[i]);
    }
    loadvf(NT - 1); pv(NT - 1);
    } else {
    for (int t = 0; t < NT; ++t) {
        if (t > 0) loadvf(t - 1);
        if (!KHOLD) loadkf(t);
        MK_SB();
        if (t + 1 < NT) stashK(t + 1);
        stashV(t);
        if (t + 2 < NT) issueK(t + 2);
        if (t + 1 < NT) issueV(t + 1);
        const bool local = t < nloc;
        f32x16 p0 = f32x16{}, p1 = f32x16{}, r0_ = f32x16{}, r1_ = f32x16{};
#pragma unroll
        for (int d0 = 0; d0 < (DIFF ? 2 : 4); ++d0) { p0 = __builtin_amdgcn_mfma_f32_32x32x16_bf16(kf[2 * d0], qf[d0], p0, 0, 0, 0); p1 = __builtin_amdgcn_mfma_f32_32x32x16_bf16(kf[2 * d0 + 1], qf[d0], p1, 0, 0, 0); }
        MK_SB();
        if (t > 0) pv(t - 1);
        if (DIFF) {
#pragma unroll
            for (int d0 = 2; d0 < 4; ++d0) { r0_ = __builtin_amdgcn_mfma_f32_32x32x16_bf16(kf[2 * d0], qf[d0], r0_, 0, 0, 0); r1_ = __builtin_amdgcn_mfma_f32_32x32x16_bf16(kf[2 * d0 + 1], qf[d0], r1_, 0, 0, 0); }
        }
        if (DUAL) {
#pragma unroll
            for (int d0 = 0; d0 < 4; ++d0) { r0_ = __builtin_amdgcn_mfma_f32_32x32x16_bf16(kf[2 * d0], qg[DUAL ? d0 : 0], r0_, 0, 0, 0); r1_ = __builtin_amdgcn_mfma_f32_32x32x16_bf16(kf[2 * d0 + 1], qg[DUAL ? d0 : 0], r1_, 0, 0, 0); }
        }
        MK_SB();
        if (MIX == 0 && local) {
            const int mb = (loc0 + t) * 64 + 4 * hi - qpos + 128;
#pragma unroll
            for (int r = 0; r < 16; ++r) { const int kc = (r & 3) + 8 * (r >> 2);
                if ((unsigned)(mb + kc) > 256u) { p0[r] = -INFINITY; if (DUAL) r0_[r] = -INFINITY; } if ((unsigned)(mb + kc + 32) > 256u) { p1[r] = -INFINITY; if (DUAL) r1_[r] = -INFINITY; } }
        }
        if (MIX == 1 && local) {
            const int dr = (loc0 + t) - qb + 7;
            const int kh = 4 * hi - cs; const LAS float* rp = rpb + dr * 31 + 15 - qc + 4 * hi;
#pragma unroll
            for (int r = 0; r < 16; ++r) { const int kc = (r & 3) + 8 * (r >> 2);
                const bool v0 = (unsigned)(kh + kc) < 16u, v1 = (unsigned)(kh + kc + 32) < 16u;
                const float b0 = rp[kc], b1 = rp[kc + 32];
                p0[r] = v0 ? p0[r] + b0 : -INFINITY; p1[r] = v1 ? p1[r] + b1 : -INFINITY; }
        }
        softmax_tile(p0, p1, l0, pa0);
        if (TWO) softmax_tile(r0_, r1_, l1, pa1);
        WG_BAR();
        if (KHOLD && t + 1 < NT) loadkf(t + 1);
    }
    loadvf(NT - 1); pv(NT - 1);
    }
    { refresh(F); const int l31f = F.lane & 31, hif = F.lane >> 5;
      const float lt0 = x32_sum(l0); const float i0 = 1.0f / lt0;
      float sc1 = 0.f;
      if (DIFF) { const float lt1 = x32_sum(l1); sc1 = tab[TAB_LAM + L] / lt1; }
      if (DUAL) { const float lt1 = x32_sum(l1); sc1 = 1.0f / lt1; }
      float ss = 0.f, ss1 = 0.f;
#pragma unroll
      for (int dh = 0; dh < 2; ++dh)
#pragma unroll
          for (int r = 0; r < 16; ++r) { float v = o0[dh][r] * i0; if (DIFF) v -= o1[dh][r] * sc1; o0[dh][r] = v; ss += v * v;
              if (DUAL) { const float v1 = o1[dh][r] * sc1; o1[dh][r] = v1; ss1 += v1 * v1; } }
      ss = x32_sum(ss); if (DUAL) ss1 = x32_sum(ss1);
      float scl;
      if (DIFF) scl = __builtin_amdgcn_rsqf(ss * (1.f / 64.f) + EPS) * tab[TAB_LAM + DEPTH + L];
      else {
          LAS float* gss = (LAS float*)(F.lds + AT_GSS);
          if (hif == 0) { gss[(rs * 32 + l31f) * 4 + hq] = ss; if (DUAL) gss[(rs * 32 + l31f) * 4 + hq + 1] = ss1; }
          WG_BAR();
          const f32x4 g4 = *(const LAS f32x4*)(gss + (rs * 32 + l31f) * 4);
          scl = __builtin_amdgcn_rsqf(((g4.x + g4.y) + (g4.z + g4.w)) * (1.f / 256.f) + EPS);
      }
      int lf = l31f;
      const int qrow_f = isctx ? NLAT + b * CTXL + qb * UQ + rs * 32 + lf : b * SEQ + qb * UQ + rs * 32 + lf;
      GAS bf16_t* yp = Y + (size_t)qrow_f * D + MIX * 256 + hq * 64 + 4 * hif;
#pragma unroll
      for (int dh = 0; dh < 2; ++dh)
#pragma unroll
          for (int g = 0; g < 4; ++g) { u32x2 o; o.x = pk2(o0[dh][4 * g] * scl, o0[dh][4 * g + 1] * scl); o.y = pk2(o0[dh][4 * g + 2] * scl, o0[dh][4 * g + 3] * scl);
              *(GAS u32x2*)(yp + dh * 32 + 8 * g) = o;
              if (DUAL) { u32x2 o2; o2.x = pk2(o1[dh][4 * g] * scl, o1[dh][4 * g + 1] * scl); o2.y = pk2(o1[dh][4 * g + 2] * scl, o1[dh][4 * g + 3] * scl);
                  *(GAS u32x2*)(yp + 64 + dh * 32 + 8 * g) = o2; } }
    }
#ifdef MK_STAMP
    if (MIX == MK_STAMP && F.tid == MK_STAMP_TID) { LAS unsigned* m_ = (LAS unsigned*)(F.lds + MISC_OFF); const unsigned a_ = m_[20]; unsigned z_ = 0; asm volatile("" : "+v"(z_)); m_[20] = z_;
        if (!isctx) { __hip_atomic_fetch_add(CTL(F) + 2048, a_, __ATOMIC_RELAXED, __HIP_MEMORY_SCOPE_AGENT); __hip_atomic_fetch_add(CTL(F) + 2049, (unsigned)(NT - 1), __ATOMIC_RELAXED, __HIP_MEMORY_SCOPE_AGENT); } }
#endif
}

template <int MIX>
__device__ __forceinline__ void run_mixer(FARGS, int L, bool need_ctx) {
    constexpr bool DUAL = (MIX == 3) && MK_DUAL, HP = (MIX == 2) && MK_CHP;
    constexpr int NU = DUAL ? 512 : 1024, NC = DUAL ? 64 : 128;
    const int G = F.G;
    const int c = (G % 8 == 0) ? (F.bx % 8) * (G / 8) + F.bx / 8 : F.bx;
    const int nlat = c < NU ? (NU - c + G - 1) / G : 0;
    const int j = (MIX & 1) ? c - 128 : c;
    const bool has_ctx = need_ctx && j >= 0 && j < NC;
    const int n = nlat + (has_ctx ? 1 : 0);
    auto unit_of = [&](int k, int& b, int& qb, int& hp, bool& isctx) { isctx = k >= nlat; const int i = isctx ? j : c + k * G; hp = 0;
        if (HP) { if (isctx) { b = i >> 2; qb = (i >> 1) & 1; hp = i & 1; } else { b = i >> 5; qb = (i & 31) >> 1; hp = i & 1; } }
        else if (DUAL) { if (isctx) { b = i >> 1; qb = i & 1; } else { b = i >> 4; qb = i & 15; } }
        else { if (isctx) { b = i >> 2; qb = i & 3; } else { b = i >> 5; qb = i & 31; } } };
    AttnPF<MIX> pf;
#pragma unroll
    for (int d0 = 0; d0 < 4; ++d0) { pf.qf[d0] = bf16x8{}; pf.qg[d0] = bf16x8{}; }
#pragma unroll
    for (int i = 0; i < MixCfg<MIX>::CK / 64; ++i) pf.k0[i] = u32x4{};
    for (int k = 0; k < n; ++k) {
        int b, qb, hp; bool isctx; unit_of(k, b, qb, hp, isctx);
        AttnNext nx; nx.valid = k + 1 < n; nx.b = 0; nx.qb = 0; nx.hp = 0; nx.isctx = false;
        if (nx.valid) unit_of(k + 1, nx.b, nx.qb, nx.hp, nx.isctx);
        attn_unit<MIX>(F, L, b, qb, isctx, hp, pf, k > 0, nx); }
}
__device__ __forceinline__ void attn_phase(FARGS, int L, bool need_ctx) {
    refresh(F);
    { LAS float* rpb = (LAS float*)(F.lds + AT_RPB); const GAS float* src = INP(14) + L * 4 * 465;
      for (int i = F.tid; i < 4 * 465; i += 512) rpb[i] = src[i] * LOG2E; }
    __syncthreads();
#ifndef MK_DOUBLE_MIX
#define MK_DOUBLE_MIX -1
#endif
#define REPM(k) for (int rep_ = 0; rep_ < ((MK_DOUBLE_MIX == (k)) ? 2 : 1); ++rep_)
    REPM(2) run_mixer<2>(F, L, need_ctx);
    REPM(3) run_mixer<3>(F, L, need_ctx);
    REPM(1) run_mixer<1>(F, L, need_ctx);
    REPM(0) run_mixer<0>(F, L, need_ctx);
    __syncthreads();
}
struct ProbPlain {
    static constexpr bool GATHER = false;
    const GAS char* A; const GAS char* Bt; int K, lda, ldb; size_t hstepA, hstepB; pg8::Order ord;
    __device__ __forceinline__ bool next(int i, pg8::Unit& u) const { return ord.next(i, u); }
    template <int NH> __device__ __forceinline__ void a_off(const pg8::Unit& u, int tid, unsigned (&v)[NH][2]) const {
        int R0, C0, R1, C1; pg8::stage_rc(tid * 16, R0, C0); pg8::stage_rc(tid * 16 + 8192, R1, C1);
        v[0][0] = (unsigned)((u.pm * 256 + R0) * lda + C0) * 2u; v[0][1] = (unsigned)((u.pm * 256 + R1) * lda + C1) * 2u;
    }
    __device__ __forceinline__ const GAS char* b_tile(const pg8::Unit& u, int t) const { return Bt + ((size_t)u.pn * 256 * ldb + (size_t)t * 64) * 2; }
};
struct EpiU { static constexpr int SID = 0;
    static constexpr bool PERM = true; static constexpr int NSTORES = 32;
    GAS bf16_t* U;
    __device__ __forceinline__ void operator()(const f32x4 (&acc)[2][2][4][2], const pg8::Unit& u, int wr, int wc, int fr, int fq) const {
        const int row0 = u.pm * 256 + wr * 64 + fr, col0 = u.pn * 256 + wc * 32 + 8 * fq;
#pragma unroll
        for (int ai = 0; ai < 2; ++ai)
#pragma unroll
            for (int m = 0; m < 4; ++m) { int frx = fr; asm volatile("" : "+v"(frx)); GAS bf16_t* rowp = U + (size_t)(u.pm * 256 + wr * 64 + frx + ai * 128 + m * 16) * DIN + col0;
#pragma unroll
                for (int bj = 0; bj < 2; ++bj) { const f32x4 v0 = acc[ai][bj][m][0], v1 = acc[ai][bj][m][1];
                    u32x4 w; w.x = pk2(v0[0], v0[1]); w.y = pk2(v0[2], v0[3]); w.z = pk2(v1[0], v1[1]); w.w = pk2(v1[2], v1[3]);
                    *(GAS u32x4*)(rowp + bj * 128) = w; } }
    }
};
struct EpiQK { static constexpr int SID = 1;
    static constexpr bool PERM = true; static constexpr int NSTORES = 32;
    GAS bf16_t* U; const GAS float* tab; const GAS float* gwin; const GAS float* gna; const GAS float* gdiff; const GAS float* ggqa; LAS float* X; float vscale;
    __device__ __forceinline__ void operator()(const f32x4 (&acc)[2][2][4][2], const pg8::Unit& u, int wr, int wc, int fr_, int fq_) const {
        int fq = fq_, fr = fr_; asm volatile("" : "+v"(fq), "+v"(fr));
        const int pn = u.pn;
        const bool lat = u.pm < 256;
        int kind = 0, nbj = 0; bool isq = false, rope = false; const GAS float* g = gwin; float qs = 1.f;
        if (pn == 0) { kind = 1; nbj = 2; isq = true; rope = true; g = gwin; } else if (pn == 1) { kind = 1; nbj = 1; rope = true; g = gwin + 64; }
        else if (pn == 2) { kind = 1; nbj = 2; isq = true; g = gna; } else if (pn == 3) { kind = 1; nbj = 2; g = gna + 64; }
        else if (pn == 5) { kind = 2; nbj = 2; isq = true; rope = true; g = gdiff; } else if (pn == 6) { kind = 2; nbj = 2; rope = true; g = gdiff + 32; }
        else if (pn == 8) { kind = 1; nbj = 2; isq = true; rope = true; g = ggqa; } else if (pn == 9) { kind = 1; nbj = 1; rope = true; g = ggqa + 64; }
        rope = rope && lat;
        if (kind == 0) body<0, false, 0>(acc, u, wr, wc, fr, fq, isq, g);
        else if (kind == 2) { if (rope) body<2, true, 2>(acc, u, wr, wc, fr, fq, isq, g); else body<2, false, 2>(acc, u, wr, wc, fr, fq, isq, g); }
        else if (nbj == 2) { if (rope) body<1, true, 2>(acc, u, wr, wc, fr, fq, isq, g); else body<1, false, 2>(acc, u, wr, wc, fr, fq, isq, g); }
        else { if (rope) body<1, true, 1>(acc, u, wr, wc, fr, fq, isq, g); else body<1, false, 1>(acc, u, wr, wc, fr, fq, isq, g); }
    }
    template <int kind, bool rope, int nbj>
    __device__ __forceinline__ void body(const f32x4 (&acc)[2][2][4][2], const pg8::Unit& u, int wr, int wc, int fr, int fq, bool isq, const GAS float* g) const {
        const int pn = u.pn, lane = fr + 16 * fq;
        float qs = 1.f;
        if (isq) qs = (kind == 2 ? 0.17677669529663687f : 0.125f) * LOG2E;
        const int row0 = u.pm * 256 + wr * 64 + fr, col0 = pn * 256 + wc * 32 + 8 * fq;
        float gg[8];
        { const int dg = kind == 2 ? 8 * fq : 32 * (wc & 1) + 8 * fq; const f32x4 a = *(const GAS f32x4*)(g + dg), b = *(const GAS f32x4*)(g + dg + 4);
          gg[0] = a.x; gg[1] = a.y; gg[2] = a.z; gg[3] = a.w; gg[4] = b.x; gg[5] = b.y; gg[6] = b.z; gg[7] = b.w; }
        auto sumsq = [&](int ai, int m, int bj) -> float { const f32x4 v0 = acc[ai][bj][m][0], v1 = acc[ai][bj][m][1];
            float s = (v0[0] * v0[0] + v0[1] * v0[1]) + (v0[2] * v0[2] + v0[3] * v0[3]) + (v1[0] * v1[0] + v1[1] * v1[1]) + (v1[2] * v1[2] + v1[3] * v1[3]);
            s += sx(s, lane, 16); s += sx(s, lane, 32); return s; };
        LAS float* Xw = X + (wr * 64 + fr) * 8 + wc; const LAS float* Xr = X + (wr * 64 + fr) * 8 + (wc ^ 1);
        float ssv[2][4][2];
#pragma unroll
        for (int ai = 0; ai < 2; ++ai)
#pragma unroll
            for (int m = 0; m < 4; ++m) { ssv[ai][m][0] = 0.f; ssv[ai][m][1] = 0.f; }
        if (kind == 1) {
#pragma unroll
            for (int ai = 0; ai < 2; ++ai)
#pragma unroll
                for (int m = 0; m < 4; ++m)
#pragma unroll
                    for (int bj = 0; bj < 2; ++bj) { const float s = sumsq(ai, m, bj); ssv[ai][m][bj] = s; if (fq == 0) Xw[(ai * 128 + m * 16) * 8 + bj * 4] = s; }
            asm volatile("s_waitcnt lgkmcnt(0)\n\ts_barrier" ::: "memory");
        }
        const int pxor = kind == 2 ? 16 : 32;
        const bool first = kind == 2 ? !(fq & 1) : (fq < 2);
        auto load_cs = [&](int it, f32x4 (&dst)[4]) {
            int frx = fr; asm volatile("" : "+v"(frx));
            const int row = u.pm * 256 + (it >> 2) * 128 + wr * 64 + (it & 3) * 16 + frx, s_ = row & 2047, prow = s_ >> 6, pcol = s_ & 63;
            const GAS float* tp = kind == 2 ? tab + TAB_T32 + ((fq < 2 ? prow : pcol) * 8) * 2 : tab + TAB_T64 + (((wc & 1) ? pcol : prow) * 16 + 8 * (fq & 1)) * 2;
#pragma unroll
            for (int e2 = 0; e2 < 4; ++e2) dst[e2] = *(const GAS f32x4*)(tp + 4 * e2); };
        f32x4 cs[4], ncs[4];
        if (rope) load_cs(0, cs);
#pragma unroll
        for (int ai = 0; ai < 2; ++ai)
#pragma unroll
            for (int m = 0; m < 4; ++m) {
                int frx = fr; asm volatile("" : "+v"(frx));
                const int rit = ai * 128 + wr * 64 + m * 16 + frx, row = u.pm * 256 + rit;
                GAS bf16_t* rowp = U + (size_t)row * DIN + col0;
                if (rope && ai * 4 + m < 7) load_cs(ai * 4 + m + 1, ncs);
                asm volatile("" ::: "memory");
#pragma unroll
                for (int bj = 0; bj < 2; ++bj) {
                    const f32x4 v0 = acc[ai][bj][m][0], v1 = acc[ai][bj][m][1];
                    float x[8] = {v0[0], v0[1], v0[2], v0[3], v1[0], v1[1], v1[2], v1[3]};
                    if (kind != 0 && bj < nbj) {
                        float ss;
                        if (kind == 1) ss = ssv[ai][m][bj] + Xr[(ai * 128 + m * 16) * 8 + bj * 4]; else ss = sumsq(ai, m, bj);
                        const float rq = qs * __builtin_amdgcn_rsqf(ss * (kind == 2 ? (1.f / 32.f) : (1.f / 64.f)) + EPS);
#pragma unroll
                        for (int e = 0; e < 8; ++e) x[e] = x[e] * gg[e];
                        if (rope) {
#pragma unroll
                            for (int e2 = 0; e2 < 4; ++e2) {
                                const float pa = sx(x[2 * e2], lane, pxor), pb = sx(x[2 * e2 + 1], lane, pxor);
                                x[2 * e2] = first ? x[2 * e2] * cs[e2].x - pa * cs[e2].y : pa * cs[e2].y + x[2 * e2] * cs[e2].x;
                                x[2 * e2 + 1] = first ? x[2 * e2 + 1] * cs[e2].z - pb * cs[e2].w : pb * cs[e2].w + x[2 * e2 + 1] * cs[e2].z;
                            }
                        }
#pragma unroll
                        for (int e = 0; e < 8; ++e) x[e] *= rq;
                    } else {
#pragma unroll
                        for (int e = 0; e < 8; ++e) x[e] *= vscale;
                    }
                    u32x4 w; w.x = pk2(x[0], x[1]); w.y = pk2(x[2], x[3]); w.z = pk2(x[4], x[5]); w.w = pk2(x[6], x[7]);
                    *(GAS u32x4*)(rowp + bj * 128) = w;
                }
#pragma unroll
                for (int e2 = 0; e2 < 4; ++e2) cs[e2] = ncs[e2];
            }
    }
};
struct EpiResid { static constexpr int SID = 2;
    static constexpr bool PERM = true; static constexpr int NSTORES = 32;
    const GAS float* slat; const GAS float* sctx; GAS bf16_t* XB; const GAS float* gate; bool first; float ascale;
    __device__ __forceinline__ void operator()(const f32x4 (&acc)[2][2][4][2], const pg8::Unit& u, int wr, int wc, int fr_, int fq) const {
        int fr = fr_; asm volatile("" : "+v"(fr));
        if (first) body<true>(acc, u, wr, wc, fr, fq); else body<false>(acc, u, wr, wc, fr, fq);
    }
    template <bool FIRST>
    __device__ __forceinline__ void body(const f32x4 (&acc)[2][2][4][2], const pg8::Unit& u, int wr, int wc, int fr, int fq) const {
        const bool islat = u.pm < 256; const int b = islat ? (u.pm >> 3) : 32;
        const GAS float* src = islat ? slat + (size_t)u.pm * 256 * D : sctx + (size_t)(u.pm - 256) * 256 * D;
        GAS bf16_t* dst = XB + (size_t)u.pm * 256 * D;
        const GAS float* gp = gate + (size_t)b * ADA;
        const int col0 = u.pn * 256 + wc * 32 + 8 * fq;
        f32x4 gv[2][2];
#pragma unroll
        for (int bj = 0; bj < 2; ++bj)
#pragma unroll
            for (int n = 0; n < 2; ++n) gv[bj][n] = *(const GAS f32x4*)(gp + col0 + bj * 128 + n * 4) * ascale;
        if (FIRST) {
#pragma unroll
            for (int ai = 0; ai < 2; ++ai)
#pragma unroll
                for (int m = 0; m < 4; ++m) {
                    const size_t ro = (size_t)(ai * 128 + wr * 64 + m * 16 + fr) * D + col0;
#pragma unroll
                    for (int bj = 0; bj < 2; ++bj) { f32x4 x0 = *(const GAS f32x4*)(src + ro + bj * 128), x1 = *(const GAS f32x4*)(src + ro + bj * 128 + 4);
                        x0 = x0 + gv[bj][0] * acc[ai][bj][m][0]; x1 = x1 + gv[bj][1] * acc[ai][bj][m][1];
                        u32x4 o; o.x = pk2(x0[0], x0[1]); o.y = pk2(x0[2], x0[3]); o.z = pk2(x1[0], x1[1]); o.w = pk2(x1[2], x1[3]);
                        *(GAS u32x4*)(dst + ro + bj * 128) = o; } }
        } else {
            u32x4 wv[2][4][2];
#pragma unroll
            for (int ai = 0; ai < 2; ++ai)
#pragma unroll
                for (int m = 0; m < 4; ++m) { const size_t ro = (size_t)(ai * 128 + wr * 64 + m * 16 + fr) * D + col0;
                    wv[ai][m][0] = *(const GAS u32x4*)(dst + ro); wv[ai][m][1] = *(const GAS u32x4*)(dst + ro + 128); }
#pragma unroll
            for (int ai = 0; ai < 2; ++ai)
#pragma unroll
                for (int m = 0; m < 4; ++m) { const size_t ro = (size_t)(ai * 128 + wr * 64 + m * 16 + fr) * D + col0;
#pragma unroll
                    for (int bj = 0; bj < 2; ++bj) { const u32x4 w = wv[ai][m][bj];
                        f32x4 x0 = (f32x4){bflo(w.x), bfhi(w.x), bflo(w.y), bfhi(w.y)}, x1 = (f32x4){bflo(w.z), bfhi(w.z), bflo(w.w), bfhi(w.w)};
                        x0 = x0 + gv[bj][0] * acc[ai][bj][m][0]; x1 = x1 + gv[bj][1] * acc[ai][bj][m][1];
                        u32x4 o; o.x = pk2(x0[0], x0[1]); o.y = pk2(x0[2], x0[3]); o.z = pk2(x1[0], x1[1]); o.w = pk2(x1[2], x1[3]);
                        *(GAS u32x4*)(dst + ro + bj * 128) = o; } }
        }
    }
};
struct MoeTab { const LAS int* tcls; const LAS int* trow; const LAS int* ccnt; };
__device__ __forceinline__ void moe_pair(int cls, int& ea, int& eb) { const int g = cls / 6, pr = cls % 6; const int ia = pr < 3 ? 0 : (pr < 5 ? 1 : 2), ib = pr < 3 ? pr + 1 : (pr < 5 ? pr - 1 : 3); ea = 4 * g + ia; eb = 4 * g + ib; }
__device__ __forceinline__ int moe_build_tables(FARGS, int L) {
    LAS int* tcls = (LAS int*)(F.lds + MOE_OFF); LAS int* trow = tcls + 320; LAS int* ccnt = trow + 320; LAS int* pre = ccnt + 32;
    if (F.tid < NCLS) ccnt[F.tid] = (int)__hip_atomic_load(CTL(F) + CW_CNT + (L * NCLS + F.tid) * 64, __ATOMIC_RELAXED, __HIP_MEMORY_SCOPE_AGENT);
    __syncthreads();
    if (F.tid == 0) { int T = 0;
#pragma unroll 1
        for (int c = 0; c < NCLS; ++c) { pre[c] = T; T += (ccnt[c] + 255) >> 8; }
        pre[NCLS] = T; }
    __syncthreads();
    const int T = pre[NCLS];
    if (F.tid < T) { int c = 0;
#pragma unroll 1
        for (int k = 1; k < NCLS; ++k) if (pre[k] <= F.tid) c = k;
        tcls[F.tid] = c; trow[F.tid] = (F.tid - pre[c]) * 256; }
    __syncthreads();
    return __builtin_amdgcn_readfirstlane(T);
}
struct ProbGateUp {
    static constexpr bool GATHER = true;
    const GAS char* A; const GAS char* W1; const GAS int* perm; int K, ldb; size_t hstepA, hstepB; pg8::Order ord; MoeTab tb;
    __device__ __forceinline__ bool next(int i, pg8::Unit& u) const { return ord.next(i, u); }
    template <int NH> __device__ __forceinline__ void a_off(const pg8::Unit& u, int tid, unsigned (&v)[NH][2]) const {
        int R0, C0, R1, C1; pg8::stage_rc(tid * 16, R0, C0); pg8::stage_rc(tid * 16 + 8192, R1, C1);
        const int cls = __builtin_amdgcn_readfirstlane(tb.tcls[u.pm]), tr = __builtin_amdgcn_readfirstlane(tb.trow[u.pm]), n = __builtin_amdgcn_readfirstlane(tb.ccnt[cls]);
        const GAS int* pp = perm + (size_t)cls * MTOT + tr;
#pragma unroll
        for (int h = 0; h < 2; ++h) { const int s0 = h * 128 + R0, s1 = h * 128 + R1;
            const int t0 = (tr + s0 < n) ? pp[s0] : 0, t1 = (tr + s1 < n) ? pp[s1] : 0;
            v[h][0] = (unsigned)(t0 * D + C0) * 2u; v[h][1] = (unsigned)(t1 * D + C1) * 2u; }
    }
    __device__ __forceinline__ const GAS char* b_tile(const pg8::Unit& u, int t) const {
        const int cls = __builtin_amdgcn_readfirstlane(tb.tcls[u.pm]); int ea, eb; moe_pair(cls, ea, eb); const int e = u.pn < 4 ? ea : eb;
        return W1 + (((size_t)e * 1024 + (u.pn & 3) * 256) * D + (size_t)t * 64) * 2;
    }
};
struct EpiGateUp { static constexpr int SID = 3;
    static constexpr bool PERM = true; static constexpr int NSTORES = 16;
    GAS bf16_t* ACT; const GAS int* perm; const GAS float* RW; MoeTab tb;
    __device__ __forceinline__ void operator()(const f32x4 (&acc)[2][2][4][2], const pg8::Unit& u, int wr, int wc, int fr, int fq) const {
        const int cls = __builtin_amdgcn_readfirstlane(tb.tcls[u.pm]), tr = __builtin_amdgcn_readfirstlane(tb.trow[u.pm]), n = __builtin_amdgcn_readfirstlane(tb.ccnt[cls]);
        const GAS int* pp = perm + (size_t)cls * MTOT + tr;
        const int wsel = u.pn >> 2, colb = wsel * 512 + (u.pn & 3) * 128 + wc * 32 + 8 * fq;
        int frx = fr; asm volatile("" : "+v"(frx));
        const int rbase = wr * 64 + frx;
        int tok[8]; float wgt[8];
#pragma unroll
        for (int i = 0; i < 8; ++i) { const int rr = (i >> 2) * 128 + (i & 3) * 16 + rbase; const int rc = rr < n - tr ? rr : n - tr - 1; tok[i] = pp[rc]; }
#pragma unroll
        for (int i = 0; i < 8; ++i) { const float w_ = RW[(size_t)tok[i] * 2 + wsel]; wgt[i] = w_; }
#pragma unroll
        for (int i = 0; i < 8; ++i) { const int rr = (i >> 2) * 128 + (i & 3) * 16 + rbase; if (!(tr + rr < n)) wgt[i] = 0.f; }
#pragma unroll
        for (int ai = 0; ai < 2; ++ai)
#pragma unroll
            for (int m = 0; m < 4; ++m) { const int rr = ai * 128 + m * 16 + rbase; const float wg = wgt[ai * 4 + m];
                float a[8];
#pragma unroll
                for (int nn = 0; nn < 2; ++nn)
#pragma unroll
                    for (int j = 0; j < 4; ++j) { const float g = acc[ai][0][m][nn][j], uu = acc[ai][1][m][nn][j];
                        a[nn * 4 + j] = g * __builtin_amdgcn_rcpf(1.0f + __builtin_amdgcn_exp2f(-g * LOG2E)) * uu * wg; }
                u32x4 w; w.x = pk2(a[0], a[1]); w.y = pk2(a[2], a[3]); w.z = pk2(a[4], a[5]); w.w = pk2(a[6], a[7]);
                *(GAS u32x4*)(ACT + (size_t)(u.pm * 256 + rr) * D + colb) = w; }
    }
};
struct ProbDown {
    static constexpr bool GATHER = false;
    const GAS char* A; const GAS char* W2; int K, ldb; size_t hstepA, hstepB; pg8::Order ord; MoeTab tb;
    __device__ __forceinline__ bool next(int i, pg8::Unit& u) const { return ord.next(i, u); }
    template <int NH> __device__ __forceinline__ void a_off(const pg8::Unit& u, int tid, unsigned (&v)[NH][2]) const {
        int R0, C0, R1, C1; pg8::stage_rc(tid * 16, R0, C0); pg8::stage_rc(tid * 16 + 8192, R1, C1);
        v[0][0] = (unsigned)((u.pm * 256 + R0) * D + C0) * 2u; v[0][1] = (unsigned)((u.pm * 256 + R1) * D + C1) * 2u;
    }
    __device__ __forceinline__ const GAS char* b_tile(const pg8::Unit& u, int t) const {
        const int cls = __builtin_amdgcn_readfirstlane(tb.tcls[u.pm]); int ea, eb; moe_pair(cls, ea, eb); const int e = t < 8 ? ea : eb;
        return W2 + (((size_t)e * 1024 + u.pn * 256) * DEXP + (size_t)(t & 7) * 64) * 2;
    }
};
template <bool LAST> struct EpiDown { static constexpr int SID = 4;
    static constexpr bool PERM = true; static constexpr int NSTORES = 0;
    GAS bf16_t* XB; GAS float* out; const GAS float* gate; const GAS int* perm; MoeTab tb;
    __device__ __forceinline__ void operator()(const f32x4 (&acc)[2][2][4][2], const pg8::Unit& u, int wr, int wc, int fr, int fq) const {
        const int cls = __builtin_amdgcn_readfirstlane(tb.tcls[u.pm]), tr = __builtin_amdgcn_readfirstlane(tb.trow[u.pm]), n = __builtin_amdgcn_readfirstlane(tb.ccnt[cls]);
        const GAS int* pp = perm + (size_t)cls * MTOT + tr;
        const int col0 = u.pn * 256 + wc * 32 + 8 * fq;
        int frx = fr; asm volatile("" : "+v"(frx));
        const int rbase = wr * 64 + frx;
        int tok8[8];
#pragma unroll
        for (int i = 0; i < 8; ++i) { const int rr = (i >> 2) * 128 + (i & 3) * 16 + rbase; const int rc = rr < n - tr ? rr : n - tr - 1; tok8[i] = pp[rc]; }
        u32x4 wv[4][2]; f32x4 gv[2][2][2];
        auto load_res = [&](int i) { const GAS bf16_t* xr = XB + (size_t)tok8[i] * D + col0; wv[i & 3][0] = *(const GAS u32x4*)xr; wv[i & 3][1] = *(const GAS u32x4*)(xr + 128); };
#pragma unroll
        for (int i = 0; i < 4; ++i) load_res(i);
        auto load_gate = [&](int i, f32x4 (&g)[2][2]) { const int tok = tok8[i]; const int b = tok < NLAT ? (tok >> 11) : 32; const GAS float* gp = gate + (size_t)b * ADA + col0;
#pragma unroll
            for (int bj = 0; bj < 2; ++bj) { g[bj][0] = *(const GAS f32x4*)(gp + bj * 128); g[bj][1] = *(const GAS f32x4*)(gp + bj * 128 + 4); } };
        load_gate(0, gv[0]);
#pragma unroll
        for (int i = 0; i < 8; ++i) { const int ai = i >> 2, m = i & 3;
            if (i + 1 < 8) load_gate(i + 1, gv[(i + 1) & 1]);
            __builtin_amdgcn_sched_barrier(0);
            const int rr = ai * 128 + m * 16 + rbase; const bool valid = tr + rr < n; const int tok = tok8[i];
#pragma unroll
            for (int bj = 0; bj < 2; ++bj) { const u32x4 w = wv[i & 3][bj];
                const f32x4 x0 = (f32x4){bflo(w.x), bfhi(w.x), bflo(w.y), bfhi(w.y)} + gv[i & 1][bj][0] * acc[ai][bj][m][0], x1 = (f32x4){bflo(w.z), bfhi(w.z), bflo(w.w), bfhi(w.w)} + gv[i & 1][bj][1] * acc[ai][bj][m][1];
                if (valid) {
                    if (LAST) { GAS float* op = out + (size_t)tok * D + col0 + bj * 128; *(GAS f32x4*)op = x0; *(GAS f32x4*)(op + 4) = x1; }
                    else { u32x4 o; o.x = pk2(x0[0], x0[1]); o.y = pk2(x0[2], x0[3]); o.z = pk2(x1[0], x1[1]); o.w = pk2(x1[2], x1[3]); *(GAS u32x4*)(XB + (size_t)tok * D + col0 + bj * 128) = o; } } }
            __builtin_amdgcn_sched_barrier(0);
            if (i + 4 < 8) load_res(i + 4);
        }
    }
};

constexpr int NPHASE = 1 + 8 * DEPTH;
__global__ void __launch_bounds__(NWAVES * 64, 2) mk_fwd(Args args) {
    extern __shared__ __attribute__((aligned(16))) unsigned char lds_raw[];
    Frame F;
    F.lds = (LAS unsigned char*)lds_raw;
    volatile LAS unsigned* MISC = (volatile LAS unsigned*)(F.lds + MISC_OFF);
    F.tid = threadIdx.x; F.lane = F.tid & 63; F.wave = __builtin_amdgcn_readfirstlane(F.tid >> 6); F.G = gridDim.x; F.bx = blockIdx.x;
    const bool t0 = F.tid == 0;
    F.ws = (GAS unsigned char*)args.ws; F.out = (GAS float*)args.out; F.ka = (kptr_t)__builtin_amdgcn_kernarg_segment_ptr();
    for (int u = F.tid; u < (LDS_BYTES - MISC_OFF) / 4; u += NWAVES * 64) ((LAS unsigned*)(F.lds + MISC_OFF))[u] = 0u;
    __syncthreads();
    XcdBarrier bar; bar.bar = (unsigned*)(CTL(F) + CW_BAR); bar.x = 0; bar.st = nullptr;
    if (args.use_bar) bar = xcd_barrier_post((unsigned*)(CTL(F) + CW_BAR), MISC + 8, t0);
    const int lo = args.ph_lo, hi = args.ph_hi;
#define IN(k) (lo <= (k) && (k) < hi)
#ifndef MK_BAR_REP
#define MK_BAR_REP 1
#endif
#ifdef MK_GSTAMP
#define GS_FLUSH() do { if (F.tid == MK_GSTAMP_TID) { LAS unsigned* m_ = (LAS unsigned*)(F.lds + MISC_OFF); const unsigned a_ = m_[16], n_ = m_[17]; unsigned z_ = 0; asm volatile("" : "+v"(z_)); m_[16] = z_; m_[17] = z_; \
    if (n_) { __hip_atomic_fetch_add(CTL(F) + 2048, a_, __ATOMIC_RELAXED, __HIP_MEMORY_SCOPE_AGENT); __hip_atomic_fetch_add(CTL(F) + 2049, n_, __ATOMIC_RELAXED, __HIP_MEMORY_SCOPE_AGENT); } } } while (0)
#else
#define GS_FLUSH() do {} while (0)
#endif
#define SEAM(k) do { GS_FLUSH(); if (IN(k) && IN((k) + 1)) { for (int br_ = 0; br_ < MK_BAR_REP; ++br_) { refresh(F); xcd_barrier(bar, F.tid == 0); } } } while (0)
#ifndef MK_PHMASK
#define MK_PHMASK 0x1ff
#endif
#define EN(k) ((MK_PHMASK >> (k)) & 1)
#ifndef MK_SEPARATE_QKPREP
#define MK_SEPARATE_QKPREP 0
#endif
#ifndef MK_DOUBLE
#define MK_DOUBLE -1
#endif
#define REP(k) for (int rep_ = 0; rep_ < ((MK_DOUBLE == (k)) ? 2 : 1); ++rep_)
#define XB_P ((GAS bf16_t*)(F.ws + WS_XB))
#define MOD_P ((const GAS float*)(F.ws + WS_MOD))
    if (EN(0) && IN(0)) { REP(0) prologue_phase(F); SEAM(0); }
    for (int L0 = 0; L0 < DEPTH; ++L0) {
        const int pb = 1 + 8 * L0;
        if (EN(1) && IN(pb + 0)) { int L = L0; OPAQUE_S(L); refresh(F);
            REP(1) norm_phase<false>(F, L, MTOT, L == 0, INP(6) + L * D, 0, 1024); SEAM(pb + 0); }
        if (EN(2) && IN(pb + 1)) { int L = L0; OPAQUE_S(L); refresh(F);
            ProbPlain P; P.A = (const GAS char*)(F.ws + WS_H); P.Bt = (const GAS char*)(F.ws + WS_WIN) + (size_t)L * DIN * D * 2; P.K = D; P.lda = D; P.ldb = D; P.hstepA = (size_t)128 * D * 2; P.hstepB = (size_t)128 * D * 2; P.ord.init(MTOT / 256, DIN / 256, F.G, F.bx);
            EpiQK E; E.U = (GAS bf16_t*)(F.ws + WS_U); E.tab = (const GAS float*)(F.ws + WS_TAB); E.gwin = INP(9) + L * 128; E.gna = INP(10) + L * 128; E.gdiff = INP(11) + L * 64; E.ggqa = INP(12) + L * 128;
            E.X = (LAS float*)(F.lds + MOE_OFF);
            E.vscale = 1.0f;
            REP(2) pg8::gemm_phase<EpiQK, ProbPlain>(F.lds, P, E, F.tid);
            SEAM(pb + 1);
        }
        if (MK_SEPARATE_QKPREP && EN(3) && IN(pb + 2)) { REP(3) qkprep_phase(F, L0, (MK_DOUBLE != 3) || rep_ == 1 || args.pad != 0); SEAM(pb + 2); }
        if (EN(4) && IN(pb + 3)) { REP(4) attn_phase(F, L0, L0 < DEPTH - 1); SEAM(pb + 3); }
        if (EN(5) && IN(pb + 4)) { int L = L0; OPAQUE_S(L); refresh(F);
            const int M2 = L < DEPTH - 1 ? MTOT : NLAT;
            ProbPlain P; P.A = (const GAS char*)(F.ws + WS_Y); P.Bt = (const GAS char*)(F.ws + WS_WOUT) + (size_t)L * D * D * 2; P.K = D; P.lda = D; P.ldb = D; P.hstepA = (size_t)128 * D * 2; P.hstepB = (size_t)128 * D * 2; P.ord.init(M2 / 256, D / 256, F.G, F.bx);
            EpiResid E; E.slat = INP(0); E.sctx = INP(2); E.XB = XB_P; E.first = L == 0; E.gate = MOD_P + (size_t)L * 33 * ADA + 2 * 1024;
#ifdef MK_PROBE_K2
            P.K = 2 * D; E.ascale = 0.5f;
#else
            E.ascale = 1.0f;
#endif
            pg8::gemm_phase<EpiResid, ProbPlain>(F.lds, P, E, F.tid);
            SEAM(pb + 4);
        }
        if (EN(6) && IN(pb + 5)) { int L = L0; OPAQUE_S(L); refresh(F);
#ifdef MK_OLD_NORM2
            REP(6) norm_phase<true>(F, L, L < DEPTH - 1 ? MTOT : NLAT, false, INP(7) + L * D, 3 * 1024, 4 * 1024, (MK_DOUBLE != 6) || rep_ == 1 || args.pad != 0); SEAM(pb + 5); }
#else
            norm2_phase(F, L, L < DEPTH - 1 ? MTOT : NLAT); SEAM(pb + 5); }
#endif
        if (EN(7) && IN(pb + 6)) { int L = L0; OPAQUE_S(L); refresh(F);
            const int T = moe_build_tables(F, L);
            MoeTab tb; tb.tcls = (const LAS int*)(F.lds + MOE_OFF); tb.trow = tb.tcls + 320; tb.ccnt = tb.trow + 320;
            ProbGateUp P; P.A = (const GAS char*)(F.ws + WS_H); P.W1 = (const GAS char*)(F.ws + WS_W1) + (size_t)L * NEXP * 1024 * D * 2; P.perm = (const GAS int*)(F.ws + WS_PERM); P.K = D; P.ldb = D; P.hstepA = 0; P.hstepB = (size_t)128 * D * 2; P.ord.init(T, 8, F.G, F.bx); P.tb = tb;
            EpiGateUp E; E.ACT = (GAS bf16_t*)(F.ws + WS_ACT); E.perm = P.perm; E.RW = (const GAS float*)(F.ws + WS_RW); E.tb = tb;
            REP(7) pg8::gemm_phase<EpiGateUp, ProbGateUp>(F.lds, P, E, F.tid);
            SEAM(pb + 6);
        }
        if (EN(8) && IN(pb + 7)) { int L = L0; OPAQUE_S(L); refresh(F);
            const int T = moe_build_tables(F, L);
            MoeTab tb; tb.tcls = (const LAS int*)(F.lds + MOE_OFF); tb.trow = tb.tcls + 320; tb.ccnt = tb.trow + 320;
            ProbDown P; P.A = (const GAS char*)(F.ws + WS_ACT); P.W2 = (const GAS char*)(F.ws + WS_W2) + (size_t)L * NEXP * 1024 * DEXP * 2; P.K = D; P.ldb = DEXP; P.hstepA = (size_t)128 * D * 2; P.hstepB = (size_t)128 * DEXP * 2; P.ord.init(T, 4, F.G, F.bx); P.tb = tb;
            if (L < DEPTH - 1) { EpiDown<false> E; E.XB = XB_P; E.out = F.out; E.gate = MOD_P + (size_t)L * 33 * ADA + 5 * 1024; E.perm = (const GAS int*)(F.ws + WS_PERM); E.tb = tb;
                pg8::gemm_phase<EpiDown<false>, ProbDown>(F.lds, P, E, F.tid); }
            else { EpiDown<true> E; E.XB = XB_P; E.out = F.out; E.gate = MOD_P + (size_t)L * 33 * ADA + 5 * 1024; E.perm = (const GAS int*)(F.ws + WS_PERM); E.tb = tb;
                pg8::gemm_phase<EpiDown<true>, ProbDown>(F.lds, P, E, F.tid); }
            SEAM(pb + 7);
        }
    }
#if defined(MK_STAMP) || defined(MK_GSTAMP)
    {
        refresh(F); xcd_barrier(bar, F.tid == 0); refresh(F);
        const unsigned num = __hip_atomic_load(CTL(F) + 2048, __ATOMIC_RELAXED, __HIP_MEMORY_SCOPE_AGENT), den = __hip_atomic_load(CTL(F) + 2049, __ATOMIC_RELAXED, __HIP_MEMORY_SCOPE_AGENT);
        const float smul = 1.0f + floorf(((float)num / (float)(den ? den : 1u)) * (1.0f / MK_STAMP_Q)) * 0.02f;
        GAS f32x4* o4 = (GAS f32x4*)F.out;
        for (size_t i = (size_t)F.bx * 512 + F.tid; i < (size_t)NLAT * D / 4; i += (size_t)F.G * 512) o4[i] = o4[i] * smul;
    }
#endif
#undef IN
#undef SEAM
}

#ifndef MK_PER_PHASE
#define MK_PER_PHASE 0
#endif
extern "C" void kernel_launch(void* const* d_in, const int* in_sizes, int n_in, void* d_out, int out_size, void* d_ws, size_t ws_size, hipStream_t stream) {
    static int grid = 0;
    if (grid == 0) {
        if (n_in != 23 || out_size != NLAT * D || ws_size < WS_END) { fprintf(stderr, "kernel_launch: unexpected shapes (n_in %d out %d ws %zu)\n", n_in, out_size, ws_size); grid = -1; return; }
        int dev = 0, cus = 0, per_cu = 0;
        if (hipGetDevice(&dev) != hipSuccess || hipDeviceGetAttribute(&cus, hipDeviceAttributeMultiprocessorCount, dev) != hipSuccess) { grid = -1; return; }
        if (hipFuncSetAttribute((const void*)mk_fwd, hipFuncAttributeMaxDynamicSharedMemorySize, LDS_BYTES) != hipSuccess) { fprintf(stderr, "kernel_launch: hipFuncSetAttribute failed\n"); grid = -1; return; }
        if (hipOccupancyMaxActiveBlocksPerMultiprocessor(&per_cu, (const void*)mk_fwd, NWAVES * 64, LDS_BYTES) != hipSuccess || per_cu < 1) fprintf(stderr, "kernel_launch: occupancy query reports %d\n", per_cu);
        (void)hipGetLastError();
        grid = cus;
    }
    if (grid < 0) return;
    (void)hipMemsetAsync((char*)d_ws + WS_CTL, 0, CTL_ZERO_BYTES, stream);
    Args a{};
    for (int i = 0; i < 23; ++i) a.in[i] = (const float*)d_in[i];
    a.out = (float*)d_out; a.ws = (unsigned char*)d_ws; a.pad = 0;
#if MK_PER_PHASE
    for (int p = 0; p < NPHASE; ++p) { a.ph_lo = p; a.ph_hi = p + 1; a.use_bar = 0; hipLaunchKernelGGL(mk_fwd, dim3(grid), dim3(NWAVES * 64), LDS_BYTES, stream, a); }
#else
    a.ph_lo = 0; a.ph_hi = NPHASE; a.use_bar = 1;
    hipLaunchKernelGGL(mk_fwd, dim3(grid), dim3(NWAVES * 64), LDS_BYTES, stream, a);
#endif
}
```
